# Optimizing an MI355X kernel written in HIP

```python
import math
import jax
import jax.numpy as jnp
from jax import lax
import numpy as np

D_MODEL = 1024
BATCH = 4
SEQ = 4096
DEPTH = 2
DEC_BATCH = 32
DEC_SEQ = 8
PAST_LEN = 8192
PAGE_SIZE = 128

HEAD_DIM = 64
GLA_WIDTH = D_MODEL // 4
NSA_WIDTH = D_MODEL // 2
ML_WIDTH = D_MODEL - GLA_WIDTH - NSA_WIDTH
D_MIX = GLA_WIDTH + NSA_WIDTH + ML_WIDTH

GLA_HEADS = GLA_WIDTH // HEAD_DIM
GLA_DK = HEAD_DIM // 2
GLA_DV = HEAD_DIM
GLA_RANK = 16
GLA_TAU = 16.0
GLA_CHUNK = 64

NSA_HEADS = NSA_WIDTH // HEAD_DIM
NSA_KV_HEADS = 2
NSA_HPG = NSA_HEADS // NSA_KV_HEADS
CMP_BLOCK = 32
CMP_STRIDE = 16
SEL_BLOCK = 64
N_SELECT = 16
WINDOW = 512
Q_BLOCK = 128
N_KV_SLOTS = 4
ROT_DIM = HEAD_DIM // 4
ROPE_THETA = 500000.0
ATTN_SCALE = HEAD_DIM ** -0.5

ML_HEADS = ML_WIDTH // HEAD_DIM
ML_DH = HEAD_DIM
ML_CHUNK = 64
CONV_W = 4

SPLIT_SIZES = (GLA_HEADS * GLA_DK, GLA_HEADS * GLA_DK, GLA_WIDTH, GLA_RANK, GLA_WIDTH,
               NSA_WIDTH, 6 * NSA_KV_HEADS * HEAD_DIM, 3 * NSA_HEADS, NSA_WIDTH,
               2 * ML_WIDTH, ML_WIDTH, 2 * ML_HEADS, ML_WIDTH, ML_WIDTH)
D_IN = sum(SPLIT_SIZES)

kernel_name = 'hybrid_gla_nsa_mlstm_step'


def _rms_norm(x, g, eps=1e-6):
    xf = x.astype(jnp.float32)
    y = xf * lax.rsqrt(jnp.mean(xf * xf, axis=-1, keepdims=True) + eps)
    return (y * g.astype(jnp.float32)).astype(x.dtype)


def _rope(x, pos):
    half = ROT_DIM // 2
    inv = jnp.exp(-math.log(ROPE_THETA) * jnp.arange(half, dtype=jnp.float32) * 2.0 / ROT_DIM)
    ang = pos.astype(jnp.float32)[:, None] * inv[None, :]
    cos = jnp.cos(ang)[:, None, :]
    sin = jnp.sin(ang)[:, None, :]
    xf = x.astype(jnp.float32)
    x1, x2, rest = xf[..., :half], xf[..., half:ROT_DIM], xf[..., ROT_DIM:]
    return jnp.concatenate([x1 * cos - x2 * sin, x2 * cos + x1 * sin, rest], axis=-1).astype(x.dtype)


def _masked_softmax(s, mask):
    s = jnp.where(mask, s, -jnp.inf)
    m = jnp.max(s, axis=-1, keepdims=True)
    m = jnp.where(jnp.isfinite(m), m, 0.0)
    e = jnp.where(mask, jnp.exp(s - m), 0.0)
    return e / jnp.maximum(jnp.sum(e, axis=-1, keepdims=True), 1e-30)


def _to_chunks(x, c):
    b, l = x.shape[:2]
    x = x.reshape((b, l // c, c) + x.shape[2:])
    x = jnp.moveaxis(x, 1, 0)
    return jnp.moveaxis(x, 2, 3)


def _from_chunks(x):
    n, b, h, c, d = x.shape
    return jnp.transpose(x, (1, 0, 3, 2, 4)).reshape(b, n * c, h, d)


def _gla_chunked(q, k, v, log_a, s0):
    l = q.shape[1]
    c = math.gcd(l, GLA_CHUNK)
    qc, kc, vc, gc = (_to_chunks(t.astype(jnp.float32), c) for t in (q, k, v, log_a))
    tri = jnp.tril(jnp.ones((c, c), dtype=bool))

    def step(s, inp):
        qi, ki, vi, gi = inp
        bcum = jnp.cumsum(gi, axis=2)
        diff = bcum[:, :, :, None, :] - bcum[:, :, None, :, :]
        dec = jnp.exp(jnp.where(tri[:, :, None], diff, -jnp.inf))
        a = jnp.einsum('bhid,bhjd,bhijd->bhij', qi, ki, dec)
        o = (jnp.einsum('bhid,bhde->bhie', qi * jnp.exp(bcum), s)
             + jnp.einsum('bhij,bhje->bhie', a, vi))
        blast = bcum[:, :, -1]
        s = (jnp.exp(blast)[..., None] * s
             + jnp.einsum('bhjd,bhje->bhde', ki * jnp.exp(blast[:, :, None] - bcum), vi))
        return s, o

    s, o = lax.scan(step, s0.astype(jnp.float32), (qc, kc, vc, gc))
    return _from_chunks(o), s


def _mlstm_chunked(q, k, v, i_pre, logf, c0, n0, m0):
    l = q.shape[1]
    c = math.gcd(l, ML_CHUNK)
    qc, kc, vc = (_to_chunks(t.astype(jnp.float32), c) for t in (q, k, v))
    ic, fc = (_to_chunks(t.astype(jnp.float32), c) for t in (i_pre, logf))
    tri = jnp.tril(jnp.ones((c, c), dtype=bool))

    def step(carry, inp):
        cs, ns, ms = carry
        qi, ki, vi, ii, fi = inp
        fcum = jnp.cumsum(fi, axis=-1)
        dmat = jnp.where(tri, fcum[..., :, None] - fcum[..., None, :] + ii[..., None, :], -jnp.inf)
        inter = fcum + ms[..., None]
        m = jnp.maximum(inter, jnp.max(dmat, axis=-1))
        w_int = jnp.exp(inter - m)
        sij = jnp.einsum('bhid,bhjd->bhij', qi, ki) * jnp.exp(dmat - m[..., None])
        num = (w_int[..., None] * jnp.einsum('bhed,bhid->bhie', cs, qi)
               + jnp.einsum('bhij,bhje->bhie', sij, vi))
        den = w_int * jnp.einsum('bhd,bhid->bhi', ns, qi) + jnp.sum(sij, axis=-1)
        h = num / jnp.maximum(jnp.abs(den), jnp.exp(-m))[..., None]
        m_last = m[..., -1]
        f_last = fcum[..., -1]
        decay = jnp.exp(f_last + ms - m_last)
        wj = jnp.exp(f_last[..., None] - fcum + ii - m_last[..., None])
        cs = decay[..., None, None] * cs + jnp.einsum('bhj,bhje,bhjd->bhed', wj, vi, ki)
        ns = decay[..., None] * ns + jnp.einsum('bhj,bhjd->bhd', wj, ki)
        return (cs, ns, m_last), h

    init = (c0.astype(jnp.float32), n0.astype(jnp.float32), m0.astype(jnp.float32))
    (cs, ns, ms), h = lax.scan(step, init, (qc, kc, vc, ic, fc))
    return _from_chunks(h), cs, ns, ms


def _cmp_summaries(x, pe, w):
    b, t, g, d = x.shape
    n_half = t // CMP_STRIDE
    halves = x[:, :n_half * CMP_STRIDE].astype(jnp.float32).reshape(b, n_half, CMP_STRIDE, g, d)
    wf = w.astype(jnp.float32)
    first = jnp.einsum('bnsgd,sde->bnge', halves[:, :-1], wf[:CMP_STRIDE])
    second = jnp.einsum('bnsgd,sde->bnge', halves[:, 1:], wf[CMP_STRIDE:])
    bias = jnp.einsum('sd,sde->e', pe.astype(jnp.float32), wf)
    return first + second + bias


def _overlap_matrix(n_cmp, n_sel):
    a = SEL_BLOCK // CMP_STRIDE
    bb = CMP_BLOCK // CMP_STRIDE
    i = jnp.arange(n_cmp)[:, None]
    j = jnp.arange(n_sel)[None, :]
    s = i - a * j + (bb - 1)
    cnt = jnp.minimum(jnp.minimum(s + 1, a + bb - 1 - s), min(a, bb))
    return jnp.maximum(cnt, 0).astype(jnp.float32)


def _nsa_selected(q, k_hist, v_hist, idx, pos):
    b, l = q.shape[:2]
    t_len = k_hist.shape[1]
    n_sel = -(-t_len // SEL_BLOCK)
    n_k = idx.shape[-1]
    pad = n_sel * SEL_BLOCK - t_len

    def blocks(x):
        x = jnp.pad(x.astype(jnp.float32), ((0, 0), (0, pad), (0, 0), (0, 0)))
        return x.reshape(b, n_sel, SEL_BLOCK, NSA_KV_HEADS, HEAD_DIM).transpose(0, 3, 1, 2, 4)

    kb, vb = blocks(k_hist), blocks(v_hist)
    qb = math.gcd(l, Q_BLOCK)
    nq = l // qb
    qx = q.astype(jnp.float32).reshape(b * nq, qb, NSA_KV_HEADS, NSA_HPG, HEAD_DIM)
    ix = idx.reshape(b, NSA_KV_HEADS, nq, qb, n_k).transpose(0, 2, 1, 3, 4).reshape(b * nq, NSA_KV_HEADS, qb, n_k)
    px = jnp.tile(pos.reshape(nq, qb), (b, 1))
    bx = jnp.repeat(jnp.arange(b), nq)
    g_ix = jnp.arange(NSA_KV_HEADS)[:, None, None]
    offs = jnp.arange(SEL_BLOCK)
    n_keys = n_k * SEL_BLOCK

    def attend(args):
        qi, ii, pi, bi = args
        ks = kb[bi][g_ix, ii]
        vs = vb[bi][g_ix, ii]
        kpos = ii[..., None] * SEL_BLOCK + offs
        mask = (kpos <= pi[None, :, None, None]).reshape(NSA_KV_HEADS, 1, qb, n_keys)
        s = jnp.einsum('qghd,gqkjd->ghqkj', qi, ks).reshape(NSA_KV_HEADS, NSA_HPG, qb, n_keys) * ATTN_SCALE
        p = _masked_softmax(s, mask)
        return jnp.einsum('ghqn,gqnd->qghd', p, vs.reshape(NSA_KV_HEADS, qb, n_keys, HEAD_DIM))

    o = lax.map(attend, (qx, ix, px, bx))
    return o.reshape(b, l, NSA_HEADS, HEAD_DIM)


def _nsa_window(q, k_ctx, v_ctx, pos0):
    b, l = q.shape[:2]
    lc = k_ctx.shape[1]
    padw = ((0, 0), (WINDOW, 0), (0, 0), (0, 0))
    kp = jnp.pad(k_ctx.astype(jnp.float32), padw)
    vp = jnp.pad(v_ctx.astype(jnp.float32), padw)
    qb = math.gcd(l, Q_BLOCK)
    nq = l // qb
    span = WINDOW + qb
    qx = jnp.moveaxis(q.astype(jnp.float32).reshape(b, nq, qb, NSA_KV_HEADS, NSA_HPG, HEAD_DIM), 1, 0)
    starts = jnp.arange(nq) * qb
    first_pos = pos0 + l - lc

    def attend(args):
        qi, i0 = args
        kk = lax.dynamic_slice_in_dim(kp, i0 + lc - l, span, axis=1)
        vv = lax.dynamic_slice_in_dim(vp, i0 + lc - l, span, axis=1)
        kpos = pos0 + i0 - WINDOW + jnp.arange(span)
        qpos = pos0 + i0 + jnp.arange(qb)
        mask = ((kpos[None, :] >= first_pos) & (kpos[None, :] <= qpos[:, None])
                & (kpos[None, :] > qpos[:, None] - WINDOW))
        s = jnp.einsum('bqghd,bkgd->bghqk', qi, kk) * ATTN_SCALE
        p = _masked_softmax(s, mask)
        return jnp.einsum('bghqk,bkgd->bqghd', p, vv)

    o = lax.map(attend, (qx, starts))
    return jnp.moveaxis(o, 0, 1).reshape(b, l, NSA_HEADS, HEAD_DIM)


def _nsa_mixer(n_q, n_kv, n_g, past_kv, win_buf, win_keep, pos0, q_g, k_g, cmp_pos, cmp_w):
    b, l, _ = n_q.shape
    pos = pos0 + jnp.arange(l)
    q = _rms_norm(n_q.reshape(b, l, NSA_HEADS, HEAD_DIM), q_g)
    q_rot = _rope(q, pos)
    kv = n_kv.reshape(b, l, 6, NSA_KV_HEADS, HEAD_DIM)
    k_slc = _rope(_rms_norm(kv[:, :, 2], k_g[1]), pos)
    k_win = _rope(_rms_norm(kv[:, :, 4], k_g[2]), pos)
    new_rows = jnp.stack([kv[:, :, 0], kv[:, :, 1], k_slc, kv[:, :, 3]], axis=2)
    new_win = jnp.stack([k_win, kv[:, :, 5]], axis=2)
    hist = jnp.concatenate([past_kv.astype(new_rows.dtype), new_rows], axis=1)
    ctx = jnp.concatenate([win_buf.astype(new_win.dtype), new_win], axis=1)
    t_len = hist.shape[1]

    kc = _rms_norm(_cmp_summaries(hist[:, :, 0], cmp_pos[0], cmp_w[0]), k_g[0])
    vc = _cmp_summaries(hist[:, :, 1], cmp_pos[1], cmp_w[1])
    n_cmp = kc.shape[1]
    qg = q.astype(jnp.float32).reshape(b, l, NSA_KV_HEADS, NSA_HPG, HEAD_DIM)
    s = jnp.einsum('blghd,bngd->bghln', qg, kc) * ATTN_SCALE
    cmp_end = jnp.arange(n_cmp) * CMP_STRIDE + CMP_BLOCK - 1
    p_cmp = _masked_softmax(s, cmp_end[None, :] <= pos[:, None])
    o_cmp = jnp.einsum('bghln,bngd->blghd', p_cmp, vc).reshape(b, l, NSA_HEADS, HEAD_DIM)

    n_sel = -(-t_len // SEL_BLOCK)
    imp = jnp.einsum('bghln,nj->bglj', p_cmp, _overlap_matrix(n_cmp, n_sel))
    blk = jnp.arange(n_sel)[None, :]
    cur = (pos // SEL_BLOCK)[:, None]
    valid = blk * SEL_BLOCK <= pos[:, None]
    forced = (blk == 0) | (blk == cur) | (blk == cur - 1)
    score = jnp.where(forced, jnp.inf, jnp.where(valid, imp, -jnp.inf))
    _, idx = lax.top_k(score, min(N_SELECT, n_sel))
    o_slc = _nsa_selected(q_rot, hist[:, :, 2], hist[:, :, 3], idx, pos)

    o_win = _nsa_window(q_rot, ctx[:, :, 0], ctx[:, :, 1], pos0)

    gate = jax.nn.sigmoid(n_g.astype(jnp.float32)).reshape(b, l, 3, NSA_HEADS, 1)
    o = gate[:, :, 0] * o_cmp + gate[:, :, 1] * o_slc + gate[:, :, 2] * o_win
    return o.reshape(b, l, NSA_WIDTH), new_rows, ctx[:, ctx.shape[1] - win_keep:]


def _hybrid_layer(x, pos0, past_kv, win_buf, win_keep, s_gla, c_ml, n_ml, m_ml, conv_ml,
                  norm_g, w_in, w_out, gla_w_gate, gla_b_gate, gla_norm_g,
                  nsa_q_norm_g, nsa_k_norm_g, nsa_cmp_pos, nsa_cmp_w,
                  ml_conv_w, ml_conv_b, ml_gate_b, ml_norm_g):
    b, l, _ = x.shape
    u = _rms_norm(x, norm_g) @ w_in
    points = np.cumsum(SPLIT_SIZES)[:-1].tolist()
    (g_q, g_k, g_v, g_a, g_z, n_q, n_kv, n_g, n_z,
     m_qk, m_v, m_if, m_o, m_z) = jnp.split(u, points, axis=-1)

    gq = g_q.reshape(b, l, GLA_HEADS, GLA_DK) * GLA_DK ** -0.5
    gk = g_k.reshape(b, l, GLA_HEADS, GLA_DK)
    gv = g_v.reshape(b, l, GLA_HEADS, GLA_DV)
    log_a = jax.nn.log_sigmoid((g_a @ gla_w_gate + gla_b_gate).astype(jnp.float32)).reshape(b, l, GLA_HEADS, GLA_DK) / GLA_TAU
    o_a, s_new = _gla_chunked(gq, gk, gv, log_a, s_gla)
    o_a = _rms_norm(o_a, gla_norm_g).reshape(b, l, GLA_WIDTH) * jax.nn.silu(g_z.astype(jnp.float32))

    o_b, new_rows, new_win = _nsa_mixer(n_q, n_kv, n_g, past_kv, win_buf, win_keep, pos0,
                                        nsa_q_norm_g, nsa_k_norm_g, nsa_cmp_pos, nsa_cmp_w)
    o_b = o_b * jax.nn.silu(n_z.astype(jnp.float32))

    xp = jnp.concatenate([conv_ml.astype(m_qk.dtype), m_qk], axis=1)
    conv = sum(xp[:, w:w + l] * ml_conv_w[w] for w in range(CONV_W)) + ml_conv_b
    qk = jax.nn.silu(conv)
    mq = qk[..., :ML_WIDTH].reshape(b, l, ML_HEADS, ML_DH)
    mk = qk[..., ML_WIDTH:].reshape(b, l, ML_HEADS, ML_DH) * ML_DH ** -0.5
    mv = m_v.reshape(b, l, ML_HEADS, ML_DH)
    gates = m_if.astype(jnp.float32).reshape(b, l, 2, ML_HEADS) + ml_gate_b.astype(jnp.float32)
    h, c_new, n_new, m_new = _mlstm_chunked(mq, mk, mv, gates[:, :, 0], jax.nn.log_sigmoid(gates[:, :, 1]),
                                            c_ml, n_ml, m_ml)
    o_gate = jax.nn.sigmoid(m_o.astype(jnp.float32)).reshape(b, l, ML_HEADS, ML_DH)
    o_c = (_rms_norm(h, ml_norm_g) * o_gate).reshape(b, l, ML_WIDTH) * jax.nn.silu(m_z.astype(jnp.float32))
    conv_new = xp[:, l:]

    mixed = jnp.concatenate([o_a, o_b, o_c], axis=-1).astype(x.dtype)
    y = x + mixed @ w_out
    return y, new_rows, new_win, s_new, c_new, n_new, m_new, conv_new


def setup_inputs(seed: int = 0) -> dict:
    key = jax.random.key(seed)
    ks = jax.random.split(key, 24)
    f32 = jnp.float32
    nrm = jax.random.normal
    n_pages = PAST_LEN // PAGE_SIZE
    n_used = DEC_BATCH * n_pages
    n_pool = n_used + max(1, n_used // 4)
    win_buf = min(WINDOW, PAST_LEN)
    page_table = jax.random.permutation(ks[9], n_pool)[:n_used].reshape(DEC_BATCH, n_pages).astype(jnp.int32)
    f_bias = jnp.stack([jnp.zeros((ML_HEADS,), f32), jnp.linspace(3.0, 6.0, ML_HEADS, dtype=f32)])
    return {
        'x_prompt': nrm(ks[0], (BATCH, SEQ, D_MODEL), f32),
        'x_sample': nrm(ks[1], (DEC_BATCH, DEC_SEQ, D_MODEL), f32),
        'cache_nsa_kv': nrm(ks[2], (DEPTH, n_pool, PAGE_SIZE, N_KV_SLOTS, NSA_KV_HEADS, HEAD_DIM), f32),
        'state_nsa_win': nrm(ks[3], (DEPTH, DEC_BATCH, win_buf, 2, NSA_KV_HEADS, HEAD_DIM), f32),
        'state_gla': 0.3 * nrm(ks[4], (DEPTH, DEC_BATCH, GLA_HEADS, GLA_DK, GLA_DV), f32),
        'state_mlstm_C': 0.3 * nrm(ks[5], (DEPTH, DEC_BATCH, ML_HEADS, ML_DH, ML_DH), f32),
        'state_mlstm_n': 0.3 * nrm(ks[6], (DEPTH, DEC_BATCH, ML_HEADS, ML_DH), f32),
        'state_mlstm_m': nrm(ks[7], (DEPTH, DEC_BATCH, ML_HEADS), f32),
        'state_mlstm_conv': nrm(ks[8], (DEPTH, DEC_BATCH, CONV_W - 1, 2 * ML_WIDTH), f32),
        'page_table': page_table,
        'norm_g': 1.0 + 0.02 * nrm(ks[10], (DEPTH, D_MODEL), f32),
        'w_in': nrm(ks[11], (DEPTH, D_MODEL, D_IN), f32) * D_MODEL ** -0.5,
        'w_out': nrm(ks[12], (DEPTH, D_MIX, D_MODEL), f32) * D_MIX ** -0.5,
        'gla_w_gate': nrm(ks[13], (DEPTH, GLA_RANK, GLA_HEADS * GLA_DK), f32) * GLA_RANK ** -0.5,
        'gla_b_gate': 0.1 * nrm(ks[14], (DEPTH, GLA_HEADS * GLA_DK), f32),
        'gla_norm_g': 1.0 + 0.02 * nrm(ks[15], (DEPTH, GLA_DV), f32),
        'nsa_q_norm_g': 1.0 + 0.02 * nrm(ks[16], (DEPTH, HEAD_DIM), f32),
        'nsa_k_norm_g': 1.0 + 0.02 * nrm(ks[17], (DEPTH, 3, HEAD_DIM), f32),
        'nsa_cmp_pos': 0.1 * nrm(ks[18], (DEPTH, 2, CMP_BLOCK, HEAD_DIM), f32),
        'nsa_cmp_w': nrm(ks[19], (DEPTH, 2, CMP_BLOCK, HEAD_DIM, HEAD_DIM), f32) * (CMP_BLOCK * HEAD_DIM) ** -0.5,
        'ml_conv_w': nrm(ks[20], (DEPTH, CONV_W, 2 * ML_WIDTH), f32) * CONV_W ** -0.5,
        'ml_conv_b': 0.01 * nrm(ks[21], (DEPTH, 2 * ML_WIDTH), f32),
        'ml_gate_b': f_bias[None] + 0.1 * nrm(ks[22], (DEPTH, 2, ML_HEADS), f32),
        'ml_norm_g': 1.0 + 0.02 * nrm(ks[23], (DEPTH, ML_DH), f32),
    }


def reference(x_prompt, x_sample, cache_nsa_kv, state_nsa_win, state_gla, state_mlstm_C, state_mlstm_n,
              state_mlstm_m, state_mlstm_conv, page_table, norm_g, w_in, w_out, gla_w_gate, gla_b_gate,
              gla_norm_g, nsa_q_norm_g, nsa_k_norm_g, nsa_cmp_pos, nsa_cmp_w, ml_conv_w, ml_conv_b,
              ml_gate_b, ml_norm_g):
    f32 = jnp.float32
    bp, sp, _ = x_prompt.shape
    bs, _, _ = x_sample.shape
    n_pages = page_table.shape[1]
    past_len = n_pages * cache_nsa_kv.shape[2]
    dt = x_prompt.dtype
    empty_kv = jnp.zeros((bp, 0, N_KV_SLOTS, NSA_KV_HEADS, HEAD_DIM), dt)
    empty_win = jnp.zeros((bp, 0, 2, NSA_KV_HEADS, HEAD_DIM), dt)
    zero_gla = jnp.zeros((bp, GLA_HEADS, GLA_DK, GLA_DV), f32)
    zero_c = jnp.zeros((bp, ML_HEADS, ML_DH, ML_DH), f32)
    zero_n = jnp.zeros((bp, ML_HEADS, ML_DH), f32)
    zero_m = jnp.zeros((bp, ML_HEADS), f32)
    zero_conv = jnp.zeros((bp, CONV_W - 1, 2 * ML_WIDTH), dt)
    keep_p = min(WINDOW, sp)
    keep_s = state_nsa_win.shape[2]

    y_prompt, y_sample = x_prompt, x_sample
    p_layers, s_layers = [], []
    for layer in range(DEPTH):
        w = (norm_g[layer], w_in[layer], w_out[layer], gla_w_gate[layer], gla_b_gate[layer], gla_norm_g[layer],
             nsa_q_norm_g[layer], nsa_k_norm_g[layer], nsa_cmp_pos[layer], nsa_cmp_w[layer],
             ml_conv_w[layer], ml_conv_b[layer], ml_gate_b[layer], ml_norm_g[layer])
        y_prompt, *p_new = _hybrid_layer(y_prompt, 0, empty_kv, empty_win, keep_p, zero_gla, zero_c, zero_n,
                                         zero_m, zero_conv, *w)
        past = cache_nsa_kv[layer][page_table].reshape(bs, past_len, N_KV_SLOTS, NSA_KV_HEADS, HEAD_DIM)
        y_sample, *s_new = _hybrid_layer(y_sample, past_len, past, state_nsa_win[layer], keep_s,
                                         state_gla[layer], state_mlstm_C[layer], state_mlstm_n[layer],
                                         state_mlstm_m[layer], state_mlstm_conv[layer], *w)
        p_layers.append(p_new)
        s_layers.append(s_new)
    p_kv, p_win, p_gla, p_c, p_n, p_m, p_conv = [jnp.stack(z) for z in zip(*p_layers)]
    s_kv, s_win, s_gla, s_c, s_n, s_m, s_conv = [jnp.stack(z) for z in zip(*s_layers)]
    return (y_prompt, y_sample, p_kv, s_kv, p_win, s_win, p_gla, s_gla, p_c, s_c, p_n, s_n, p_m, s_m, p_conv, s_conv)
```

```cpp
#ifndef CPU_EMU
#include <hip/hip_runtime.h>
#define HD __host__ __device__ __forceinline__
#else
#include <cmath>
#include <cstdio>
#include <cstdlib>
#include <cstring>
#include <cstdint>
#define HD inline
#endif
#include <stdint.h>
#include <math.h>

#ifndef CFG_BATCH
#define CFG_BATCH 4
#define CFG_SEQ 4096
#define CFG_DEC_BATCH 32
#define CFG_PAST_LEN 8192
#endif
constexpr int BATCH = CFG_BATCH, SEQ = CFG_SEQ, DEC_BATCH = CFG_DEC_BATCH, DEC_SEQ = 8, PAST_LEN = CFG_PAST_LEN, DEPTH = 2;
constexpr int D = 1024, D_IN = 3888, PAGE = 128;
constexpr int NP = BATCH * SEQ, NS = DEC_BATCH * DEC_SEQ, NT = NP + NS, NSEQ = BATCH + DEC_BATCH;
constexpr int NPAGES = PAST_LEN / PAGE, NUSED = DEC_BATCH * NPAGES, NPOOL = NUSED + (NUSED / 4 > 1 ? NUSED / 4 : 1);
constexpr int WIN = 512, WKEEP_P = SEQ < WIN ? SEQ : WIN, WKEEP_S = PAST_LEN < WIN ? PAST_LEN : WIN;
constexpr int NCP = SEQ / 16 - 1, NCS = (PAST_LEN + DEC_SEQ) / 16 - 1, NCMAX = NCP > NCS ? NCP : NCS;
constexpr int NSELP = (SEQ + 63) / 64, NSELS = (PAST_LEN + DEC_SEQ + 63) / 64, NSELMAX = NSELP > NSELS ? NSELP : NSELS;
constexpr int C_GQ = 0, C_GK = 128, C_GV = 256, C_GA = 512, C_GZ = 528, C_NQ = 784, C_NKV = 1296, C_NG = 2064, C_NZ = 2088,
              C_MQK = 2600, C_MV = 3112, C_MIF = 3368, C_MO = 3376, C_MZ = 3632;
constexpr size_t O_Y = 0;
constexpr size_t O_PROWS = O_Y + (size_t)NT * D;
constexpr size_t O_SROWS = O_PROWS + (size_t)DEPTH * NP * 512;
constexpr size_t O_PWIN = O_SROWS + (size_t)DEPTH * NS * 512;
constexpr size_t O_SWIN = O_PWIN + (size_t)DEPTH * BATCH * WKEEP_P * 256;
constexpr size_t O_PGLA = O_SWIN + (size_t)DEPTH * DEC_BATCH * WKEEP_S * 256;
constexpr size_t O_SGLA = O_PGLA + (size_t)DEPTH * BATCH * 4 * 32 * 64;
constexpr size_t O_PC = O_SGLA + (size_t)DEPTH * DEC_BATCH * 4 * 32 * 64;
constexpr size_t O_SC = O_PC + (size_t)DEPTH * BATCH * 4 * 64 * 64;
constexpr size_t O_PN = O_SC + (size_t)DEPTH * DEC_BATCH * 4 * 64 * 64;
constexpr size_t O_SN = O_PN + (size_t)DEPTH * BATCH * 4 * 64;
constexpr size_t O_PM = O_SN + (size_t)DEPTH * DEC_BATCH * 4 * 64;
constexpr size_t O_SM = O_PM + (size_t)DEPTH * BATCH * 4;
constexpr size_t O_PCONV = O_SM + (size_t)DEPTH * DEC_BATCH * 4;
constexpr size_t O_SCONV = O_PCONV + (size_t)DEPTH * BATCH * 3 * 512;
constexpr size_t O_END = O_SCONV + (size_t)DEPTH * DEC_BATCH * 3 * 512;
constexpr size_t W_RSTD = 0;
constexpr size_t W_XN = W_RSTD + NT;
constexpr size_t W_U = W_XN + (size_t)NT * D;
constexpr size_t W_QN = W_U + (size_t)NT * D_IN;
constexpr size_t W_QR = W_QN + (size_t)NT * 512;
constexpr size_t W_WINNEW = W_QR + (size_t)NT * 512;
constexpr size_t W_LOGA = W_WINNEW + (size_t)NT * 256;
constexpr size_t W_MQ = W_LOGA + (size_t)NT * 128;
constexpr size_t W_MK = W_MQ + (size_t)NT * 256;
constexpr size_t W_CBIAS = W_MK + (size_t)NT * 256;
constexpr size_t W_KC = W_CBIAS + 128;
constexpr size_t W_VC = W_KC + (size_t)NSEQ * NCMAX * 128;
constexpr size_t W_PCMP = W_VC + (size_t)NSEQ * NCMAX * 128;
constexpr size_t W_OCMP = W_PCMP + (size_t)NT * 8 * NCMAX;
constexpr size_t W_IMP = W_OCMP + (size_t)NT * 512;
constexpr size_t W_SEL = W_IMP + (size_t)NT * 2 * NSELMAX;
constexpr size_t W_PSLC = W_SEL + (size_t)NT * 2 * 16;
constexpr size_t W_OSLC = W_PSLC + (size_t)NT * 8 * 1024;
constexpr size_t W_PWIN = W_OSLC + (size_t)NT * 512;
constexpr size_t W_OWIN = W_PWIN + (size_t)NT * 8 * 512;
constexpr size_t W_OA = W_OWIN + (size_t)NT * 512;
constexpr size_t W_H = W_OA + (size_t)NT * 256;
constexpr size_t W_MIXED = W_H + (size_t)NT * 256;
constexpr size_t W_Y0 = W_MIXED + (size_t)NT * D;
constexpr size_t W_END = W_Y0 + (size_t)NT * D;

struct P {
    const float *x_prompt, *x_sample, *cache, *state_win, *state_gla, *state_C, *state_n, *state_m, *state_conv;
    const int* page_table;
    const float *norm_g, *w_in, *w_out, *gla_w_gate, *gla_b_gate, *gla_norm_g, *q_norm_g, *k_norm_g, *cmp_pos, *cmp_w,
        *conv_w, *conv_b, *gate_b, *ml_norm_g;
    float* out;
    float* ws;
};

HD int seq_of_row(int r) { return r < NP ? r / SEQ : BATCH + (r - NP) / DEC_SEQ; }
HD int seq_row0(int s) { return s < BATCH ? s * SEQ : NP + (s - BATCH) * DEC_SEQ; }
HD int seq_len(int s) { return s < BATCH ? SEQ : DEC_SEQ; }
HD int seq_pos0(int s) { return s < BATCH ? 0 : PAST_LEN; }
HD int seq_ncmp(int s) { return s < BATCH ? NCP : NCS; }
HD int seq_nsel(int s) { return s < BATCH ? NSELP : NSELS; }
HD int row_pos(int r) { return r < NP ? r % SEQ : PAST_LEN + (r - NP) % DEC_SEQ; }
HD const float* xrow(const P& p, int L, int r) {
    if (L == 0) return r < NP ? p.x_prompt + (size_t)r * D : p.x_sample + (size_t)(r - NP) * D;
    return p.ws + W_Y0 + (size_t)r * D;
}
HD float* new_rows_ptr(const P& p, int L, int r) {
    return r < NP ? p.out + O_PROWS + ((size_t)L * NP + r) * 512 : p.out + O_SROWS + ((size_t)L * NS + (r - NP)) * 512;
}
HD const float* hist(const P& p, int L, int s, int r, int slot, int g) {
    if (s < BATCH) return p.out + O_PROWS + ((size_t)L * NP + (size_t)s * SEQ + r) * 512 + slot * 128 + g * 64;
    const int b = s - BATCH;
    if (r < PAST_LEN) { const int page = p.page_table[b * NPAGES + r / PAGE];
        return p.cache + (((size_t)L * NPOOL + page) * PAGE + (r % PAGE)) * 512 + slot * 128 + g * 64; }
    return p.out + O_SROWS + ((size_t)L * NS + b * DEC_SEQ + (r - PAST_LEN)) * 512 + slot * 128 + g * 64;
}
HD const float* ctxp(const P& p, int L, int s, int kpos, int kv, int g) {
    if (s < BATCH) return p.ws + W_WINNEW + ((size_t)s * SEQ + kpos) * 256 + kv * 128 + g * 64;
    const int b = s - BATCH;
    if (kpos < PAST_LEN) return p.state_win + (((size_t)L * DEC_BATCH + b) * WKEEP_S + (kpos - (PAST_LEN - WKEEP_S))) * 256 + kv * 128 + g * 64;
    return p.ws + W_WINNEW + ((size_t)NP + b * DEC_SEQ + (kpos - PAST_LEN)) * 256 + kv * 128 + g * 64;
}
HD float log_sigmoidf(float x) { return fminf(x, 0.f) - log1pf(expf(-fabsf(x))); }
HD float sigmoidf_(float x) { return 1.f / (1.f + expf(-x)); }
HD float siluf(float x) { return x / (1.f + expf(-x)); }
HD float rope_inv(int i) { return expf(-logf(500000.0f) * (float)i * 2.0f / 16.0f); }

HD void k_rstd(const P& p, int L, long it) {
    const float* x = xrow(p, L, (int)it); float s = 0.f;
    for (int k = 0; k < D; ++k) s += x[k] * x[k];
    p.ws[W_RSTD + it] = 1.0f / sqrtf(s / D + 1e-6f);
}
HD void k_xn(const P& p, int L, long it) {
    const int r = (int)(it / D), k = (int)(it % D);
    p.ws[W_XN + it] = xrow(p, L, r)[k] * p.ws[W_RSTD + r] * p.norm_g[L * D + k];
}
HD void k_gemm_in(const P& p, int L, long it) {
    const int r = (int)(it / D_IN), c = (int)(it % D_IN);
    const float* a = p.ws + W_XN + (size_t)r * D; const float* w = p.w_in + (size_t)L * D * D_IN + c; float s = 0.f;
    for (int k = 0; k < D; ++k) s += a[k] * w[(size_t)k * D_IN];
    p.ws[W_U + it] = s;
}
HD void k_q(const P& p, int L, long it) {
    const int r = (int)(it / 8), h = (int)(it % 8), pos = row_pos(r);
    const float* u = p.ws + W_U + (size_t)r * D_IN + C_NQ + h * 64; float ss = 0.f;
    for (int d = 0; d < 64; ++d) ss += u[d] * u[d];
    const float rs = 1.0f / sqrtf(ss / 64 + 1e-6f); const float* g = p.q_norm_g + L * 64;
    float* qn = p.ws + W_QN + (size_t)r * 512 + h * 64; float* qr = p.ws + W_QR + (size_t)r * 512 + h * 64;
    for (int d = 0; d < 64; ++d) { const float v = u[d] * rs * g[d]; qn[d] = v; qr[d] = v; }
    for (int i = 0; i < 8; ++i) { const float ang = (float)pos * rope_inv(i), c = cosf(ang), sn = sinf(ang);
        const float x1 = qn[i], x2 = qn[i + 8]; qr[i] = x1 * c - x2 * sn; qr[i + 8] = x2 * c + x1 * sn; }
}
HD void k_kv(const P& p, int L, long it) {
    const int r = (int)(it / 12), s6 = (int)((it % 12) / 2), g = (int)(it % 2), pos = row_pos(r);
    const float* u = p.ws + W_U + (size_t)r * D_IN + C_NKV + s6 * 128 + g * 64;
    float* dst; float* dst2 = nullptr;
    if (s6 < 4) dst = new_rows_ptr(p, L, r) + s6 * 128 + g * 64;
    else {
        const int kv = s6 - 4; dst = p.ws + W_WINNEW + (size_t)r * 256 + kv * 128 + g * 64;
        if (r < NP) { const int b = r / SEQ, t = r % SEQ; if (t >= SEQ - WKEEP_P) dst2 = p.out + O_PWIN + (((size_t)L * BATCH + b) * WKEEP_P + (t - (SEQ - WKEEP_P))) * 256 + kv * 128 + g * 64; }
        else { const int b = (r - NP) / DEC_SEQ, t = (r - NP) % DEC_SEQ; const int i = WKEEP_S - DEC_SEQ + t; if (i >= 0) dst2 = p.out + O_SWIN + (((size_t)L * DEC_BATCH + b) * WKEEP_S + i) * 256 + kv * 128 + g * 64; }
    }
    if (s6 == 2 || s6 == 4) {
        float ss = 0.f; for (int d = 0; d < 64; ++d) ss += u[d] * u[d];
        const float rs = 1.0f / sqrtf(ss / 64 + 1e-6f); const float* gg = p.k_norm_g + (L * 3 + (s6 == 2 ? 1 : 2)) * 64;
        for (int d = 16; d < 64; ++d) { const float v = u[d] * rs * gg[d]; dst[d] = v; if (dst2) dst2[d] = v; }
        for (int i = 0; i < 8; ++i) { const float ang = (float)pos * rope_inv(i), c = cosf(ang), sn = sinf(ang);
            const float x1 = u[i] * rs * gg[i], x2 = u[i + 8] * rs * gg[i + 8]; const float a = x1 * c - x2 * sn, b2 = x2 * c + x1 * sn;
            dst[i] = a; dst[i + 8] = b2; if (dst2) { dst2[i] = a; dst2[i + 8] = b2; } }
    } else {
        for (int d = 0; d < 64; ++d) { dst[d] = u[d]; if (dst2) dst2[d] = u[d]; }
    }
}
HD void k_win_copy(const P& p, int L, long it) {
    constexpr int NOLD = WKEEP_S - DEC_SEQ > 0 ? WKEEP_S - DEC_SEQ : 0;
    const int e = (int)(it % 256); const long q = it / 256; const int i = (int)(q % NOLD), b = (int)(q / NOLD);
    p.out[O_SWIN + (((size_t)L * DEC_BATCH + b) * WKEEP_S + i) * 256 + e] = p.state_win[(((size_t)L * DEC_BATCH + b) * WKEEP_S + i + DEC_SEQ) * 256 + e];
}
HD void k_gla_gate(const P& p, int L, long it) {
    const int r = (int)(it / 128), j = (int)(it % 128);
    const float* u = p.ws + W_U + (size_t)r * D_IN + C_GA; float s = p.gla_b_gate[L * 128 + j];
    for (int q = 0; q < 16; ++q) s += u[q] * p.gla_w_gate[(L * 16 + q) * 128 + j];
    p.ws[W_LOGA + it] = log_sigmoidf(s) * (1.0f / 16.0f);
}
HD float conv_xp(const P& p, int L, int s, int tp, int ch) {
    if (tp < 3) return s < BATCH ? 0.f : p.state_conv[(((size_t)L * DEC_BATCH + (s - BATCH)) * 3 + tp) * 512 + ch];
    return p.ws[W_U + (size_t)(seq_row0(s) + tp - 3) * D_IN + C_MQK + ch];
}
HD void k_conv(const P& p, int L, long it) {
    const int r = (int)(it / 512), ch = (int)(it % 512), s = seq_of_row(r), t = r - seq_row0(s);
    float a = p.conv_b[L * 512 + ch];
    for (int w = 0; w < 4; ++w) a += conv_xp(p, L, s, t + w, ch) * p.conv_w[(L * 4 + w) * 512 + ch];
    const float v = siluf(a);
    if (ch < 256) p.ws[W_MQ + (size_t)r * 256 + ch] = v; else p.ws[W_MK + (size_t)r * 256 + ch - 256] = v * 0.125f;
}
HD void k_conv_out(const P& p, int L, long it) {
    const int ch = (int)(it % 512), i = (int)((it / 512) % 3), s = (int)(it / 1536);
    const float v = conv_xp(p, L, s, seq_len(s) + i, ch);
    if (s < BATCH) p.out[O_PCONV + (((size_t)L * BATCH + s) * 3 + i) * 512 + ch] = v;
    else p.out[O_SCONV + (((size_t)L * DEC_BATCH + (s - BATCH)) * 3 + i) * 512 + ch] = v;
}
HD void k_cmp_bias(const P& p, int L, long it) {
    const int kv = (int)(it / 64), e = (int)(it % 64); float s = 0.f;
    for (int q = 0; q < 32 * 64; ++q) s += p.cmp_pos[((size_t)(L * 2 + kv)) * 2048 + q] * p.cmp_w[(((size_t)(L * 2 + kv)) * 2048 + q) * 64 + e];
    p.ws[W_CBIAS + it] = s;
}
HD void k_cmp_sum(const P& p, int L, long it) {
    const int e = (int)(it % 64), g = (int)((it / 64) % 2), kv = (int)((it / 128) % 2); const long q = it / 256; const int j = (int)(q % NCMAX), s = (int)(q / NCMAX);
    if (j >= seq_ncmp(s)) return;
    float a = p.ws[W_CBIAS + kv * 64 + e];
    const float* w = p.cmp_w + ((size_t)(L * 2 + kv)) * 2048 * 64 + e;
    for (int t = 0; t < 32; ++t) { const float* x = hist(p, L, s, 16 * j + t, kv, g);
        for (int d = 0; d < 64; ++d) a += x[d] * w[(size_t)(t * 64 + d) * 64]; }
    p.ws[(kv ? W_VC : W_KC) + ((size_t)s * NCMAX + j) * 128 + g * 64 + e] = a;
}
HD void k_kc_norm(const P& p, int L, long it) {
    const int g = (int)(it % 2); const long q = it / 2; const int j = (int)(q % NCMAX), s = (int)(q / NCMAX);
    if (j >= seq_ncmp(s)) return;
    float* k = p.ws + W_KC + ((size_t)s * NCMAX + j) * 128 + g * 64; float ss = 0.f;
    for (int d = 0; d < 64; ++d) ss += k[d] * k[d];
    const float rs = 1.0f / sqrtf(ss / 64 + 1e-6f);
    for (int d = 0; d < 64; ++d) k[d] = k[d] * rs * p.k_norm_g[(L * 3 + 0) * 64 + d];
}
HD void k_cmp_score(const P& p, int L, long it) {
    const int n = (int)(it % NCMAX); const long q = it / NCMAX; const int h = (int)(q % 8), r = (int)(q / 8), s = seq_of_row(r), pos = row_pos(r);
    if (n >= seq_ncmp(s)) return;
    float v = -INFINITY;
    if (16 * n + 31 <= pos) { const float* qq = p.ws + W_QN + (size_t)r * 512 + h * 64; const float* k = p.ws + W_KC + ((size_t)s * NCMAX + n) * 128 + (h / 4) * 64;
        float a = 0.f; for (int d = 0; d < 64; ++d) a += qq[d] * k[d]; v = a * 0.125f; }
    p.ws[W_PCMP + it] = v;
}
HD void softmax_row(float* x, int n) {
    float m = -INFINITY; for (int i = 0; i < n; ++i) m = fmaxf(m, x[i]);
    if (m == -INFINITY) m = 0.f;
    float sum = 0.f; for (int i = 0; i < n; ++i) { const float e = (x[i] == -INFINITY) ? 0.f : expf(x[i] - m); x[i] = e; sum += e; }
    const float inv = 1.0f / fmaxf(sum, 1e-30f);
    for (int i = 0; i < n; ++i) x[i] *= inv;
}
HD void k_cmp_softmax(const P& p, int L, long it) { const int r = (int)(it / 8); softmax_row(p.ws + W_PCMP + it * NCMAX, seq_ncmp(seq_of_row(r))); }
HD void k_cmp_out(const P& p, int L, long it) {
    const int d = (int)(it % 64), h = (int)((it / 64) % 8), r = (int)(it / 512), s = seq_of_row(r), nc = seq_ncmp(s);
    const float* pr = p.ws + W_PCMP + ((size_t)r * 8 + h) * NCMAX; const float* v = p.ws + W_VC + (size_t)s * NCMAX * 128 + (h / 4) * 64 + d; float a = 0.f;
    for (int n = 0; n < nc; ++n) a += pr[n] * v[(size_t)n * 128];
    p.ws[W_OCMP + it] = a;
}
HD void k_imp(const P& p, int L, long it) {
    const int j = (int)(it % NSELMAX), g = (int)((it / NSELMAX) % 2), r = (int)(it / (2 * NSELMAX)), s = seq_of_row(r), nc = seq_ncmp(s);
    if (j >= seq_nsel(s)) return;
    float a = 0.f;
    for (int h = 0; h < 4; ++h) { const float* pr = p.ws + W_PCMP + ((size_t)r * 8 + g * 4 + h) * NCMAX;
        for (int q = 0; q < 5; ++q) { const int i = 4 * j - 1 + q; if (i >= 0 && i < nc) a += pr[i] * ((q == 0 || q == 4) ? 1.f : 2.f); } }
    p.ws[W_IMP + it] = a;
}
HD void k_topk(const P& p, int L, long it) {
    const int g = (int)(it % 2), r = (int)(it / 2), s = seq_of_row(r), pos = row_pos(r), ns = seq_nsel(s), cur = pos / 64;
    const float* imp = p.ws + W_IMP + ((size_t)r * 2 + g) * NSELMAX; int* sel = (int*)(p.ws + W_SEL) + ((size_t)r * 2 + g) * 16;
    unsigned long long c0 = 0, c1 = 0, c2 = 0, c3 = 0;
    const int nk = ns < 16 ? ns : 16;
    for (int k = 0; k < 16; ++k) {
        int bj = -1; float bs = 0.f;
        if (k < nk) for (int j = 0; j < ns; ++j) {
            const unsigned long long bit = 1ull << (j & 63); const unsigned long long cw = (j < 64) ? c0 : (j < 128) ? c1 : (j < 192) ? c2 : c3;
            if (cw & bit) continue;
            const bool forced = (j == 0) || (j == cur) || (j == cur - 1), valid = j * 64 <= pos;
            const float sc = forced ? INFINITY : (valid ? imp[j] : -INFINITY);
            if (bj < 0 || sc > bs) { bj = j; bs = sc; }
        }
        sel[k] = bj;
        if (bj >= 0) { const unsigned long long bit = 1ull << (bj & 63); if (bj < 64) c0 |= bit; else if (bj < 128) c1 |= bit; else if (bj < 192) c2 |= bit; else c3 |= bit; }
    }
}
HD void k_slc_score(const P& p, int L, long it) {
    const int ks = (int)(it % 1024), h = (int)((it / 1024) % 8), r = (int)(it / 8192), s = seq_of_row(r), pos = row_pos(r), g = h / 4;
    const int blk = ((const int*)(p.ws + W_SEL))[((size_t)r * 2 + g) * 16 + ks / 64];
    float v = -INFINITY;
    if (blk >= 0) { const int kpos = blk * 64 + (ks % 64);
        if (kpos <= pos) { const float* qq = p.ws + W_QR + (size_t)r * 512 + h * 64; const float* k = hist(p, L, s, kpos, 2, g);
            float a = 0.f; for (int d = 0; d < 64; ++d) a += qq[d] * k[d]; v = a * 0.125f; } }
    p.ws[W_PSLC + it] = v;
}
HD void k_slc_softmax(const P& p, int L, long it) { softmax_row(p.ws + W_PSLC + it * 1024, 1024); }
HD void k_slc_out(const P& p, int L, long it) {
    const int d = (int)(it % 64), h = (int)((it / 64) % 8), r = (int)(it / 512), s = seq_of_row(r), g = h / 4;
    const float* pr = p.ws + W_PSLC + ((size_t)r * 8 + h) * 1024; const int* sel = (const int*)(p.ws + W_SEL) + ((size_t)r * 2 + g) * 16; float a = 0.f;
    for (int ks = 0; ks < 1024; ++ks) { const float pv = pr[ks]; if (pv != 0.f) a += pv * hist(p, L, s, sel[ks / 64] * 64 + (ks % 64), 3, g)[d]; }
    p.ws[W_OSLC + it] = a;
}
HD int seq_first_pos(int s) { return s < BATCH ? 0 : PAST_LEN - WKEEP_S; }
HD void k_win_score(const P& p, int L, long it) {
    const int w = (int)(it % 512), h = (int)((it / 512) % 8), r = (int)(it / 4096), s = seq_of_row(r), pos = row_pos(r), g = h / 4, kpos = pos - w;
    float v = -INFINITY;
    if (kpos >= seq_first_pos(s)) { const float* qq = p.ws + W_QR + (size_t)r * 512 + h * 64; const float* k = ctxp(p, L, s, kpos, 0, g);
        float a = 0.f; for (int d = 0; d < 64; ++d) a += qq[d] * k[d]; v = a * 0.125f; }
    p.ws[W_PWIN + it] = v;
}
HD void k_win_softmax(const P& p, int L, long it) { softmax_row(p.ws + W_PWIN + it * 512, 512); }
HD void k_win_out(const P& p, int L, long it) {
    const int d = (int)(it % 64), h = (int)((it / 64) % 8), r = (int)(it / 512), s = seq_of_row(r), pos = row_pos(r), g = h / 4;
    const float* pr = p.ws + W_PWIN + ((size_t)r * 8 + h) * 512; float a = 0.f;
    for (int w = 0; w < 512; ++w) { const float pv = pr[w]; if (pv != 0.f) a += pv * ctxp(p, L, s, pos - w, 1, g)[d]; }
    p.ws[W_OWIN + it] = a;
}
HD void k_gla(const P& p, int L, long it) {
    const int dv = (int)(it % 64), h = (int)((it / 64) % 4), s = (int)(it / 256), r0 = seq_row0(s), len = seq_len(s);
    float S[32];
#pragma unroll
    for (int k = 0; k < 32; ++k) S[k] = s < BATCH ? 0.f : p.state_gla[((((size_t)L * DEC_BATCH + (s - BATCH)) * 4 + h) * 32 + k) * 64 + dv];
    for (int t = 0; t < len; ++t) {
        const int r = r0 + t; const float* u = p.ws + W_U + (size_t)r * D_IN; const float* la = p.ws + W_LOGA + (size_t)r * 128 + h * 32;
        const float v = u[C_GV + h * 64 + dv]; float o = 0.f;
#pragma unroll
        for (int k = 0; k < 32; ++k) { S[k] = expf(la[k]) * S[k] + u[C_GK + h * 32 + k] * v; o += u[C_GQ + h * 32 + k] * S[k]; }
        p.ws[W_OA + (size_t)r * 256 + h * 64 + dv] = o * 0.17677669529663687f;
    }
    float* so = s < BATCH ? p.out + O_PGLA + (((size_t)L * BATCH + s) * 4 + h) * 2048 : p.out + O_SGLA + (((size_t)L * DEC_BATCH + (s - BATCH)) * 4 + h) * 2048;
#pragma unroll
    for (int k = 0; k < 32; ++k) so[k * 64 + dv] = S[k];
}
HD void k_mlstm(const P& p, int L, long it) {
    const int e = (int)(it % 64), h = (int)((it / 64) % 4), s = (int)(it / 256), r0 = seq_row0(s), len = seq_len(s);
    float C[64], n[64]; float m = s < BATCH ? 0.f : p.state_m[((size_t)L * DEC_BATCH + (s - BATCH)) * 4 + h];
#pragma unroll
    for (int d = 0; d < 64; ++d) { C[d] = s < BATCH ? 0.f : p.state_C[((((size_t)L * DEC_BATCH + (s - BATCH)) * 4 + h) * 64 + e) * 64 + d];
        n[d] = s < BATCH ? 0.f : p.state_n[(((size_t)L * DEC_BATCH + (s - BATCH)) * 4 + h) * 64 + d]; }
    const float bi = p.gate_b[(L * 2 + 0) * 4 + h], bf = p.gate_b[(L * 2 + 1) * 4 + h];
    for (int t = 0; t < len; ++t) {
        const int r = r0 + t; const float* u = p.ws + W_U + (size_t)r * D_IN; const float* q = p.ws + W_MQ + (size_t)r * 256 + h * 64; const float* k = p.ws + W_MK + (size_t)r * 256 + h * 64;
        const float ip = u[C_MIF + h] + bi, lf = log_sigmoidf(u[C_MIF + 4 + h] + bf), mn = fmaxf(lf + m, ip), fp = expf(lf + m - mn), iq = expf(ip - mn), v = u[C_MV + h * 64 + e];
        float num = 0.f, den = 0.f;
#pragma unroll
        for (int d = 0; d < 64; ++d) { C[d] = fp * C[d] + iq * v * k[d]; n[d] = fp * n[d] + iq * k[d]; num += C[d] * q[d]; den += n[d] * q[d]; }
        m = mn;
        p.ws[W_H + (size_t)r * 256 + h * 64 + e] = num / fmaxf(fabsf(den), expf(-m));
    }
    const size_t sb = s < BATCH ? ((size_t)L * BATCH + s) * 4 + h : ((size_t)L * DEC_BATCH + (s - BATCH)) * 4 + h;
    float* co = p.out + (s < BATCH ? O_PC : O_SC) + (sb * 64 + e) * 64;
#pragma unroll
    for (int d = 0; d < 64; ++d) co[d] = C[d];
    float nv = 0.f;
#pragma unroll
    for (int d = 0; d < 64; ++d) if (d == e) nv = n[d];
    p.out[(s < BATCH ? O_PN : O_SN) + sb * 64 + e] = nv;
    if (e == 0) p.out[(s < BATCH ? O_PM : O_SM) + sb] = m;
}
HD void k_mix_gla(const P& p, int L, long it) {
    const int h = (int)(it % 4), r = (int)(it / 4); const float* o = p.ws + W_OA + (size_t)r * 256 + h * 64; float ss = 0.f;
    for (int d = 0; d < 64; ++d) ss += o[d] * o[d];
    const float rs = 1.0f / sqrtf(ss / 64 + 1e-6f); const float* u = p.ws + W_U + (size_t)r * D_IN + C_GZ + h * 64;
    for (int d = 0; d < 64; ++d) p.ws[W_MIXED + (size_t)r * D + h * 64 + d] = o[d] * rs * p.gla_norm_g[L * 64 + d] * siluf(u[d]);
}
HD void k_mix_nsa(const P& p, int L, long it) {
    const int c = (int)(it % 512), r = (int)(it / 512), h = c / 64; const float* u = p.ws + W_U + (size_t)r * D_IN;
    const float g0 = sigmoidf_(u[C_NG + h]), g1 = sigmoidf_(u[C_NG + 8 + h]), g2 = sigmoidf_(u[C_NG + 16 + h]);
    const float o = g0 * p.ws[W_OCMP + it] + g1 * p.ws[W_OSLC + it] + g2 * p.ws[W_OWIN + it];
    p.ws[W_MIXED + (size_t)r * D + 256 + c] = o * siluf(u[C_NZ + c]);
}
HD void k_mix_ml(const P& p, int L, long it) {
    const int h = (int)(it % 4), r = (int)(it / 4); const float* o = p.ws + W_H + (size_t)r * 256 + h * 64; float ss = 0.f;
    for (int d = 0; d < 64; ++d) ss += o[d] * o[d];
    const float rs = 1.0f / sqrtf(ss / 64 + 1e-6f); const float* u = p.ws + W_U + (size_t)r * D_IN;
    for (int d = 0; d < 64; ++d) p.ws[W_MIXED + (size_t)r * D + 768 + h * 64 + d] = o[d] * rs * p.ml_norm_g[L * 64 + d] * sigmoidf_(u[C_MO + h * 64 + d]) * siluf(u[C_MZ + h * 64 + d]);
}
HD void k_gemm_out(const P& p, int L, long it) {
    const int r = (int)(it / D), c = (int)(it % D);
    const float* a = p.ws + W_MIXED + (size_t)r * D; const float* w = p.w_out + (size_t)L * D * D + c; float s = xrow(p, L, r)[c];
    for (int k = 0; k < D; ++k) s += a[k] * w[(size_t)k * D];
    (L == DEPTH - 1 ? p.out + O_Y : p.ws + W_Y0)[it] = s;
}

typedef void (*ItemFn)(const P&, int, long);
#ifndef CPU_EMU
template <ItemFn F> __global__ void __launch_bounds__(256) kw(P p, int L, long n) {
    const long i = (long)blockIdx.x * 256 + threadIdx.x; if (i < n) F(p, L, i);
}
#define RUN(F, n) do { const long _n = (long)(n); if (_n > 0) hipLaunchKernelGGL(kw<F>, dim3((unsigned)((_n + 255) / 256)), dim3(256), 0, stream, p, L, _n); } while (0)
#else
template <ItemFn F> static void run_items(const P& p, int L, long n) {
#pragma omp parallel for schedule(dynamic, 256)
    for (long i = 0; i < n; ++i) F(p, L, i);
}
#define RUN(F, n) run_items<F>(p, L, (long)(n))
#endif

#ifndef CPU_EMU
static void forward(const P& p, hipStream_t stream) {
#else
static void forward(const P& p) {
#endif
    for (int L = 0; L < DEPTH; ++L) {
        RUN(k_rstd, NT);
        RUN(k_xn, (long)NT * D);
        RUN(k_gemm_in, (long)NT * D_IN);
        RUN(k_q, (long)NT * 8);
        RUN(k_kv, (long)NT * 12);
        RUN(k_win_copy, (long)DEC_BATCH * (WKEEP_S - DEC_SEQ > 0 ? WKEEP_S - DEC_SEQ : 0) * 256);
        RUN(k_gla_gate, (long)NT * 128);
        RUN(k_conv, (long)NT * 512);
        RUN(k_conv_out, (long)NSEQ * 3 * 512);
        RUN(k_cmp_bias, 128);
        RUN(k_cmp_sum, (long)NSEQ * NCMAX * 256);
        RUN(k_kc_norm, (long)NSEQ * NCMAX * 2);
        RUN(k_cmp_score, (long)NT * 8 * NCMAX);
        RUN(k_cmp_softmax, (long)NT * 8);
        RUN(k_cmp_out, (long)NT * 512);
        RUN(k_imp, (long)NT * 2 * NSELMAX);
        RUN(k_topk, (long)NT * 2);
        RUN(k_slc_score, (long)NT * 8 * 1024);
        RUN(k_slc_softmax, (long)NT * 8);
        RUN(k_slc_out, (long)NT * 512);
        RUN(k_win_score, (long)NT * 8 * 512);
        RUN(k_win_softmax, (long)NT * 8);
        RUN(k_win_out, (long)NT * 512);
        RUN(k_gla, (long)NSEQ * 256);
        RUN(k_mlstm, (long)NSEQ * 256);
        RUN(k_mix_gla, (long)NT * 4);
        RUN(k_mix_nsa, (long)NT * 512);
        RUN(k_mix_ml, (long)NT * 4);
        RUN(k_gemm_out, (long)NT * D);
    }
}

static P make_params(void* const* d_in, void* d_out, void* d_ws) {
    P p;
    p.x_prompt = (const float*)d_in[0]; p.x_sample = (const float*)d_in[1]; p.cache = (const float*)d_in[2]; p.state_win = (const float*)d_in[3];
    p.state_gla = (const float*)d_in[4]; p.state_C = (const float*)d_in[5]; p.state_n = (const float*)d_in[6]; p.state_m = (const float*)d_in[7];
    p.state_conv = (const float*)d_in[8]; p.page_table = (const int*)d_in[9]; p.norm_g = (const float*)d_in[10]; p.w_in = (const float*)d_in[11];
    p.w_out = (const float*)d_in[12]; p.gla_w_gate = (const float*)d_in[13]; p.gla_b_gate = (const float*)d_in[14]; p.gla_norm_g = (const float*)d_in[15];
    p.q_norm_g = (const float*)d_in[16]; p.k_norm_g = (const float*)d_in[17]; p.cmp_pos = (const float*)d_in[18]; p.cmp_w = (const float*)d_in[19];
    p.conv_w = (const float*)d_in[20]; p.conv_b = (const float*)d_in[21]; p.gate_b = (const float*)d_in[22]; p.ml_norm_g = (const float*)d_in[23];
    p.out = (float*)d_out; p.ws = (float*)d_ws;
    return p;
}

#ifndef CPU_EMU
extern "C" void kernel_launch(void* const* d_in, const int* in_sizes, int n_in, void* d_out, int out_size, void* d_ws, size_t ws_size, hipStream_t stream) {
    P p = make_params(d_in, d_out, d_ws);
    forward(p, stream);
}
#endif
```

```cpp
#ifndef CPU_EMU
#include <hip/hip_runtime.h>
#define HD __host__ __device__ __forceinline__
#else
#include "emu.h"
#define HD inline
#endif
#include <stdint.h>
#include <math.h>

#ifndef CFG_BATCH
#define CFG_BATCH 4
#define CFG_SEQ 4096
#define CFG_DEC_BATCH 32
#define CFG_PAST_LEN 8192
#endif
constexpr int BATCH = CFG_BATCH, SEQ = CFG_SEQ, DEC_BATCH = CFG_DEC_BATCH, DEC_SEQ = 8, PAST_LEN = CFG_PAST_LEN, DEPTH = 2;
constexpr int D = 1024, D_IN = 3888, PAGE = 128;
constexpr int NP = BATCH * SEQ, NS = DEC_BATCH * DEC_SEQ, NT = NP + NS, NSEQ = BATCH + DEC_BATCH;
constexpr int NPAGES = PAST_LEN / PAGE, NUSED = DEC_BATCH * NPAGES, NPOOL = NUSED + (NUSED / 4 > 1 ? NUSED / 4 : 1);
constexpr int WIN = 512, WKEEP_P = SEQ < WIN ? SEQ : WIN, WKEEP_S = PAST_LEN < WIN ? PAST_LEN : WIN;
constexpr int NCP = SEQ / 16 - 1, NCS = (PAST_LEN + DEC_SEQ) / 16 - 1, NCMAX = NCP > NCS ? NCP : NCS;
constexpr int NSELP = (SEQ + 63) / 64, NSELS = (PAST_LEN + DEC_SEQ + 63) / 64, NSELMAX = NSELP > NSELS ? NSELP : NSELS;
constexpr int C_GQ = 0, C_GK = 128, C_GV = 256, C_GZ = 512, C_NQ = 768, C_NKV = 1280, C_NZ = 2048, C_MQK = 2560, C_MV = 3072, C_MO = 3328, C_MZ = 3584,
              C_GA = 3840, C_NG = 3856, C_MIF = 3880;
HD int orig_col(int n) { return n < 512 ? n : n < 768 ? 528 + (n - 512) : n < 1280 ? 784 + (n - 768) : n < 2048 ? 1296 + (n - 1280) : n < 2560 ? 2088 + (n - 2048) : n < 3072 ? 2600 + (n - 2560)
    : n < 3328 ? 3112 + (n - 3072) : n < 3584 ? 3376 + (n - 3328) : n < 3840 ? 3632 + (n - 3584) : n < 3856 ? 512 + (n - 3840) : n < 3880 ? 2064 + (n - 3856) : 3368 + (n - 3880); }
constexpr size_t O_Y = 0;
constexpr size_t O_PROWS = O_Y + (size_t)NT * D;
constexpr size_t O_SROWS = O_PROWS + (size_t)DEPTH * NP * 512;
constexpr size_t O_PWIN = O_SROWS + (size_t)DEPTH * NS * 512;
constexpr size_t O_SWIN = O_PWIN + (size_t)DEPTH * BATCH * WKEEP_P * 256;
constexpr size_t O_PGLA = O_SWIN + (size_t)DEPTH * DEC_BATCH * WKEEP_S * 256;
constexpr size_t O_SGLA = O_PGLA + (size_t)DEPTH * BATCH * 4 * 32 * 64;
constexpr size_t O_PC = O_SGLA + (size_t)DEPTH * DEC_BATCH * 4 * 32 * 64;
constexpr size_t O_SC = O_PC + (size_t)DEPTH * BATCH * 4 * 64 * 64;
constexpr size_t O_PN = O_SC + (size_t)DEPTH * DEC_BATCH * 4 * 64 * 64;
constexpr size_t O_SN = O_PN + (size_t)DEPTH * BATCH * 4 * 64;
constexpr size_t O_PM = O_SN + (size_t)DEPTH * DEC_BATCH * 4 * 64;
constexpr size_t O_SM = O_PM + (size_t)DEPTH * BATCH * 4;
constexpr size_t O_PCONV = O_SM + (size_t)DEPTH * DEC_BATCH * 4;
constexpr size_t O_SCONV = O_PCONV + (size_t)DEPTH * BATCH * 3 * 512;
constexpr size_t O_END = O_SCONV + (size_t)DEPTH * DEC_BATCH * 3 * 512;
constexpr size_t W_RSTD = 0;
constexpr size_t W_XN = W_RSTD + NT;
constexpr size_t W_U = W_XN + (size_t)NT * D;
constexpr size_t W_QN = W_U + (size_t)NT * D_IN;
constexpr size_t W_QR = W_QN + (size_t)NT * 512;
constexpr size_t W_WINNEW = W_QR + (size_t)NT * 512;
constexpr size_t W_LOGA = W_WINNEW + (size_t)NT * 256;
constexpr size_t W_MQ = W_LOGA + (size_t)NT * 128;
constexpr size_t W_MK = W_MQ + (size_t)NT * 256;
constexpr size_t W_CBIAS = W_MK + (size_t)NT * 256;
constexpr size_t W_KC = W_CBIAS + 256;
constexpr size_t W_VC = W_KC + (size_t)NSEQ * NCMAX * 128;
constexpr size_t W_PCMP = W_VC + (size_t)NSEQ * NCMAX * 128;
constexpr size_t W_OCMP = W_PCMP + (size_t)NT * 8 * NCMAX;
constexpr size_t W_IMP = W_OCMP + (size_t)NT * 512;
constexpr size_t W_SEL = W_IMP + (size_t)NT * 2 * NSELMAX;
constexpr size_t W_PSLC = W_SEL + (size_t)NT * 2 * 16;
constexpr size_t W_OSLC = W_PSLC + (size_t)NT * 8 * 1024;
constexpr size_t W_PWIN = W_OSLC + (size_t)NT * 512;
constexpr size_t W_OWIN = W_PWIN + (size_t)NT * 8 * 512;
constexpr size_t W_OA = W_OWIN + (size_t)NT * 512;
constexpr size_t W_H = W_OA + (size_t)NT * 256;
constexpr size_t W_MIXED = W_H + (size_t)NT * 256;
constexpr size_t W_Y0 = W_MIXED + (size_t)NT * D;
constexpr size_t W_DEN = W_Y0 + (size_t)NT * D;
constexpr size_t W_MT = W_DEN + (size_t)NT * 4;
constexpr size_t W_GSLOC = W_MT + (size_t)NT * 4;
constexpr size_t W_GSBL = W_GSLOC + (size_t)BATCH * 4 * (SEQ / 64) * 2048;
constexpr size_t W_MCLOC = W_GSBL + (size_t)BATCH * 4 * (SEQ / 64) * 32;
constexpr size_t W_MFG = W_MCLOC + (size_t)BATCH * 4 * (SEQ / 64) * 4160;
constexpr size_t W_SPART = W_MFG + (size_t)BATCH * 4 * (SEQ / 64) * 4;
constexpr size_t W_SLIST = W_SPART + (size_t)DEC_BATCH * 2 * 40 * 32 * 68;
constexpr size_t W_END = W_SLIST + (size_t)DEC_BATCH * 2 * 2 * 112;
constexpr int NTP = (NT + 255) / 256 * 256, D_INP = 4096;
constexpr size_t WB_WINT = (W_END * 4 + 255) / 256 * 256;
constexpr size_t WB_WOUTT = WB_WINT + (size_t)DEPTH * D_INP * D * 2;
constexpr size_t WB_XB = WB_WOUTT + (size_t)DEPTH * D * D * 2;
constexpr size_t WB_MIXB = WB_XB + (size_t)NTP * D * 2;
constexpr int NQT = SEQ / 64, NCPADP = (NCP + 63) / 64 * 64, NCPADS = (NCS + 63) / 64 * 64, NCPAD = NCPADP > NCPADS ? NCPADP : NCPADS;
constexpr size_t WB_QNB = WB_MIXB + (size_t)NTP * D * 2;
constexpr size_t WB_QRB = WB_QNB + (size_t)NT * 512 * 2;
constexpr size_t WB_KSB = WB_QRB + (size_t)NT * 512 * 2;
constexpr size_t WB_VST = WB_KSB + (size_t)BATCH * 2 * SEQ * 64 * 2;
constexpr size_t WB_KWB = WB_VST + (size_t)BATCH * 2 * SEQ * 64 * 2;
constexpr size_t WB_VWT = WB_KWB + (size_t)BATCH * 2 * SEQ * 64 * 2;
constexpr size_t WB_KCB = WB_VWT + (size_t)BATCH * 2 * SEQ * 64 * 2;
constexpr size_t WB_VCT = WB_KCB + (size_t)NSEQ * 2 * NCPAD * 64 * 2;
constexpr size_t WB_WCT = WB_VCT + (size_t)NSEQ * 2 * NCPAD * 64 * 2;
constexpr int U_LD = D_INP;
constexpr size_t WB_UB = WB_WCT + (size_t)DEPTH * 2 * 64 * 2048 * 2;
constexpr size_t WB_BAR = WB_UB + (size_t)NTP * U_LD * 2;
constexpr size_t WB_END = WB_BAR + 16384;
typedef unsigned short bf16_t;
#ifdef CPU_EMU
HD bf16_t f2bf(float f) { unsigned u = __builtin_bit_cast(unsigned, f); return (bf16_t)((u + 0x7fffu + ((u >> 16) & 1u)) >> 16); }
#else
__device__ __forceinline__ bf16_t f2bf(float f) { const __bf16 h = (__bf16)f; return __builtin_bit_cast(bf16_t, h); }
__host__ inline bf16_t f2bf_host(float f) { unsigned u = __builtin_bit_cast(unsigned, f); return (bf16_t)((u + 0x7fffu + ((u >> 16) & 1u)) >> 16); }
#endif
HD float bf2f(bf16_t h) { return __builtin_bit_cast(float, (unsigned)h << 16); }

constexpr int NPTR = 26;
struct P {
    const float *x_prompt, *x_sample, *cache, *state_win, *state_gla, *state_C, *state_n, *state_m, *state_conv;
    const int* page_table;
    const float *norm_g, *w_in, *w_out, *gla_w_gate, *gla_b_gate, *gla_norm_g, *q_norm_g, *k_norm_g, *cmp_pos, *cmp_w,
        *conv_w, *conv_b, *gate_b, *ml_norm_g;
    float* out;
    float* ws;
};
static_assert(sizeof(P) == NPTR * 8, "P is a table of NPTR pointers");

HD int seq_of_row(int r) { return r < NP ? r / SEQ : BATCH + (r - NP) / DEC_SEQ; }
HD int seq_row0(int s) { return s < BATCH ? s * SEQ : NP + (s - BATCH) * DEC_SEQ; }
HD int seq_len(int s) { return s < BATCH ? SEQ : DEC_SEQ; }
HD int seq_pos0(int s) { return s < BATCH ? 0 : PAST_LEN; }
HD int seq_ncmp(int s) { return s < BATCH ? NCP : NCS; }
HD int seq_nsel(int s) { return s < BATCH ? NSELP : NSELS; }
HD int row_pos(int r) { return r < NP ? r % SEQ : PAST_LEN + (r - NP) % DEC_SEQ; }
HD const float* xrow(const P& p, int L, int r) {
    if (L == 0) return r < NP ? p.x_prompt + (size_t)r * D : p.x_sample + (size_t)(r - NP) * D;
    return p.ws + W_Y0 + (size_t)r * D;
}
HD float* new_rows_ptr(const P& p, int L, int r) {
    return r < NP ? p.out + O_PROWS + ((size_t)L * NP + r) * 512 : p.out + O_SROWS + ((size_t)L * NS + (r - NP)) * 512;
}
HD const float* hist(const P& p, int L, int s, int r, int slot, int g) {
    if (s < BATCH) return p.out + O_PROWS + ((size_t)L * NP + (size_t)s * SEQ + r) * 512 + slot * 128 + g * 64;
    const int b = s - BATCH;
    if (r < PAST_LEN) { const int page = p.page_table[b * NPAGES + r / PAGE];
        return p.cache + (((size_t)L * NPOOL + page) * PAGE + (r % PAGE)) * 512 + slot * 128 + g * 64; }
    return p.out + O_SROWS + ((size_t)L * NS + b * DEC_SEQ + (r - PAST_LEN)) * 512 + slot * 128 + g * 64;
}
HD const float* ctxp(const P& p, int L, int s, int kpos, int kv, int g) {
    if (s < BATCH) return p.ws + W_WINNEW + ((size_t)s * SEQ + kpos) * 256 + kv * 128 + g * 64;
    const int b = s - BATCH;
    if (kpos < PAST_LEN) return p.state_win + (((size_t)L * DEC_BATCH + b) * WKEEP_S + (kpos - (PAST_LEN - WKEEP_S))) * 256 + kv * 128 + g * 64;
    return p.ws + W_WINNEW + ((size_t)NP + b * DEC_SEQ + (kpos - PAST_LEN)) * 256 + kv * 128 + g * 64;
}
HD bf16_t* wsb(const P& p, size_t off) { return (bf16_t*)((char*)p.ws + off); }
struct URow { const bf16_t* q; HD float operator[](size_t i) const { return bf2f(q[i]); } HD URow operator+(size_t k) const { return URow{q + k}; } };
HD bf16_t* ubase(const P& p) { return (bf16_t*)((char*)p.ws + WB_UB); }
HD URow urow(const P& p, int r) { return URow{ubase(p) + (size_t)r * U_LD}; }
HD bf16_t* mixb(const P& p) { return (bf16_t*)((char*)p.ws + WB_MIXB); }
HD bf16_t* xbp(const P& p) { return (bf16_t*)((char*)p.ws + WB_XB); }
HD bf16_t* wintp(const P& p, int L) { return (bf16_t*)((char*)p.ws + WB_WINT) + (size_t)L * D_INP * D; }
HD bf16_t* wouttp(const P& p, int L) { return (bf16_t*)((char*)p.ws + WB_WOUTT) + (size_t)L * D * D; }
#ifdef CPU_EMU
HD float EXPF(float x) { return expf(x); }
HD float RCPF(float x) { return 1.0f / x; }
HD float RSQRTF(float x) { return 1.0f / sqrtf(x); }
HD float LOG1PF(float e) { return log1pf(e); }
HD void SINCOSF(float a, float& sn, float& c) { sn = sinf(a); c = cosf(a); }
#else
__device__ __forceinline__ float EXPF(float x) { return __builtin_amdgcn_exp2f(x * 1.4426950408889634f); }
__device__ __forceinline__ float RCPF(float x) { return __builtin_amdgcn_rcpf(x); }
__device__ __forceinline__ float RSQRTF(float x) { return __builtin_amdgcn_rsqf(x); }
__device__ __forceinline__ float LOG1PF(float e) { return __builtin_amdgcn_logf(1.0f + e) * 0.6931471805599453f; }
__device__ __forceinline__ void SINCOSF(float a, float& sn, float& c) { const float fr = __builtin_amdgcn_fractf(a * 0.15915494309189535f); sn = __builtin_amdgcn_sinf(fr); c = __builtin_amdgcn_cosf(fr); }
#endif
HD float log_sigmoidf(float x) { return fminf(x, 0.f) - LOG1PF(EXPF(-fabsf(x))); }
HD float sigmoidf_(float x) { return RCPF(1.f + EXPF(-x)); }
HD float siluf(float x) { return x * RCPF(1.f + EXPF(-x)); }
HD float rope_inv(int i) { return EXPF(-logf(500000.0f) * (float)i * 2.0f / 16.0f); }

HD void k_prep_win(const P& p, int L, long it) {
    const int n = (int)(it % D_INP), kc = (int)((it / D_INP) % (D / 8)), L2 = (int)(it / ((long)D_INP * (D / 8)));
    bf16_t* o = wintp(p, L2) + (size_t)n * D + kc * 8;
    for (int j = 0; j < 8; ++j) { const int k = kc * 8 + j; o[j] = n < D_IN ? f2bf(p.norm_g[L2 * D + k] * p.w_in[((size_t)L2 * D + k) * D_IN + orig_col(n)]) : (bf16_t)0; }
}
HD void k_prep_wout(const P& p, int L, long it) {
    const int n = (int)(it % D), kc = (int)((it / D) % (D / 8)), L2 = (int)(it / ((long)D * (D / 8)));
    bf16_t* o = wouttp(p, L2) + (size_t)n * D + kc * 8;
    for (int j = 0; j < 8; ++j) { const int k = kc * 8 + j; o[j] = f2bf(p.w_out[((size_t)L2 * D + k) * D + n]); }
}
HD void k_gemm_in_emu(const P& p, int L, long it) {
    const int r = (int)(it / D_IN), c = (int)(it % D_IN);
    const bf16_t* a = xbp(p) + (size_t)r * D; const bf16_t* w = wintp(p, L) + (size_t)c * D; float s = 0.f;
    for (int k = 0; k < D; ++k) s += bf2f(a[k]) * bf2f(w[k]);
    ubase(p)[(size_t)r * U_LD + c] = f2bf(s * p.ws[W_RSTD + r]);
}
HD void k_win_copy(const P& p, int L, long it) {
    constexpr int NOLD = WKEEP_S - DEC_SEQ > 0 ? WKEEP_S - DEC_SEQ : 0;
    const int e = (int)(it % 256); const long q = it / 256; const int i = (int)(q % NOLD), b = (int)(q / NOLD);
    p.out[O_SWIN + (((size_t)L * DEC_BATCH + b) * WKEEP_S + i) * 256 + e] = p.state_win[(((size_t)L * DEC_BATCH + b) * WKEEP_S + i + DEC_SEQ) * 256 + e];
}
HD float conv_xp(const P& p, int L, int s, int tp, int ch) {
    if (tp < 3) return s < BATCH ? 0.f : p.state_conv[(((size_t)L * DEC_BATCH + (s - BATCH)) * 3 + tp) * 512 + ch];
    return urow(p, seq_row0(s) + tp - 3)[C_MQK + ch];
}
HD void k_conv_out(const P& p, int L, long it) {
    const int ch = (int)(it % 512), i = (int)((it / 512) % 3), s = (int)(it / 1536);
    const float v = conv_xp(p, L, s, seq_len(s) + i, ch);
    if (s < BATCH) p.out[O_PCONV + (((size_t)L * BATCH + s) * 3 + i) * 512 + ch] = v;
    else p.out[O_SCONV + (((size_t)L * DEC_BATCH + (s - BATCH)) * 3 + i) * 512 + ch] = v;
}
HD void k_cmp_sum(const P& p, int L, long it) {
    const int e = (int)(it % 64), g = (int)((it / 64) % 2), kv = (int)((it / 128) % 2); const long q = it / 256; const int j = (int)(q % NCMAX), s = (int)(q / NCMAX);
    if (j >= seq_ncmp(s)) return;
    float a = p.ws[W_CBIAS + kv * 64 + e];
    const float* w = p.cmp_w + ((size_t)(L * 2 + kv)) * 2048 * 64 + e;
    for (int t = 0; t < 32; ++t) { const float* x = hist(p, L, s, 16 * j + t, kv, g);
        for (int d = 0; d < 64; ++d) a += x[d] * w[(size_t)(t * 64 + d) * 64]; }
    p.ws[(kv ? W_VC : W_KC) + ((size_t)s * NCMAX + j) * 128 + g * 64 + e] = a;
}
HD void k_kc_norm(const P& p, int L, long it) {
    const int g = (int)(it % 2); const long q = it / 2; const int j = (int)(q % NCPAD), s = (int)(q / NCPAD);
    bf16_t* kb = wsb(p, WB_KCB) + (((size_t)s * 2 + g) * NCPAD + j) * 64; bf16_t* vt = wsb(p, WB_VCT) + (((size_t)s * 2 + g) * (NCPAD / 64) + j / 64) * 4096 + (j % 64);
    if (j >= seq_ncmp(s)) { for (int d = 0; d < 64; ++d) { kb[d] = 0; vt[(size_t)d * 64] = 0; } return; }
    float* k = p.ws + W_KC + ((size_t)s * NCMAX + j) * 128 + g * 64; const float* v = p.ws + W_VC + ((size_t)s * NCMAX + j) * 128 + g * 64; float ss = 0.f;
    for (int d = 0; d < 64; ++d) ss += k[d] * k[d];
    const float rs = RSQRTF(ss / 64 + 1e-6f);
    for (int d = 0; d < 64; ++d) { k[d] = k[d] * rs * p.k_norm_g[(L * 3 + 0) * 64 + d]; kb[d] = f2bf(k[d]); vt[(size_t)d * 64] = f2bf(v[d]); }
}
HD void k_cmp_score(const P& p, int L, long it) {
    const int n = (int)(it % NCMAX); const long q = it / NCMAX; const int h = (int)(q % 8), r = NP + (int)(q / 8), s = seq_of_row(r), pos = row_pos(r);
    if (n >= seq_ncmp(s)) return;
    float v = -INFINITY;
    if (16 * n + 31 <= pos) { const float* qq = p.ws + W_QN + (size_t)r * 512 + h * 64; const float* k = p.ws + W_KC + ((size_t)s * NCMAX + n) * 128 + (h / 4) * 64;
        float a = 0.f; for (int d = 0; d < 64; ++d) a += qq[d] * k[d]; v = a * 0.125f; }
    p.ws[W_PCMP + (size_t)NP * 8 * NCMAX + it] = v;
}
HD void softmax_row(float* x, int n) {
    float m = -INFINITY; for (int i = 0; i < n; ++i) m = fmaxf(m, x[i]);
    if (m == -INFINITY) m = 0.f;
    float sum = 0.f; for (int i = 0; i < n; ++i) { const float e = (x[i] == -INFINITY) ? 0.f : EXPF(x[i] - m); x[i] = e; sum += e; }
    const float inv = 1.0f / fmaxf(sum, 1e-30f);
    for (int i = 0; i < n; ++i) x[i] *= inv;
}
HD void k_cmp_softmax(const P& p, int L, long it) { const int r = NP + (int)(it / 8); softmax_row(p.ws + W_PCMP + ((size_t)NP * 8 + it) * NCMAX, seq_ncmp(seq_of_row(r))); }
HD void k_cmp_out(const P& p, int L, long it) {
    const int d = (int)(it % 64), h = (int)((it / 64) % 8), r = NP + (int)(it / 512), s = seq_of_row(r), nc = seq_ncmp(s);
    const float* pr = p.ws + W_PCMP + ((size_t)r * 8 + h) * NCMAX; const float* v = p.ws + W_VC + (size_t)s * NCMAX * 128 + (h / 4) * 64 + d; float a = 0.f;
    for (int n = 0; n < nc; ++n) a += pr[n] * v[(size_t)n * 128];
    p.ws[W_OCMP + (size_t)NP * 512 + it] = a;
}
HD void k_imp(const P& p, int L, long it) {
    const int j = (int)(it % NSELMAX), g = (int)((it / NSELMAX) % 2), r = NP + (int)(it / (2 * NSELMAX)), s = seq_of_row(r), nc = seq_ncmp(s);
    if (j >= seq_nsel(s)) return;
    float a = 0.f;
    for (int h = 0; h < 4; ++h) { const float* pr = p.ws + W_PCMP + ((size_t)r * 8 + g * 4 + h) * NCMAX;
        for (int q = 0; q < 5; ++q) { const int i = 4 * j - 1 + q; if (i >= 0 && i < nc) a += pr[i] * ((q == 0 || q == 4) ? 1.f : 2.f); } }
    p.ws[W_IMP + (size_t)NP * 2 * NSELMAX + it] = a;
}
HD void k_topk(const P& p, int L, long it) {
    const int g = (int)(it % 2), r = NP + (int)(it / 2), s = seq_of_row(r), pos = row_pos(r), ns = seq_nsel(s), cur = pos / 64;
    const float* imp = p.ws + W_IMP + ((size_t)r * 2 + g) * NSELMAX; int* sel = (int*)(p.ws + W_SEL) + ((size_t)r * 2 + g) * 16;
    unsigned long long c0 = 0, c1 = 0, c2 = 0, c3 = 0;
    const int nk = ns < 16 ? ns : 16;
    for (int k = 0; k < 16; ++k) {
        int bj = -1; float bs = 0.f;
        if (k < nk) for (int j = 0; j < ns; ++j) {
            const unsigned long long bit = 1ull << (j & 63); const unsigned long long cw = (j < 64) ? c0 : (j < 128) ? c1 : (j < 192) ? c2 : c3;
            if (cw & bit) continue;
            const bool forced = (j == 0) || (j == cur) || (j == cur - 1), valid = j * 64 <= pos;
            const float sc = forced ? INFINITY : (valid ? imp[j] : -INFINITY);
            if (bj < 0 || sc > bs) { bj = j; bs = sc; }
        }
        sel[k] = bj;
        if (bj >= 0) { const unsigned long long bit = 1ull << (bj & 63); if (bj < 64) c0 |= bit; else if (bj < 128) c1 |= bit; else if (bj < 192) c2 |= bit; else c3 |= bit; }
    }
}
HD void k_slc_score(const P& p, int L, long it) {
    const int ks = (int)(it % 1024), h = (int)((it / 1024) % 8), r = NP + (int)(it / 8192), s = seq_of_row(r), pos = row_pos(r), g = h / 4;
    const int blk = ((const int*)(p.ws + W_SEL))[((size_t)r * 2 + g) * 16 + ks / 64];
    float v = -INFINITY;
    if (blk >= 0) { const int kpos = blk * 64 + (ks % 64);
        if (kpos <= pos) { const float* qq = p.ws + W_QR + (size_t)r * 512 + h * 64; const float* k = hist(p, L, s, kpos, 2, g);
            float a = 0.f; for (int d = 0; d < 64; ++d) a += qq[d] * k[d]; v = a * 0.125f; } }
    p.ws[W_PSLC + (size_t)NP * 8 * 1024 + it] = v;
}
HD void k_slc_softmax(const P& p, int L, long it) { softmax_row(p.ws + W_PSLC + ((size_t)NP * 8 + it) * 1024, 1024); }
HD void k_slc_out(const P& p, int L, long it) {
    const int d = (int)(it % 64), h = (int)((it / 64) % 8), r = NP + (int)(it / 512), s = seq_of_row(r), g = h / 4;
    const float* pr = p.ws + W_PSLC + ((size_t)r * 8 + h) * 1024; const int* sel = (const int*)(p.ws + W_SEL) + ((size_t)r * 2 + g) * 16; float a = 0.f;
    for (int ks = 0; ks < 1024; ++ks) { const float pv = pr[ks]; if (pv != 0.f) a += pv * hist(p, L, s, sel[ks / 64] * 64 + (ks % 64), 3, g)[d]; }
    p.ws[W_OSLC + (size_t)NP * 512 + it] = a;
}
HD int seq_first_pos(int s) { return s < BATCH ? 0 : PAST_LEN - WKEEP_S; }
HD void k_win_score(const P& p, int L, long it) {
    const int w = (int)(it % 512), h = (int)((it / 512) % 8), r = NP + (int)(it / 4096), s = seq_of_row(r), pos = row_pos(r), g = h / 4, kpos = pos - w;
    float v = -INFINITY;
    if (kpos >= seq_first_pos(s)) { const float* qq = p.ws + W_QR + (size_t)r * 512 + h * 64; const float* k = ctxp(p, L, s, kpos, 0, g);
        float a = 0.f; for (int d = 0; d < 64; ++d) a += qq[d] * k[d]; v = a * 0.125f; }
    p.ws[W_PWIN + (size_t)NP * 8 * 512 + it] = v;
}
HD void k_win_softmax(const P& p, int L, long it) { softmax_row(p.ws + W_PWIN + ((size_t)NP * 8 + it) * 512, 512); }
HD void k_win_out(const P& p, int L, long it) {
    const int d = (int)(it % 64), h = (int)((it / 64) % 8), r = NP + (int)(it / 512), s = seq_of_row(r), pos = row_pos(r), g = h / 4;
    const float* pr = p.ws + W_PWIN + ((size_t)r * 8 + h) * 512; float a = 0.f;
    for (int w = 0; w < 512; ++w) { const float pv = pr[w]; if (pv != 0.f) a += pv * ctxp(p, L, s, pos - w, 1, g)[d]; }
    p.ws[W_OWIN + (size_t)NP * 512 + it] = a;
}
HD void k_gla(const P& p, int L, long it) {
    const int dv = (int)(it % 64), h = (int)((it / 64) % 4), s = BATCH + (int)(it / 256), r0 = seq_row0(s), len = seq_len(s);
    float S[32];
#pragma unroll
    for (int k = 0; k < 32; ++k) S[k] = s < BATCH ? 0.f : p.state_gla[((((size_t)L * DEC_BATCH + (s - BATCH)) * 4 + h) * 32 + k) * 64 + dv];
    for (int t = 0; t < len; ++t) {
        const int r = r0 + t; const URow u = urow(p, r); const float* la = p.ws + W_LOGA + (size_t)r * 128 + h * 32;
        const float v = u[C_GV + h * 64 + dv]; float o = 0.f;
#pragma unroll
        for (int k = 0; k < 32; ++k) { S[k] = EXPF(la[k]) * S[k] + u[C_GK + h * 32 + k] * v; o += u[C_GQ + h * 32 + k] * S[k]; }
        p.ws[W_OA + (size_t)r * 256 + h * 64 + dv] = o * 0.17677669529663687f;
    }
    float* so = s < BATCH ? p.out + O_PGLA + (((size_t)L * BATCH + s) * 4 + h) * 2048 : p.out + O_SGLA + (((size_t)L * DEC_BATCH + (s - BATCH)) * 4 + h) * 2048;
#pragma unroll
    for (int k = 0; k < 32; ++k) so[k * 64 + dv] = S[k];
}
HD void k_mlstm(const P& p, int L, long it) {
    const int e = (int)(it % 65), h = (int)((it / 65) % 4), s = BATCH + (int)(it / 260), r0 = seq_row0(s), len = seq_len(s);
    float C[64]; float m = s < BATCH ? 0.f : p.state_m[((size_t)L * DEC_BATCH + (s - BATCH)) * 4 + h];
#pragma unroll
    for (int d = 0; d < 64; ++d) C[d] = s < BATCH ? 0.f : (e < 64 ? p.state_C[((((size_t)L * DEC_BATCH + (s - BATCH)) * 4 + h) * 64 + e) * 64 + d]
                                                                  : p.state_n[(((size_t)L * DEC_BATCH + (s - BATCH)) * 4 + h) * 64 + d]);
    const float bi = p.gate_b[(L * 2 + 0) * 4 + h], bf = p.gate_b[(L * 2 + 1) * 4 + h];
    for (int t = 0; t < len; ++t) {
        const int r = r0 + t; const URow u = urow(p, r); const float* q = p.ws + W_MQ + (size_t)r * 256 + h * 64; const float* k = p.ws + W_MK + (size_t)r * 256 + h * 64;
        const float ip = u[C_MIF + h] + bi, lf = log_sigmoidf(u[C_MIF + 4 + h] + bf), mn = fmaxf(lf + m, ip), fp = EXPF(lf + m - mn), iq = EXPF(ip - mn), v = e < 64 ? u[C_MV + h * 64 + e] : 1.0f;
        float num = 0.f;
#pragma unroll
        for (int d = 0; d < 64; ++d) { C[d] = fp * C[d] + iq * v * k[d]; num += C[d] * q[d]; }
        m = mn;
        if (e < 64) p.ws[W_H + (size_t)r * 256 + h * 64 + e] = num;
        else { p.ws[W_DEN + (size_t)r * 4 + h] = num; p.ws[W_MT + (size_t)r * 4 + h] = m; }
    }
    const size_t sb = s < BATCH ? ((size_t)L * BATCH + s) * 4 + h : ((size_t)L * DEC_BATCH + (s - BATCH)) * 4 + h;
    float* co = e < 64 ? p.out + (s < BATCH ? O_PC : O_SC) + (sb * 64 + e) * 64 : p.out + (s < BATCH ? O_PN : O_SN) + sb * 64;
#pragma unroll
    for (int d = 0; d < 64; ++d) co[d] = C[d];
    if (e == 64) p.out[(s < BATCH ? O_PM : O_SM) + sb] = m;
}
HD void k_mix_gla(const P& p, int L, long it) {
    const int h = (int)(it % 4), r = NP + (int)(it / 4); const float* o = p.ws + W_OA + (size_t)r * 256 + h * 64; float ss = 0.f;
    for (int d = 0; d < 64; ++d) ss += o[d] * o[d];
    const float rs = RSQRTF(ss / 64 + 1e-6f); const URow u = urow(p, r) + (C_GZ + h * 64);
    for (int d = 0; d < 64; ++d) mixb(p)[(size_t)r * D + h * 64 + d] = f2bf(o[d] * rs * p.gla_norm_g[L * 64 + d] * siluf(u[d]));
}
HD void k_mix_ml(const P& p, int L, long it) {
    const int h = (int)(it % 4), r = NP + (int)(it / 4); const float* o = p.ws + W_H + (size_t)r * 256 + h * 64; float ss = 0.f;
    const float dinv = 1.0f / fmaxf(fabsf(p.ws[W_DEN + (size_t)NP * 4 + it]), EXPF(-p.ws[W_MT + (size_t)NP * 4 + it]));
    for (int d = 0; d < 64; ++d) ss += o[d] * dinv * o[d] * dinv;
    const float rs = dinv / sqrtf(ss / 64 + 1e-6f); const URow u = urow(p, r);
    for (int d = 0; d < 64; ++d) mixb(p)[(size_t)r * D + 768 + h * 64 + d] = f2bf(o[d] * rs * p.ml_norm_g[L * 64 + d] * sigmoidf_(u[C_MO + h * 64 + d]) * siluf(u[C_MZ + h * 64 + d]));
}
HD void k_gemm_out_emu(const P& p, int L, long it) {
    const int r = (int)(it / D), c = (int)(it % D);
    const bf16_t* a = mixb(p) + (size_t)r * D; const bf16_t* w = wouttp(p, L) + (size_t)c * D; float s = 0.f;
    for (int k = 0; k < D; ++k) s += bf2f(a[k]) * bf2f(w[k]);
    (L == DEPTH - 1 ? p.out + O_Y : p.ws + W_Y0)[it] = xrow(p, L, r)[c] + s;
}

#ifdef CPU_EMU
#define LDSQ
#define EXP2F(x) exp2f(x)
#else
#define LDSQ __attribute__((address_space(3)))
#define EXP2F(x) __builtin_amdgcn_exp2f(x)
typedef short bf16x8 __attribute__((ext_vector_type(8)));
typedef short bf16x4 __attribute__((ext_vector_type(4)));
typedef float f32x4 __attribute__((ext_vector_type(4)));
typedef float f32x16 __attribute__((ext_vector_type(16)));
#endif
typedef LDSQ unsigned char* ldsp_t;
#ifdef CPU_EMU
#define LDS_ADDF(ptr, v) (*(ptr) += (v))
#else
#define LDS_ADDF(ptr, v) ((void)__hip_atomic_fetch_add((ptr), (v), __ATOMIC_RELAXED, __HIP_MEMORY_SCOPE_WORKGROUP))
#endif
#ifdef CPU_EMU
#define LDS_BARRIER() emu_syncthreads()
#define SCHED_FENCE() do {} while (0)
#else
#define SCHED_FENCE() __builtin_amdgcn_sched_barrier(0)
#define LDS_BARRIER() asm volatile("s_waitcnt lgkmcnt(0)\n\ts_barrier" ::: "memory")
#endif
#ifndef CPU_EMU
__device__ __forceinline__ int lane_fresh() { int l = (int)__builtin_amdgcn_mbcnt_hi(~0u, __builtin_amdgcn_mbcnt_lo(~0u, 0u)); asm volatile("" : "+v"(l)); return l; }
__device__ __forceinline__ int xl_shfl_xor_i(int v, int m) {
    if (m == 1) return __builtin_amdgcn_update_dpp(0, v, 0xB1, 0xF, 0xF, true);
    if (m == 2) return __builtin_amdgcn_update_dpp(0, v, 0x4E, 0xF, 0xF, true);
    if (m == 7) return __builtin_amdgcn_update_dpp(0, v, 0x141, 0xF, 0xF, true);
    if (m == 15) return __builtin_amdgcn_update_dpp(0, v, 0x140, 0xF, 0xF, true);
    return __builtin_amdgcn_ds_bpermute((lane_fresh() ^ m) << 2, v);
}
__device__ __forceinline__ float xl_shfl_xor(float v, int m) { return __builtin_bit_cast(float, xl_shfl_xor_i(__builtin_bit_cast(int, v), m)); }
__device__ __forceinline__ int xl_shfl_xor(int v, int m) { return xl_shfl_xor_i(v, m); }
__device__ __forceinline__ float xl_shfl(float v, int src) { return __builtin_bit_cast(float, __builtin_amdgcn_ds_bpermute(src << 2, __builtin_bit_cast(int, v))); }
__device__ __forceinline__ int xl_shfl(int v, int src) { return __builtin_amdgcn_ds_bpermute(src << 2, v); }
#define __shfl_xor xl_shfl_xor
#define __shfl xl_shfl
#endif
constexpr int LDS_MISC = 8 * 19456;
#ifdef CPU_EMU
#define opaque_tid() ((int)threadIdx.x)
#define RFL(x) (x)
HD int opaque_i(int v) { return v; }
#else
__device__ __forceinline__ int opaque_i(int v) { asm volatile("" : "+v"(v)); return v; }
constexpr int LDS_WTAB = LDS_MISC + 320;
__device__ __forceinline__ int hw_tid(__attribute__((address_space(3))) unsigned char* ldsb) {
    const unsigned hw = (unsigned)__builtin_amdgcn_s_getreg((5 << 11) | 4) & 63u;
    const int wv = __builtin_amdgcn_readfirstlane(*(__attribute__((address_space(3))) const int*)(ldsb + LDS_WTAB + hw * 4));
    unsigned t = (unsigned)wv * 64u + __builtin_amdgcn_mbcnt_hi(~0u, __builtin_amdgcn_mbcnt_lo(~0u, 0u)); asm volatile("" : "+v"(t)); return (int)t;
}
#define RFL(x) __builtin_amdgcn_readfirstlane(x)
#define opaque_tid() hw_tid(lds)
#endif
constexpr int NTHREADS = 512;
constexpr int KT_STRIDE = 144, VT_STRIDE = 136, KT_BYTES = 64 * KT_STRIDE, VT_BYTES = 64 * VT_STRIDE;
constexpr int NSA_KT = 0, NSA_VT = 3 * KT_BYTES, NSA_IMP = NSA_VT + 3 * VT_BYTES, NSA_MASK = NSA_IMP + 8 * 8 * 64 * 4, NSA_END = NSA_MASK + 8 * 8 * 8;
constexpr int NSA_COMB = 73728;
constexpr float C2LOG = 0.125f * 1.4426950408889634f;
constexpr float NEG_BIG = -1.0e30f;

typedef unsigned u32x4_t __attribute__((ext_vector_type(4)));
#ifdef CPU_EMU
HD float rlane(float v, int i) { return __shfl(v, i); }
#else
__device__ __forceinline__ float rlane(float v, int i) { return __builtin_bit_cast(float, __builtin_amdgcn_readlane(__builtin_bit_cast(int, v), i)); }
#endif
#ifdef CPU_EMU
HD unsigned pack2bf(float lo, float hi) { return (unsigned)f2bf(lo) | ((unsigned)f2bf(hi) << 16); }
#else
typedef __bf16 hwbf16x2_t __attribute__((ext_vector_type(2)));
typedef float hwf32x2_t __attribute__((ext_vector_type(2)));
__device__ __forceinline__ unsigned pack2bf(float lo, float hi) { const hwf32x2_t v = {lo, hi}; const hwbf16x2_t b = __builtin_convertvector(v, hwbf16x2_t); return __builtin_bit_cast(unsigned, b); }
#endif
HD void ld8f(const float* q, float (&f)[8]) { const f32x4 a = *(const f32x4*)q, b = *(const f32x4*)(q + 4); f[0] = a[0]; f[1] = a[1]; f[2] = a[2]; f[3] = a[3]; f[4] = b[0]; f[5] = b[1]; f[6] = b[2]; f[7] = b[3]; }
struct AttnSt { f32x16 o0, o1; float m, l; };
template <bool MASK> HD bool softmax_tile(f32x16& s0, f32x16& s1, int lim2, int lo2, bool sel, AttnSt& st, bf16x8 (&pf)[4], float& alpha) {
    float tmax = NEG_BIG;
    if (MASK) {
#pragma unroll
        for (int r = 0; r < 16; ++r) { const int kc = (r & 3) + 8 * (r >> 2);
            s0[r] = (kc <= lim2 && kc > lo2) ? s0[r] : NEG_BIG; s1[r] = (kc + 32 <= lim2 && kc + 32 > lo2) ? s1[r] : NEG_BIG; tmax = fmaxf(tmax, fmaxf(s0[r], s1[r])); }
    } else {
#pragma unroll
        for (int r = 0; r < 16; ++r) tmax = fmaxf(tmax, fmaxf(s0[r], s1[r]));
        tmax = sel ? tmax : NEG_BIG;
    }
    tmax = fmaxf(tmax, __shfl_xor(tmax, 32));
    const float mn = fmaxf(st.m, tmax); const bool any = __ballot(mn > st.m) != 0ull;
    alpha = 1.0f;
    if (any) { alpha = EXP2F(st.m - mn); st.l *= alpha; }
    st.m = mn;
    float ls = 0.f;
#pragma unroll
    for (int r = 0; r < 16; ++r) { float p0 = EXP2F(s0[r] - mn), p1 = EXP2F(s1[r] - mn);
        if (MASK) { p0 = s0[r] > -1.0e29f ? p0 : 0.f; p1 = s1[r] > -1.0e29f ? p1 : 0.f; }
        s0[r] = p0; s1[r] = p1; ls += p0 + p1; }
    u32x4_t w0, w1, w2, w3;
#pragma unroll
    for (int i = 0; i < 4; ++i) { w0[i] = pack2bf(s0[2 * i], s0[2 * i + 1]); w1[i] = pack2bf(s0[8 + 2 * i], s0[8 + 2 * i + 1]); w2[i] = pack2bf(s1[2 * i], s1[2 * i + 1]); w3[i] = pack2bf(s1[8 + 2 * i], s1[8 + 2 * i + 1]); }
    if (!MASK) { const unsigned km = sel ? 0xffffffffu : 0u; w0 &= km; w1 &= km; w2 &= km; w3 &= km; ls = sel ? ls : 0.f; }
    st.l += ls;
    pf[0] = __builtin_bit_cast(bf16x8, w0); pf[1] = __builtin_bit_cast(bf16x8, w1); pf[2] = __builtin_bit_cast(bf16x8, w2); pf[3] = __builtin_bit_cast(bf16x8, w3);
    return any;
}
HD void attn_init(AttnSt& s) { for (int r = 0; r < 16; ++r) { s.o0[r] = 0.f; s.o1[r] = 0.f; } s.m = NEG_BIG; s.l = 0.f; }
HD short bfbits(float f) { return (short)f2bf(f); }
template <bool IMP, bool MASK>
HD void attn_tile(ldsp_t lds, int buf, const bf16x8 (&qf)[4], float mb, int lim2, int lo2, bool sel, AttnSt& st, f32x16& i0, f32x16& i1, int ntile64, int c, int hi) {
    f32x16 s0, s1;
    for (int r = 0; r < 16; ++r) { s0[r] = -mb; s1[r] = -mb; }
    const ldsp_t kt = lds + NSA_KT + buf * KT_BYTES + c * KT_STRIDE + hi * 16;
#pragma unroll
    for (int ks = 0; ks < 4; ++ks) {
        const bf16x8 k0 = *(const LDSQ bf16x8*)(kt + ks * 32), k1 = *(const LDSQ bf16x8*)(kt + 32 * KT_STRIDE + ks * 32);
        s0 = __builtin_amdgcn_mfma_f32_32x32x16_bf16(k0, qf[ks], s0, 0, 0, 0);
        s1 = __builtin_amdgcn_mfma_f32_32x32x16_bf16(k1, qf[ks], s1, 0, 0, 0);
    }
    float ls = 0.f;
#pragma unroll
    for (int r = 0; r < 16; ++r) { float p0 = EXP2F(s0[r]), p1 = EXP2F(s1[r]);
        if (MASK) { const int kc = (r & 3) + 8 * (r >> 2); p0 = (kc <= lim2 && kc > lo2) ? p0 : 0.f; p1 = (kc + 32 <= lim2 && kc + 32 > lo2) ? p1 : 0.f; }
        s0[r] = p0; s1[r] = p1; ls += p0 + p1; }
    u32x4_t w0, w1, w2, w3;
#pragma unroll
    for (int i = 0; i < 4; ++i) { w0[i] = pack2bf(s0[2 * i], s0[2 * i + 1]); w1[i] = pack2bf(s0[8 + 2 * i], s0[8 + 2 * i + 1]); w2[i] = pack2bf(s1[2 * i], s1[2 * i + 1]); w3[i] = pack2bf(s1[8 + 2 * i], s1[8 + 2 * i + 1]); }
    if (!MASK) { const unsigned km = sel ? 0xffffffffu : 0u; w0 &= km; w1 &= km; w2 &= km; w3 &= km; ls = sel ? ls : 0.f; }
    st.l += ls;
    bf16x8 pf[4];
    pf[0] = __builtin_bit_cast(bf16x8, w0); pf[1] = __builtin_bit_cast(bf16x8, w1); pf[2] = __builtin_bit_cast(bf16x8, w2); pf[3] = __builtin_bit_cast(bf16x8, w3);
    const ldsp_t vt = lds + NSA_VT + buf * VT_BYTES + c * VT_STRIDE + hi * 8;
#pragma unroll
    for (int ks = 0; ks < 4; ++ks) {
        const bf16x4 a0 = *(const LDSQ bf16x4*)(vt + ks * 32), a1 = *(const LDSQ bf16x4*)(vt + ks * 32 + 16);
        const bf16x4 b0 = *(const LDSQ bf16x4*)(vt + 32 * VT_STRIDE + ks * 32), b1 = *(const LDSQ bf16x4*)(vt + 32 * VT_STRIDE + ks * 32 + 16);
        bf16x8 v0, v1;
#pragma unroll
        for (int j = 0; j < 4; ++j) { v0[j] = a0[j]; v0[4 + j] = a1[j]; v1[j] = b0[j]; v1[4 + j] = b1[j]; }
        st.o0 = __builtin_amdgcn_mfma_f32_32x32x16_bf16(v0, pf[ks], st.o0, 0, 0, 0);
        st.o1 = __builtin_amdgcn_mfma_f32_32x32x16_bf16(v1, pf[ks], st.o1, 0, 0, 0);
        if (IMP) {
#pragma unroll
            for (int jt = 0; jt < 2; ++jt) { const int base = ntile64 * 64 + 16 * ks + 4 * hi - 4 * (jt * 32 + c); bf16x8 af;
#pragma unroll
                for (int jj = 0; jj < 8; ++jj) { const int dl = base + 8 * (jj >> 2) + (jj & 3); af[jj] = (dl == -1 || dl == 3) ? (short)0x3F80 : ((dl >= 0 && dl <= 2) ? (short)0x4000 : (short)0); }
                if (jt == 0) i0 = __builtin_amdgcn_mfma_f32_32x32x16_bf16(af, pf[ks], i0, 0, 0, 0); else i1 = __builtin_amdgcn_mfma_f32_32x32x16_bf16(af, pf[ks], i1, 0, 0, 0); }
        }
    }
}
HD void imp_tile(ldsp_t lds, int buf, const bf16x8 (&qf)[4], float mb, float inv, int lim2, f32x16& i0, f32x16& i1, int ntile64, int c, int hi) {
    f32x16 s0, s1;
    for (int r = 0; r < 16; ++r) { s0[r] = -mb; s1[r] = -mb; }
    const ldsp_t kt = lds + NSA_KT + buf * KT_BYTES + c * KT_STRIDE + hi * 16;
#pragma unroll
    for (int ks = 0; ks < 4; ++ks) {
        const bf16x8 k0 = *(const LDSQ bf16x8*)(kt + ks * 32), k1 = *(const LDSQ bf16x8*)(kt + 32 * KT_STRIDE + ks * 32);
        s0 = __builtin_amdgcn_mfma_f32_32x32x16_bf16(k0, qf[ks], s0, 0, 0, 0);
        s1 = __builtin_amdgcn_mfma_f32_32x32x16_bf16(k1, qf[ks], s1, 0, 0, 0);
    }
#pragma unroll
    for (int r = 0; r < 16; ++r) { const int kc = (r & 3) + 8 * (r >> 2); s0[r] = kc <= lim2 ? EXP2F(s0[r]) * inv : 0.f; s1[r] = kc + 32 <= lim2 ? EXP2F(s1[r]) * inv : 0.f; }
    u32x4_t w0, w1, w2, w3;
#pragma unroll
    for (int i = 0; i < 4; ++i) { w0[i] = pack2bf(s0[2 * i], s0[2 * i + 1]); w1[i] = pack2bf(s0[8 + 2 * i], s0[8 + 2 * i + 1]); w2[i] = pack2bf(s1[2 * i], s1[2 * i + 1]); w3[i] = pack2bf(s1[8 + 2 * i], s1[8 + 2 * i + 1]); }
    bf16x8 pf[4];
    pf[0] = __builtin_bit_cast(bf16x8, w0); pf[1] = __builtin_bit_cast(bf16x8, w1); pf[2] = __builtin_bit_cast(bf16x8, w2); pf[3] = __builtin_bit_cast(bf16x8, w3);
#pragma unroll
    for (int ks = 0; ks < 4; ++ks)
#pragma unroll
        for (int jt = 0; jt < 2; ++jt) { const int base = ntile64 * 64 + 16 * ks + 4 * hi - 4 * (jt * 32 + c); bf16x8 af;
            const int jlo = 16 * ntile64 + 4 * ks;
            if (jlo + 4 < 32 * jt || jlo > 32 * jt + 31) continue;
#pragma unroll
            for (int jj = 0; jj < 8; ++jj) { const int dl = base + 8 * (jj >> 2) + (jj & 3); af[jj] = (dl == -1 || dl == 3) ? (short)0x3F80 : ((dl >= 0 && dl <= 2) ? (short)0x4000 : (short)0); }
            if (jt == 0) i0 = __builtin_amdgcn_mfma_f32_32x32x16_bf16(af, pf[ks], i0, 0, 0, 0); else i1 = __builtin_amdgcn_mfma_f32_32x32x16_bf16(af, pf[ks], i1, 0, 0, 0); }
}
HD float score_bound(const bf16x8 (&qf)[4], const float* kgain, int lane) {
    float ss = 0.f;
#pragma unroll
    for (int ks = 0; ks < 4; ++ks)
#pragma unroll
        for (int j = 0; j < 8; ++j) { const float v = bf2f((bf16_t)qf[ks][j]); ss += v * v; }
    ss += __shfl_xor(ss, 32);
    float g = fabsf(kgain[lane]);
    g = fmaxf(g, __shfl_xor(g, 1)); g = fmaxf(g, __shfl_xor(g, 2)); g = fmaxf(g, __shfl_xor(g, 7)); g = fmaxf(g, __shfl_xor(g, 15));
    g = fmaxf(fmaxf(rlane(g, 0), rlane(g, 16)), fmaxf(rlane(g, 32), rlane(g, 48)));
    return sqrtf(ss) * 8.0f * g * 1.01f + 0.01f;
}
HD void tile_load(const bf16_t* k, const bf16_t* vt, int tid, bf16x8& rk, bf16x8& rv) { rk = *(const bf16x8*)(k + tid * 8); rv = *(const bf16x8*)(vt + tid * 8); }
HD void tile_store(ldsp_t lds, int buf, int tid, const bf16x8& rk, const bf16x8& rv) {
    const int row = tid >> 3, ch = tid & 7;
    *(LDSQ bf16x8*)(lds + NSA_KT + buf * KT_BYTES + row * KT_STRIDE + ch * 16) = rk;
    bf16x4 a, b;
    for (int j = 0; j < 4; ++j) { a[j] = rv[j]; b[j] = rv[4 + j]; }
    *(LDSQ bf16x4*)(lds + NSA_VT + buf * VT_BYTES + row * VT_STRIDE + ch * 16) = a; *(LDSQ bf16x4*)(lds + NSA_VT + buf * VT_BYTES + row * VT_STRIDE + ch * 16 + 8) = b;
}
HD void qk_tile(ldsp_t lds, int buf, const bf16x8 (&qf)[4], float mb, f32x16& s0, f32x16& s1, int c, int hi) {
    for (int r = 0; r < 16; ++r) { s0[r] = -mb; s1[r] = -mb; }
    const ldsp_t kt = lds + NSA_KT + buf * KT_BYTES + c * KT_STRIDE + hi * 16;
#pragma unroll
    for (int ks = 0; ks < 4; ++ks) {
        const bf16x8 k0 = *(const LDSQ bf16x8*)(kt + ks * 32), k1 = *(const LDSQ bf16x8*)(kt + 32 * KT_STRIDE + ks * 32);
        s0 = __builtin_amdgcn_mfma_f32_32x32x16_bf16(k0, qf[ks], s0, 0, 0, 0);
        s1 = __builtin_amdgcn_mfma_f32_32x32x16_bf16(k1, qf[ks], s1, 0, 0, 0);
    }
}
template <bool MASK> HD void sm_tile(f32x16& s0, f32x16& s1, int lim2, int lo2, bool sel, float& l, bf16x8 (&pf)[4]) {
    float ls = 0.f;
#pragma unroll
    for (int r = 0; r < 16; ++r) { float p0 = EXP2F(s0[r]), p1 = EXP2F(s1[r]);
        if (MASK) { const int kc = (r & 3) + 8 * (r >> 2); p0 = (kc <= lim2 && kc > lo2) ? p0 : 0.f; p1 = (kc + 32 <= lim2 && kc + 32 > lo2) ? p1 : 0.f; }
        s0[r] = p0; s1[r] = p1; ls += p0 + p1; }
    u32x4_t w0, w1, w2, w3;
#pragma unroll
    for (int i = 0; i < 4; ++i) { w0[i] = pack2bf(s0[2 * i], s0[2 * i + 1]); w1[i] = pack2bf(s0[8 + 2 * i], s0[8 + 2 * i + 1]); w2[i] = pack2bf(s1[2 * i], s1[2 * i + 1]); w3[i] = pack2bf(s1[8 + 2 * i], s1[8 + 2 * i + 1]); }
    if (!MASK) { const unsigned km = sel ? 0xffffffffu : 0u; w0 &= km; w1 &= km; w2 &= km; w3 &= km; ls = sel ? ls : 0.f; }
    l += ls;
    pf[0] = __builtin_bit_cast(bf16x8, w0); pf[1] = __builtin_bit_cast(bf16x8, w1); pf[2] = __builtin_bit_cast(bf16x8, w2); pf[3] = __builtin_bit_cast(bf16x8, w3);
}
HD void pv_tile(ldsp_t lds, int buf, const bf16x8 (&pf)[4], AttnSt& st, int c, int hi) {
    const ldsp_t vt = lds + NSA_VT + buf * VT_BYTES + c * VT_STRIDE + hi * 8;
#pragma unroll
    for (int ks = 0; ks < 4; ++ks) {
        const bf16x4 a0 = *(const LDSQ bf16x4*)(vt + ks * 32), a1 = *(const LDSQ bf16x4*)(vt + ks * 32 + 16);
        const bf16x4 b0 = *(const LDSQ bf16x4*)(vt + 32 * VT_STRIDE + ks * 32), b1 = *(const LDSQ bf16x4*)(vt + 32 * VT_STRIDE + ks * 32 + 16);
        bf16x8 v0, v1;
#pragma unroll
        for (int j = 0; j < 4; ++j) { v0[j] = a0[j]; v0[4 + j] = a1[j]; v1[j] = b0[j]; v1[4 + j] = b1[j]; }
        st.o0 = __builtin_amdgcn_mfma_f32_32x32x16_bf16(v0, pf[ks], st.o0, 0, 0, 0);
        st.o1 = __builtin_amdgcn_mfma_f32_32x32x16_bf16(v1, pf[ks], st.o1, 0, 0, 0);
    }
}
struct TilePipe { bf16x8 k1, v1; };
HD void tp_start(ldsp_t lds, int tid, const bf16_t* kb, const bf16_t* vb, int nt, TilePipe& tp) {
    bf16x8 rk, rv, rk2, rv2; tile_load(kb, vb, tid, rk, rv);
    if (1 < nt) tile_load(kb + 4096, vb + 4096, tid, rk2, rv2);
    if (2 < nt) tile_load(kb + 2 * 4096, vb + 2 * 4096, tid, tp.k1, tp.v1);
    tile_store(lds, 0, tid, rk, rv);
    if (1 < nt) tile_store(lds, 1, tid, rk2, rv2);
    LDS_BARRIER();
}
HD void tp_advance(ldsp_t lds, int tid, const bf16_t* kb, const bf16_t* vb, int t, int nt, TilePipe& tp) {
    if (t + 2 < nt) tile_store(lds, (t + 2) % 3, tid, tp.k1, tp.v1);
    if (t + 3 < nt) tile_load(kb + (size_t)(t + 3) * 4096, vb + (size_t)(t + 3) * 4096, tid, tp.k1, tp.v1);
    LDS_BARRIER();
}
struct TileParm { bool masked, sel, skip; int lim2, lo2; };
struct BranchCtx { int qt, pos, hi, nlim, nlim_min, kb0; unsigned long long selmask; };
template <int BR> HD TileParm tile_parm(int t, const BranchCtx& x) {
    TileParm q; q.skip = false; q.sel = true; q.lo2 = -100000; q.lim2 = 0;
    if (BR == 0) { q.masked = !(64 * t + 63 <= x.nlim_min); q.lim2 = x.nlim - 64 * t - 4 * x.hi; }
    else if (BR == 1) { const bool s = ((x.selmask >> t) & 1ull) != 0ull; q.masked = t >= x.qt;
        if (q.masked) q.lim2 = s ? x.pos - 64 * t - 4 * x.hi : -100000; else { q.sel = s; q.skip = __ballot(s) == 0ull; } }
    else { const int kbx = x.kb0 + t, off = 64 * kbx + 4 * x.hi; q.masked = !(kbx < x.qt && kbx > x.qt - 8); q.lim2 = x.pos - off; q.lo2 = x.pos - WIN - off; }
    return q;
}
HD void sm_pv(ldsp_t lds, int buf, const TileParm& q, f32x16& s0, f32x16& s1, AttnSt& st, int c, int hi) {
    bf16x8 pf[4];
    if (q.masked) sm_tile<true>(s0, s1, q.lim2, q.lo2, true, st.l, pf); else sm_tile<false>(s0, s1, 0, 0, q.sel, st.l, pf);
    pv_tile(lds, buf, pf, st, c, hi);
}
HD void qk_sm_int(ldsp_t lds, int bufn, const bf16x8 (&qf)[4], float mb, f32x16& n0, f32x16& n1, f32x16& c0, f32x16& c1, bool sel, float& l, bf16x8 (&pf)[4], int c, int hi) {
    for (int r = 0; r < 16; ++r) { n0[r] = -mb; n1[r] = -mb; }
    const ldsp_t kt = lds + NSA_KT + bufn * KT_BYTES + c * KT_STRIDE + hi * 16;
    bf16x8 k0 = *(const LDSQ bf16x8*)(kt), k1 = *(const LDSQ bf16x8*)(kt + 32 * KT_STRIDE);
    float ls = 0.f;
#pragma unroll
    for (int ks = 0; ks < 4; ++ks) {
        n0 = __builtin_amdgcn_mfma_f32_32x32x16_bf16(k0, qf[ks], n0, 0, 0, 0);
        n1 = __builtin_amdgcn_mfma_f32_32x32x16_bf16(k1, qf[ks], n1, 0, 0, 0);
        if (ks < 3) { k0 = *(const LDSQ bf16x8*)(kt + (ks + 1) * 32); k1 = *(const LDSQ bf16x8*)(kt + 32 * KT_STRIDE + (ks + 1) * 32); }
#pragma unroll
        for (int r = 4 * ks; r < 4 * ks + 4; ++r) { const float p0 = EXP2F(c0[r]), p1 = EXP2F(c1[r]); c0[r] = p0; c1[r] = p1; ls += p0 + p1; }
        SCHED_FENCE();
    }
    u32x4_t w0, w1, w2, w3;
#pragma unroll
    for (int i = 0; i < 4; ++i) { w0[i] = pack2bf(c0[2 * i], c0[2 * i + 1]); w1[i] = pack2bf(c0[8 + 2 * i], c0[8 + 2 * i + 1]); w2[i] = pack2bf(c1[2 * i], c1[2 * i + 1]); w3[i] = pack2bf(c1[8 + 2 * i], c1[8 + 2 * i + 1]); }
    const unsigned km = sel ? 0xffffffffu : 0u; w0 &= km; w1 &= km; w2 &= km; w3 &= km; l += sel ? ls : 0.f;
    pf[0] = __builtin_bit_cast(bf16x8, w0); pf[1] = __builtin_bit_cast(bf16x8, w1); pf[2] = __builtin_bit_cast(bf16x8, w2); pf[3] = __builtin_bit_cast(bf16x8, w3);
}
template <int BR> HD void nsa_branch(ldsp_t lds, int tid, const bf16_t* kb, const bf16_t* vb, int nt, int i0, int i1, const bf16x8 (&qf)[4], float mb, AttnSt& st, TilePipe& tp, const BranchCtx& x, int c, int hi) {
    tp_start(lds, tid, kb, vb, nt, tp);
    f32x16 a0, a1, b0, b1; bf16x8 pf[4];
    int t = 0;
#pragma unroll 1
    for (; t < i0; ++t) { const TileParm q = tile_parm<BR>(t, x); qk_tile(lds, t % 3, qf, mb, a0, a1, c, hi); sm_pv(lds, t % 3, q, a0, a1, st, c, hi); tp_advance(lds, tid, kb, vb, t, nt, tp); }
    bool pending = false;
    if (t < i1) {
        qk_tile(lds, t % 3, qf, mb, a0, a1, c, hi);
#pragma unroll 1
        for (; t < i1; ++t) {
            const bool sel = BR == 1 ? ((x.selmask >> t) & 1ull) != 0ull : true;
            qk_sm_int(lds, (t + 1) % 3, qf, mb, b0, b1, a0, a1, sel, st.l, pf, c, hi); pv_tile(lds, t % 3, pf, st, c, hi); tp_advance(lds, tid, kb, vb, t, nt, tp);
            a0 = b0; a1 = b1;
        }
        pending = t < nt;
    }
#pragma unroll 1
    for (; t < nt; ++t) { const TileParm q = tile_parm<BR>(t, x); if (!pending) qk_tile(lds, t % 3, qf, mb, a0, a1, c, hi); pending = false; sm_pv(lds, t % 3, q, a0, a1, st, c, hi); tp_advance(lds, tid, kb, vb, t, nt, tp); }
}
struct NsaIdx { int row, head, hi; };
HD NsaIdx nsa_idx(ldsp_t lds, int b, int g, int qt) { const int tid = opaque_tid(), lane = tid & 63, w = tid >> 6, c = lane & 31; NsaIdx x; x.row = b * SEQ + 64 * qt + 8 * w + (c >> 2); x.head = g * 4 + (c & 3); x.hi = lane >> 5; return x; }
HD float nsa_gate(const P& p, ldsp_t lds, int b, int g, int qt, int br) { const NsaIdx x = nsa_idx(lds, b, g, qt); return sigmoidf_(urow(p, x.row)[C_NG + br * 8 + x.head]); }
HD void nsa_load_q(const P& p, ldsp_t lds, int b, int g, int qt, size_t wb, bf16x8 (&qf)[4]) { const NsaIdx x = nsa_idx(lds, b, g, qt);
    const bf16_t* qp = wsb(p, wb) + (size_t)x.row * 512 + x.head * 64 + x.hi * 8;
#pragma unroll
    for (int ks = 0; ks < 4; ++ks) qf[ks] = *(const bf16x8*)(qp + ks * 16); }
HD float nsa_gate_raw(const P& p, ldsp_t lds, int b, int g, int qt, int br) { const NsaIdx x = nsa_idx(lds, b, g, qt); return urow(p, x.row)[C_NG + br * 8 + x.head]; }
HD void nsa_unit(const P& p, int L, ldsp_t lds, int b, int g, int qt) {
    const int tid = opaque_tid(), lane = tid & 63, w = RFL(tid >> 6), c = lane & 31, hi = lane >> 5;
    const int pos = 64 * qt + 8 * w + (c >> 2);
    const size_t bg = (size_t)b * 2 + g;
    bf16x8 qf[4]; TilePipe tp; AttnSt st; f32x16 i0, i1;
    LDSQ float* combl = (LDSQ float*)(lds + NSA_COMB + w * 8192) + lane;
    for (int r = 0; r < 16; ++r) { i0[r] = 0.f; i1[r] = 0.f; }
    bf16x8 qfr[4];
    nsa_load_q(p, lds, b, g, qt, WB_QNB, qf); nsa_load_q(p, lds, b, g, qt, WB_QRB, qfr);
    const float gr0 = nsa_gate_raw(p, lds, b, g, qt, 0), gr1 = nsa_gate_raw(p, lds, b, g, qt, 1), gr2 = nsa_gate_raw(p, lds, b, g, qt, 2);
    attn_init(st);
    {
        const float mb = score_bound(qf, p.k_norm_g + (L * 3 + 0) * 64, lane);
        const int nt_n = ((4 * qt + 2) >> 6) + 1;
        const bf16_t* kb = wsb(p, WB_KCB) + bg * NCPAD * 64; const bf16_t* vb = wsb(p, WB_VCT) + bg * (NCPAD / 64) * 4096;
        const int nlim = (pos - 31) >> 4, nlim_min = (64 * qt + 8 * w - 31) >> 4;
        BranchCtx bx; bx.qt = qt; bx.pos = pos; bx.hi = hi; bx.nlim = nlim; bx.nlim_min = nlim_min; bx.kb0 = 0; bx.selmask = 0ull;
        { int ni = (nlim_min + 1) >> 6; ni = ni < 0 ? 0 : (ni > nt_n ? nt_n : ni);
          nsa_branch<0>(lds, tid, kb, vb, nt_n, 0, ni, qf, mb, st, tp, bx, c, hi); }
        {
            const float lt1 = st.l + __shfl_xor(st.l, 32), inv1 = lt1 > 0.f ? RCPF(lt1) : 0.f;
            tp_start(lds, tid, kb, vb, nt_n, tp);
            for (int t = 0; t < nt_n; ++t) { imp_tile(lds, t % 3, qf, mb, inv1, nlim - 64 * t - 4 * hi, i0, i1, t, c, hi); tp_advance(lds, tid, kb, vb, t, nt_n, tp); }
        }
    }
    unsigned long long selmask;
    {
        const float lt = st.l + __shfl_xor(st.l, 32), inv = lt > 0.f ? RCPF(lt) : 0.f, gate = sigmoidf_(gr0) * inv;
        LDSQ float* impw = (LDSQ float*)(lds + NSA_IMP) + w * 512;
#pragma unroll
        for (int r = 0; r < 16; ++r) { combl[r * 64] = gate * st.o0[r]; combl[(16 + r) * 64] = gate * st.o1[r];
            float v0 = i0[r], v1 = i1[r];
            v0 += __shfl_xor(v0, 1); v0 += __shfl_xor(v0, 2); v1 += __shfl_xor(v1, 1); v1 += __shfl_xor(v1, 2);
            if ((c & 3) == 0) { const int j = (r & 3) + 8 * (r >> 2) + 4 * hi; impw[(c >> 2) * 64 + j] = v0; impw[(c >> 2) * 64 + 32 + j] = v1; } }
        __syncthreads();
        LDSQ unsigned long long* maskw = (LDSQ unsigned long long*)(lds + NSA_MASK) + w * 8;
#pragma unroll 1
        for (int q = 0; q < 8; ++q) {
            const int j = lane; const bool forced = (j == 0) || (j == qt) || (j == qt - 1), valid = j <= qt;
            const unsigned key = forced ? 0xFFFFFFFFu : (valid ? __builtin_bit_cast(unsigned, impw[q * 64 + j]) + 1u : 0u);
            unsigned thr = 0u;
#pragma unroll 4
            for (int bit = 31; bit >= 0; --bit) { const unsigned cand = thr | (1u << bit); if (__builtin_popcountll(__ballot(key >= cand)) >= 16) thr = cand; }
            const unsigned long long mgt = __ballot(key > thr), meq = __ballot(key == thr), below = (lane == 0) ? 0ull : (~0ull >> (64 - lane));
            const int need = 16 - __builtin_popcountll(mgt);
            const bool pick = key > thr || (key == thr && __builtin_popcountll(meq & below) < need);
            const unsigned long long mk = __ballot(pick);
            if (lane == 0) maskw[q] = mk;
        }
        __syncthreads();
        selmask = maskw[c >> 2];
    }
#pragma unroll
    for (int ks = 0; ks < 4; ++ks) qf[ks] = qfr[ks];
    attn_init(st);
    {
        const bf16_t* kb = wsb(p, WB_KSB) + bg * SEQ * 64; const bf16_t* vb = wsb(p, WB_VST) + bg * NQT * 4096;
        const int nt_n = qt + 1; const float mb = score_bound(qf, p.k_norm_g + (L * 3 + 1) * 64, lane);
        BranchCtx bx; bx.qt = qt; bx.pos = pos; bx.hi = hi; bx.nlim = 0; bx.nlim_min = 0; bx.kb0 = 0; bx.selmask = selmask;
        nsa_branch<1>(lds, tid, kb, vb, nt_n, 0, qt, qf, mb, st, tp, bx, c, hi);
        const float lt = st.l + __shfl_xor(st.l, 32), inv = lt > 0.f ? RCPF(lt) : 0.f, gate = sigmoidf_(gr1) * inv;
#pragma unroll
        for (int r = 0; r < 16; ++r) { combl[r * 64] += gate * st.o0[r]; combl[(16 + r) * 64] += gate * st.o1[r]; }
    }
    attn_init(st);
    {
        const bf16_t* kb = wsb(p, WB_KWB) + bg * SEQ * 64; const bf16_t* vb = wsb(p, WB_VWT) + bg * NQT * 4096;
        const int kb0 = qt - 8 > 0 ? qt - 8 : 0, nt_n = qt - kb0 + 1;
        const float mb = score_bound(qf, p.k_norm_g + (L * 3 + 2) * 64, lane);
        const bf16_t* kb2 = kb + (size_t)kb0 * 4096; const bf16_t* vb2 = vb + (size_t)kb0 * 4096;
        BranchCtx bx; bx.qt = qt; bx.pos = pos; bx.hi = hi; bx.nlim = 0; bx.nlim_min = 0; bx.kb0 = kb0; bx.selmask = 0ull;
        nsa_branch<2>(lds, tid, kb2, vb2, nt_n, qt >= 8 ? 1 : 0, nt_n - 1, qf, mb, st, tp, bx, c, hi);
        const float lt = st.l + __shfl_xor(st.l, 32), inv = lt > 0.f ? RCPF(lt) : 0.f, gate = sigmoidf_(gr2) * inv;
#pragma unroll
        for (int r = 0; r < 16; ++r) { st.o0[r] = combl[r * 64] + gate * st.o0[r]; st.o1[r] = combl[(16 + r) * 64] + gate * st.o1[r]; }
    }
    const NsaIdx xo = nsa_idx(lds, b, g, qt); const int hi2 = xo.hi;
    bf16_t* mo = mixb(p) + (size_t)xo.row * D + 256 + xo.head * 64; const URow nz = urow(p, xo.row) + (C_NZ + xo.head * 64);
#pragma unroll
    for (int q4 = 0; q4 < 4; ++q4) { const int d0 = 8 * q4 + 4 * hi2;
        const bf16x4 z0 = *(const bf16x4*)(nz.q + d0), z1 = *(const bf16x4*)(nz.q + 32 + d0); bf16x4 r0, r1;
#pragma unroll
        for (int e = 0; e < 4; ++e) { r0[e] = (short)f2bf(st.o0[4 * q4 + e] * siluf(bf2f((bf16_t)z0[e]))); r1[e] = (short)f2bf(st.o1[4 * q4 + e] * siluf(bf2f((bf16_t)z1[e]))); }
        *(bf16x4*)(mo + d0) = r0; *(bf16x4*)(mo + 32 + d0) = r1; }
}
HD void bphase_nsa_prompt(const P& p, int L, ldsp_t lds) {
    constexpr int NPAIR = BATCH * 2 * (NQT / 2);
    for (int pi0 = blockIdx.x; pi0 < NPAIR; pi0 += gridDim.x) {
        const int G = (int)gridDim.x, pi = (G % 8 == 0 && NPAIR % G == 0) ? ((pi0 % G) % 8) * (G / 8) + (pi0 % G) / 8 + (pi0 / G) * G : pi0;
        const int bgi = pi / (NQT / 2), q = pi % (NQT / 2);
        nsa_unit(p, L, lds, bgi >> 1, bgi & 1, NQT - 1 - q);
        nsa_unit(p, L, lds, bgi >> 1, bgi & 1, q);
    }
}

#ifdef CPU_EMU
#define WAVE_SYNC() emu_wave_sync()
#else
#define WAVE_SYNC() do { __builtin_amdgcn_fence(__ATOMIC_ACQ_REL, "wavefront"); __builtin_amdgcn_wave_barrier(); } while (0)
#endif
constexpr int GL_Q = 0, GL_K = 5120, GL_V = 10240, GL_WAVE = 19456;
HD int sw64(int row, int chunk) { return row * 80 + (chunk << 4); }
HD int sw128(int row, int chunk) { return row * 144 + (chunk << 4); }
HD int swv(int row, int q) { return row * 136 + (q << 3); }
static_assert(GL_V + 64 * 136 <= GL_WAVE && 64 * 144 <= GL_V, "per-wave LDS map");
HD float* gs_loc(const P& p, int b, int h, int c) { return p.ws + W_GSLOC + (((size_t)b * 4 + h) * NQT + c) * 2048; }
HD float* gs_bl(const P& p, int b, int h, int c) { return p.ws + W_GSBL + (((size_t)b * 4 + h) * NQT + c) * 32; }
template <class Src> HD void stage_vt_load(Src vsrc  , size_t row_stride, int lane, float (&tmp)[64]) {
#pragma unroll
    for (int j = 0; j < 64; ++j) tmp[j] = vsrc[(size_t)j * row_stride + lane];
}
HD void stage_vt_store(ldsp_t lw, int lane, const float (&tmp)[64]) {
#pragma unroll
    for (int j = 0; j < 64; ++j) *(LDSQ bf16_t*)(lw + GL_V + swv(lane, j >> 2) + (j & 3) * 2) = f2bf(tmp[j]);
    SCHED_FENCE();
}
HD bf16x8 ld_vt_frag(ldsp_t lw, int e, int q) {
    const bf16x4 a = *(const LDSQ bf16x4*)(lw + GL_V + swv(e, q)), b = *(const LDSQ bf16x4*)(lw + GL_V + swv(e, q + 2)); bf16x8 v;
    for (int j = 0; j < 4; ++j) { v[j] = a[j]; v[4 + j] = b[j]; } return v;
}
HD bf16x8 ld_vt_nat(ldsp_t lw, int e, int q) {
    const bf16x4 a = *(const LDSQ bf16x4*)(lw + GL_V + swv(e, q)), b = *(const LDSQ bf16x4*)(lw + GL_V + swv(e, q + 1)); bf16x8 v;
    for (int j = 0; j < 4; ++j) { v[j] = a[j]; v[4 + j] = b[j]; } return v;
}
HD void gla_cumsum(const P& p, int row0, int h, int lane, float (&bc)[32], float& tot0, float& blast) {
    const int dk = lane & 31, half = lane >> 5; const float* la = p.ws + W_LOGA + (size_t)(row0 + half * 32) * 128 + h * 32 + dk; float run = 0.f;
#pragma unroll
    for (int i = 0; i < 32; ++i) { run += la[(size_t)i * 128]; bc[i] = run; }
    tot0 = __shfl(run, dk); const float tot1 = __shfl(run, 32 + dk); blast = tot0 + tot1;
    if (half) {
#pragma unroll
        for (int i = 0; i < 32; ++i) bc[i] += tot0; }
}
HD void gla_g1_unit(const P& p, int L, ldsp_t lw, int b, int h, int c, int lane_) {
    const int lane = opaque_i(lane_);
    const int row0 = b * SEQ + c * 64, dk = lane & 31, half = lane >> 5, hi = half;
    WAVE_SYNC();
    float bc[32], tot0, blast; gla_cumsum(p, row0, h, lane, bc, tot0, blast);
    float vtmp[64]; stage_vt_load(urow(p, row0) + (C_GV + h * 64), U_LD, lane, vtmp);
    const URow ku = urow(p, row0 + half * 32) + (C_GK + h * 32 + dk);
#pragma unroll
    for (int i = 0; i < 32; ++i) { const int j = half * 32 + i;
        *(LDSQ bf16_t*)(lw + GL_Q + sw128(dk, j >> 3) + (j & 7) * 2) = f2bf(ku[(size_t)i * U_LD] * EXPF(blast - bc[i])); }
    stage_vt_store(lw, lane, vtmp);
    if (lane < 32) gs_bl(p, b, h, c)[lane] = blast;
    WAVE_SYNC();
    f32x16 a0, a1;
    for (int r = 0; r < 16; ++r) { a0[r] = 0.f; a1[r] = 0.f; }
#pragma unroll
    for (int ks = 0; ks < 4; ++ks) {
        const bf16x8 kf = *(const LDSQ bf16x8*)(lw + GL_Q + sw128(dk, 2 * ks + hi));
        a0 = __builtin_amdgcn_mfma_f32_32x32x16_bf16(ld_vt_nat(lw, dk, 4 * ks + 2 * hi), kf, a0, 0, 0, 0);
        a1 = __builtin_amdgcn_mfma_f32_32x32x16_bf16(ld_vt_nat(lw, 32 + dk, 4 * ks + 2 * hi), kf, a1, 0, 0, 0);
    }
    float* so = gs_loc(p, b, h, c);
#pragma unroll
    for (int r = 0; r < 16; ++r) { const int e = (r & 3) + 8 * (r >> 2) + 4 * hi; so[e * 32 + dk] = a0[r]; so[(32 + e) * 32 + dk] = a1[r]; }
}
HD void k_gla_scan(const P& p, int L, long it) {
    const int d = (int)(it % 32), e = (int)((it / 32) % 64), h = (int)((it / 2048) % 4), b = (int)(it / 8192); float S = 0.f;
    for (int c0 = 0; c0 < NQT; c0 += 16) { float loc[16], al[16];
#pragma unroll
        for (int k = 0; k < 16; ++k) { const int c = c0 + k < NQT ? c0 + k : NQT - 1; loc[k] = gs_loc(p, b, h, c)[e * 32 + d]; al[k] = gs_bl(p, b, h, c)[d]; }
#pragma unroll
        for (int k = 0; k < 16; ++k) if (c0 + k < NQT) { const float prev = S; S = EXPF(al[k]) * S + loc[k]; loc[k] = prev; }
#pragma unroll
        for (int k = 0; k < 16; ++k) if (c0 + k < NQT) gs_loc(p, b, h, c0 + k)[e * 32 + d] = loc[k]; }
    p.out[O_PGLA + (((size_t)L * BATCH + b) * 4 + h) * 2048 + d * 64 + e] = S;
}
HD void gla_g2_unit(const P& p, int L, ldsp_t lw, int b, int h, int c, int lane_) {
    const int lane = opaque_i(lane_);
    const int row0 = b * SEQ + c * 64, dk = lane & 31, half = lane >> 5, hi = half, cl = lane & 31;
    WAVE_SYNC();
    float bc[32], tot0, blast; gla_cumsum(p, row0, h, lane, bc, tot0, blast);
    float svr[2][2][8];
    { const float* ss = gs_loc(p, b, h, c);
#pragma unroll
      for (int et = 0; et < 2; ++et)
#pragma unroll
        for (int ks = 0; ks < 2; ++ks) ld8f(ss + (32 * et + cl) * 32 + 16 * ks + 8 * hi, svr[et][ks]); }
    float vtmp[64]; stage_vt_load(urow(p, row0) + (C_GV + h * 64), U_LD, lane, vtmp);
    const URow qu = urow(p, row0 + half * 32) + (C_GQ + h * 32 + dk); const URow ku = qu + (C_GK - C_GQ);
#pragma unroll
    for (int i = 0; i < 32; ++i) { const int j = half * 32 + i; const float dl = bc[i] - tot0;
        *(LDSQ bf16_t*)(lw + GL_Q + sw64(j, dk >> 3) + (dk & 7) * 2) = f2bf(qu[(size_t)i * U_LD] * 0.17677669529663687f * EXPF(dl));
        *(LDSQ bf16_t*)(lw + GL_K + sw64(j, dk >> 3) + (dk & 7) * 2) = f2bf(ku[(size_t)i * U_LD] * EXPF(-dl)); }
    stage_vt_store(lw, lane, vtmp);
    WAVE_SYNC();
    bf16x8 sf[2][2];
    {
#pragma unroll
      for (int et = 0; et < 2; ++et)
#pragma unroll
        for (int ks = 0; ks < 2; ++ks)
            {
#pragma unroll
              for (int jj = 0; jj < 8; ++jj) { const int d = 16 * ks + 8 * hi + jj; const float br = __shfl(tot0, d); sf[et][ks][jj] = (short)f2bf(svr[et][ks][jj] * EXPF(br)); } } }
    const URow gz = urow(p, row0) + (C_GZ + h * 64); const float* ng = p.gla_norm_g + L * 64;
#pragma unroll
    for (int it = 0; it < 2; ++it) {
        const int i = 32 * it + cl;
        bf16x8 qf[2];
        qf[0] = *(const LDSQ bf16x8*)(lw + GL_Q + sw64(i, hi)); qf[1] = *(const LDSQ bf16x8*)(lw + GL_Q + sw64(i, 2 + hi));
        f32x16 o0, o1;
        for (int r = 0; r < 16; ++r) { o0[r] = 0.f; o1[r] = 0.f; }
#pragma unroll
        for (int ks = 0; ks < 2; ++ks) { o0 = __builtin_amdgcn_mfma_f32_32x32x16_bf16(sf[0][ks], qf[ks], o0, 0, 0, 0); o1 = __builtin_amdgcn_mfma_f32_32x32x16_bf16(sf[1][ks], qf[ks], o1, 0, 0, 0); }
#pragma unroll
        for (int jt = 0; jt <= it; ++jt) {
            f32x16 at;
            for (int r = 0; r < 16; ++r) at[r] = 0.f;
#pragma unroll
            for (int ks = 0; ks < 2; ++ks) at = __builtin_amdgcn_mfma_f32_32x32x16_bf16(*(const LDSQ bf16x8*)(lw + GL_K + sw64(32 * jt + cl, 2 * ks + hi)), qf[ks], at, 0, 0, 0);
            bf16x8 pf[2];
#pragma unroll
            for (int r = 0; r < 16; ++r) { const int jl = (r & 3) + 8 * (r >> 2) + 4 * hi; const float v = (jt < it || jl <= cl) ? at[r] : 0.f; pf[r >> 3][r & 7] = (short)f2bf(v); }
#pragma unroll
            for (int s = 0; s < 2; ++s) { const int q = 8 * jt + 4 * s + hi;
                o0 = __builtin_amdgcn_mfma_f32_32x32x16_bf16(ld_vt_frag(lw, cl, q), pf[s], o0, 0, 0, 0);
                o1 = __builtin_amdgcn_mfma_f32_32x32x16_bf16(ld_vt_frag(lw, 32 + cl, q), pf[s], o1, 0, 0, 0); }
        }
        float ss = 0.f;
#pragma unroll
        for (int r = 0; r < 16; ++r) ss += o0[r] * o0[r] + o1[r] * o1[r];
        ss += __shfl_xor(ss, 32);
        const float rs = RSQRTF(ss * (1.0f / 64) + 1e-6f);
        bf16_t* mo = mixb(p) + (size_t)(row0 + i) * D + h * 64; const URow gzr = gz + (size_t)i * U_LD;
#pragma unroll
        for (int q4 = 0; q4 < 4; ++q4) { const int e0 = 8 * q4 + 4 * hi;
            const bf16x4 z0 = *(const bf16x4*)(gzr.q + e0), z1 = *(const bf16x4*)(gzr.q + 32 + e0); const f32x4 g0 = *(const f32x4*)(ng + e0), g1 = *(const f32x4*)(ng + 32 + e0); bf16x4 r0, r1;
#pragma unroll
            for (int k = 0; k < 4; ++k) { r0[k] = (short)f2bf(o0[4 * q4 + k] * rs * g0[k] * siluf(bf2f((bf16_t)z0[k]))); r1[k] = (short)f2bf(o1[4 * q4 + k] * rs * g1[k] * siluf(bf2f((bf16_t)z1[k]))); }
            *(bf16x4*)(mo + e0) = r0; *(bf16x4*)(mo + 32 + e0) = r1; }
    }
}
constexpr int LDS_WX = LDS_MISC + 1024;
HD float* ml_cloc(const P& p, int b, int h, int c) { return p.ws + W_MCLOC + (((size_t)b * 4 + h) * NQT + c) * 4160; }
HD float* ml_fg(const P& p, int b, int h, int c) { return p.ws + W_MFG + (((size_t)b * 4 + h) * NQT + c) * 4; }
HD float wave_max(float v) { for (int o = 1; o < 64; o <<= 1) v = fmaxf(v, __shfl_xor(v, o)); return v; }
HD void ml_gates(const P& p, int L, int row0, int h, int lane, float& ii, float& fcum) {
    const URow u = urow(p, row0 + lane) + C_MIF;
    ii = u[h] + p.gate_b[(L * 2 + 0) * 4 + h]; float f = log_sigmoidf(u[4 + h] + p.gate_b[(L * 2 + 1) * 4 + h]);
    for (int o = 1; o < 64; o <<= 1) { const float t = __shfl(f, lane - o >= 0 ? lane - o : lane); if (lane >= o) f += t; }
    fcum = f;
}
HD void ml_g1_unit(const P& p, int L, ldsp_t lw, int b, int h, int c, int lane_) {
    const int lane = opaque_i(lane_);
    const int row0 = b * SEQ + c * 64, cl = lane & 31, hi = lane >> 5;
    WAVE_SYNC();
    float ii, fcum; ml_gates(p, L, row0, h, lane, ii, fcum);
    const float F = __shfl(fcum, 63), g = ii - fcum, G = F + wave_max(g), wj = EXPF(F + g - G);
    float nacc = 0.f;
    float vtmp[64]; stage_vt_load(urow(p, row0) + (C_MV + h * 64), U_LD, lane, vtmp);
    const float* ku = p.ws + W_MK + (size_t)row0 * 256 + h * 64 + lane;
#pragma unroll 32
    for (int j = 0; j < 64; ++j) { const float v = ku[(size_t)j * 256] * __shfl(wj, j); nacc += v; *(LDSQ bf16_t*)(lw + GL_Q + sw128(lane, j >> 3) + (j & 7) * 2) = f2bf(v); }
    stage_vt_store(lw, lane, vtmp);
    WAVE_SYNC();
    f32x16 a[2][2];
    for (int x = 0; x < 4; ++x) for (int r = 0; r < 16; ++r) a[x >> 1][x & 1][r] = 0.f;
#pragma unroll
    for (int ks = 0; ks < 4; ++ks) {
        const bf16x8 v0 = ld_vt_nat(lw, cl, 4 * ks + 2 * hi), v1 = ld_vt_nat(lw, 32 + cl, 4 * ks + 2 * hi);
#pragma unroll
        for (int dt = 0; dt < 2; ++dt) { const bf16x8 kf = *(const LDSQ bf16x8*)(lw + GL_Q + sw128(32 * dt + cl, 2 * ks + hi));
            a[0][dt] = __builtin_amdgcn_mfma_f32_32x32x16_bf16(v0, kf, a[0][dt], 0, 0, 0); a[1][dt] = __builtin_amdgcn_mfma_f32_32x32x16_bf16(v1, kf, a[1][dt], 0, 0, 0); }
    }
    float* so = ml_cloc(p, b, h, c);
#pragma unroll
    for (int et = 0; et < 2; ++et)
#pragma unroll
        for (int dt = 0; dt < 2; ++dt)
#pragma unroll
            for (int r = 0; r < 16; ++r) so[(32 * et + (r & 3) + 8 * (r >> 2) + 4 * hi) * 64 + 32 * dt + cl] = a[et][dt][r];
    so[64 * 64 + lane] = nacc;
    if (lane == 0) { float* fg = ml_fg(p, b, h, c); fg[0] = F; fg[1] = G; }
}
HD void k_ml_scan(const P& p, int L, long it) {
    const int d = (int)(it % 64), e = (int)((it / 64) % 65), h = (int)((it / 4160) % 4), b = (int)(it / 16640); float S = 0.f, ms = 0.f;
    for (int c0 = 0; c0 < NQT; c0 += 16) { float loc[16], Fv[16], Gv[16];
#pragma unroll
        for (int k = 0; k < 16; ++k) { const int c = c0 + k < NQT ? c0 + k : NQT - 1; loc[k] = ml_cloc(p, b, h, c)[e * 64 + d]; const float* fg = ml_fg(p, b, h, c); Fv[k] = fg[0]; Gv[k] = fg[1]; }
#pragma unroll
        for (int k = 0; k < 16; ++k) if (c0 + k < NQT) { const float mn = fmaxf(Fv[k] + ms, Gv[k]), prev = S; S = EXPF(Fv[k] + ms - mn) * S + EXPF(Gv[k] - mn) * loc[k]; loc[k] = prev; Fv[k] = ms; ms = mn; }
#pragma unroll
        for (int k = 0; k < 16; ++k) if (c0 + k < NQT) { ml_cloc(p, b, h, c0 + k)[e * 64 + d] = loc[k]; if (e == 64 && d == 0) ml_fg(p, b, h, c0 + k)[2] = Fv[k]; } }
    const size_t sb = ((size_t)L * BATCH + b) * 4 + h;
    if (e < 64) p.out[O_PC + (sb * 64 + e) * 64 + d] = S; else { p.out[O_PN + sb * 64 + d] = S; if (d == 0) p.out[O_PM + sb] = ms; }
}
HD void ml_g2_unit(const P& p, int L, ldsp_t lw, LDSQ float* gx, int b, int h, int c, int lane_) {
    const int lane = opaque_i(lane_);
    const int row0 = b * SEQ + c * 64, cl = lane & 31, hi = lane >> 5;
    WAVE_SYNC();
    float ii, fcum; ml_gates(p, L, row0, h, lane, ii, fcum);
    const float ms = ml_fg(p, b, h, c)[2], g = ii - fcum;
    float M = fmaxf(g, ms);
    for (int o = 1; o < 64; o <<= 1) { const float t = __shfl(M, lane - o >= 0 ? lane - o : lane); if (lane >= o) M = fmaxf(M, t); }
    gx[lane] = g;
    { float vtmp[64]; stage_vt_load(urow(p, row0) + (C_MV + h * 64), U_LD, lane, vtmp);
      const float* ku = p.ws + W_MK + (size_t)row0 * 256 + h * 64 + lane;
#pragma unroll 32
      for (int j = 0; j < 64; ++j) *(LDSQ bf16_t*)(lw + GL_Q + sw128(j, lane >> 3) + (lane & 7) * 2) = f2bf(ku[(size_t)j * 256]);
      SCHED_FENCE();
      stage_vt_store(lw, lane, vtmp); }
    WAVE_SYNC();
    const float* cs = ml_cloc(p, b, h, c);
    const float* ng = p.ml_norm_g + L * 64;
#pragma unroll 1
    for (int it = 0; it < 2; ++it) {
        const int i = 32 * it + cl; const float Mi = __shfl(M, i), fi = __shfl(fcum, i), wint = EXPF(ms - Mi);
        const float* qr = p.ws + W_MQ + (size_t)(row0 + i) * 256 + h * 64;
        bf16x8 qf[4]; float nq = 0.f; float ca[4][8], cb[4][8];
#pragma unroll
        for (int ks = 0; ks < 4; ++ks) { ld8f(cs + cl * 64 + 16 * ks + 8 * hi, ca[ks]); ld8f(cs + (32 + cl) * 64 + 16 * ks + 8 * hi, cb[ks]); }
#pragma unroll
        for (int ks = 0; ks < 4; ++ks) { float qv8[8], nv8[8]; ld8f(qr + 16 * ks + 8 * hi, qv8); ld8f(cs + 64 * 64 + 16 * ks + 8 * hi, nv8);
#pragma unroll
            for (int jj = 0; jj < 8; ++jj) { qf[ks][jj] = (short)f2bf(qv8[jj]); nq += qv8[jj] * nv8[jj]; } }
        nq += __shfl_xor(nq, 32);
        f32x16 o0, o1;
        for (int r = 0; r < 16; ++r) { o0[r] = 0.f; o1[r] = 0.f; }
#pragma unroll
        for (int ks = 0; ks < 4; ++ks) { bf16x8 c0, c1;
#pragma unroll
            for (int jj = 0; jj < 8; ++jj) { c0[jj] = (short)f2bf(ca[ks][jj]); c1[jj] = (short)f2bf(cb[ks][jj]); }
            o0 = __builtin_amdgcn_mfma_f32_32x32x16_bf16(c0, qf[ks], o0, 0, 0, 0); o1 = __builtin_amdgcn_mfma_f32_32x32x16_bf16(c1, qf[ks], o1, 0, 0, 0); }
        bf16_t* mo = mixb(p) + (size_t)(row0 + i) * D + 768 + h * 64; const URow ur = urow(p, row0 + i);
        bf16x4 ga0[4], ga1[4], gz0[4], gz1[4];
#pragma unroll
        for (int q4 = 0; q4 < 4; ++q4) { const int e0 = 8 * q4 + 4 * hi; const bf16_t* uo = ur.q + C_MO + h * 64 + e0; const bf16_t* uz = ur.q + C_MZ + h * 64 + e0;
            ga0[q4] = *(const bf16x4*)uo; ga1[q4] = *(const bf16x4*)(uo + 32); gz0[q4] = *(const bf16x4*)uz; gz1[q4] = *(const bf16x4*)(uz + 32); }
        SCHED_FENCE();
#pragma unroll
        for (int r = 0; r < 16; ++r) { o0[r] *= wint; o1[r] *= wint; }
        float dsum = 0.f;
#pragma unroll 1
        for (int jt = 0; jt <= it; ++jt) {
            f32x16 st;
            for (int r = 0; r < 16; ++r) st[r] = 0.f;
#pragma unroll
            for (int ks = 0; ks < 4; ++ks) st = __builtin_amdgcn_mfma_f32_32x32x16_bf16(*(const LDSQ bf16x8*)(lw + GL_Q + sw128(32 * jt + cl, 2 * ks + hi)), qf[ks], st, 0, 0, 0);
            bf16x8 pf[2];
#pragma unroll
            for (int r = 0; r < 16; ++r) { const int jl = (r & 3) + 8 * (r >> 2) + 4 * hi;
                const float v = (jt < it || jl <= cl) ? st[r] * EXPF(gx[32 * jt + jl] - Mi) : 0.f; dsum += v; pf[r >> 3][r & 7] = (short)f2bf(v); }
#pragma unroll
            for (int s = 0; s < 2; ++s) { const int q = 8 * jt + 4 * s + hi;
                o0 = __builtin_amdgcn_mfma_f32_32x32x16_bf16(ld_vt_frag(lw, cl, q), pf[s], o0, 0, 0, 0);
                o1 = __builtin_amdgcn_mfma_f32_32x32x16_bf16(ld_vt_frag(lw, 32 + cl, q), pf[s], o1, 0, 0, 0); }
        }
        dsum += __shfl_xor(dsum, 32);
        const float den = wint * nq + dsum, hinv = RCPF(fmaxf(fabsf(den), EXPF(-(fi + Mi))));
        float ss = 0.f;
#pragma unroll
        for (int r = 0; r < 16; ++r) { o0[r] *= hinv; o1[r] *= hinv; ss += o0[r] * o0[r] + o1[r] * o1[r]; }
        ss += __shfl_xor(ss, 32);
        const float rs = RSQRTF(ss * (1.0f / 64) + 1e-6f);
#pragma unroll
        for (int q4 = 0; q4 < 4; ++q4) { const int e0 = 8 * q4 + 4 * hi;
            const bf16x4 a0 = ga0[q4], a1 = ga1[q4], z0 = gz0[q4], z1 = gz1[q4]; const f32x4 g0 = *(const f32x4*)(ng + e0), g1 = *(const f32x4*)(ng + 32 + e0); bf16x4 r0, r1;
#pragma unroll
            for (int k = 0; k < 4; ++k) { r0[k] = (short)f2bf(o0[4 * q4 + k] * rs * g0[k] * sigmoidf_(bf2f((bf16_t)a0[k])) * siluf(bf2f((bf16_t)z0[k])));
                r1[k] = (short)f2bf(o1[4 * q4 + k] * rs * g1[k] * sigmoidf_(bf2f((bf16_t)a1[k])) * siluf(bf2f((bf16_t)z1[k]))); }
            *(bf16x4*)(mo + e0) = r0; *(bf16x4*)(mo + 32 + e0) = r1; }
    }
}
HD void bphase_rec_g1(const P& p, int L, ldsp_t lds) {
    const int w = RFL(opaque_tid() >> 6); const ldsp_t lw = lds + w * GL_WAVE; constexpr int NU = BATCH * 4 * NQT;
#define lane (opaque_tid() & 63)
    for (int u2 = blockIdx.x * 8 + w; u2 < 2 * NU; u2 += gridDim.x * 8) { const int u = u2 % NU;
        if (u2 < NU) gla_g1_unit(p, L, lw, u / (4 * NQT), (u / NQT) % 4, u % NQT, lane); else ml_g1_unit(p, L, lw, u / (4 * NQT), (u / NQT) % 4, u % NQT, lane); }
#undef lane
}
HD void bphase_rec_g2(const P& p, int L, ldsp_t lds) {
    const int w = RFL(opaque_tid() >> 6); const ldsp_t lw = lds + w * GL_WAVE; LDSQ float* gx = (LDSQ float*)(lds + LDS_WX + w * 256); constexpr int NU = BATCH * 4 * NQT;
#define lane (opaque_tid() & 63)
    for (int u2 = blockIdx.x * 8 + w; u2 < 2 * NU; u2 += gridDim.x * 8) { const int u = u2 % NU;
        if (u2 < NU) gla_g2_unit(p, L, lw, u / (4 * NQT), (u / NQT) % 4, u % NQT, lane); else ml_g2_unit(p, L, lw, gx, u / (4 * NQT), (u / NQT) % 4, u % NQT, lane); }
#undef lane
}

constexpr int CS_STRIDE = 528, CS_BUF = 33 * CS_STRIDE, CS_GROUP = 2 * CS_BUF;
static_assert(2 * CS_GROUP + 32 * 256 * 4 <= LDS_MISC, "summary staging + partial-sum exchange fit the scratch region");
HD bf16_t* wctp(const P& p, int L, int kv) { return (bf16_t*)((char*)p.ws + WB_WCT) + ((size_t)(L * 2 + kv)) * 64 * 2048; }
HD void k_prep_wc(const P& p, int L, long it) {
    const int lane = (int)(it % 64), et = (int)((it / 64) % 2), ks = (int)((it / 128) % 4), hs = (int)((it / 512) % 2), r = (int)((it / 1024) % 16), kv = (int)((it / 16384) % 2), L2 = (int)(it / 32768);
    bf16_t* o = wctp(p, L2, kv) + (size_t)(it % 16384) * 8; const int e = 32 * et + (lane & 31), s = 16 * hs + r, d0 = 16 * ks + 8 * (lane >> 5);
    const float* w = p.cmp_w + (((size_t)(L2 * 2 + kv) * 32 + s) * 64 + d0) * 64 + e;
    for (int j = 0; j < 8; ++j) o[j] = f2bf(w[(size_t)j * 64]);
}
HD void k_cmp_pad(const P& p, int L, long it) {
    const int g = (int)(it % 2); const long q = it / 2; const int j = (int)(q % NCPAD), s = (int)(q / NCPAD);
    if (j < seq_ncmp(s)) return;
    bf16_t* kb = wsb(p, WB_KCB) + (((size_t)s * 2 + g) * NCPAD + j) * 64; bf16_t* vt = wsb(p, WB_VCT) + (((size_t)s * 2 + g) * (NCPAD / 64) + j / 64) * 4096 + (j % 64);
    for (int d = 0; d < 64; ++d) { kb[d] = 0; vt[(size_t)d * 64] = 0; }
}
HD void cs_stage_load(const float* const (&bp)[9], int r, f32x4 (&rg)[9]) {
#pragma unroll
    for (int q = 0; q < 9; ++q) { f32x4 v = {0.f, 0.f, 0.f, 0.f}; if (bp[q]) v = *(const f32x4*)(bp[q] + (size_t)r * 512); rg[q] = v; }
}
HD void cs_stage_store(ldsp_t lg, int buf, int tl, const f32x4 (&rg)[9]) {
#pragma unroll
    for (int q = 0; q < 9; ++q) { const int i = tl + q * 256; const int jj = i >> 6, c4 = i & 63;
        if (i < 33 * 64) { bf16x4 o; for (int e = 0; e < 4; ++e) o[e] = (short)f2bf(rg[q][e]); *(LDSQ bf16x4*)(lg + buf * CS_BUF + jj * CS_STRIDE + c4 * 8) = o; } }
}
template <int WHICH  > HD void bphase_cmp_sum_t(const P& p, int L, ldsp_t lds) {
    const int tid = opaque_tid(), lane = tid & 63, w = tid >> 6, grp = w >> 2, kv = (w >> 1) & 1, g = w & 1, tl = tid & 255, cl = lane & 31, hi = lane >> 5;
    constexpr int TP = (SEQ / 16 + 31) / 32, TS = ((PAST_LEN + DEC_SEQ) / 16 + 31) / 32, U0 = WHICH ? BATCH * TP : 0, NUNIT = WHICH ? DEC_BATCH * TS : BATCH * TP;
    constexpr bool SPLIT = (WHICH == 0);
    constexpr int NITER = SPLIT ? NUNIT : (NUNIT + 1) / 2, NSTEP = SPLIT ? 8 : 16;
    const ldsp_t lg = lds + grp * CS_GROUP;
    for (int itx = blockIdx.x; itx < NITER; itx += gridDim.x) {
        const int un = SPLIT ? U0 + itx : U0 + 2 * itx + grp; const bool live = SPLIT ? true : (2 * itx + grp < NUNIT); const int r0 = SPLIT ? 8 * grp : 0;
        int s = 0, t = 0;
        if (live) { if (un < BATCH * TP) { s = un / TP; t = un % TP; } else { s = BATCH + (un - BATCH * TP) / TS; t = (un - BATCH * TP) % TS; } }
        const int nhalf = live ? (s < BATCH ? SEQ / 16 : (PAST_LEN + DEC_SEQ) / 16) : 0, j0 = 32 * t;
        f32x4 rg[9]; f32x16 a0, a1; const float* bp[9];
        for (int r = 0; r < 16; ++r) { a0[r] = 0.f; a1[r] = 0.f; }
#pragma unroll
        for (int q = 0; q < 9; ++q) { const int i = tl + q * 256, jj = i >> 6, c4 = i & 63; bp[q] = (i < 33 * 64 && j0 + jj < nhalf) ? hist(p, L, s, 16 * (j0 + jj), 0, 0) + c4 * 4 : nullptr; }
        cs_stage_load(bp, r0, rg); cs_stage_store(lg, 0, tl, rg); cs_stage_load(bp, r0 + 1, rg); LDS_BARRIER();
        const bf16_t* wt = wctp(p, L, kv) + (size_t)lane * 8;
#define CS_WLOADH(R, HS, WF) { _Pragma("unroll") for (int ks = 0; ks < 4; ++ks) { const bf16_t* wp = wt + ((((R) * 2 + (HS)) * 4 + ks) * 2) * 512; \
            WF[ks][0] = *(const bf16x8*)wp; WF[ks][1] = *(const bf16x8*)(wp + 512); } }
#define CS_COMPUTEH(BUF, HS, WF) { const ldsp_t xb = lg + (BUF) * CS_BUF + cl * CS_STRIDE + (kv * 2 + g) * 128 + hi * 16; \
            _Pragma("unroll") for (int ks = 0; ks < 4; ++ks) { const bf16x8 xf = *(const LDSQ bf16x8*)(xb + (HS) * CS_STRIDE + ks * 32); \
                a0 = __builtin_amdgcn_mfma_f32_32x32x16_bf16(WF[ks][0], xf, a0, 0, 0, 0); \
                a1 = __builtin_amdgcn_mfma_f32_32x32x16_bf16(WF[ks][1], xf, a1, 0, 0, 0); } }
        bf16x8 wfa[4][2], wfb[4][2];
        CS_WLOADH(r0, 0, wfa) CS_WLOADH(r0, 1, wfb)
#pragma unroll 1
        for (int rr = 0; rr < NSTEP; ++rr) {
            const int r = r0 + rr;
            CS_COMPUTEH(rr & 1, 0, wfa)
            if (rr + 1 < NSTEP) CS_WLOADH(r + 1, 0, wfa)
            SCHED_FENCE();
            CS_COMPUTEH(rr & 1, 1, wfb)
            if (rr + 1 < NSTEP) CS_WLOADH(r + 1, 1, wfb)
            SCHED_FENCE();
            if (rr + 1 < NSTEP) cs_stage_store(lg, (rr + 1) & 1, tl, rg);
            if (rr + 2 < NSTEP) cs_stage_load(bp, r + 2, rg);
            LDS_BARRIER();
        }
        if (SPLIT) {
            LDSQ float* xs = (LDSQ float*)(lds + 2 * CS_GROUP) + tl;
            if (grp == 1) {
#pragma unroll
                for (int r = 0; r < 16; ++r) { xs[r * 256] = a0[r]; xs[(16 + r) * 256] = a1[r]; } }
            __syncthreads();
            if (grp == 0) {
#pragma unroll
                for (int r = 0; r < 16; ++r) { a0[r] += xs[r * 256]; a1[r] += xs[(16 + r) * 256]; } }
            __syncthreads();
        }
#undef CS_WLOADH
#undef CS_COMPUTEH
        const int j = j0 + cl; const bool ok = live && j < seq_ncmp(s) && (!SPLIT || grp == 0);
        const float* bias = p.ws + W_CBIAS + L * 128 + kv * 64;
        float ss = 0.f;
#pragma unroll
        for (int r = 0; r < 16; ++r) { const int e = (r & 3) + 8 * (r >> 2) + 4 * hi; a0[r] += bias[e]; a1[r] += bias[32 + e]; ss += a0[r] * a0[r] + a1[r] * a1[r]; }
        ss += __shfl_xor(ss, 32);
        const float rs = kv == 0 ? RSQRTF(ss * (1.0f / 64) + 1e-6f) : 1.0f; const float* kg = p.k_norm_g + (L * 3 + 0) * 64;
        if (ok) {
            bf16_t* kb = wsb(p, WB_KCB) + (((size_t)s * 2 + g) * NCPAD + j) * 64; bf16_t* vt = wsb(p, WB_VCT) + (((size_t)s * 2 + g) * (NCPAD / 64) + j / 64) * 4096 + (j % 64);
#pragma unroll
            for (int r = 0; r < 16; ++r) { const int e = (r & 3) + 8 * (r >> 2) + 4 * hi;
                const float v0 = kv == 0 ? a0[r] * rs * kg[e] : a0[r], v1 = kv == 0 ? a1[r] * rs * kg[32 + e] : a1[r];
                if (kv == 0) { kb[e] = f2bf(v0); kb[32 + e] = f2bf(v1); } else { vt[(size_t)e * 64] = f2bf(v0); vt[(size_t)(32 + e) * 64] = f2bf(v1); } }
        }
    }
}

HD void bphase_cmp_sum_p(const P& p, int L, ldsp_t lds) { bphase_cmp_sum_t<0>(p, L, lds); }
HD void bphase_cmp_sum_s(const P& p, int L, ldsp_t lds) { bphase_cmp_sum_t<1>(p, L, lds); }
constexpr int SP_NCMP = 8, SP_NITEM = 40, SP_STRIDE = 68, SP_WIN0 = 8, SP_NWIN = 3, SP_SLC0 = 11, SP_NSLC = 28, SL_MAX = 4 * SP_NSLC;
constexpr int NJ = NSELS - 1;
static_assert(PAST_LEN % 64 == 0 && NJ <= 128 && NJ >= 16 && WKEEP_S % 64 == 0 && (WKEEP_S + DEC_SEQ + 63) / 64 <= 3 * SP_NWIN, "sample NSA geometry");
HD float* spart(const P& p, int b, int g, int item) { return p.ws + W_SPART + ((((size_t)b * 2 + g) * SP_NITEM + item) * 32) * SP_STRIDE; }
HD int* slist(const P& p, int b, int g) { return (int*)(p.ws + W_SLIST) + ((size_t)b * 2 + g) * 2 * SL_MAX; }
template <bool MASK>
HD void wattn_tile(ldsp_t lw, const bf16x8 (&qf)[4], int lim2, int lo2, bool sel, AttnSt& st, bf16x8 (&pf)[4], int c, int hi) {
    f32x16 s0, s1;
    for (int r = 0; r < 16; ++r) { s0[r] = 0.f; s1[r] = 0.f; }
#pragma unroll
    for (int ks = 0; ks < 4; ++ks) {
        s0 = __builtin_amdgcn_mfma_f32_32x32x16_bf16(*(const LDSQ bf16x8*)(lw + sw128(c, 2 * ks + hi)), qf[ks], s0, 0, 0, 0);
        s1 = __builtin_amdgcn_mfma_f32_32x32x16_bf16(*(const LDSQ bf16x8*)(lw + sw128(32 + c, 2 * ks + hi)), qf[ks], s1, 0, 0, 0);
    }
    float alpha;
    if (softmax_tile<MASK>(s0, s1, lim2, lo2, sel, st, pf, alpha)) {
#pragma unroll
        for (int r = 0; r < 16; ++r) { st.o0[r] *= alpha; st.o1[r] *= alpha; } }
#pragma unroll
    for (int ks = 0; ks < 4; ++ks) {
        st.o0 = __builtin_amdgcn_mfma_f32_32x32x16_bf16(ld_vt_frag(lw, c, 4 * ks + hi), pf[ks], st.o0, 0, 0, 0);
        st.o1 = __builtin_amdgcn_mfma_f32_32x32x16_bf16(ld_vt_frag(lw, 32 + c, 4 * ks + hi), pf[ks], st.o1, 0, 0, 0);
    }
}
HD void wattn_probs(ldsp_t lw, const bf16x8 (&qf)[4], int lim2, float m, float inv, bf16x8 (&pf)[4], int c, int hi) {
    f32x16 s0, s1;
    for (int r = 0; r < 16; ++r) { s0[r] = 0.f; s1[r] = 0.f; }
#pragma unroll
    for (int ks = 0; ks < 4; ++ks) {
        s0 = __builtin_amdgcn_mfma_f32_32x32x16_bf16(*(const LDSQ bf16x8*)(lw + sw128(c, 2 * ks + hi)), qf[ks], s0, 0, 0, 0);
        s1 = __builtin_amdgcn_mfma_f32_32x32x16_bf16(*(const LDSQ bf16x8*)(lw + sw128(32 + c, 2 * ks + hi)), qf[ks], s1, 0, 0, 0);
    }
#pragma unroll
    for (int r = 0; r < 16; ++r) { const int kc = (r & 3) + 8 * (r >> 2);
        s0[r] = kc <= lim2 ? EXP2F(s0[r] - m) * inv : 0.f; s1[r] = kc + 32 <= lim2 ? EXP2F(s1[r] - m) * inv : 0.f; }
#pragma unroll
    for (int j = 0; j < 8; ++j) { pf[0][j] = bfbits(s0[j]); pf[1][j] = bfbits(s0[8 + j]); pf[2][j] = bfbits(s1[j]); pf[3][j] = bfbits(s1[8 + j]); }
}
HD void wimp_tile(const bf16x8 (&pf)[4], f32x16& acc, int nt, int jt, int c, int hi) {
#pragma unroll
    for (int ks = 0; ks < 4; ++ks) { const int base = nt * 64 + 16 * ks + 4 * hi - 4 * (jt * 32 + c); bf16x8 af;
#pragma unroll
        for (int jj = 0; jj < 8; ++jj) { const int dl = base + 8 * (jj >> 2) + (jj & 3); af[jj] = (dl == -1 || dl == 3) ? (short)0x3F80 : ((dl >= 0 && dl <= 2) ? (short)0x4000 : (short)0); }
        acc = __builtin_amdgcn_mfma_f32_32x32x16_bf16(af, pf[ks], acc, 0, 0, 0); }
}
HD void wstage_f32(ldsp_t lw, const float* kbase, const float* vbase, size_t rs, int nvalid, int lane_) {
    const int lane = opaque_i(lane_);
#pragma unroll 4
    for (int i = 0; i < 16; ++i) { const int row = 4 * i + (lane >> 4), c4 = lane & 15; f32x4 kv = {0.f, 0.f, 0.f, 0.f}, vv = {0.f, 0.f, 0.f, 0.f};
        if (row < nvalid) { kv = *(const f32x4*)(kbase + (size_t)row * rs + c4 * 4); vv = *(const f32x4*)(vbase + (size_t)row * rs + c4 * 4); }
        bf16x4 kb; for (int e = 0; e < 4; ++e) kb[e] = (short)f2bf(kv[e]);
        *(LDSQ bf16x4*)(lw + sw128(row, c4 >> 1) + (c4 & 1) * 8) = kb;
#pragma unroll
        for (int e = 0; e < 4; ++e) *(LDSQ bf16_t*)(lw + GL_V + swv(4 * c4 + e, row >> 2) + (row & 3) * 2) = f2bf(vv[e]); }
}
HD void wstage_bf16(ldsp_t lw, const bf16_t* k, const bf16_t* vt, int lane_) {
    const int lane = opaque_i(lane_);
#pragma unroll
    for (int i = 0; i < 8; ++i) { const int id = i * 64 + lane; *(LDSQ bf16x8*)(lw + sw128(id >> 3, id & 7)) = *(const bf16x8*)(k + id * 8); }
#pragma unroll
    for (int i = 0; i < 16; ++i) { const int id = i * 64 + lane; *(LDSQ bf16x4*)(lw + GL_V + swv(id >> 4, id & 15)) = *(const bf16x4*)(vt + id * 4); }
}
HD void wpart_store(const P& p, int b, int g, int item, const AttnSt& st, int c, int hi) {
    float* o = spart(p, b, g, item) + c * SP_STRIDE; const float lt = st.l + __shfl_xor(st.l, 32);
    if (hi == 0) { o[0] = st.m; o[1] = lt; }
#pragma unroll
    for (int r = 0; r < 16; ++r) { const int d = (r & 3) + 8 * (r >> 2) + 4 * hi; o[4 + d] = st.o0[r]; o[4 + 32 + d] = st.o1[r]; }
}
HD void wload_q(const P& p, size_t wb, int b, int g, int c, int hi, bf16x8 (&qf)[4]) {
    const bf16_t* qp = wsb(p, wb) + (size_t)(NP + b * DEC_SEQ + (c >> 2)) * 512 + (g * 4 + (c & 3)) * 64 + hi * 8;
#pragma unroll
    for (int ks = 0; ks < 4; ++ks) qf[ks] = *(const bf16x8*)(qp + ks * 16);
}
static_assert(NCPADS / 64 <= SP_NCMP && SP_NCMP == 8, "one compressed tile per wave");
HD void snsa_cmp_unit(const P& p, int L, ldsp_t lds, int b, int g) {
    const int tid = opaque_tid(), lane = tid & 63, w = RFL(tid >> 6), c = lane & 31, hi = lane >> 5, s = BATCH + b; const size_t sg = (size_t)s * 2 + g;
    const ldsp_t lw = lds + w * GL_WAVE; LDSQ float* mstat = (LDSQ float*)(lds + LDS_WX);
    LDSQ float* impw = (LDSQ float*)lds;
    bf16x8 qf[4], pf[4]; AttnSt st; attn_init(st); f32x16 ima, imb;
    for (int r = 0; r < 16; ++r) { ima[r] = 0.f; imb[r] = 0.f; }
    const bool live = w < NCPADS / 64;
    if (live) {
        wload_q(p, WB_QNB, b, g, c, hi, qf);
        const int nlim = (PAST_LEN + (c >> 2) - 31) >> 4;
        wstage_bf16(lw, wsb(p, WB_KCB) + sg * NCPAD * 64 + (size_t)w * 4096, wsb(p, WB_VCT) + sg * (NCPAD / 64) * 4096 + (size_t)w * 4096, lane); WAVE_SYNC();
        wattn_tile<true>(lw, qf, nlim - 64 * w - 4 * hi, -100000, true, st, pf, c, hi);
        wimp_tile(pf, ima, w, w >> 1, c, hi);
        if ((w & 1) && (w >> 1) + 1 < 4) wimp_tile(pf, imb, w, (w >> 1) + 1, c, hi);
    }
    wpart_store(p, b, g, w, st, c, hi);
    { const float lt = st.l + __shfl_xor(st.l, 32); if (hi == 0) { mstat[(w * 32 + c) * 2] = st.m; mstat[(w * 32 + c) * 2 + 1] = lt; } }
    __syncthreads();
    float f;
    { float M = NEG_BIG;
#pragma unroll
      for (int k = 0; k < 8; ++k) M = fmaxf(M, mstat[(k * 32 + c) * 2]);
      float Lt = 0.f;
#pragma unroll
      for (int k = 0; k < 8; ++k) Lt += mstat[(k * 32 + c) * 2 + 1] * EXP2F(mstat[(k * 32 + c) * 2] - M);
      f = Lt > 0.f ? EXP2F(st.m - M) * RCPF(Lt) : 0.f; }
    for (int i = tid; i < 1024; i += NTHREADS) impw[i] = 0.f;
    __syncthreads();
    if (live) {
#define SNSA_IMP_ADD(IM, JT) { _Pragma("unroll") for (int r = 0; r < 16; ++r) { const int j = (r & 3) + 8 * (r >> 2) + 4 * hi; float v0 = IM[r] * f; \
        v0 += __shfl_xor(v0, 1); v0 += __shfl_xor(v0, 2); if ((c & 3) == 0) LDS_ADDF(&impw[(c >> 2) * 128 + (JT) * 32 + j], v0); } }
        SNSA_IMP_ADD(ima, w >> 1)
        if ((w & 1) && (w >> 1) + 1 < 4) SNSA_IMP_ADD(imb, (w >> 1) + 1)
#undef SNSA_IMP_ADD
    }
    __syncthreads();
    if (w != 0) return;
    unsigned long long u0 = 0ull, u1 = 0ull; unsigned qa = 0u, qb = 0u;
#pragma unroll 1
    for (int q = 0; q < 8; ++q) {
        const int ja = lane, jb = 64 + lane;
        const float sa = (ja < NJ) ? ((ja == 0 || ja == NJ - 1) ? INFINITY : impw[q * 128 + ja]) : -INFINITY, sb = (jb < NJ) ? ((jb == NJ - 1) ? INFINITY : impw[q * 128 + jb]) : -INFINITY;
        int ra = 0, rb = 0;
#pragma unroll 8
        for (int i = 0; i < 64; ++i) { const float a = rlane(sa, i), bq = rlane(sb, i);
            ra += ((a > sa || (a == sa && i < lane)) ? 1 : 0) + ((bq > sa) ? 1 : 0);
            rb += ((a > sb || a == sb) ? 1 : 0) + ((bq > sb || (bq == sb && i < lane)) ? 1 : 0); }
        const bool sela = ra < 15 && ja < NJ, selb = rb < 15 && jb < NJ;
        u0 |= __ballot(sela); u1 |= __ballot(selb); qa |= sela ? (1u << q) : 0u; qb |= selb ? (1u << q) : 0u;
    }
    int* sl = slist(p, b, g);
    const unsigned long long below = (lane == 0) ? 0ull : (~0ull >> (64 - lane));
    const int n0 = __builtin_popcountll(u0), n1 = __builtin_popcountll(u1);
    if ((u0 >> lane) & 1ull) { const int idx = __builtin_popcountll(u0 & below); sl[idx] = lane; sl[SL_MAX + idx] = (int)qa; }
    if ((u1 >> lane) & 1ull) { const int idx = n0 + __builtin_popcountll(u1 & below); sl[idx] = 64 + lane; sl[SL_MAX + idx] = (int)qb; }
    for (int idx = n0 + n1 + lane; idx < SL_MAX; idx += 64) { sl[idx] = (idx == n0 + n1) ? NJ : -1; sl[SL_MAX + idx] = 0xFF; }
}
HD void snsa_win_item(const P& p, int L, ldsp_t lw, int b, int g, int wi, int lane_) {
    const int lane = opaque_i(lane_), c = lane & 31, hi = lane >> 5, t = c >> 2;
    bf16x8 qf[4], pf[4]; AttnSt st; attn_init(st);
    wload_q(p, WB_QRB, b, g, c, hi, qf);
    constexpr int NCT = (WKEEP_S + DEC_SEQ + 63) / 64;
    for (int k = 0; k < 3; ++k) { const int wt = wi * 3 + k; if (wt >= NCT) break;
        const int ci0 = 64 * wt; const float* kbase; int nvalid;
        if (ci0 < WKEEP_S) { kbase = p.state_win + (((size_t)L * DEC_BATCH + b) * WKEEP_S + ci0) * 256 + g * 64; nvalid = 64; }
        else { kbase = p.ws + W_WINNEW + ((size_t)NP + b * DEC_SEQ + (ci0 - WKEEP_S)) * 256 + g * 64; nvalid = WKEEP_S + DEC_SEQ - ci0; }
        WAVE_SYNC(); wstage_f32(lw, kbase, kbase + 128, 256, nvalid, lane); WAVE_SYNC();
        if (ci0 + 63 <= WKEEP_S && ci0 > WKEEP_S + DEC_SEQ - 1 - WIN) wattn_tile<false>(lw, qf, 0, 0, true, st, pf, c, hi);
        else wattn_tile<true>(lw, qf, WKEEP_S + t - ci0 - 4 * hi, WKEEP_S + t - WIN - ci0 - 4 * hi, true, st, pf, c, hi); }
    wpart_store(p, b, g, SP_WIN0 + wi, st, c, hi);
}
HD void snsa_slc_item(const P& p, int L, ldsp_t lw, int b, int g, int si, int lane_) {
    const int lane = opaque_i(lane_), c = lane & 31, hi = lane >> 5, t = c >> 2, s = BATCH + b;
    bf16x8 qf[4], pf[4]; AttnSt st; attn_init(st);
    wload_q(p, WB_QRB, b, g, c, hi, qf);
    const int* sl = slist(p, b, g);
    for (int k = 0; k < 4; ++k) { const int e = si * 4 + k, blk = sl[e]; if (blk < 0) break;
        const unsigned qm = (unsigned)sl[SL_MAX + e];
        const float* kbase = hist(p, L, s, 64 * blk, 2, g); const int nvalid = blk < NJ ? 64 : DEC_SEQ;
        WAVE_SYNC(); wstage_f32(lw, kbase, kbase + 128, 512, nvalid, lane); WAVE_SYNC();
        const bool sel = ((qm >> t) & 1u) != 0u;
        if (blk < NJ) wattn_tile<false>(lw, qf, 0, 0, sel, st, pf, c, hi); else wattn_tile<true>(lw, qf, sel ? PAST_LEN + t - 64 * blk - 4 * hi : -100000, -100000, true, st, pf, c, hi); }
    wpart_store(p, b, g, SP_SLC0 + si, st, c, hi);
}
HD void bphase_snsa_a(const P& p, int L, ldsp_t lds) {
    const int w = RFL(opaque_tid() >> 6); const ldsp_t lw = lds + w * GL_WAVE; const int rb = (int)gridDim.x - 1 - (int)blockIdx.x;
    for (int u = rb; u < DEC_BATCH * 2; u += gridDim.x) { snsa_cmp_unit(p, L, lds, u >> 1, u & 1); __syncthreads(); }
#define lane (opaque_tid() & 63)
    for (int u = blockIdx.x * 8 + w; u < DEC_BATCH * 2 * SP_NWIN; u += gridDim.x * 8) { const int bg = u / SP_NWIN, k = u % SP_NWIN; snsa_win_item(p, L, lw, bg >> 1, bg & 1, k, lane); }
#undef lane
}
HD void bphase_snsa_b(const P& p, int L, ldsp_t lds) {
    const int w = RFL(opaque_tid() >> 6); const ldsp_t lw = lds + w * GL_WAVE;
#define lane (opaque_tid() & 63)
    for (int u = blockIdx.x * 8 + w; u < DEC_BATCH * 2 * SP_NSLC; u += gridDim.x * 8) { const int bg = u / SP_NSLC, k = u % SP_NSLC; snsa_slc_item(p, L, lw, bg >> 1, bg & 1, k, lane); }
#undef lane
}
HD void k_snsa_combine(const P& p, int L, long it) {
    const int d = (int)(it % 64), head = (int)((it / 64) % 8), rs = (int)(it / 512), b = rs / DEC_SEQ, t = rs % DEC_SEQ, g = head >> 2, col = t * 4 + (head & 3), r = NP + rs;
    const URow u = urow(p, r); float o = 0.f;
    for (int br = 0; br < 3; ++br) { const int i0 = br == 0 ? 0 : br == 1 ? SP_SLC0 : SP_WIN0, n = br == 0 ? SP_NCMP : br == 1 ? SP_NSLC : SP_NWIN;
        float M = NEG_BIG; for (int i = 0; i < n; ++i) M = fmaxf(M, spart(p, b, g, i0 + i)[col * SP_STRIDE]);
        float Ls = 0.f, Os = 0.f;
        for (int i = 0; i < n; ++i) { const float* q = spart(p, b, g, i0 + i) + col * SP_STRIDE; const float wgt = EXP2F(q[0] - M); Ls += q[1] * wgt; Os += q[4 + d] * wgt; }
        if (Ls > 0.f) o += sigmoidf_(u[C_NG + br * 8 + head]) * Os * RCPF(Ls); }
    mixb(p)[(size_t)r * D + 256 + head * 64 + d] = f2bf(o * siluf(u[C_NZ + head * 64 + d]));
}

HD float sum8(float v) { v += __shfl_xor(v, 1); v += __shfl_xor(v, 2); v += __shfl_xor(v, 7); return v; }
HD float wave_sum(float v) { v = sum8(v); v += __shfl_xor(v, 15); return (rlane(v, 0) + rlane(v, 16)) + (rlane(v, 32) + rlane(v, 48)); }
HD void cvt8(const bf16x8& x, float (&f)[8]) {
#pragma unroll
    for (int j = 0; j < 8; ++j) f[j] = bf2f((bf16_t)x[j]); }
HD bf16x8 pack8(const float (&f)[8]) { bf16x8 o;
#pragma unroll
    for (int j = 0; j < 8; ++j) o[j] = (short)f2bf(f[j]);
    return o; }
HD void st8f(float* dst, const float (&f)[8]) { f32x4 a = {f[0], f[1], f[2], f[3]}, b = {f[4], f[5], f[6], f[7]}; *(f32x4*)dst = a; *(f32x4*)(dst + 4) = b; }
HD void bphase_xin(const P& p, int L, ldsp_t lds) {
    const int w = RFL(opaque_tid() >> 6), lane = opaque_tid() & 63; const int stride = (int)gridDim.x * 8;
#pragma unroll 1
    for (int r = blockIdx.x * 8 + w; r < NT; r += 2 * stride) {
        const int r2 = r + stride; const bool two = r2 < NT;
        const float* x = xrow(p, L, r); const float* x2 = xrow(p, L, two ? r2 : r); float ss = 0.f, ss2 = 0.f; f32x4 v[4], v2[4];
#pragma unroll
        for (int k = 0; k < 4; ++k) v[k] = *(const f32x4*)(x + k * 256 + lane * 4);
#pragma unroll
        for (int k = 0; k < 4; ++k) v2[k] = *(const f32x4*)(x2 + k * 256 + lane * 4);
#pragma unroll
        for (int k = 0; k < 4; ++k) { ss += v[k][0] * v[k][0] + v[k][1] * v[k][1] + v[k][2] * v[k][2] + v[k][3] * v[k][3]; ss2 += v2[k][0] * v2[k][0] + v2[k][1] * v2[k][1] + v2[k][2] * v2[k][2] + v2[k][3] * v2[k][3]; }
        ss = wave_sum(ss); ss2 = wave_sum(ss2);
        if (lane == 0) { p.ws[W_RSTD + r] = RSQRTF(ss * (1.0f / D) + 1e-6f); if (two) p.ws[W_RSTD + r2] = RSQRTF(ss2 * (1.0f / D) + 1e-6f); }
        bf16_t* o = xbp(p) + (size_t)r * D; bf16_t* o2 = xbp(p) + (size_t)r2 * D;
#pragma unroll
        for (int k = 0; k < 4; ++k) { bf16x4 b; for (int e = 0; e < 4; ++e) b[e] = (short)f2bf(v[k][e]); *(bf16x4*)(o + k * 256 + lane * 4) = b; }
        if (two) {
#pragma unroll
            for (int k = 0; k < 4; ++k) { bf16x4 b; for (int e = 0; e < 4; ++e) b[e] = (short)f2bf(v2[k][e]); *(bf16x4*)(o2 + k * 256 + lane * 4) = b; } }
    }
}
HD void bphase_cmp_bias(const P& p, int L, ldsp_t lds) {
    const int w = RFL(opaque_tid() >> 6), lane = opaque_tid() & 63;
    for (int o = blockIdx.x * 8 + w; o < DEPTH * 128; o += gridDim.x * 8) { const int e = o % 64, lk = o / 64; float s = 0.f;
#pragma unroll 8
        for (int i = 0; i < 32; ++i) { const int q = lane + 64 * i; s += p.cmp_pos[(size_t)lk * 2048 + q] * p.cmp_w[((size_t)lk * 2048 + q) * 64 + e]; }
        s = wave_sum(s);
        if (lane == 0) p.ws[W_CBIAS + o] = s; }
}
template <int IN> HD void bphase_sgemm_t(const P& p, int L, ldsp_t lds) {
    static_assert(NP % 256 == 0, "prompt rows fill whole 256-row GEMM panels");
    constexpr int NTILE = IN ? 4 : 1, N = IN ? D_INP : D, NRT = (NS + 31) / 32, NCG = N / (32 * NTILE), NU = NRT * NCG;
    const int tid = opaque_tid(), w = RFL(tid >> 6), lane = tid & 63;
    const bf16_t* A = IN ? xbp(p) : mixb(p); const bf16_t* Bt = IN ? wintp(p, L) : wouttp(p, L);
    LDSQ float* red = (LDSQ float*)lds;
#pragma unroll 1
    for (int un = blockIdx.x; un < NU; un += gridDim.x) {
        const int rt = un % NRT, cg = un / NRT, row0 = NP + 32 * rt, col0 = cg * 32 * NTILE;
        f32x16 acc[NTILE];
#pragma unroll
        for (int j = 0; j < NTILE; ++j)
#pragma unroll
            for (int e = 0; e < 16; ++e) acc[j][e] = 0.f;
        const bf16_t* ap = A + (size_t)(row0 + (lane & 31)) * D + 128 * w + 8 * (lane >> 5);
        const bf16_t* bp = Bt + (size_t)(col0 + (lane & 31)) * D + 128 * w + 8 * (lane >> 5);
#pragma unroll
        for (int hh = 0; hh < 2; ++hh) {
            bf16x8 af[4], bfr[NTILE][4];
#pragma unroll
            for (int s = 0; s < 4; ++s) af[s] = *(const bf16x8*)(ap + 16 * (4 * hh + s));
#pragma unroll
            for (int j = 0; j < NTILE; ++j)
#pragma unroll
                for (int s = 0; s < 4; ++s) bfr[j][s] = *(const bf16x8*)(bp + (size_t)j * 32 * D + 16 * (4 * hh + s));
#pragma unroll
            for (int s = 0; s < 4; ++s)
#pragma unroll
                for (int j = 0; j < NTILE; ++j) acc[j] = __builtin_amdgcn_mfma_f32_32x32x16_bf16(af[s], bfr[j][s], acc[j], 0, 0, 0);
            SCHED_FENCE();
        }
#pragma unroll
        for (int j = 0; j < NTILE; ++j)
#pragma unroll
            for (int e = 0; e < 16; ++e) red[((w * NTILE + j) * 16 + e) * 64 + lane] = acc[j][e];
        __syncthreads();
        float rsr[2] = {0.f, 0.f};
        if (IN) {
#pragma unroll
            for (int k = 0; k < 2; ++k) { const int reg = w + 8 * k, row = row0 + (reg & 3) + 8 * (reg >> 2) + 4 * (lane >> 5);
                if (L == 0) rsr[k] = row < NT ? p.ws[W_RSTD + row] : 0.f;
                else { const f32x4* q = (const f32x4*)(p.ws + W_XN + (size_t)row * 32); f32x4 a = q[0];
#pragma unroll
                    for (int e = 1; e < 8; ++e) a += q[e];
                    rsr[k] = RSQRTF(((a[0] + a[1]) + (a[2] + a[3])) * (1.0f / D) + 1e-6f); } } }
#pragma unroll
        for (int i = 0; i < NTILE * 2; ++i) { const int idx = tid + 512 * i, ln = idx & 63, reg = (idx >> 6) & 15, j = idx >> 10; float sm = 0.f;
#pragma unroll
            for (int w2 = 0; w2 < 8; ++w2) sm += red[((w2 * NTILE + j) * 16 + reg) * 64 + ln];
            const int row = row0 + (reg & 3) + 8 * (reg >> 2) + 4 * (ln >> 5), col = col0 + 32 * j + (ln & 31);
            if (IN) { if (row < NT) ubase(p)[(size_t)row * U_LD + col] = f2bf(sm * rsr[i & 1]); }
            else { const float y = row < NT ? xrow(p, L, row)[col] + sm : 0.f;
                if (row < NT) (L == DEPTH - 1 ? p.out + O_Y : p.ws + W_Y0)[(size_t)row * D + col] = y;
                if (L + 1 < DEPTH) {
                    if (row < NT) xbp(p)[(size_t)row * D + col] = f2bf(y);
                    float ss = y * y; ss += __shfl_xor(ss, 1); ss += __shfl_xor(ss, 2); ss += __shfl_xor(ss, 4); ss += __shfl_xor(ss, 8); ss += __shfl_xor(ss, 16);
                    if ((ln & 31) == 0 && row < NTP) p.ws[W_XN + (size_t)row * 32 + cg] = ss; } } }
        __syncthreads();
    }
}
HD void bphase_sgemm_in(const P& p, int L, ldsp_t lds) { bphase_sgemm_t<1>(p, L, lds); }
HD void bphase_sgemm_out(const P& p, int L, ldsp_t lds) { bphase_sgemm_t<0>(p, L, lds); }
HD void rope8(float (&x)[8], int l7, const float (&rc)[8], const float (&rsn)[8]) {
#pragma unroll
    for (int j = 0; j < 8; ++j) { const float pt = __shfl_xor(x[j], 1); x[j] = l7 == 0 ? x[j] * rc[j] - pt * rsn[j] : (l7 == 1 ? x[j] * rc[j] + pt * rsn[j] : x[j]); }
}
HD void bphase_rows(const P& p, int L, ldsp_t lds) {
    const int w = RFL(opaque_tid() >> 6), lane = opaque_tid() & 63, l7 = lane & 7;
    constexpr int NGP = NP / 8, NUN = NGP + NS;
#pragma unroll 1
    for (int un = blockIdx.x * 8 + w; un < NUN; un += gridDim.x * 8) {
        const int r0 = un < NGP ? un * 8 : NP + (un - NGP), ntk = un < NGP ? 8 : 1, s = seq_of_row(r0), t0 = r0 - seq_row0(s);
        float pw[3][8];
#pragma unroll
        for (int i = 0; i < 3; ++i) { const int tp = t0 + i;
            if (tp < 3) {
#pragma unroll
                for (int j = 0; j < 8; ++j) pw[i][j] = s < BATCH ? 0.f : p.state_conv[(((size_t)L * DEC_BATCH + (s - BATCH)) * 3 + tp) * 512 + 8 * lane + j]; }
            else cvt8(*(const bf16x8*)(ubase(p) + (size_t)(r0 + i - 3) * U_LD + C_MQK + 8 * lane), pw[i]); }
        const ldsp_t vtl = lds + w * GL_WAVE + lane * 16;
        bf16x8 R1, R2, R3, R5, R7;
        { const bf16_t* ur = ubase(p) + (size_t)r0 * U_LD + 8 * lane;
          R1 = *(const bf16x8*)(ur + 512); R2 = *(const bf16x8*)(ur + 1024); R3 = *(const bf16x8*)(ur + 1536); R5 = *(const bf16x8*)(ur + 2560); R7 = *(const bf16x8*)(ur + 3584); }
#pragma unroll 1
        for (int ti = 0; ti < ntk; ++ti) { {
            const int r = r0 + ti, pos = row_pos(r);
            bf16x8 N1, N2, N3, N5, N7;
            { const bf16_t* ur = ubase(p) + (size_t)(ti + 1 < ntk ? r + 1 : r) * U_LD + 8 * lane;
              N1 = *(const bf16x8*)(ur + 512); N2 = *(const bf16x8*)(ur + 1024); N3 = *(const bf16x8*)(ur + 1536); N5 = *(const bf16x8*)(ur + 2560); N7 = *(const bf16x8*)(ur + 3584); }
            float rc[8], rsn[8];
            { const float ang = (float)pos * rope_inv(l7); float c, sn; SINCOSF(ang, sn, c);
#pragma unroll
              for (int j = 0; j < 8; ++j) { rc[j] = rlane(c, j); rsn[j] = rlane(sn, j); } }
            { float v[8]; cvt8(lane >= 32 ? R1 : R2, v); float ss = 0.f;
#pragma unroll
              for (int j = 0; j < 8; ++j) ss += v[j] * v[j];
              const float rs = RSQRTF(sum8(ss) * (1.0f / 64) + 1e-6f);
#pragma unroll
              for (int j = 0; j < 8; ++j) v[j] *= rs * p.q_norm_g[L * 64 + 8 * l7 + j] * C2LOG;
              const int head = lane >= 32 ? (lane - 32) >> 3 : 4 + (lane >> 3); const size_t qo = (size_t)r * 512 + head * 64 + 8 * l7;
              *(bf16x8*)(wsb(p, WB_QNB) + qo) = pack8(v); rope8(v, l7, rc, rsn); *(bf16x8*)(wsb(p, WB_QRB) + qo) = pack8(v); }
            float* nr = new_rows_ptr(p, L, r);
            if (lane >= 32) { float v[8]; cvt8(R2, v); st8f(nr + ((lane - 32) >> 4) * 128 + (((lane - 32) >> 3) & 1) * 64 + 8 * l7, v); }
            { const int role = lane >> 4, g = (lane >> 3) & 1; float v[8]; cvt8(R3, v); float ss = 0.f;
#pragma unroll
              for (int j = 0; j < 8; ++j) ss += v[j] * v[j];
              const float rs = RSQRTF(sum8(ss) * (1.0f / 64) + 1e-6f);
              float kn[8];
#pragma unroll
              for (int j = 0; j < 8; ++j) kn[j] = v[j] * rs * p.k_norm_g[(L * 3 + (role == 0 ? 1 : 2)) * 64 + 8 * l7 + j];
              rope8(kn, l7, rc, rsn);
              if ((role & 1) == 0) {
#pragma unroll
                  for (int j = 0; j < 8; ++j) v[j] = kn[j]; }
              const bf16x8 vb = pack8(v);
              if (r < NP && (role & 1)) {
#pragma unroll
                  for (int j = 0; j < 8; ++j) *(LDSQ bf16_t*)(vtl + j * 1024 + ti * 2) = (bf16_t)vb[j]; }
              if (role < 2) st8f(nr + (2 + role) * 128 + g * 64 + 8 * l7, v);
              else { st8f(p.ws + W_WINNEW + (size_t)r * 256 + (role - 2) * 128 + g * 64 + 8 * l7, v);
                  float* wo = nullptr; const int t = t0 + ti;
                  if (r < NP) { if (t >= SEQ - WKEEP_P) wo = p.out + O_PWIN + (((size_t)L * BATCH + s) * WKEEP_P + (t - (SEQ - WKEEP_P))) * 256; }
                  else { const int i = WKEEP_S - DEC_SEQ + t; if (i >= 0) wo = p.out + O_SWIN + (((size_t)L * DEC_BATCH + (s - BATCH)) * WKEEP_S + i) * 256; }
                  if (wo) st8f(wo + (role - 2) * 128 + g * 64 + 8 * l7, v); }
              if (r < NP && (role & 1) == 0) *(bf16x8*)(wsb(p, role == 0 ? WB_KSB : WB_KWB) + (((size_t)s * 2 + g) * SEQ + (t0 + ti)) * 64 + 8 * l7) = vb; }
            { float f7[8]; cvt8(R7, f7); float a0 = p.gla_b_gate[L * 128 + lane], a1 = p.gla_b_gate[L * 128 + 64 + lane];
#pragma unroll
              for (int q = 0; q < 16; ++q) { const float x = rlane(f7[q & 7], 32 + (q >> 3)); a0 += x * p.gla_w_gate[(L * 16 + q) * 128 + lane]; a1 += x * p.gla_w_gate[(L * 16 + q) * 128 + 64 + lane]; }
              p.ws[W_LOGA + (size_t)r * 128 + lane] = log_sigmoidf(a0) * (1.0f / 16.0f); p.ws[W_LOGA + (size_t)r * 128 + 64 + lane] = log_sigmoidf(a1) * (1.0f / 16.0f); }
            { float x0[8], o[8]; cvt8(R5, x0);
#pragma unroll
              for (int j = 0; j < 8; ++j) { const int ch = 8 * lane + j; const float* cwp = p.conv_w + (size_t)L * 2048 + ch; const float a = p.conv_b[L * 512 + ch] + pw[0][j] * cwp[0] + pw[1][j] * cwp[512] + pw[2][j] * cwp[1024] + x0[j] * cwp[1536]; o[j] = siluf(a) * (lane < 32 ? 1.0f : 0.125f);
                  pw[0][j] = pw[1][j]; pw[1][j] = pw[2][j]; pw[2][j] = x0[j]; }
              st8f(lane < 32 ? p.ws + W_MQ + (size_t)r * 256 + 8 * lane : p.ws + W_MK + (size_t)r * 256 + 8 * (lane - 32), o); }
            R1 = N1; R2 = N2; R3 = N3; R5 = N5; R7 = N7;
            } SCHED_FENCE();
        }
        if (r0 < NP && ((lane >> 4) & 1)) { const int role = lane >> 4, g = (lane >> 3) & 1;
            bf16_t* vt = wsb(p, role == 1 ? WB_VST : WB_VWT) + (((size_t)s * 2 + g) * NQT + t0 / 64) * 4096 + (size_t)(8 * l7) * 64 + (t0 % 64);
#pragma unroll
            for (int j = 0; j < 8; ++j) *(bf16x8*)(vt + (size_t)j * 64) = *(const LDSQ bf16x8*)(vtl + j * 1024); }
    }
}

typedef void (*ItemFn)(const P&, int, long);
typedef void (*BlockFn)(const P&, int, ldsp_t);
static P make_params(void* const* d_in, void* d_out, void* d_ws) {
    P p;
    p.x_prompt = (const float*)d_in[0]; p.x_sample = (const float*)d_in[1]; p.cache = (const float*)d_in[2]; p.state_win = (const float*)d_in[3];
    p.state_gla = (const float*)d_in[4]; p.state_C = (const float*)d_in[5]; p.state_n = (const float*)d_in[6]; p.state_m = (const float*)d_in[7];
    p.state_conv = (const float*)d_in[8]; p.page_table = (const int*)d_in[9]; p.norm_g = (const float*)d_in[10]; p.w_in = (const float*)d_in[11];
    p.w_out = (const float*)d_in[12]; p.gla_w_gate = (const float*)d_in[13]; p.gla_b_gate = (const float*)d_in[14]; p.gla_norm_g = (const float*)d_in[15];
    p.q_norm_g = (const float*)d_in[16]; p.k_norm_g = (const float*)d_in[17]; p.cmp_pos = (const float*)d_in[18]; p.cmp_w = (const float*)d_in[19];
    p.conv_w = (const float*)d_in[20]; p.conv_b = (const float*)d_in[21]; p.gate_b = (const float*)d_in[22]; p.ml_norm_g = (const float*)d_in[23];
    p.out = (float*)d_out; p.ws = (float*)d_ws;
    return p;
}
#define LAYER_PROGRAM(LL) { const int L = LL; \
        if (XIN_NEEDED(L)) { BLK(bphase_xin); GRID_BAR(); } \
        GEMM_IN(); \
        BLK(bphase_sgemm_in); \
        GRID_BAR(); \
        BLK(bphase_rows); \
        PH(k_win_copy, (long)DEC_BATCH * (WKEEP_S - DEC_SEQ > 0 ? WKEEP_S - DEC_SEQ : 0) * 256); \
        PH(k_conv_out, (long)NSEQ * 3 * 512); \
        GRID_BAR(); \
        BLK(bphase_rec_g1); \
        BLK(bphase_cmp_sum_s); \
        PH(k_cmp_pad, (long)NSEQ * NCPAD * 2); \
        GRID_BAR(); \
        PH_MID(k_gla, (long)DEC_BATCH * 256, 5); \
        PH_MID(k_mlstm, (long)DEC_BATCH * 260, 4); \
        PH_MID(k_gla_scan, (long)BATCH * 8192, 1); \
        PH_MID(k_ml_scan, (long)BATCH * 16640, 0); \
        BLK(bphase_snsa_a); \
        BLK(bphase_cmp_sum_p); \
        GRID_BAR(); \
        BLK(bphase_nsa_prompt); \
        BLK(bphase_rec_g2); \
        BLK(bphase_snsa_b); \
        PH(k_mix_gla, (long)NS * 4); \
        PH(k_mix_ml, (long)NS * 4); \
        GRID_BAR(); \
        PH(k_snsa_combine, (long)NS * 512); \
        GRID_BAR(); \
        GEMM_OUT(); \
        BLK(bphase_sgemm_out); \
        GRID_BAR(); \
    }
constexpr int LDS_BYTES = LDS_MISC + 1024 + 2048;
static_assert(NSA_END <= NSA_COMB && NSA_COMB + 8 * 8192 <= LDS_MISC, "NSA unit LDS map");

#ifdef CPU_EMU
template <ItemFn F> static void run_items(const P& p, int L, long n) {
#pragma omp parallel for schedule(dynamic, 256)
    for (long i = 0; i < n; ++i) F(p, L, i);
}
struct EmuArgs { BlockFn f; const P* p; int L; };
static void emu_tramp(void* a) { EmuArgs* e = (EmuArgs*)a; e->f(*e->p, e->L, (ldsp_t)emu_lds); }
static void emu_phase(BlockFn f, const P& p, int L) {
    const int G = 8;
#pragma omp parallel for schedule(dynamic, 1)
    for (int bx = 0; bx < G; ++bx) { EmuArgs a{f, &p, L}; emu_run_block(NTHREADS, bx, G, LDS_BYTES, emu_tramp, &a); }
}
#define PH(F, n) run_items<F>(p, L, (long)(n))
#define PH_MID(F, n, ROT) run_items<F>(p, L, (long)(n))
#define XIN_NEEDED(L) true
#define BLK(F) emu_phase(F, p, L)
#define GRID_BAR() do {} while (0)
#define GEMM_IN() PH(k_gemm_in_emu, (long)NP * D_IN)
#define GEMM_OUT() PH(k_gemm_out_emu, (long)NP * D)
static void forward(const P& p) {
#else

namespace pg8 {
#define PG8_LAS __attribute__((address_space(3)))
typedef unsigned short bf16_t;
typedef short bf16x8 __attribute__((ext_vector_type(8)));
typedef float f32x4 __attribute__((ext_vector_type(4)));
typedef unsigned u32x4 __attribute__((ext_vector_type(4)));
constexpr int BM = 256, BK = 64, HALF = 128, HTB = HALF * BK * 2  , STAGE_BYTES = 8 * HTB, NXCD = 8, WGM = 8;

__host__ __device__ __forceinline__ int lds_byte(int r, int c) { const int st = (r >> 4) * 2 + (c >> 5), rr = r & 15, cc = c & 31, ob = rr * 64 + cc * 2; return st * 1024 + (ob ^ (((ob >> 9) & 1) << 5)); }
__host__ __device__ __forceinline__ void stage_rc(int b, int& R, int& C) { const int st = b / 1024, sb = b % 1024, swz = sb ^ (((sb >> 9) & 1) << 5); R = (st >> 1) * 16 + swz / 64; C = (st & 1) * 32 + (swz % 64) / 2; }
__host__ __device__ __forceinline__ int perm32(int rho) { const int n = rho >> 4, i = rho & 15; return 8 * (i >> 2) + 4 * n + (i & 3); }

struct Unit { int pm, pn; };
struct Gemm { const bf16_t* A; const bf16_t* Bt; int M, N, K; };

struct StaticOrder {
    int nM, nN, nwg, G, c;
    __host__ __device__ void init(int M, int N, int G_, int c_) { nM = M / BM; nN = N / BM; nwg = nM * nN; G = G_; c = c_; }
    __host__ __device__ bool next(int i, Unit& u) const {
        const long L = (long)i * G + c; if (L >= nwg) return false;
        int wgid = (int)L; { const int q = nwg / NXCD, r = nwg % NXCD, xcd = wgid % NXCD, off = wgid / NXCD; wgid = (xcd < r ? xcd * (q + 1) : r * (q + 1) + (xcd - r) * q) + off; }
        const int nig = WGM * nN, gid = wgid / nig, fm = gid * WGM, gsz = (nM - fm) < WGM ? (nM - fm) : WGM;
        u.pm = fm + ((wgid % nig) % gsz); u.pn = (wgid % nig) / gsz; return true;
    }
    __device__ __forceinline__ void a_ready(const Unit&) const {}
    __device__ __forceinline__ void done(const Unit&) const {}
};
__device__ __forceinline__ unsigned cvt_pk_bf16(float lo, float hi) { unsigned r; asm volatile("v_cvt_pk_bf16_f32 %0, %1, %2" : "=v"(r) : "v"(lo), "v"(hi)); return r; }
struct EpiInBf16 {
    static constexpr bool PERM = true, AFTER_DRAIN = false;
    bf16_t* U; const float* rstd; const float* pss;
    __device__ __forceinline__ void operator()(const f32x4 (&acc)[2][2][4][2], const Unit& u, int wr, int wc, int fr, int fq) const {
        const int row0 = u.pm * BM + wr * 64 + fr, col0 = u.pn * BM + wc * 32 + 8 * fq;
#pragma unroll
        for (int ai = 0; ai < 2; ++ai)
#pragma unroll
            for (int m = 0; m < 4; ++m) { const int row = row0 + ai * HALF + m * 16; if (row >= NT) continue; float rs;
                if (pss) { const f32x4* q = (const f32x4*)(pss + (size_t)row * 32); const f32x4 a = (q[0] + q[1]) + (q[2] + q[3]); rs = __builtin_amdgcn_rsqf(((a[0] + a[1]) + (a[2] + a[3])) * (1.0f / D) + 1e-6f); }
                else rs = rstd[row];
                bf16_t* rowp = U + (size_t)row * U_LD + col0;
#pragma unroll
                for (int bj = 0; bj < 2; ++bj) { const f32x4 v0 = acc[ai][bj][m][0] * rs, v1 = acc[ai][bj][m][1] * rs; u32x4 wv;
                    wv.x = cvt_pk_bf16(v0[0], v0[1]); wv.y = cvt_pk_bf16(v0[2], v0[3]); wv.z = cvt_pk_bf16(v1[0], v1[1]); wv.w = cvt_pk_bf16(v1[2], v1[3]);
                    *(u32x4*)(rowp + bj * HALF) = wv; } }
    }
};
struct EpiOutF32 {
    static constexpr bool PERM = true, AFTER_DRAIN = false;
    float* Y; const float* Xa; const float* Xb;
    bf16_t* XB; float* PSS;
    __device__ __forceinline__ void operator()(const f32x4 (&acc)[2][2][4][2], const Unit& u, int wr, int wc, int fr, int fq) const {
        const int row0 = u.pm * BM + wr * 64 + fr, col0 = u.pn * BM + wc * 32 + 8 * fq;
#pragma unroll
        for (int ai = 0; ai < 2; ++ai)
#pragma unroll
            for (int m = 0; m < 4; ++m) { const int row = row0 + ai * HALF + m * 16; if (row >= NT) continue;
                const float* xr = row < NP ? Xa + (size_t)row * D : Xb + (size_t)(row - NP) * D; float* rowp = Y + (size_t)row * D; float ss = 0.f;
#pragma unroll
                for (int bj = 0; bj < 2; ++bj) { const int c = col0 + bj * HALF;
                    const f32x4 y0 = acc[ai][bj][m][0] + *(const f32x4*)(xr + c), y1 = acc[ai][bj][m][1] + *(const f32x4*)(xr + c + 4);
                    *(f32x4*)(rowp + c) = y0; *(f32x4*)(rowp + c + 4) = y1;
                    if (XB) { ss += y0[0] * y0[0] + y0[1] * y0[1] + y0[2] * y0[2] + y0[3] * y0[3] + y1[0] * y1[0] + y1[1] * y1[1] + y1[2] * y1[2] + y1[3] * y1[3]; u32x4 wv;
                        wv.x = cvt_pk_bf16(y0[0], y0[1]); wv.y = cvt_pk_bf16(y0[2], y0[3]); wv.z = cvt_pk_bf16(y1[0], y1[1]); wv.w = cvt_pk_bf16(y1[2], y1[3]);
                        *(u32x4*)(XB + (size_t)row * D + c) = wv; } }
                if (XB) { ss += xl_shfl_xor(ss, 16); ss += xl_shfl_xor(ss, 32); if (fq == 0) PSS[(size_t)row * 32 + u.pn * 4 + wc] = ss; } }
    }
};
template <class Epi, class Sched, bool ALIGN_EPI = false, bool SP2 = false>
__device__ __forceinline__ void gemm_phase(PG8_LAS unsigned char* lds, const Gemm g, const Sched& S, const Epi& E) {
    const int tid = hw_tid(lds), wid = __builtin_amdgcn_readfirstlane(tid >> 6), lane = tid & 63, wr = wid >> 2, wc = wid & 3, fr = lane & 15, fq = lane >> 4;
    const int K = g.K, nt = K / BK;
    unsigned voffA[2], voffB[2];
#pragma unroll
    for (int i = 0; i < 2; ++i) { int R, C; stage_rc(tid * 16 + i * 8192, R, C); const int Rb = Epi::PERM ? ((R & ~31) + perm32(R & 31)) : R;
        voffA[i] = (unsigned)(R * K + C) * 2u; voffB[i] = (unsigned)(Rb * K + C) * 2u; }
    const size_t kstep = (size_t)(BK * 2);
    const size_t hstep = (size_t)HALF * K * 2;
    const size_t tstep = 2 * hstep;
    const unsigned ldsw = (unsigned)wid * 1024u;
    const int aoff = lds_byte(wr * 64 + fr, fq * 8), boff = lds_byte(wc * 32 + fr, fq * 8);
#define PG8_SA(b, h) (((b) * 2 + (h)) * HTB)
#define PG8_SB(b, h) ((4 + (b) * 2 + (h)) * HTB)
#define PG8_STAGE(bufoff, gbase, voff) do { _Pragma("unroll") for (int _i = 0; _i < 2; ++_i) \
        __builtin_amdgcn_global_load_lds((const unsigned*)((const char*)(gbase) + (voff)[_i]), (PG8_LAS unsigned*)(lds + (bufoff) + ldsw + _i * 8192), 16, 0, 0); } while (0)
#define PG8_LDA(dst, b, h) do { _Pragma("unroll") for (int m = 0; m < 4; ++m) _Pragma("unroll") for (int k = 0; k < 2; ++k) dst[m][k] = *(const PG8_LAS bf16x8*)(lds + PG8_SA(b, h) + aoff + m * 2048 + k * 1024); } while (0)
#define PG8_LDB(dst, b, h) do { _Pragma("unroll") for (int n = 0; n < 2; ++n) _Pragma("unroll") for (int k = 0; k < 2; ++k) dst[n][k] = *(const PG8_LAS bf16x8*)(lds + PG8_SB(b, h) + boff + n * 2048 + k * 1024); } while (0)
#define PG8_MMA(ai, bj, At, Bt) do { __builtin_amdgcn_s_setprio(1); _Pragma("unroll") for (int m = 0; m < 4; ++m) _Pragma("unroll") for (int n = 0; n < 2; ++n) _Pragma("unroll") for (int k = 0; k < 2; ++k) \
        acc[ai][bj][m][n] = __builtin_amdgcn_mfma_f32_16x16x32_bf16(Bt[n][k], At[m][k], acc[ai][bj][m][n], 0, 0, 0); __builtin_amdgcn_s_setprio(0); } while (0)
#define PG8_WAIT_V(n) asm volatile("s_waitcnt vmcnt(" #n ")" ::: "memory")
#define PG8_WAIT_L(n) asm volatile("s_waitcnt lgkmcnt(" #n ")" ::: "memory")
#define PG8_BAR __builtin_amdgcn_s_barrier()
#define PG8_SCHED __builtin_amdgcn_sched_barrier(0)
    Unit cur, nxt; int ui = 0;
    if (!S.next(0, cur)) return;
    f32x4 acc[2][2][4][2];
#pragma unroll
    for (int a = 0; a < 2; ++a)
#pragma unroll
        for (int b = 0; b < 2; ++b)
#pragma unroll
            for (int m = 0; m < 4; ++m)
#pragma unroll
                for (int n = 0; n < 2; ++n) acc[a][b][m][n] = (f32x4){0.f, 0.f, 0.f, 0.f};
    bf16x8 At[4][2], B0[2][2], B1[2][2];
    const char* cA = (const char*)g.A + (size_t)cur.pm * tstep; const char* cB = (const char*)g.Bt + (size_t)cur.pn * tstep;
    S.a_ready(cur);
    if constexpr (SP2) {
        PG8_STAGE(PG8_SB(0, 0), cB, voffB); PG8_STAGE(PG8_SB(0, 1), cB + hstep, voffB); PG8_STAGE(PG8_SA(0, 0), cA, voffA); PG8_STAGE(PG8_SA(0, 1), cA + hstep, voffA);
        if (wr == 1) PG8_BAR;
        PG8_WAIT_V(2); PG8_BAR;
        PG8_STAGE(PG8_SB(1, 0), cB + kstep, voffB); PG8_STAGE(PG8_SA(1, 0), cA + kstep, voffA); PG8_STAGE(PG8_SB(1, 1), cB + hstep + kstep, voffB);
        PG8_WAIT_V(6); PG8_BAR;
    } else {
        PG8_STAGE(PG8_SB(0, 0), cB, voffB); PG8_STAGE(PG8_SA(0, 0), cA, voffA); PG8_STAGE(PG8_SB(0, 1), cB + hstep, voffB); PG8_STAGE(PG8_SA(0, 1), cA + hstep, voffA);
        if (wr == 1) PG8_BAR;
        PG8_WAIT_V(4); PG8_BAR;
        PG8_STAGE(PG8_SB(1, 0), cB + kstep, voffB); PG8_STAGE(PG8_SA(1, 0), cA + kstep, voffA); PG8_STAGE(PG8_SB(1, 1), cB + hstep + kstep, voffB);
        PG8_WAIT_V(6); PG8_BAR;
    }
    for (;;) {
        const bool has_next = S.next(ui + 1, nxt);
        const char* nA = has_next ? (const char*)g.A + (size_t)nxt.pm * tstep : cA; const char* nB = has_next ? (const char*)g.Bt + (size_t)nxt.pn * tstep : cB;
        for (int t = 0; t < nt; t += 2) {
            const bool last = (t == nt - 2);
            const char* a1 = cA + (size_t)(t + 1) * kstep;
            const char* a2 = last ? nA : cA + (size_t)(t + 2) * kstep; const char* b2 = last ? nB : cB + (size_t)(t + 2) * kstep;
            const char* a3 = a2 + kstep; const char* b3 = b2 + kstep;
            if (last && has_next) S.a_ready(nxt);
            if constexpr (SP2) {
            PG8_LDB(B0, 0, 0); PG8_LDB(B1, 0, 1); PG8_SCHED; PG8_LDA(At, 0, 0); PG8_STAGE(PG8_SA(1, 1), a1 + hstep, voffA);
            PG8_WAIT_V(8); PG8_WAIT_L(0); PG8_BAR; PG8_MMA(0, 0, At, B0); PG8_MMA(0, 1, At, B1); PG8_BAR; PG8_SCHED;
            PG8_LDA(At, 0, 1); PG8_STAGE(PG8_SB(0, 0), b2, voffB); PG8_STAGE(PG8_SB(0, 1), b2 + hstep, voffB); PG8_STAGE(PG8_SA(0, 0), a2, voffA);
            PG8_WAIT_V(8); PG8_WAIT_L(0); PG8_BAR; PG8_MMA(1, 0, At, B0); PG8_MMA(1, 1, At, B1); PG8_BAR; PG8_SCHED;
            PG8_LDB(B0, 1, 0); PG8_LDB(B1, 1, 1); PG8_SCHED; PG8_LDA(At, 1, 0); PG8_STAGE(PG8_SA(0, 1), a2 + hstep, voffA);
            PG8_WAIT_V(8); PG8_WAIT_L(0); PG8_BAR; PG8_MMA(0, 0, At, B0); PG8_MMA(0, 1, At, B1); PG8_BAR; PG8_SCHED;
            PG8_LDA(At, 1, 1); PG8_STAGE(PG8_SB(1, 0), b3, voffB); PG8_STAGE(PG8_SB(1, 1), b3 + hstep, voffB); PG8_STAGE(PG8_SA(1, 0), a3, voffA);
            PG8_WAIT_V(8); PG8_WAIT_L(0); PG8_BAR; PG8_MMA(1, 0, At, B0); PG8_MMA(1, 1, At, B1); PG8_BAR; PG8_SCHED;
            } else {
            PG8_LDB(B0, 0, 0); PG8_SCHED; PG8_LDA(At, 0, 0); PG8_STAGE(PG8_SA(1, 1), a1 + hstep, voffA);
            PG8_WAIT_L(8); PG8_BAR; PG8_WAIT_L(0); PG8_MMA(0, 0, At, B0); PG8_BAR; PG8_SCHED;
            PG8_LDB(B1, 0, 1); PG8_STAGE(PG8_SB(0, 0), b2, voffB);
            PG8_BAR; PG8_WAIT_L(0); PG8_MMA(0, 1, At, B1); PG8_BAR;
            PG8_LDA(At, 0, 1); PG8_STAGE(PG8_SA(0, 0), a2, voffA);
            PG8_BAR; PG8_WAIT_L(0); PG8_MMA(1, 0, At, B0); PG8_BAR; PG8_SCHED;
            PG8_STAGE(PG8_SB(0, 1), b2 + hstep, voffB);
            PG8_WAIT_V(6); PG8_BAR; PG8_MMA(1, 1, At, B1); PG8_BAR;
            PG8_LDB(B0, 1, 0); PG8_SCHED; PG8_LDA(At, 1, 0); PG8_STAGE(PG8_SA(0, 1), a2 + hstep, voffA);
            PG8_WAIT_L(8); PG8_BAR; PG8_WAIT_L(0); PG8_MMA(0, 0, At, B0); PG8_BAR; PG8_SCHED;
            PG8_LDB(B1, 1, 1); PG8_STAGE(PG8_SB(1, 0), b3, voffB);
            PG8_BAR; PG8_WAIT_L(0); PG8_MMA(0, 1, At, B1); PG8_BAR;
            PG8_LDA(At, 1, 1); PG8_STAGE(PG8_SA(1, 0), a3, voffA);
            PG8_BAR; PG8_WAIT_L(0); PG8_MMA(1, 0, At, B0); PG8_BAR; PG8_SCHED;
            PG8_STAGE(PG8_SB(1, 1), b3 + hstep, voffB);
            PG8_WAIT_V(6); PG8_BAR; PG8_MMA(1, 1, At, B1); PG8_BAR;
            }
        }
        if constexpr (ALIGN_EPI) { if (wr == 0) PG8_BAR; }
        if constexpr (!Epi::AFTER_DRAIN) { E(acc, cur, wr, wc, fr, fq); S.done(cur); }
        if (!has_next) break;
#pragma unroll
        for (int a = 0; a < 2; ++a)
#pragma unroll
            for (int b = 0; b < 2; ++b)
#pragma unroll
                for (int m = 0; m < 4; ++m)
#pragma unroll
                    for (int n = 0; n < 2; ++n) acc[a][b][m][n] = (f32x4){0.f, 0.f, 0.f, 0.f};
        cur = nxt; cA = nA; cB = nB; ++ui;
        if constexpr (ALIGN_EPI) { if (wr == 1) PG8_BAR; }
    }
    PG8_WAIT_V(0);
    if constexpr (!ALIGN_EPI) { if (wr == 0) PG8_BAR; }
    PG8_BAR;
    if constexpr (Epi::AFTER_DRAIN) { E.fused(acc, cur, wr, wc, fr, fq, lds, wid, lane); S.done(cur); }
#undef PG8_SA
#undef PG8_SB
#undef PG8_STAGE
#undef PG8_LDA
#undef PG8_LDB
#undef PG8_MMA
#undef PG8_WAIT_V
#undef PG8_WAIT_L
#undef PG8_BAR
#undef PG8_SCHED
}
}
#define XB_TMO      128
#define XB_XCNT(j)  (256  + 64 * (j))
#define XB_XSUB(j)  (1280 + 64 * (j))
#define XB_XGEN(j)  (2304 + 64 * (j))
#define XB_TOP      3328
#define XB_TOPGEN   3392
#define XCD_BAR_WORDS 3456
#define XB_SPIN_CAP (1u << 22)
#define LAS __attribute__((address_space(3)))
__device__ __forceinline__ unsigned xb_ld(unsigned* p)              { return __hip_atomic_load(p, __ATOMIC_RELAXED, __HIP_MEMORY_SCOPE_AGENT); }
__device__ __forceinline__ unsigned xb_add(unsigned* p, unsigned v) { return __hip_atomic_fetch_add(p, v, __ATOMIC_RELAXED, __HIP_MEMORY_SCOPE_AGENT); }
__device__ __forceinline__ unsigned xb_xcc_id() { return (unsigned)__builtin_amdgcn_s_getreg((3 << 11) | 20) & 0xFu; }
#define XB_SPIN(cond, bar) do { unsigned _sp = 0; while (cond) { __builtin_amdgcn_s_sleep(1); \
    if ((++_sp & 255u) == 0u) { if (xb_ld(&(bar)[XB_TMO])) break; if (_sp > XB_SPIN_CAP) { atomicAdd(&(bar)[XB_TMO], 1u); break; } } } } while (0)
struct XcdBarrier { unsigned* bar; unsigned x; volatile LAS unsigned* st; };
#define XB_TID0() (hw_tid((LAS unsigned char*)b.st - LDS_MISC) == 0)
__device__ __forceinline__ XcdBarrier xcd_barrier_post(unsigned* bar, volatile LAS unsigned* st) {
    XcdBarrier b; b.bar = bar; b.x = xb_xcc_id(); b.st = st;
    if (XB_TID0()) (void)xb_add(&bar[XB_XCNT(b.x)], 1u);
    return b;
}
__device__ __forceinline__ void xcd_barrier_complete(unsigned* bar, unsigned x, unsigned& nloc, unsigned& nx) {
    const unsigned G = gridDim.x * gridDim.y * gridDim.z;
    unsigned sum, cnt, mine, sp = 0u;
    for (;;) {
        sum = 0u; cnt = 0u; mine = 0u;
#pragma unroll
        for (unsigned j = 0; j < 16; ++j) { const unsigned c = xb_ld(&bar[XB_XCNT(j)]); sum += c; cnt += (c > 0u) ? 1u : 0u; mine = (j == x) ? c : mine; }
        if (sum == G) break;
        __builtin_amdgcn_s_sleep(1);
        if ((++sp & 255u) == 0u) { if (xb_ld(&bar[XB_TMO])) break; if (sp > XB_SPIN_CAP) { atomicAdd(&bar[XB_TMO], 1u); break; } }
    }
    nloc = mine > 0u ? mine : 1u; nx = cnt > 0u ? cnt : 1u;
}
__device__ __forceinline__ void xcd_barrier(const XcdBarrier& b) {
    asm volatile("s_waitcnt vmcnt(0)" ::: "memory");
    __syncthreads();
    if (XB_TID0()) {
        unsigned* bar = b.bar;
        __builtin_amdgcn_s_waitcnt(0);
        unsigned nloc = b.st[0], nx = b.st[1];
        if (nloc == 0u) { xcd_barrier_complete(bar, b.x, nloc, nx); b.st[0] = nloc; b.st[1] = nx; }
        const unsigned old = xb_add(&bar[XB_XSUB(b.x)], 1u);
        const unsigned gen = old / nloc;
        if (old + 1u == (gen + 1u) * nloc) {
            __builtin_amdgcn_fence(__ATOMIC_RELEASE, "agent");
            asm volatile("s_waitcnt vmcnt(0)" ::: "memory");
            const unsigned og = xb_add(&bar[XB_TOP], 1u);
            const unsigned tg = og / nx;
            if (og + 1u == (tg + 1u) * nx) xb_add(&bar[XB_TOPGEN], 1u);
            else XB_SPIN(xb_ld(&bar[XB_TOPGEN]) == tg, bar);
            __builtin_amdgcn_fence(__ATOMIC_ACQUIRE, "agent");
            xb_add(&bar[XB_XGEN(b.x)], 1u);
            asm volatile("s_waitcnt vmcnt(0)" ::: "memory");
        } else {
            XB_SPIN(xb_ld(&bar[XB_XGEN(b.x)]) == gen, bar);
            __builtin_amdgcn_fence(__ATOMIC_ACQUIRE, "agent");
            asm volatile("s_waitcnt vmcnt(0)" ::: "memory");
        }
    }
    __syncthreads();
}

constexpr int LDS_PTAB = LDS_MISC + 64;
__device__ __forceinline__ P load_params(LAS unsigned char* ldsb) {
    unsigned off = LDS_PTAB; asm volatile("" : "+s"(off) :: "memory");
    LAS const unsigned long long* t = (LAS const unsigned long long*)(ldsb + off);
    union { P p; const void* v[NPTR]; } u;
#pragma unroll
    for (int i = 0; i < NPTR; ++i) { const unsigned long long x = t[i]; const unsigned lo = __builtin_amdgcn_readfirstlane((unsigned)x), hi = __builtin_amdgcn_readfirstlane((unsigned)(x >> 32));
        u.v[i] = (const void*)(__attribute__((address_space(1))) const void*)(((unsigned long long)hi << 32) | lo); }
    return u.p;
}
#define PH(F, n) do { const unsigned _t = (unsigned)hw_tid((LAS unsigned char*)lds); const long _G = (long)gridDim.x; const P _q = load_params((LAS unsigned char*)lds); \
        for (long _i = ((long)blockIdx.x + _G * (_t >> 6)) * 64 + (_t & 63); _i < (long)(n); _i += _G * NTHREADS) F(_q, L, _i); } while (0)
#define PH_MID(F, n, ROT) do { const unsigned _t = (unsigned)hw_tid((LAS unsigned char*)lds); const long _G = (long)gridDim.x, _b0 = _G / 8, _nb = _G - _b0 - _G / 4, _lb = (long)blockIdx.x - _b0; \
        const P _q = load_params((LAS unsigned char*)lds); \
        if (_lb >= 0 && _lb < _nb) for (long _i = (_lb + _nb * (long)(((_t >> 6) + (ROT)) & 7u)) * 64 + (_t & 63); _i < (long)(n); _i += _nb * NTHREADS) F(_q, L, _i); } while (0)
#define BLK(F) do { __syncthreads(); const P _q = load_params((LAS unsigned char*)lds); F(_q, L, (ldsp_t)lds); } while (0)
#define GRID_BAR() xcd_barrier(bar)
#define XIN_NEEDED(L) ((L) == 0)
#define GEMM_IN() do { const P p = load_params((LAS unsigned char*)lds); pg8::Gemm g{xbp(p), wintp(p, L), NP, D_INP, D}; pg8::StaticOrder S; S.init(NP, D_INP, (int)gridDim.x, (int)blockIdx.x); \
        pg8::EpiInBf16 E{ubase(p), p.ws + W_RSTD, L == 0 ? (const float*)nullptr : p.ws + W_XN}; pg8::gemm_phase<pg8::EpiInBf16, pg8::StaticOrder, true, true>((LAS unsigned char*)lds, g, S, E); } while (0)
#define GEMM_OUT() do { const P p = load_params((LAS unsigned char*)lds); pg8::Gemm g{mixb(p), wouttp(p, L), NP, D, D}; pg8::StaticOrder S; S.init(NP, D, (int)gridDim.x, (int)blockIdx.x); \
        pg8::EpiOutF32 E{L == DEPTH - 1 ? p.out + O_Y : p.ws + W_Y0, L == 0 ? p.x_prompt : p.ws + W_Y0, L == 0 ? p.x_sample : p.ws + W_Y0 + (size_t)NP * D, L + 1 < DEPTH ? xbp(p) : (bf16_t*)nullptr, p.ws + W_XN}; \
        pg8::gemm_phase<pg8::EpiOutF32, pg8::StaticOrder, true, true>((LAS unsigned char*)lds, g, S, E); } while (0)
__global__ void __launch_bounds__(NTHREADS, 2) mega(P parg, unsigned* barw) {
    extern __shared__ __attribute__((aligned(16))) unsigned char lds[];
    if (threadIdx.x < 16) ((LAS unsigned*)((LAS unsigned char*)lds + LDS_MISC))[threadIdx.x] = 0u;
    if ((threadIdx.x & 63) == 0) { const unsigned hw = (unsigned)__builtin_amdgcn_s_getreg((5 << 11) | 4) & 63u; *(LAS int*)((LAS unsigned char*)lds + LDS_WTAB + hw * 4) = (int)(threadIdx.x >> 6); }
    if (threadIdx.x == 64) { union { P p; unsigned long long v[NPTR]; } u; u.p = parg;
#pragma unroll
        for (int i = 0; i < NPTR; ++i) ((LAS unsigned long long*)((LAS unsigned char*)lds + LDS_PTAB))[i] = u.v[i]; }
    __syncthreads();
    XcdBarrier bar = xcd_barrier_post(barw, (volatile LAS unsigned*)((LAS unsigned char*)lds + LDS_MISC));
#endif
    { const int L = 0; PH(k_prep_win, (long)DEPTH * D_INP * (D / 8)); PH(k_prep_wout, (long)DEPTH * D * (D / 8)); PH(k_prep_wc, (long)DEPTH * 32768); BLK(bphase_cmp_bias); }
    static_assert(DEPTH == 2, "layer program is instantiated per layer");
    LAYER_PROGRAM(0)
    LAYER_PROGRAM(1)
}

#ifndef CPU_EMU
extern "C" void kernel_launch(void* const* d_in, const int* in_sizes, int n_in, void* d_out, int out_size, void* d_ws, size_t ws_size, hipStream_t stream) {
    P p = make_params(d_in, d_out, d_ws);
    static int grid = 0;
    if (!grid) {
        int dev = 0, cus = 0, per_cu = 0;
        hipGetDevice(&dev);
        hipDeviceGetAttribute(&cus, hipDeviceAttributeMultiprocessorCount, dev);
        (void)hipFuncSetAttribute((const void*)mega, hipFuncAttributeMaxDynamicSharedMemorySize, LDS_BYTES);
        (void)hipOccupancyMaxActiveBlocksPerMultiprocessor(&per_cu, (const void*)mega, NTHREADS, LDS_BYTES);
        (void)hipGetLastError(); grid = cus;
    }
    unsigned* barw = (unsigned*)((char*)d_ws + WB_BAR);
    hipMemsetAsync(barw, 0, 16384, stream);
    hipLaunchKernelGGL(mega, dim3(grid), dim3(NTHREADS), LDS_BYTES, stream, p, barw);
}
#endif
```

```cpp
#ifndef CPU_EMU
#include <hip/hip_runtime.h>
#define HD __host__ __device__ __forceinline__
#else
#include "emu.h"
#define HD inline
#endif
#include <stdint.h>
#include <math.h>

#ifndef CFG_BATCH
#define CFG_BATCH 4
#define CFG_SEQ 4096
#define CFG_DEC_BATCH 32
#define CFG_PAST_LEN 8192
#endif
constexpr int BATCH = CFG_BATCH, SEQ = CFG_SEQ, DEC_BATCH = CFG_DEC_BATCH, DEC_SEQ = 8, PAST_LEN = CFG_PAST_LEN, DEPTH = 2;
constexpr int D = 1024, D_IN = 3888, PAGE = 128;
constexpr int NP = BATCH * SEQ, NS = DEC_BATCH * DEC_SEQ, NT = NP + NS, NSEQ = BATCH + DEC_BATCH;
constexpr int NPAGES = PAST_LEN / PAGE, NUSED = DEC_BATCH * NPAGES, NPOOL = NUSED + (NUSED / 4 > 1 ? NUSED / 4 : 1);
constexpr int WIN = 512, WKEEP_P = SEQ < WIN ? SEQ : WIN, WKEEP_S = PAST_LEN < WIN ? PAST_LEN : WIN;
constexpr int NCP = SEQ / 16 - 1, NCS = (PAST_LEN + DEC_SEQ) / 16 - 1, NCMAX = NCP > NCS ? NCP : NCS;
constexpr int NSELP = (SEQ + 63) / 64, NSELS = (PAST_LEN + DEC_SEQ + 63) / 64, NSELMAX = NSELP > NSELS ? NSELP : NSELS;
constexpr int C_GQ = 0, C_GK = 128, C_GV = 256, C_GZ = 512, C_NQ = 768, C_NKV = 1280, C_NZ = 2048, C_MQK = 2560, C_MV = 3072, C_MO = 3328, C_MZ = 3584,
              C_GA = 3840, C_NG = 3856, C_MIF = 3880;
HD int orig_col(int n) { return n < 512 ? n : n < 768 ? 528 + (n - 512) : n < 1280 ? 784 + (n - 768) : n < 2048 ? 1296 + (n - 1280) : n < 2560 ? 2088 + (n - 2048) : n < 3072 ? 2600 + (n - 2560)
    : n < 3328 ? 3112 + (n - 3072) : n < 3584 ? 3376 + (n - 3328) : n < 3840 ? 3632 + (n - 3584) : n < 3856 ? 512 + (n - 3840) : n < 3880 ? 2064 + (n - 3856) : 3368 + (n - 3880); }
constexpr size_t O_Y = 0;
constexpr size_t O_PROWS = O_Y + (size_t)NT * D;
constexpr size_t O_SROWS = O_PROWS + (size_t)DEPTH * NP * 512;
constexpr size_t O_PWIN = O_SROWS + (size_t)DEPTH * NS * 512;
constexpr size_t O_SWIN = O_PWIN + (size_t)DEPTH * BATCH * WKEEP_P * 256;
constexpr size_t O_PGLA = O_SWIN + (size_t)DEPTH * DEC_BATCH * WKEEP_S * 256;
constexpr size_t O_SGLA = O_PGLA + (size_t)DEPTH * BATCH * 4 * 32 * 64;
constexpr size_t O_PC = O_SGLA + (size_t)DEPTH * DEC_BATCH * 4 * 32 * 64;
constexpr size_t O_SC = O_PC + (size_t)DEPTH * BATCH * 4 * 64 * 64;
constexpr size_t O_PN = O_SC + (size_t)DEPTH * DEC_BATCH * 4 * 64 * 64;
constexpr size_t O_SN = O_PN + (size_t)DEPTH * BATCH * 4 * 64;
constexpr size_t O_PM = O_SN + (size_t)DEPTH * DEC_BATCH * 4 * 64;
constexpr size_t O_SM = O_PM + (size_t)DEPTH * BATCH * 4;
constexpr size_t O_PCONV = O_SM + (size_t)DEPTH * DEC_BATCH * 4;
constexpr size_t O_SCONV = O_PCONV + (size_t)DEPTH * BATCH * 3 * 512;
constexpr size_t O_END = O_SCONV + (size_t)DEPTH * DEC_BATCH * 3 * 512;
constexpr size_t W_RSTD = 0;
constexpr size_t W_XN = W_RSTD + NT;
constexpr size_t W_U = W_XN + (size_t)NT * D;
constexpr size_t W_QN = W_U + (size_t)NT * D_IN;
constexpr size_t W_QR = W_QN + (size_t)NT * 512;
constexpr size_t W_WINNEW = W_QR + (size_t)NT * 512;
constexpr size_t W_LOGA = W_WINNEW + (size_t)NT * 256;
constexpr size_t W_MQ = W_LOGA + (size_t)NT * 128;
constexpr size_t W_MK = W_MQ + (size_t)NT * 256;
constexpr size_t W_CBIAS = W_MK + (size_t)NT * 256;
constexpr size_t W_KC = W_CBIAS + 256;
constexpr size_t W_VC = W_KC + (size_t)NSEQ * NCMAX * 128;
constexpr size_t W_PCMP = W_VC + (size_t)NSEQ * NCMAX * 128;
constexpr size_t W_OCMP = W_PCMP + (size_t)NT * 8 * NCMAX;
constexpr size_t W_IMP = W_OCMP + (size_t)NT * 512;
constexpr size_t W_SEL = W_IMP + (size_t)NT * 2 * NSELMAX;
constexpr size_t W_PSLC = W_SEL + (size_t)NT * 2 * 16;
constexpr size_t W_OSLC = W_PSLC + (size_t)NT * 8 * 1024;
constexpr size_t W_PWIN = W_OSLC + (size_t)NT * 512;
constexpr size_t W_OWIN = W_PWIN + (size_t)NT * 8 * 512;
constexpr size_t W_OA = W_OWIN + (size_t)NT * 512;
constexpr size_t W_H = W_OA + (size_t)NT * 256;
constexpr size_t W_MIXED = W_H + (size_t)NT * 256;
constexpr size_t W_Y0 = W_MIXED + (size_t)NT * D;
constexpr size_t W_DEN = W_Y0 + (size_t)NT * D;
constexpr size_t W_MT = W_DEN + (size_t)NT * 4;
constexpr size_t W_GSLOC = W_MT + (size_t)NT * 4;
constexpr size_t W_GSBL = W_GSLOC + (size_t)BATCH * 4 * (SEQ / 64) * 2048;
constexpr size_t W_MCLOC = W_GSBL + (size_t)BATCH * 4 * (SEQ / 64) * 32;
constexpr size_t W_MFG = W_MCLOC + (size_t)BATCH * 4 * (SEQ / 64) * 4160;
constexpr size_t W_SPART = W_MFG + (size_t)BATCH * 4 * (SEQ / 64) * 4;
constexpr size_t W_SLIST = W_SPART + (size_t)DEC_BATCH * 2 * 40 * 32 * 68;
constexpr size_t W_END = W_SLIST + (size_t)DEC_BATCH * 2 * 2 * 112;
constexpr int NTP = (NT + 255) / 256 * 256, D_INP = 4096;
constexpr size_t WB_WINT = (W_END * 4 + 255) / 256 * 256;
constexpr size_t WB_WOUTT = WB_WINT + (size_t)DEPTH * D_INP * D * 2;
constexpr size_t WB_XB = WB_WOUTT + (size_t)DEPTH * D * D * 2;
constexpr size_t WB_MIXB = WB_XB + (size_t)NTP * D * 2;
constexpr int NQT = SEQ / 64, NCPADP = (NCP + 63) / 64 * 64, NCPADS = (NCS + 63) / 64 * 64, NCPAD = NCPADP > NCPADS ? NCPADP : NCPADS;
constexpr size_t WB_QNB = WB_MIXB + (size_t)NTP * D * 2;
constexpr size_t WB_QRB = WB_QNB + (size_t)NT * 512 * 2;
constexpr size_t WB_KSB = WB_QRB + (size_t)NT * 512 * 2;
constexpr size_t WB_VST = WB_KSB + (size_t)BATCH * 2 * SEQ * 64 * 2;
constexpr size_t WB_KWB = WB_VST + (size_t)BATCH * 2 * SEQ * 64 * 2;
constexpr size_t WB_VWT = WB_KWB + (size_t)BATCH * 2 * SEQ * 64 * 2;
constexpr size_t WB_KCB = WB_VWT + (size_t)BATCH * 2 * SEQ * 64 * 2;
constexpr size_t WB_VCT = WB_KCB + (size_t)NSEQ * 2 * NCPAD * 64 * 2;
constexpr size_t WB_WCT = WB_VCT + (size_t)NSEQ * 2 * NCPAD * 64 * 2;
constexpr int U_LD = D_INP;
constexpr size_t WB_UB = WB_WCT + (size_t)DEPTH * 2 * 64 * 2048 * 2;
constexpr size_t WB_BAR = WB_UB + (size_t)NTP * U_LD * 2;
constexpr size_t WB_END = WB_BAR + 16384;
typedef unsigned short bf16_t;
#ifdef CPU_EMU
HD bf16_t f2bf(float f) { unsigned u = __builtin_bit_cast(unsigned, f); return (bf16_t)((u + 0x7fffu + ((u >> 16) & 1u)) >> 16); }
#else
__device__ __forceinline__ bf16_t f2bf(float f) { const __bf16 h = (__bf16)f; return __builtin_bit_cast(bf16_t, h); }
__host__ inline bf16_t f2bf_host(float f) { unsigned u = __builtin_bit_cast(unsigned, f); return (bf16_t)((u + 0x7fffu + ((u >> 16) & 1u)) >> 16); }
#endif
HD float bf2f(bf16_t h) { return __builtin_bit_cast(float, (unsigned)h << 16); }

constexpr int NPTR = 26;
struct P {
    const float *x_prompt, *x_sample, *cache, *state_win, *state_gla, *state_C, *state_n, *state_m, *state_conv;
    const int* page_table;
    const float *norm_g, *w_in, *w_out, *gla_w_gate, *gla_b_gate, *gla_norm_g, *q_norm_g, *k_norm_g, *cmp_pos, *cmp_w,
        *conv_w, *conv_b, *gate_b, *ml_norm_g;
    float* out;
    float* ws;
};
static_assert(sizeof(P) == NPTR * 8, "P is a table of NPTR pointers");

HD int seq_of_row(int r) { return r < NP ? r / SEQ : BATCH + (r - NP) / DEC_SEQ; }
HD int seq_row0(int s) { return s < BATCH ? s * SEQ : NP + (s - BATCH) * DEC_SEQ; }
HD int seq_len(int s) { return s < BATCH ? SEQ : DEC_SEQ; }
HD int seq_pos0(int s) { return s < BATCH ? 0 : PAST_LEN; }
HD int seq_ncmp(int s) { return s < BATCH ? NCP : NCS; }
HD int seq_nsel(int s) { return s < BATCH ? NSELP : NSELS; }
HD int row_pos(int r) { return r < NP ? r % SEQ : PAST_LEN + (r - NP) % DEC_SEQ; }
HD const float* xrow(const P& p, int L, int r) {
    if (L == 0) return r < NP ? p.x_prompt + (size_t)r * D : p.x_sample + (size_t)(r - NP) * D;
    return p.ws + W_Y0 + (size_t)r * D;
}
HD float* new_rows_ptr(const P& p, int L, int r) {
    return r < NP ? p.out + O_PROWS + ((size_t)L * NP + r) * 512 : p.out + O_SROWS + ((size_t)L * NS + (r - NP)) * 512;
}
HD const float* hist(const P& p, int L, int s, int r, int slot, int g) {
    if (s < BATCH) return p.out + O_PROWS + ((size_t)L * NP + (size_t)s * SEQ + r) * 512 + slot * 128 + g * 64;
    const int b = s - BATCH;
    if (r < PAST_LEN) { const int page = p.page_table[b * NPAGES + r / PAGE];
        return p.cache + (((size_t)L * NPOOL + page) * PAGE + (r % PAGE)) * 512 + slot * 128 + g * 64; }
    return p.out + O_SROWS + ((size_t)L * NS + b * DEC_SEQ + (r - PAST_LEN)) * 512 + slot * 128 + g * 64;
}
HD const float* ctxp(const P& p, int L, int s, int kpos, int kv, int g) {
    if (s < BATCH) return p.ws + W_WINNEW + ((size_t)s * SEQ + kpos) * 256 + kv * 128 + g * 64;
    const int b = s - BATCH;
    if (kpos < PAST_LEN) return p.state_win + (((size_t)L * DEC_BATCH + b) * WKEEP_S + (kpos - (PAST_LEN - WKEEP_S))) * 256 + kv * 128 + g * 64;
    return p.ws + W_WINNEW + ((size_t)NP + b * DEC_SEQ + (kpos - PAST_LEN)) * 256 + kv * 128 + g * 64;
}
HD bf16_t* wsb(const P& p, size_t off) { return (bf16_t*)((char*)p.ws + off); }
struct URow { const bf16_t* q; HD float operator[](size_t i) const { return bf2f(q[i]); } HD URow operator+(size_t k) const { return URow{q + k}; } };
HD bf16_t* ubase(const P& p) { return (bf16_t*)((char*)p.ws + WB_UB); }
HD URow urow(const P& p, int r) { return URow{ubase(p) + (size_t)r * U_LD}; }
HD bf16_t* mixb(const P& p) { return (bf16_t*)((char*)p.ws + WB_MIXB); }
HD bf16_t* xbp(const P& p) { return (bf16_t*)((char*)p.ws + WB_XB); }
HD bf16_t* wintp(const P& p, int L) { return (bf16_t*)((char*)p.ws + WB_WINT) + (size_t)L * D_INP * D; }
HD bf16_t* wouttp(const P& p, int L) { return (bf16_t*)((char*)p.ws + WB_WOUTT) + (size_t)L * D * D; }
#ifdef CPU_EMU
HD float EXPF(float x) { return expf(x); }
HD float RCPF(float x) { return 1.0f / x; }
HD float RSQRTF(float x) { return 1.0f / sqrtf(x); }
HD float LOG1PF(float e) { return log1pf(e); }
HD void SINCOSF(float a, float& sn, float& c) { sn = sinf(a); c = cosf(a); }
#else
__device__ __forceinline__ float EXPF(float x) { return __builtin_amdgcn_exp2f(x * 1.4426950408889634f); }
__device__ __forceinline__ float RCPF(float x) { return __builtin_amdgcn_rcpf(x); }
__device__ __forceinline__ float RSQRTF(float x) { return __builtin_amdgcn_rsqf(x); }
__device__ __forceinline__ float LOG1PF(float e) { return __builtin_amdgcn_logf(1.0f + e) * 0.6931471805599453f; }
__device__ __forceinline__ void SINCOSF(float a, float& sn, float& c) { const float fr = __builtin_amdgcn_fractf(a * 0.15915494309189535f); sn = __builtin_amdgcn_sinf(fr); c = __builtin_amdgcn_cosf(fr); }
#endif
HD float log_sigmoidf(float x) { return fminf(x, 0.f) - LOG1PF(EXPF(-fabsf(x))); }
HD float sigmoidf_(float x) { return RCPF(1.f + EXPF(-x)); }
HD float siluf(float x) { return x * RCPF(1.f + EXPF(-x)); }
HD float rope_inv(int i) { return EXPF(-logf(500000.0f) * (float)i * 2.0f / 16.0f); }

HD void k_prep_win(const P& p, int L, long it) {
    const int n = (int)(it % D_INP), kc = (int)((it / D_INP) % (D / 8)), L2 = (int)(it / ((long)D_INP * (D / 8)));
    bf16_t* o = wintp(p, L2) + (size_t)n * D + kc * 8;
    for (int j = 0; j < 8; ++j) { const int k = kc * 8 + j; o[j] = n < D_IN ? f2bf(p.norm_g[L2 * D + k] * p.w_in[((size_t)L2 * D + k) * D_IN + orig_col(n)]) : (bf16_t)0; }
}
HD void k_prep_wout(const P& p, int L, long it) {
    const int n = (int)(it % D), kc = (int)((it / D) % (D / 8)), L2 = (int)(it / ((long)D * (D / 8)));
    bf16_t* o = wouttp(p, L2) + (size_t)n * D + kc * 8;
    for (int j = 0; j < 8; ++j) { const int k = kc * 8 + j; o[j] = f2bf(p.w_out[((size_t)L2 * D + k) * D + n]); }
}
HD void k_gemm_in_emu(const P& p, int L, long it) {
    const int r = (int)(it / D_IN), c = (int)(it % D_IN);
    const bf16_t* a = xbp(p) + (size_t)r * D; const bf16_t* w = wintp(p, L) + (size_t)c * D; float s = 0.f;
    for (int k = 0; k < D; ++k) s += bf2f(a[k]) * bf2f(w[k]);
    ubase(p)[(size_t)r * U_LD + c] = f2bf(s * p.ws[W_RSTD + r]);
}
HD void k_win_copy(const P& p, int L, long it) {
    constexpr int NOLD = WKEEP_S - DEC_SEQ > 0 ? WKEEP_S - DEC_SEQ : 0;
    const int e = (int)(it % 256); const long q = it / 256; const int i = (int)(q % NOLD), b = (int)(q / NOLD);
    p.out[O_SWIN + (((size_t)L * DEC_BATCH + b) * WKEEP_S + i) * 256 + e] = p.state_win[(((size_t)L * DEC_BATCH + b) * WKEEP_S + i + DEC_SEQ) * 256 + e];
}
HD float conv_xp(const P& p, int L, int s, int tp, int ch) {
    if (tp < 3) return s < BATCH ? 0.f : p.state_conv[(((size_t)L * DEC_BATCH + (s - BATCH)) * 3 + tp) * 512 + ch];
    return urow(p, seq_row0(s) + tp - 3)[C_MQK + ch];
}
HD void k_conv_out(const P& p, int L, long it) {
    const int ch = (int)(it % 512), i = (int)((it / 512) % 3), s = (int)(it / 1536);
    const float v = conv_xp(p, L, s, seq_len(s) + i, ch);
    if (s < BATCH) p.out[O_PCONV + (((size_t)L * BATCH + s) * 3 + i) * 512 + ch] = v;
    else p.out[O_SCONV + (((size_t)L * DEC_BATCH + (s - BATCH)) * 3 + i) * 512 + ch] = v;
}
HD void k_cmp_sum(const P& p, int L, long it) {
    const int e = (int)(it % 64), g = (int)((it / 64) % 2), kv = (int)((it / 128) % 2); const long q = it / 256; const int j = (int)(q % NCMAX), s = (int)(q / NCMAX);
    if (j >= seq_ncmp(s)) return;
    float a = p.ws[W_CBIAS + kv * 64 + e];
    const float* w = p.cmp_w + ((size_t)(L * 2 + kv)) * 2048 * 64 + e;
    for (int t = 0; t < 32; ++t) { const float* x = hist(p, L, s, 16 * j + t, kv, g);
        for (int d = 0; d < 64; ++d) a += x[d] * w[(size_t)(t * 64 + d) * 64]; }
    p.ws[(kv ? W_VC : W_KC) + ((size_t)s * NCMAX + j) * 128 + g * 64 + e] = a;
}
HD void k_kc_norm(const P& p, int L, long it) {
    const int g = (int)(it % 2); const long q = it / 2; const int j = (int)(q % NCPAD), s = (int)(q / NCPAD);
    bf16_t* kb = wsb(p, WB_KCB) + (((size_t)s * 2 + g) * NCPAD + j) * 64; bf16_t* vt = wsb(p, WB_VCT) + (((size_t)s * 2 + g) * (NCPAD / 64) + j / 64) * 4096 + (j % 64);
    if (j >= seq_ncmp(s)) { for (int d = 0; d < 64; ++d) { kb[d] = 0; vt[(size_t)d * 64] = 0; } return; }
    float* k = p.ws + W_KC + ((size_t)s * NCMAX + j) * 128 + g * 64; const float* v = p.ws + W_VC + ((size_t)s * NCMAX + j) * 128 + g * 64; float ss = 0.f;
    for (int d = 0; d < 64; ++d) ss += k[d] * k[d];
    const float rs = RSQRTF(ss / 64 + 1e-6f);
    for (int d = 0; d < 64; ++d) { k[d] = k[d] * rs * p.k_norm_g[(L * 3 + 0) * 64 + d]; kb[d] = f2bf(k[d]); vt[(size_t)d * 64] = f2bf(v[d]); }
}
HD void k_cmp_score(const P& p, int L, long it) {
    const int n = (int)(it % NCMAX); const long q = it / NCMAX; const int h = (int)(q % 8), r = NP + (int)(q / 8), s = seq_of_row(r), pos = row_pos(r);
    if (n >= seq_ncmp(s)) return;
    float v = -INFINITY;
    if (16 * n + 31 <= pos) { const float* qq = p.ws + W_QN + (size_t)r * 512 + h * 64; const float* k = p.ws + W_KC + ((size_t)s * NCMAX + n) * 128 + (h / 4) * 64;
        float a = 0.f; for (int d = 0; d < 64; ++d) a += qq[d] * k[d]; v = a * 0.125f; }
    p.ws[W_PCMP + (size_t)NP * 8 * NCMAX + it] = v;
}
HD void softmax_row(float* x, int n) {
    float m = -INFINITY; for (int i = 0; i < n; ++i) m = fmaxf(m, x[i]);
    if (m == -INFINITY) m = 0.f;
    float sum = 0.f; for (int i = 0; i < n; ++i) { const float e = (x[i] == -INFINITY) ? 0.f : EXPF(x[i] - m); x[i] = e; sum += e; }
    const float inv = 1.0f / fmaxf(sum, 1e-30f);
    for (int i = 0; i < n; ++i) x[i] *= inv;
}
HD void k_cmp_softmax(const P& p, int L, long it) { const int r = NP + (int)(it / 8); softmax_row(p.ws + W_PCMP + ((size_t)NP * 8 + it) * NCMAX, seq_ncmp(seq_of_row(r))); }
HD void k_cmp_out(const P& p, int L, long it) {
    const int d = (int)(it % 64), h = (int)((it / 64) % 8), r = NP + (int)(it / 512), s = seq_of_row(r), nc = seq_ncmp(s);
    const float* pr = p.ws + W_PCMP + ((size_t)r * 8 + h) * NCMAX; const float* v = p.ws + W_VC + (size_t)s * NCMAX * 128 + (h / 4) * 64 + d; float a = 0.f;
    for (int n = 0; n < nc; ++n) a += pr[n] * v[(size_t)n * 128];
    p.ws[W_OCMP + (size_t)NP * 512 + it] = a;
}
HD void k_imp(const P& p, int L, long it) {
    const int j = (int)(it % NSELMAX), g = (int)((it / NSELMAX) % 2), r = NP + (int)(it / (2 * NSELMAX)), s = seq_of_row(r), nc = seq_ncmp(s);
    if (j >= seq_nsel(s)) return;
    float a = 0.f;
    for (int h = 0; h < 4; ++h) { const float* pr = p.ws + W_PCMP + ((size_t)r * 8 + g * 4 + h) * NCMAX;
        for (int q = 0; q < 5; ++q) { const int i = 4 * j - 1 + q; if (i >= 0 && i < nc) a += pr[i] * ((q == 0 || q == 4) ? 1.f : 2.f); } }
    p.ws[W_IMP + (size_t)NP * 2 * NSELMAX + it] = a;
}
HD void k_topk(const P& p, int L, long it) {
    const int g = (int)(it % 2), r = NP + (int)(it / 2), s = seq_of_row(r), pos = row_pos(r), ns = seq_nsel(s), cur = pos / 64;
    const float* imp = p.ws + W_IMP + ((size_t)r * 2 + g) * NSELMAX; int* sel = (int*)(p.ws + W_SEL) + ((size_t)r * 2 + g) * 16;
    unsigned long long c0 = 0, c1 = 0, c2 = 0, c3 = 0;
    const int nk = ns < 16 ? ns : 16;
    for (int k = 0; k < 16; ++k) {
        int bj = -1; float bs = 0.f;
        if (k < nk) for (int j = 0; j < ns; ++j) {
            const unsigned long long bit = 1ull << (j & 63); const unsigned long long cw = (j < 64) ? c0 : (j < 128) ? c1 : (j < 192) ? c2 : c3;
            if (cw & bit) continue;
            const bool forced = (j == 0) || (j == cur) || (j == cur - 1), valid = j * 64 <= pos;
            const float sc = forced ? INFINITY : (valid ? imp[j] : -INFINITY);
            if (bj < 0 || sc > bs) { bj = j; bs = sc; }
        }
        sel[k] = bj;
        if (bj >= 0) { const unsigned long long bit = 1ull << (bj & 63); if (bj < 64) c0 |= bit; else if (bj < 128) c1 |= bit; else if (bj < 192) c2 |= bit; else c3 |= bit; }
    }
}
HD void k_slc_score(const P& p, int L, long it) {
    const int ks = (int)(it % 1024), h = (int)((it / 1024) % 8), r = NP + (int)(it / 8192), s = seq_of_row(r), pos = row_pos(r), g = h / 4;
    const int blk = ((const int*)(p.ws + W_SEL))[((size_t)r * 2 + g) * 16 + ks / 64];
    float v = -INFINITY;
    if (blk >= 0) { const int kpos = blk * 64 + (ks % 64);
        if (kpos <= pos) { const float* qq = p.ws + W_QR + (size_t)r * 512 + h * 64; const float* k = hist(p, L, s, kpos, 2, g);
            float a = 0.f; for (int d = 0; d < 64; ++d) a += qq[d] * k[d]; v = a * 0.125f; } }
    p.ws[W_PSLC + (size_t)NP * 8 * 1024 + it] = v;
}
HD void k_slc_softmax(const P& p, int L, long it) { softmax_row(p.ws + W_PSLC + ((size_t)NP * 8 + it) * 1024, 1024); }
HD void k_slc_out(const P& p, int L, long it) {
    const int d = (int)(it % 64), h = (int)((it / 64) % 8), r = NP + (int)(it / 512), s = seq_of_row(r), g = h / 4;
    const float* pr = p.ws + W_PSLC + ((size_t)r * 8 + h) * 1024; const int* sel = (const int*)(p.ws + W_SEL) + ((size_t)r * 2 + g) * 16; float a = 0.f;
    for (int ks = 0; ks < 1024; ++ks) { const float pv = pr[ks]; if (pv != 0.f) a += pv * hist(p, L, s, sel[ks / 64] * 64 + (ks % 64), 3, g)[d]; }
    p.ws[W_OSLC + (size_t)NP * 512 + it] = a;
}
HD int seq_first_pos(int s) { return s < BATCH ? 0 : PAST_LEN - WKEEP_S; }
HD void k_win_score(const P& p, int L, long it) {
    const int w = (int)(it % 512), h = (int)((it / 512) % 8), r = NP + (int)(it / 4096), s = seq_of_row(r), pos = row_pos(r), g = h / 4, kpos = pos - w;
    float v = -INFINITY;
    if (kpos >= seq_first_pos(s)) { const float* qq = p.ws + W_QR + (size_t)r * 512 + h * 64; const float* k = ctxp(p, L, s, kpos, 0, g);
        float a = 0.f; for (int d = 0; d < 64; ++d) a += qq[d] * k[d]; v = a * 0.125f; }
    p.ws[W_PWIN + (size_t)NP * 8 * 512 + it] = v;
}
HD void k_win_softmax(const P& p, int L, long it) { softmax_row(p.ws + W_PWIN + ((size_t)NP * 8 + it) * 512, 512); }
HD void k_win_out(const P& p, int L, long it) {
    const int d = (int)(it % 64), h = (int)((it / 64) % 8), r = NP + (int)(it / 512), s = seq_of_row(r), pos = row_pos(r), g = h / 4;
    const float* pr = p.ws + W_PWIN + ((size_t)r * 8 + h) * 512; float a = 0.f;
    for (int w = 0; w < 512; ++w) { const float pv = pr[w]; if (pv != 0.f) a += pv * ctxp(p, L, s, pos - w, 1, g)[d]; }
    p.ws[W_OWIN + (size_t)NP * 512 + it] = a;
}
HD void k_gla(const P& p, int L, long it) {
    const int dv = (int)(it % 64), h = (int)((it / 64) % 4), s = BATCH + (int)(it / 256), r0 = seq_row0(s), len = seq_len(s);
    float S[32];
#pragma unroll
    for (int k = 0; k < 32; ++k) S[k] = s < BATCH ? 0.f : p.state_gla[((((size_t)L * DEC_BATCH + (s - BATCH)) * 4 + h) * 32 + k) * 64 + dv];
    for (int t = 0; t < len; ++t) {
        const int r = r0 + t; const URow u = urow(p, r); const float* la = p.ws + W_LOGA + (size_t)r * 128 + h * 32;
        const float v = u[C_GV + h * 64 + dv]; float o = 0.f;
#pragma unroll
        for (int k = 0; k < 32; ++k) { S[k] = EXPF(la[k]) * S[k] + u[C_GK + h * 32 + k] * v; o += u[C_GQ + h * 32 + k] * S[k]; }
        p.ws[W_OA + (size_t)r * 256 + h * 64 + dv] = o * 0.17677669529663687f;
    }
    float* so = s < BATCH ? p.out + O_PGLA + (((size_t)L * BATCH + s) * 4 + h) * 2048 : p.out + O_SGLA + (((size_t)L * DEC_BATCH + (s - BATCH)) * 4 + h) * 2048;
#pragma unroll
    for (int k = 0; k < 32; ++k) so[k * 64 + dv] = S[k];
}
HD void k_mlstm(const P& p, int L, long it) {
    const int e = (int)(it % 65), h = (int)((it / 65) % 4), s = BATCH + (int)(it / 260), r0 = seq_row0(s), len = seq_len(s);
    float C[64]; float m = s < BATCH ? 0.f : p.state_m[((size_t)L * DEC_BATCH + (s - BATCH)) * 4 + h];
#pragma unroll
    for (int d = 0; d < 64; ++d) C[d] = s < BATCH ? 0.f : (e < 64 ? p.state_C[((((size_t)L * DEC_BATCH + (s - BATCH)) * 4 + h) * 64 + e) * 64 + d]
                                                                  : p.state_n[(((size_t)L * DEC_BATCH + (s - BATCH)) * 4 + h) * 64 + d]);
    const float bi = p.gate_b[(L * 2 + 0) * 4 + h], bf = p.gate_b[(L * 2 + 1) * 4 + h];
    for (int t = 0; t < len; ++t) {
        const int r = r0 + t; const URow u = urow(p, r); const float* q = p.ws + W_MQ + (size_t)r * 256 + h * 64; const float* k = p.ws + W_MK + (size_t)r * 256 + h * 64;
        const float ip = u[C_MIF + h] + bi, lf = log_sigmoidf(u[C_MIF + 4 + h] + bf), mn = fmaxf(lf + m, ip), fp = EXPF(lf + m - mn), iq = EXPF(ip - mn), v = e < 64 ? u[C_MV + h * 64 + e] : 1.0f;
        float num = 0.f;
#pragma unroll
        for (int d = 0; d < 64; ++d) { C[d] = fp * C[d] + iq * v * k[d]; num += C[d] * q[d]; }
        m = mn;
        if (e < 64) p.ws[W_H + (size_t)r * 256 + h * 64 + e] = num;
        else { p.ws[W_DEN + (size_t)r * 4 + h] = num; p.ws[W_MT + (size_t)r * 4 + h] = m; }
    }
    const size_t sb = s < BATCH ? ((size_t)L * BATCH + s) * 4 + h : ((size_t)L * DEC_BATCH + (s - BATCH)) * 4 + h;
    float* co = e < 64 ? p.out + (s < BATCH ? O_PC : O_SC) + (sb * 64 + e) * 64 : p.out + (s < BATCH ? O_PN : O_SN) + sb * 64;
#pragma unroll
    for (int d = 0; d < 64; ++d) co[d] = C[d];
    if (e == 64) p.out[(s < BATCH ? O_PM : O_SM) + sb] = m;
}
HD void k_mix_gla(const P& p, int L, long it) {
    const int h = (int)(it % 4), r = NP + (int)(it / 4); const float* o = p.ws + W_OA + (size_t)r * 256 + h * 64; float ss = 0.f;
    for (int d = 0; d < 64; ++d) ss += o[d] * o[d];
    const float rs = RSQRTF(ss / 64 + 1e-6f); const URow u = urow(p, r) + (C_GZ + h * 64);
    for (int d = 0; d < 64; ++d) mixb(p)[(size_t)r * D + h * 64 + d] = f2bf(o[d] * rs * p.gla_norm_g[L * 64 + d] * siluf(u[d]));
}
HD void k_mix_ml(const P& p, int L, long it) {
    const int h = (int)(it % 4), r = NP + (int)(it / 4); const float* o = p.ws + W_H + (size_t)r * 256 + h * 64; float ss = 0.f;
    const float dinv = 1.0f / fmaxf(fabsf(p.ws[W_DEN + (size_t)NP * 4 + it]), EXPF(-p.ws[W_MT + (size_t)NP * 4 + it]));
    for (int d = 0; d < 64; ++d) ss += o[d] * dinv * o[d] * dinv;
    const float rs = dinv / sqrtf(ss / 64 + 1e-6f); const URow u = urow(p, r);
    for (int d = 0; d < 64; ++d) mixb(p)[(size_t)r * D + 768 + h * 64 + d] = f2bf(o[d] * rs * p.ml_norm_g[L * 64 + d] * sigmoidf_(u[C_MO + h * 64 + d]) * siluf(u[C_MZ + h * 64 + d]));
}
HD void k_gemm_out_emu(const P& p, int L, long it) {
    const int r = (int)(it / D), c = (int)(it % D);
    const bf16_t* a = mixb(p) + (size_t)r * D; const bf16_t* w = wouttp(p, L) + (size_t)c * D; float s = 0.f;
    for (int k = 0; k < D; ++k) s += bf2f(a[k]) * bf2f(w[k]);
    (L == DEPTH - 1 ? p.out + O_Y : p.ws + W_Y0)[it] = xrow(p, L, r)[c] + s;
}

#ifdef CPU_EMU
#define LDSQ
#define EXP2F(x) exp2f(x)
#else
#define LDSQ __attribute__((address_space(3)))
#define EXP2F(x) __builtin_amdgcn_exp2f(x)
typedef short bf16x8 __attribute__((ext_vector_type(8)));
typedef short bf16x4 __attribute__((ext_vector_type(4)));
typedef float f32x4 __attribute__((ext_vector_type(4)));
typedef float f32x16 __attribute__((ext_vector_type(16)));
#endif
typedef LDSQ unsigned char* ldsp_t;
#ifdef CPU_EMU
#define LDS_ADDF(ptr, v) (*(ptr) += (v))
#else
#define LDS_ADDF(ptr, v) ((void)__hip_atomic_fetch_add((ptr), (v), __ATOMIC_RELAXED, __HIP_MEMORY_SCOPE_WORKGROUP))
#endif
#ifdef CPU_EMU
#define LDS_BARRIER() emu_syncthreads()
#define SCHED_FENCE() do {} while (0)
#else
#define SCHED_FENCE() __builtin_amdgcn_sched_barrier(0)
#define LDS_BARRIER() asm volatile("s_waitcnt lgkmcnt(0)\n\ts_barrier" ::: "memory")
#endif
#ifndef CPU_EMU
__device__ __forceinline__ int lane_fresh() { int l = (int)__builtin_amdgcn_mbcnt_hi(~0u, __builtin_amdgcn_mbcnt_lo(~0u, 0u)); asm volatile("" : "+v"(l)); return l; }
__device__ __forceinline__ int xl_shfl_xor_i(int v, int m) {
    if (m == 1) return __builtin_amdgcn_update_dpp(0, v, 0xB1, 0xF, 0xF, true);
    if (m == 2) return __builtin_amdgcn_update_dpp(0, v, 0x4E, 0xF, 0xF, true);
    if (m == 7) return __builtin_amdgcn_update_dpp(0, v, 0x141, 0xF, 0xF, true);
    if (m == 15) return __builtin_amdgcn_update_dpp(0, v, 0x140, 0xF, 0xF, true);
    return __builtin_amdgcn_ds_bpermute((lane_fresh() ^ m) << 2, v);
}
__device__ __forceinline__ float xl_shfl_xor(float v, int m) { return __builtin_bit_cast(float, xl_shfl_xor_i(__builtin_bit_cast(int, v), m)); }
__device__ __forceinline__ int xl_shfl_xor(int v, int m) { return xl_shfl_xor_i(v, m); }
__device__ __forceinline__ float xl_shfl(float v, int src) { return __builtin_bit_cast(float, __builtin_amdgcn_ds_bpermute(src << 2, __builtin_bit_cast(int, v))); }
__device__ __forceinline__ int xl_shfl(int v, int src) { return __builtin_amdgcn_ds_bpermute(src << 2, v); }
#define __shfl_xor xl_shfl_xor
#define __shfl xl_shfl
#endif
constexpr int LDS_MISC = 8 * 19456;
#ifdef CPU_EMU
#define opaque_tid() ((int)threadIdx.x)
#define RFL(x) (x)
HD int opaque_i(int v) { return v; }
#else
__device__ __forceinline__ int opaque_i(int v) { asm volatile("" : "+v"(v)); return v; }
constexpr int LDS_WTAB = LDS_MISC + 320;
__device__ __forceinline__ int hw_tid(__attribute__((address_space(3))) unsigned char* ldsb) {
    const unsigned hw = (unsigned)__builtin_amdgcn_s_getreg((5 << 11) | 4) & 63u;
    const int wv = __builtin_amdgcn_readfirstlane(*(__attribute__((address_space(3))) const int*)(ldsb + LDS_WTAB + hw * 4));
    unsigned t = (unsigned)wv * 64u + __builtin_amdgcn_mbcnt_hi(~0u, __builtin_amdgcn_mbcnt_lo(~0u, 0u)); asm volatile("" : "+v"(t)); return (int)t;
}
#define RFL(x) __builtin_amdgcn_readfirstlane(x)
#define opaque_tid() hw_tid(lds)
#endif
constexpr int NTHREADS = 512;
constexpr int KT_STRIDE = 144, VT_STRIDE = 136, KT_BYTES = 64 * KT_STRIDE, VT_BYTES = 64 * VT_STRIDE;
constexpr int NSA_KT = 0, NSA_VT = 3 * KT_BYTES, NSA_IMP = NSA_VT + 3 * VT_BYTES, NSA_MASK = NSA_IMP + 8 * 8 * 64 * 4, NSA_END = NSA_MASK + 8 * 8 * 8;
constexpr int NSA_COMB = 73728;
constexpr float C2LOG = 0.125f * 1.4426950408889634f;
constexpr float NEG_BIG = -1.0e30f;

typedef unsigned u32x4_t __attribute__((ext_vector_type(4)));
#ifdef CPU_EMU
HD float rlane(float v, int i) { return __shfl(v, i); }
#else
__device__ __forceinline__ float rlane(float v, int i) { return __builtin_bit_cast(float, __builtin_amdgcn_readlane(__builtin_bit_cast(int, v), i)); }
#endif
#ifdef CPU_EMU
HD unsigned pack2bf(float lo, float hi) { return (unsigned)f2bf(lo) | ((unsigned)f2bf(hi) << 16); }
#else
typedef __bf16 hwbf16x2_t __attribute__((ext_vector_type(2)));
typedef float hwf32x2_t __attribute__((ext_vector_type(2)));
__device__ __forceinline__ unsigned pack2bf(float lo, float hi) { const hwf32x2_t v = {lo, hi}; const hwbf16x2_t b = __builtin_convertvector(v, hwbf16x2_t); return __builtin_bit_cast(unsigned, b); }
#endif
HD void ld8f(const float* q, float (&f)[8]) { const f32x4 a = *(const f32x4*)q, b = *(const f32x4*)(q + 4); f[0] = a[0]; f[1] = a[1]; f[2] = a[2]; f[3] = a[3]; f[4] = b[0]; f[5] = b[1]; f[6] = b[2]; f[7] = b[3]; }
struct AttnSt { f32x16 o0, o1; float m, l; };
template <bool MASK> HD bool softmax_tile(f32x16& s0, f32x16& s1, int lim2, int lo2, bool sel, AttnSt& st, bf16x8 (&pf)[4], float& alpha) {
    float tmax = NEG_BIG;
    if (MASK) {
#pragma unroll
        for (int r = 0; r < 16; ++r) { const int kc = (r & 3) + 8 * (r >> 2);
            s0[r] = (kc <= lim2 && kc > lo2) ? s0[r] : NEG_BIG; s1[r] = (kc + 32 <= lim2 && kc + 32 > lo2) ? s1[r] : NEG_BIG; tmax = fmaxf(tmax, fmaxf(s0[r], s1[r])); }
    } else {
#pragma unroll
        for (int r = 0; r < 16; ++r) tmax = fmaxf(tmax, fmaxf(s0[r], s1[r]));
        tmax = sel ? tmax : NEG_BIG;
    }
    tmax = fmaxf(tmax, __shfl_xor(tmax, 32));
    const float mn = fmaxf(st.m, tmax); const bool any = __ballot(mn > st.m) != 0ull;
    alpha = 1.0f;
    if (any) { alpha = EXP2F(st.m - mn); st.l *= alpha; }
    st.m = mn;
    float ls = 0.f;
#pragma unroll
    for (int r = 0; r < 16; ++r) { float p0 = EXP2F(s0[r] - mn), p1 = EXP2F(s1[r] - mn);
        if (MASK) { p0 = s0[r] > -1.0e29f ? p0 : 0.f; p1 = s1[r] > -1.0e29f ? p1 : 0.f; }
        s0[r] = p0; s1[r] = p1; ls += p0 + p1; }
    u32x4_t w0, w1, w2, w3;
#pragma unroll
    for (int i = 0; i < 4; ++i) { w0[i] = pack2bf(s0[2 * i], s0[2 * i + 1]); w1[i] = pack2bf(s0[8 + 2 * i], s0[8 + 2 * i + 1]); w2[i] = pack2bf(s1[2 * i], s1[2 * i + 1]); w3[i] = pack2bf(s1[8 + 2 * i], s1[8 + 2 * i + 1]); }
    if (!MASK) { const unsigned km = sel ? 0xffffffffu : 0u; w0 &= km; w1 &= km; w2 &= km; w3 &= km; ls = sel ? ls : 0.f; }
    st.l += ls;
    pf[0] = __builtin_bit_cast(bf16x8, w0); pf[1] = __builtin_bit_cast(bf16x8, w1); pf[2] = __builtin_bit_cast(bf16x8, w2); pf[3] = __builtin_bit_cast(bf16x8, w3);
    return any;
}
HD void attn_init(AttnSt& s) { for (int r = 0; r < 16; ++r) { s.o0[r] = 0.f; s.o1[r] = 0.f; } s.m = NEG_BIG; s.l = 0.f; }
HD short bfbits(float f) { return (short)f2bf(f); }
template <bool IMP, bool MASK>
HD void attn_tile(ldsp_t lds, int buf, const bf16x8 (&qf)[4], float mb, int lim2, int lo2, bool sel, AttnSt& st, f32x16& i0, f32x16& i1, int ntile64, int c, int hi) {
    f32x16 s0, s1;
    for (int r = 0; r < 16; ++r) { s0[r] = -mb; s1[r] = -mb; }
    const ldsp_t kt = lds + NSA_KT + buf * KT_BYTES + c * KT_STRIDE + hi * 16;
#pragma unroll
    for (int ks = 0; ks < 4; ++ks) {
        const bf16x8 k0 = *(const LDSQ bf16x8*)(kt + ks * 32), k1 = *(const LDSQ bf16x8*)(kt + 32 * KT_STRIDE + ks * 32);
        s0 = __builtin_amdgcn_mfma_f32_32x32x16_bf16(k0, qf[ks], s0, 0, 0, 0);
        s1 = __builtin_amdgcn_mfma_f32_32x32x16_bf16(k1, qf[ks], s1, 0, 0, 0);
    }
    float ls = 0.f;
#pragma unroll
    for (int r = 0; r < 16; ++r) { float p0 = EXP2F(s0[r]), p1 = EXP2F(s1[r]);
        if (MASK) { const int kc = (r & 3) + 8 * (r >> 2); p0 = (kc <= lim2 && kc > lo2) ? p0 : 0.f; p1 = (kc + 32 <= lim2 && kc + 32 > lo2) ? p1 : 0.f; }
        s0[r] = p0; s1[r] = p1; ls += p0 + p1; }
    u32x4_t w0, w1, w2, w3;
#pragma unroll
    for (int i = 0; i < 4; ++i) { w0[i] = pack2bf(s0[2 * i], s0[2 * i + 1]); w1[i] = pack2bf(s0[8 + 2 * i], s0[8 + 2 * i + 1]); w2[i] = pack2bf(s1[2 * i], s1[2 * i + 1]); w3[i] = pack2bf(s1[8 + 2 * i], s1[8 + 2 * i + 1]); }
    if (!MASK) { const unsigned km = sel ? 0xffffffffu : 0u; w0 &= km; w1 &= km; w2 &= km; w3 &= km; ls = sel ? ls : 0.f; }
    st.l += ls;
    bf16x8 pf[4];
    pf[0] = __builtin_bit_cast(bf16x8, w0); pf[1] = __builtin_bit_cast(bf16x8, w1); pf[2] = __builtin_bit_cast(bf16x8, w2); pf[3] = __builtin_bit_cast(bf16x8, w3);
    const ldsp_t vt = lds + NSA_VT + buf * VT_BYTES + c * VT_STRIDE + hi * 8;
#pragma unroll
    for (int ks = 0; ks < 4; ++ks) {
        const bf16x4 a0 = *(const LDSQ bf16x4*)(vt + ks * 32), a1 = *(const LDSQ bf16x4*)(vt + ks * 32 + 16);
        const bf16x4 b0 = *(const LDSQ bf16x4*)(vt + 32 * VT_STRIDE + ks * 32), b1 = *(const LDSQ bf16x4*)(vt + 32 * VT_STRIDE + ks * 32 + 16);
        bf16x8 v0, v1;
#pragma unroll
        for (int j = 0; j < 4; ++j) { v0[j] = a0[j]; v0[4 + j] = a1[j]; v1[j] = b0[j]; v1[4 + j] = b1[j]; }
        st.o0 = __builtin_amdgcn_mfma_f32_32x32x16_bf16(v0, pf[ks], st.o0, 0, 0, 0);
        st.o1 = __builtin_amdgcn_mfma_f32_32x32x16_bf16(v1, pf[ks], st.o1, 0, 0, 0);
        if (IMP) {
#pragma unroll
            for (int jt = 0; jt < 2; ++jt) { const int base = ntile64 * 64 + 16 * ks + 4 * hi - 4 * (jt * 32 + c); bf16x8 af;
#pragma unroll
                for (int jj = 0; jj < 8; ++jj) { const int dl = base + 8 * (jj >> 2) + (jj & 3); af[jj] = (dl == -1 || dl == 3) ? (short)0x3F80 : ((dl >= 0 && dl <= 2) ? (short)0x4000 : (short)0); }
                if (jt == 0) i0 = __builtin_amdgcn_mfma_f32_32x32x16_bf16(af, pf[ks], i0, 0, 0, 0); else i1 = __builtin_amdgcn_mfma_f32_32x32x16_bf16(af, pf[ks], i1, 0, 0, 0); }
        }
    }
}
HD void imp_tile(ldsp_t lds, int buf, const bf16x8 (&qf)[4], float mb, float inv, int lim2, f32x16& i0, f32x16& i1, int ntile64, int c, int hi) {
    f32x16 s0, s1;
    for (int r = 0; r < 16; ++r) { s0[r] = -mb; s1[r] = -mb; }
    const ldsp_t kt = lds + NSA_KT + buf * KT_BYTES + c * KT_STRIDE + hi * 16;
#pragma unroll
    for (int ks = 0; ks < 4; ++ks) {
        const bf16x8 k0 = *(const LDSQ bf16x8*)(kt + ks * 32), k1 = *(const LDSQ bf16x8*)(kt + 32 * KT_STRIDE + ks * 32);
        s0 = __builtin_amdgcn_mfma_f32_32x32x16_bf16(k0, qf[ks], s0, 0, 0, 0);
        s1 = __builtin_amdgcn_mfma_f32_32x32x16_bf16(k1, qf[ks], s1, 0, 0, 0);
    }
#pragma unroll
    for (int r = 0; r < 16; ++r) { const int kc = (r & 3) + 8 * (r >> 2); s0[r] = kc <= lim2 ? EXP2F(s0[r]) * inv : 0.f; s1[r] = kc + 32 <= lim2 ? EXP2F(s1[r]) * inv : 0.f; }
    u32x4_t w0, w1, w2, w3;
#pragma unroll
    for (int i = 0; i < 4; ++i) { w0[i] = pack2bf(s0[2 * i], s0[2 * i + 1]); w1[i] = pack2bf(s0[8 + 2 * i], s0[8 + 2 * i + 1]); w2[i] = pack2bf(s1[2 * i], s1[2 * i + 1]); w3[i] = pack2bf(s1[8 + 2 * i], s1[8 + 2 * i + 1]); }
    bf16x8 pf[4];
    pf[0] = __builtin_bit_cast(bf16x8, w0); pf[1] = __builtin_bit_cast(bf16x8, w1); pf[2] = __builtin_bit_cast(bf16x8, w2); pf[3] = __builtin_bit_cast(bf16x8, w3);
#pragma unroll
    for (int ks = 0; ks < 4; ++ks)
#pragma unroll
        for (int jt = 0; jt < 2; ++jt) { const int base = ntile64 * 64 + 16 * ks + 4 * hi - 4 * (jt * 32 + c); bf16x8 af;
            const int jlo = 16 * ntile64 + 4 * ks;
            if (jlo + 4 < 32 * jt || jlo > 32 * jt + 31) continue;
#pragma unroll
            for (int jj = 0; jj < 8; ++jj) { const int dl = base + 8 * (jj >> 2) + (jj & 3); af[jj] = (dl == -1 || dl == 3) ? (short)0x3F80 : ((dl >= 0 && dl <= 2) ? (short)0x4000 : (short)0); }
            if (jt == 0) i0 = __builtin_amdgcn_mfma_f32_32x32x16_bf16(af, pf[ks], i0, 0, 0, 0); else i1 = __builtin_amdgcn_mfma_f32_32x32x16_bf16(af, pf[ks], i1, 0, 0, 0); }
}
HD float score_bound(const bf16x8 (&qf)[4], const float* kgain, int lane) {
    float ss = 0.f;
#pragma unroll
    for (int ks = 0; ks < 4; ++ks)
#pragma unroll
        for (int j = 0; j < 8; ++j) { const float v = bf2f((bf16_t)qf[ks][j]); ss += v * v; }
    ss += __shfl_xor(ss, 32);
    float g = fabsf(kgain[lane]);
    g = fmaxf(g, __shfl_xor(g, 1)); g = fmaxf(g, __shfl_xor(g, 2)); g = fmaxf(g, __shfl_xor(g, 7)); g = fmaxf(g, __shfl_xor(g, 15));
    g = fmaxf(fmaxf(rlane(g, 0), rlane(g, 16)), fmaxf(rlane(g, 32), rlane(g, 48)));
    return sqrtf(ss) * 8.0f * g * 1.01f + 0.01f;
}
HD void tile_load(const bf16_t* k, const bf16_t* vt, int tid, bf16x8& rk, bf16x8& rv) { rk = *(const bf16x8*)(k + tid * 8); rv = *(const bf16x8*)(vt + tid * 8); }
HD void tile_store(ldsp_t lds, int buf, int tid, const bf16x8& rk, const bf16x8& rv) {
    const int row = tid >> 3, ch = tid & 7;
    *(LDSQ bf16x8*)(lds + NSA_KT + buf * KT_BYTES + row * KT_STRIDE + ch * 16) = rk;
    bf16x4 a, b;
    for (int j = 0; j < 4; ++j) { a[j] = rv[j]; b[j] = rv[4 + j]; }
    *(LDSQ bf16x4*)(lds + NSA_VT + buf * VT_BYTES + row * VT_STRIDE + ch * 16) = a; *(LDSQ bf16x4*)(lds + NSA_VT + buf * VT_BYTES + row * VT_STRIDE + ch * 16 + 8) = b;
}
HD void qk_tile(ldsp_t lds, int buf, const bf16x8 (&qf)[4], float mb, f32x16& s0, f32x16& s1, int c, int hi) {
    for (int r = 0; r < 16; ++r) { s0[r] = -mb; s1[r] = -mb; }
    const ldsp_t kt = lds + NSA_KT + buf * KT_BYTES + c * KT_STRIDE + hi * 16;
#pragma unroll
    for (int ks = 0; ks < 4; ++ks) {
        const bf16x8 k0 = *(const LDSQ bf16x8*)(kt + ks * 32), k1 = *(const LDSQ bf16x8*)(kt + 32 * KT_STRIDE + ks * 32);
        s0 = __builtin_amdgcn_mfma_f32_32x32x16_bf16(k0, qf[ks], s0, 0, 0, 0);
        s1 = __builtin_amdgcn_mfma_f32_32x32x16_bf16(k1, qf[ks], s1, 0, 0, 0);
    }
}
template <bool MASK> HD void sm_tile(f32x16& s0, f32x16& s1, int lim2, int lo2, bool sel, float& l, bf16x8 (&pf)[4]) {
    float ls = 0.f;
#pragma unroll
    for (int r = 0; r < 16; ++r) { float p0 = EXP2F(s0[r]), p1 = EXP2F(s1[r]);
        if (MASK) { const int kc = (r & 3) + 8 * (r >> 2); p0 = (kc <= lim2 && kc > lo2) ? p0 : 0.f; p1 = (kc + 32 <= lim2 && kc + 32 > lo2) ? p1 : 0.f; }
        s0[r] = p0; s1[r] = p1; ls += p0 + p1; }
    u32x4_t w0, w1, w2, w3;
#pragma unroll
    for (int i = 0; i < 4; ++i) { w0[i] = pack2bf(s0[2 * i], s0[2 * i + 1]); w1[i] = pack2bf(s0[8 + 2 * i], s0[8 + 2 * i + 1]); w2[i] = pack2bf(s1[2 * i], s1[2 * i + 1]); w3[i] = pack2bf(s1[8 + 2 * i], s1[8 + 2 * i + 1]); }
    if (!MASK) { const unsigned km = sel ? 0xffffffffu : 0u; w0 &= km; w1 &= km; w2 &= km; w3 &= km; ls = sel ? ls : 0.f; }
    l += ls;
    pf[0] = __builtin_bit_cast(bf16x8, w0); pf[1] = __builtin_bit_cast(bf16x8, w1); pf[2] = __builtin_bit_cast(bf16x8, w2); pf[3] = __builtin_bit_cast(bf16x8, w3);
}
HD void pv_tile(ldsp_t lds, int buf, const bf16x8 (&pf)[4], AttnSt& st, int c, int hi) {
    const ldsp_t vt = lds + NSA_VT + buf * VT_BYTES + c * VT_STRIDE + hi * 8;
#pragma unroll
    for (int ks = 0; ks < 4; ++ks) {
        const bf16x4 a0 = *(const LDSQ bf16x4*)(vt + ks * 32), a1 = *(const LDSQ bf16x4*)(vt + ks * 32 + 16);
        const bf16x4 b0 = *(const LDSQ bf16x4*)(vt + 32 * VT_STRIDE + ks * 32), b1 = *(const LDSQ bf16x4*)(vt + 32 * VT_STRIDE + ks * 32 + 16);
        bf16x8 v0, v1;
#pragma unroll
        for (int j = 0; j < 4; ++j) { v0[j] = a0[j]; v0[4 + j] = a1[j]; v1[j] = b0[j]; v1[4 + j] = b1[j]; }
        st.o0 = __builtin_amdgcn_mfma_f32_32x32x16_bf16(v0, pf[ks], st.o0, 0, 0, 0);
        st.o1 = __builtin_amdgcn_mfma_f32_32x32x16_bf16(v1, pf[ks], st.o1, 0, 0, 0);
    }
}
struct TilePipe { bf16x8 k1, v1; };
HD void tp_start(ldsp_t lds, int tid, const bf16_t* kb, const bf16_t* vb, int nt, TilePipe& tp) {
    bf16x8 rk, rv, rk2, rv2; tile_load(kb, vb, tid, rk, rv);
    if (1 < nt) tile_load(kb + 4096, vb + 4096, tid, rk2, rv2);
    if (2 < nt) tile_load(kb + 2 * 4096, vb + 2 * 4096, tid, tp.k1, tp.v1);
    tile_store(lds, 0, tid, rk, rv);
    if (1 < nt) tile_store(lds, 1, tid, rk2, rv2);
    LDS_BARRIER();
}
HD void tp_advance(ldsp_t lds, int tid, const bf16_t* kb, const bf16_t* vb, int t, int nt, TilePipe& tp) {
    if (t + 2 < nt) tile_store(lds, (t + 2) % 3, tid, tp.k1, tp.v1);
    if (t + 3 < nt) tile_load(kb + (size_t)(t + 3) * 4096, vb + (size_t)(t + 3) * 4096, tid, tp.k1, tp.v1);
    LDS_BARRIER();
}
struct TileParm { bool masked, sel, skip; int lim2, lo2; };
struct BranchCtx { int qt, pos, hi, nlim, nlim_min, kb0; unsigned long long selmask; };
template <int BR> HD TileParm tile_parm(int t, const BranchCtx& x) {
    TileParm q; q.skip = false; q.sel = true; q.lo2 = -100000; q.lim2 = 0;
    if (BR == 0) { q.masked = !(64 * t + 63 <= x.nlim_min); q.lim2 = x.nlim - 64 * t - 4 * x.hi; }
    else if (BR == 1) { const bool s = ((x.selmask >> t) & 1ull) != 0ull; q.masked = t >= x.qt;
        if (q.masked) q.lim2 = s ? x.pos - 64 * t - 4 * x.hi : -100000; else { q.sel = s; q.skip = __ballot(s) == 0ull; } }
    else { const int kbx = x.kb0 + t, off = 64 * kbx + 4 * x.hi; q.masked = !(kbx < x.qt && kbx > x.qt - 8); q.lim2 = x.pos - off; q.lo2 = x.pos - WIN - off; }
    return q;
}
HD void sm_pv(ldsp_t lds, int buf, const TileParm& q, f32x16& s0, f32x16& s1, AttnSt& st, int c, int hi) {
    bf16x8 pf[4];
    if (q.masked) sm_tile<true>(s0, s1, q.lim2, q.lo2, true, st.l, pf); else sm_tile<false>(s0, s1, 0, 0, q.sel, st.l, pf);
    pv_tile(lds, buf, pf, st, c, hi);
}
HD void qk_sm_int(ldsp_t lds, int bufn, const bf16x8 (&qf)[4], float mb, f32x16& n0, f32x16& n1, f32x16& c0, f32x16& c1, bool sel, float& l, bf16x8 (&pf)[4], int c, int hi) {
    for (int r = 0; r < 16; ++r) { n0[r] = -mb; n1[r] = -mb; }
    const ldsp_t kt = lds + NSA_KT + bufn * KT_BYTES + c * KT_STRIDE + hi * 16;
    bf16x8 k0 = *(const LDSQ bf16x8*)(kt), k1 = *(const LDSQ bf16x8*)(kt + 32 * KT_STRIDE);
    float ls = 0.f;
#pragma unroll
    for (int ks = 0; ks < 4; ++ks) {
        n0 = __builtin_amdgcn_mfma_f32_32x32x16_bf16(k0, qf[ks], n0, 0, 0, 0);
        n1 = __builtin_amdgcn_mfma_f32_32x32x16_bf16(k1, qf[ks], n1, 0, 0, 0);
        if (ks < 3) { k0 = *(const LDSQ bf16x8*)(kt + (ks + 1) * 32); k1 = *(const LDSQ bf16x8*)(kt + 32 * KT_STRIDE + (ks + 1) * 32); }
#pragma unroll
        for (int r = 4 * ks; r < 4 * ks + 4; ++r) { const float p0 = EXP2F(c0[r]), p1 = EXP2F(c1[r]); c0[r] = p0; c1[r] = p1; ls += p0 + p1; }
        SCHED_FENCE();
    }
    u32x4_t w0, w1, w2, w3;
#pragma unroll
    for (int i = 0; i < 4; ++i) { w0[i] = pack2bf(c0[2 * i], c0[2 * i + 1]); w1[i] = pack2bf(c0[8 + 2 * i], c0[8 + 2 * i + 1]); w2[i] = pack2bf(c1[2 * i], c1[2 * i + 1]); w3[i] = pack2bf(c1[8 + 2 * i], c1[8 + 2 * i + 1]); }
    const unsigned km = sel ? 0xffffffffu : 0u; w0 &= km; w1 &= km; w2 &= km; w3 &= km; l += sel ? ls : 0.f;
    pf[0] = __builtin_bit_cast(bf16x8, w0); pf[1] = __builtin_bit_cast(bf16x8, w1); pf[2] = __builtin_bit_cast(bf16x8, w2); pf[3] = __builtin_bit_cast(bf16x8, w3);
}
template <int BR> HD void nsa_branch(ldsp_t lds, int tid, const bf16_t* kb, const bf16_t* vb, int nt, int i0, int i1, const bf16x8 (&qf)[4], float mb, AttnSt& st, TilePipe& tp, const BranchCtx& x, int c, int hi) {
    tp_start(lds, tid, kb, vb, nt, tp);
    f32x16 a0, a1, b0, b1; bf16x8 pf[4];
    int t = 0;
#pragma unroll 1
    for (; t < i0; ++t) { const TileParm q = tile_parm<BR>(t, x); qk_tile(lds, t % 3, qf, mb, a0, a1, c, hi); sm_pv(lds, t % 3, q, a0, a1, st, c, hi); tp_advance(lds, tid, kb, vb, t, nt, tp); }
    bool pending = false;
    if (t < i1) {
        qk_tile(lds, t % 3, qf, mb, a0, a1, c, hi);
#pragma unroll 1
        for (; t < i1; ++t) {
            const bool sel = BR == 1 ? ((x.selmask >> t) & 1ull) != 0ull : true;
            qk_sm_int(lds, (t + 1) % 3, qf, mb, b0, b1, a0, a1, sel, st.l, pf, c, hi); pv_tile(lds, t % 3, pf, st, c, hi); tp_advance(lds, tid, kb, vb, t, nt, tp);
            a0 = b0; a1 = b1;
        }
        pending = t < nt;
    }
#pragma unroll 1
    for (; t < nt; ++t) { const TileParm q = tile_parm<BR>(t, x); if (!pending) qk_tile(lds, t % 3, qf, mb, a0, a1, c, hi); pending = false; sm_pv(lds, t % 3, q, a0, a1, st, c, hi); tp_advance(lds, tid, kb, vb, t, nt, tp); }
}
struct NsaIdx { int row, head, hi; };
HD NsaIdx nsa_idx(ldsp_t lds, int b, int g, int qt) { const int tid = opaque_tid(), lane = tid & 63, w = tid >> 6, c = lane & 31; NsaIdx x; x.row = b * SEQ + 64 * qt + 8 * w + (c >> 2); x.head = g * 4 + (c & 3); x.hi = lane >> 5; return x; }
HD float nsa_gate(const P& p, ldsp_t lds, int b, int g, int qt, int br) { const NsaIdx x = nsa_idx(lds, b, g, qt); return sigmoidf_(urow(p, x.row)[C_NG + br * 8 + x.head]); }
HD void nsa_load_q(const P& p, ldsp_t lds, int b, int g, int qt, size_t wb, bf16x8 (&qf)[4]) { const NsaIdx x = nsa_idx(lds, b, g, qt);
    const bf16_t* qp = wsb(p, wb) + (size_t)x.row * 512 + x.head * 64 + x.hi * 8;
#pragma unroll
    for (int ks = 0; ks < 4; ++ks) qf[ks] = *(const bf16x8*)(qp + ks * 16); }
HD float nsa_gate_raw(const P& p, ldsp_t lds, int b, int g, int qt, int br) { const NsaIdx x = nsa_idx(lds, b, g, qt); return urow(p, x.row)[C_NG + br * 8 + x.head]; }
HD void nsa_unit(const P& p, int L, ldsp_t lds, int b, int g, int qt) {
    const int tid = opaque_tid(), lane = tid & 63, w = RFL(tid >> 6), c = lane & 31, hi = lane >> 5;
    const int pos = 64 * qt + 8 * w + (c >> 2);
    const size_t bg = (size_t)b * 2 + g;
    bf16x8 qf[4]; TilePipe tp; AttnSt st; f32x16 i0, i1;
    LDSQ float* combl = (LDSQ float*)(lds + NSA_COMB + w * 8192) + lane;
    for (int r = 0; r < 16; ++r) { i0[r] = 0.f; i1[r] = 0.f; }
    bf16x8 qfr[4];
    nsa_load_q(p, lds, b, g, qt, WB_QNB, qf); nsa_load_q(p, lds, b, g, qt, WB_QRB, qfr);
    const float gr0 = nsa_gate_raw(p, lds, b, g, qt, 0), gr1 = nsa_gate_raw(p, lds, b, g, qt, 1), gr2 = nsa_gate_raw(p, lds, b, g, qt, 2);
    attn_init(st);
    {
        const float mb = score_bound(qf, p.k_norm_g + (L * 3 + 0) * 64, lane);
        const int nt_n = ((4 * qt + 2) >> 6) + 1;
        const bf16_t* kb = wsb(p, WB_KCB) + bg * NCPAD * 64; const bf16_t* vb = wsb(p, WB_VCT) + bg * (NCPAD / 64) * 4096;
        const int nlim = (pos - 31) >> 4, nlim_min = (64 * qt + 8 * w - 31) >> 4;
        BranchCtx bx; bx.qt = qt; bx.pos = pos; bx.hi = hi; bx.nlim = nlim; bx.nlim_min = nlim_min; bx.kb0 = 0; bx.selmask = 0ull;
        { int ni = (nlim_min + 1) >> 6; ni = ni < 0 ? 0 : (ni > nt_n ? nt_n : ni);
          nsa_branch<0>(lds, tid, kb, vb, nt_n, 0, ni, qf, mb, st, tp, bx, c, hi); }
        {
            const float lt1 = st.l + __shfl_xor(st.l, 32), inv1 = lt1 > 0.f ? RCPF(lt1) : 0.f;
            tp_start(lds, tid, kb, vb, nt_n, tp);
            for (int t = 0; t < nt_n; ++t) { imp_tile(lds, t % 3, qf, mb, inv1, nlim - 64 * t - 4 * hi, i0, i1, t, c, hi); tp_advance(lds, tid, kb, vb, t, nt_n, tp); }
        }
    }
    unsigned long long selmask;
    {
        const float lt = st.l + __shfl_xor(st.l, 32), inv = lt > 0.f ? RCPF(lt) : 0.f, gate = sigmoidf_(gr0) * inv;
        LDSQ float* impw = (LDSQ float*)(lds + NSA_IMP) + w * 512;
#pragma unroll
        for (int r = 0; r < 16; ++r) { combl[r * 64] = gate * st.o0[r]; combl[(16 + r) * 64] = gate * st.o1[r];
            float v0 = i0[r], v1 = i1[r];
            v0 += __shfl_xor(v0, 1); v0 += __shfl_xor(v0, 2); v1 += __shfl_xor(v1, 1); v1 += __shfl_xor(v1, 2);
            if ((c & 3) == 0) { const int j = (r & 3) + 8 * (r >> 2) + 4 * hi; impw[(c >> 2) * 64 + j] = v0; impw[(c >> 2) * 64 + 32 + j] = v1; } }
        __syncthreads();
        LDSQ unsigned long long* maskw = (LDSQ unsigned long long*)(lds + NSA_MASK) + w * 8;
#pragma unroll 1
        for (int q = 0; q < 8; ++q) {
            const int j = lane; const bool forced = (j == 0) || (j == qt) || (j == qt - 1), valid = j <= qt;
            const unsigned key = forced ? 0xFFFFFFFFu : (valid ? __builtin_bit_cast(unsigned, impw[q * 64 + j]) + 1u : 0u);
            unsigned thr = 0u;
#pragma unroll 4
            for (int bit = 31; bit >= 0; --bit) { const unsigned cand = thr | (1u << bit); if (__builtin_popcountll(__ballot(key >= cand)) >= 16) thr = cand; }
            const unsigned long long mgt = __ballot(key > thr), meq = __ballot(key == thr), below = (lane == 0) ? 0ull : (~0ull >> (64 - lane));
            const int need = 16 - __builtin_popcountll(mgt);
            const bool pick = key > thr || (key == thr && __builtin_popcountll(meq & below) < need);
            const unsigned long long mk = __ballot(pick);
            if (lane == 0) maskw[q] = mk;
        }
        __syncthreads();
        selmask = maskw[c >> 2];
    }
#pragma unroll
    for (int ks = 0; ks < 4; ++ks) qf[ks] = qfr[ks];
    attn_init(st);
    {
        const bf16_t* kb = wsb(p, WB_KSB) + bg * SEQ * 64; const bf16_t* vb = wsb(p, WB_VST) + bg * NQT * 4096;
        const int nt_n = qt + 1; const float mb = score_bound(qf, p.k_norm_g + (L * 3 + 1) * 64, lane);
        BranchCtx bx; bx.qt = qt; bx.pos = pos; bx.hi = hi; bx.nlim = 0; bx.nlim_min = 0; bx.kb0 = 0; bx.selmask = selmask;
        nsa_branch<1>(lds, tid, kb, vb, nt_n, 0, qt, qf, mb, st, tp, bx, c, hi);
        const float lt = st.l + __shfl_xor(st.l, 32), inv = lt > 0.f ? RCPF(lt) : 0.f, gate = sigmoidf_(gr1) * inv;
#pragma unroll
        for (int r = 0; r < 16; ++r) { combl[r * 64] += gate * st.o0[r]; combl[(16 + r) * 64] += gate * st.o1[r]; }
    }
    attn_init(st);
    {
        const bf16_t* kb = wsb(p, WB_KWB) + bg * SEQ * 64; const bf16_t* vb = wsb(p, WB_VWT) + bg * NQT * 4096;
        const int kb0 = qt - 8 > 0 ? qt - 8 : 0, nt_n = qt - kb0 + 1;
        const float mb = score_bound(qf, p.k_norm_g + (L * 3 + 2) * 64, lane);
        const bf16_t* kb2 = kb + (size_t)kb0 * 4096; const bf16_t* vb2 = vb + (size_t)kb0 * 4096;
        BranchCtx bx; bx.qt = qt; bx.pos = pos; bx.hi = hi; bx.nlim = 0; bx.nlim_min = 0; bx.kb0 = kb0; bx.selmask = 0ull;
        nsa_branch<2>(lds, tid, kb2, vb2, nt_n, qt >= 8 ? 1 : 0, nt_n - 1, qf, mb, st, tp, bx, c, hi);
        const float lt = st.l + __shfl_xor(st.l, 32), inv = lt > 0.f ? RCPF(lt) : 0.f, gate = sigmoidf_(gr2) * inv;
#pragma unroll
        for (int r = 0; r < 16; ++r) { st.o0[r] = combl[r * 64] + gate * st.o0[r]; st.o1[r] = combl[(16 + r) * 64] + gate * st.o1[r]; }
    }
    const NsaIdx xo = nsa_idx(lds, b, g, qt); const int hi2 = xo.hi;
    bf16_t* mo = mixb(p) + (size_t)xo.row * D + 256 + xo.head * 64; const URow nz = urow(p, xo.row) + (C_NZ + xo.head * 64);
#pragma unroll
    for (int q4 = 0; q4 < 4; ++q4) { const int d0 = 8 * q4 + 4 * hi2;
        const bf16x4 z0 = *(const bf16x4*)(nz.q + d0), z1 = *(const bf16x4*)(nz.q + 32 + d0); bf16x4 r0, r1;
#pragma unroll
        for (int e = 0; e < 4; ++e) { r0[e] = (short)f2bf(st.o0[4 * q4 + e] * siluf(bf2f((bf16_t)z0[e]))); r1[e] = (short)f2bf(st.o1[4 * q4 + e] * siluf(bf2f((bf16_t)z1[e]))); }
        *(bf16x4*)(mo + d0) = r0; *(bf16x4*)(mo + 32 + d0) = r1; }
}
HD void bphase_nsa_prompt(const P& p, int L, ldsp_t lds) {
    constexpr int NPAIR = BATCH * 2 * (NQT / 2);
    for (int pi0 = blockIdx.x; pi0 < NPAIR; pi0 += gridDim.x) {
        const int G = (int)gridDim.x, pi = (G % 8 == 0 && NPAIR % G == 0) ? ((pi0 % G) % 8) * (G / 8) + (pi0 % G) / 8 + (pi0 / G) * G : pi0;
        const int bgi = pi / (NQT / 2), q = pi % (NQT / 2);
        nsa_unit(p, L, lds, bgi >> 1, bgi & 1, NQT - 1 - q);
        nsa_unit(p, L, lds, bgi >> 1, bgi & 1, q);
    }
}

#ifdef CPU_EMU
#define WAVE_SYNC() emu_wave_sync()
#else
#define WAVE_SYNC() do { __builtin_amdgcn_fence(__ATOMIC_ACQ_REL, "wavefront"); __builtin_amdgcn_wave_barrier(); } while (0)
#endif
constexpr int GL_Q = 0, GL_K = 5120, GL_V = 10240, GL_WAVE = 19456;
HD int sw64(int row, int chunk) { return row * 80 + (chunk << 4); }
HD int sw128(int row, int chunk) { return row * 144 + (chunk << 4); }
HD int swv(int row, int q) { return row * 136 + (q << 3); }
static_assert(GL_V + 64 * 136 <= GL_WAVE && 64 * 144 <= GL_V, "per-wave LDS map");
HD float* gs_loc(const P& p, int b, int h, int c) { return p.ws + W_GSLOC + (((size_t)b * 4 + h) * NQT + c) * 2048; }
HD float* gs_bl(const P& p, int b, int h, int c) { return p.ws + W_GSBL + (((size_t)b * 4 + h) * NQT + c) * 32; }
template <class Src> HD void stage_vt_load(Src vsrc  , size_t row_stride, int lane, float (&tmp)[64]) {
#pragma unroll
    for (int j = 0; j < 64; ++j) tmp[j] = vsrc[(size_t)j * row_stride + lane];
}
HD void stage_vt_store(ldsp_t lw, int lane, const float (&tmp)[64]) {
#pragma unroll
    for (int j = 0; j < 64; ++j) *(LDSQ bf16_t*)(lw + GL_V + swv(lane, j >> 2) + (j & 3) * 2) = f2bf(tmp[j]);
    SCHED_FENCE();
}
HD bf16x8 ld_vt_frag(ldsp_t lw, int e, int q) {
    const bf16x4 a = *(const LDSQ bf16x4*)(lw + GL_V + swv(e, q)), b = *(const LDSQ bf16x4*)(lw + GL_V + swv(e, q + 2)); bf16x8 v;
    for (int j = 0; j < 4; ++j) { v[j] = a[j]; v[4 + j] = b[j]; } return v;
}
HD bf16x8 ld_vt_nat(ldsp_t lw, int e, int q) {
    const bf16x4 a = *(const LDSQ bf16x4*)(lw + GL_V + swv(e, q)), b = *(const LDSQ bf16x4*)(lw + GL_V + swv(e, q + 1)); bf16x8 v;
    for (int j = 0; j < 4; ++j) { v[j] = a[j]; v[4 + j] = b[j]; } return v;
}
HD void gla_cumsum(const P& p, int row0, int h, int lane, float (&bc)[32], float& tot0, float& blast) {
    const int dk = lane & 31, half = lane >> 5; const float* la = p.ws + W_LOGA + (size_t)(row0 + half * 32) * 128 + h * 32 + dk; float run = 0.f;
#pragma unroll
    for (int i = 0; i < 32; ++i) { run += la[(size_t)i * 128]; bc[i] = run; }
    tot0 = __shfl(run, dk); const float tot1 = __shfl(run, 32 + dk); blast = tot0 + tot1;
    if (half) {
#pragma unroll
        for (int i = 0; i < 32; ++i) bc[i] += tot0; }
}
HD void gla_g1_unit(const P& p, int L, ldsp_t lw, int b, int h, int c, int lane_) {
    const int lane = opaque_i(lane_);
    const int row0 = b * SEQ + c * 64, dk = lane & 31, half = lane >> 5, hi = half;
    WAVE_SYNC();
    float bc[32], tot0, blast; gla_cumsum(p, row0, h, lane, bc, tot0, blast);
    float vtmp[64]; stage_vt_load(urow(p, row0) + (C_GV + h * 64), U_LD, lane, vtmp);
    const URow ku = urow(p, row0 + half * 32) + (C_GK + h * 32 + dk);
#pragma unroll
    for (int i = 0; i < 32; ++i) { const int j = half * 32 + i;
        *(LDSQ bf16_t*)(lw + GL_Q + sw128(dk, j >> 3) + (j & 7) * 2) = f2bf(ku[(size_t)i * U_LD] * EXPF(blast - bc[i])); }
    stage_vt_store(lw, lane, vtmp);
    if (lane < 32) gs_bl(p, b, h, c)[lane] = blast;
    WAVE_SYNC();
    f32x16 a0, a1;
    for (int r = 0; r < 16; ++r) { a0[r] = 0.f; a1[r] = 0.f; }
#pragma unroll
    for (int ks = 0; ks < 4; ++ks) {
        const bf16x8 kf = *(const LDSQ bf16x8*)(lw + GL_Q + sw128(dk, 2 * ks + hi));
        a0 = __builtin_amdgcn_mfma_f32_32x32x16_bf16(ld_vt_nat(lw, dk, 4 * ks + 2 * hi), kf, a0, 0, 0, 0);
        a1 = __builtin_amdgcn_mfma_f32_32x32x16_bf16(ld_vt_nat(lw, 32 + dk, 4 * ks + 2 * hi), kf, a1, 0, 0, 0);
    }
    float* so = gs_loc(p, b, h, c);
#pragma unroll
    for (int r = 0; r < 16; ++r) { const int e = (r & 3) + 8 * (r >> 2) + 4 * hi; so[e * 32 + dk] = a0[r]; so[(32 + e) * 32 + dk] = a1[r]; }
}
HD void k_gla_scan(const P& p, int L, long it) {
    const int d = (int)(it % 32), e = (int)((it / 32) % 64), h = (int)((it / 2048) % 4), b = (int)(it / 8192); float S = 0.f;
    for (int c0 = 0; c0 < NQT; c0 += 16) { float loc[16], al[16];
#pragma unroll
        for (int k = 0; k < 16; ++k) { const int c = c0 + k < NQT ? c0 + k : NQT - 1; loc[k] = gs_loc(p, b, h, c)[e * 32 + d]; al[k] = gs_bl(p, b, h, c)[d]; }
#pragma unroll
        for (int k = 0; k < 16; ++k) if (c0 + k < NQT) { const float prev = S; S = EXPF(al[k]) * S + loc[k]; loc[k] = prev; }
#pragma unroll
        for (int k = 0; k < 16; ++k) if (c0 + k < NQT) gs_loc(p, b, h, c0 + k)[e * 32 + d] = loc[k]; }
    p.out[O_PGLA + (((size_t)L * BATCH + b) * 4 + h) * 2048 + d * 64 + e] = S;
}
HD void gla_g2_unit(const P& p, int L, ldsp_t lw, int b, int h, int c, int lane_) {
    const int lane = opaque_i(lane_);
    const int row0 = b * SEQ + c * 64, dk = lane & 31, half = lane >> 5, hi = half, cl = lane & 31;
    WAVE_SYNC();
    float bc[32], tot0, blast; gla_cumsum(p, row0, h, lane, bc, tot0, blast);
    float svr[2][2][8];
    { const float* ss = gs_loc(p, b, h, c);
#pragma unroll
      for (int et = 0; et < 2; ++et)
#pragma unroll
        for (int ks = 0; ks < 2; ++ks) ld8f(ss + (32 * et + cl) * 32 + 16 * ks + 8 * hi, svr[et][ks]); }
    float vtmp[64]; stage_vt_load(urow(p, row0) + (C_GV + h * 64), U_LD, lane, vtmp);
    const URow qu = urow(p, row0 + half * 32) + (C_GQ + h * 32 + dk); const URow ku = qu + (C_GK - C_GQ);
#pragma unroll
    for (int i = 0; i < 32; ++i) { const int j = half * 32 + i; const float dl = bc[i] - tot0;
        *(LDSQ bf16_t*)(lw + GL_Q + sw64(j, dk >> 3) + (dk & 7) * 2) = f2bf(qu[(size_t)i * U_LD] * 0.17677669529663687f * EXPF(dl));
        *(LDSQ bf16_t*)(lw + GL_K + sw64(j, dk >> 3) + (dk & 7) * 2) = f2bf(ku[(size_t)i * U_LD] * EXPF(-dl)); }
    stage_vt_store(lw, lane, vtmp);
    WAVE_SYNC();
    bf16x8 sf[2][2];
    {
#pragma unroll
      for (int et = 0; et < 2; ++et)
#pragma unroll
        for (int ks = 0; ks < 2; ++ks)
            {
#pragma unroll
              for (int jj = 0; jj < 8; ++jj) { const int d = 16 * ks + 8 * hi + jj; const float br = __shfl(tot0, d); sf[et][ks][jj] = (short)f2bf(svr[et][ks][jj] * EXPF(br)); } } }
    const URow gz = urow(p, row0) + (C_GZ + h * 64); const float* ng = p.gla_norm_g + L * 64;
#pragma unroll
    for (int it = 0; it < 2; ++it) {
        const int i = 32 * it + cl;
        bf16x8 qf[2];
        qf[0] = *(const LDSQ bf16x8*)(lw + GL_Q + sw64(i, hi)); qf[1] = *(const LDSQ bf16x8*)(lw + GL_Q + sw64(i, 2 + hi));
        f32x16 o0, o1;
        for (int r = 0; r < 16; ++r) { o0[r] = 0.f; o1[r] = 0.f; }
#pragma unroll
        for (int ks = 0; ks < 2; ++ks) { o0 = __builtin_amdgcn_mfma_f32_32x32x16_bf16(sf[0][ks], qf[ks], o0, 0, 0, 0); o1 = __builtin_amdgcn_mfma_f32_32x32x16_bf16(sf[1][ks], qf[ks], o1, 0, 0, 0); }
#pragma unroll
        for (int jt = 0; jt <= it; ++jt) {
            f32x16 at;
            for (int r = 0; r < 16; ++r) at[r] = 0.f;
#pragma unroll
            for (int ks = 0; ks < 2; ++ks) at = __builtin_amdgcn_mfma_f32_32x32x16_bf16(*(const LDSQ bf16x8*)(lw + GL_K + sw64(32 * jt + cl, 2 * ks + hi)), qf[ks], at, 0, 0, 0);
            bf16x8 pf[2];
#pragma unroll
            for (int r = 0; r < 16; ++r) { const int jl = (r & 3) + 8 * (r >> 2) + 4 * hi; const float v = (jt < it || jl <= cl) ? at[r] : 0.f; pf[r >> 3][r & 7] = (short)f2bf(v); }
#pragma unroll
            for (int s = 0; s < 2; ++s) { const int q = 8 * jt + 4 * s + hi;
                o0 = __builtin_amdgcn_mfma_f32_32x32x16_bf16(ld_vt_frag(lw, cl, q), pf[s], o0, 0, 0, 0);
                o1 = __builtin_amdgcn_mfma_f32_32x32x16_bf16(ld_vt_frag(lw, 32 + cl, q), pf[s], o1, 0, 0, 0); }
        }
        float ss = 0.f;
#pragma unroll
        for (int r = 0; r < 16; ++r) ss += o0[r] * o0[r] + o1[r] * o1[r];
        ss += __shfl_xor(ss, 32);
        const float rs = RSQRTF(ss * (1.0f / 64) + 1e-6f);
        bf16_t* mo = mixb(p) + (size_t)(row0 + i) * D + h * 64; const URow gzr = gz + (size_t)i * U_LD;
#pragma unroll
        for (int q4 = 0; q4 < 4; ++q4) { const int e0 = 8 * q4 + 4 * hi;
            const bf16x4 z0 = *(const bf16x4*)(gzr.q + e0), z1 = *(const bf16x4*)(gzr.q + 32 + e0); const f32x4 g0 = *(const f32x4*)(ng + e0), g1 = *(const f32x4*)(ng + 32 + e0); bf16x4 r0, r1;
#pragma unroll
            for (int k = 0; k < 4; ++k) { r0[k] = (short)f2bf(o0[4 * q4 + k] * rs * g0[k] * siluf(bf2f((bf16_t)z0[k]))); r1[k] = (short)f2bf(o1[4 * q4 + k] * rs * g1[k] * siluf(bf2f((bf16_t)z1[k]))); }
            *(bf16x4*)(mo + e0) = r0; *(bf16x4*)(mo + 32 + e0) = r1; }
    }
}
constexpr int LDS_WX = LDS_MISC + 1024;
HD float* ml_cloc(const P& p, int b, int h, int c) { return p.ws + W_MCLOC + (((size_t)b * 4 + h) * NQT + c) * 4160; }
HD float* ml_fg(const P& p, int b, int h, int c) { return p.ws + W_MFG + (((size_t)b * 4 + h) * NQT + c) * 4; }
HD float wave_max(float v) { for (int o = 1; o < 64; o <<= 1) v = fmaxf(v, __shfl_xor(v, o)); return v; }
HD void ml_gates(const P& p, int L, int row0, int h, int lane, float& ii, float& fcum) {
    const URow u = urow(p, row0 + lane) + C_MIF;
    ii = u[h] + p.gate_b[(L * 2 + 0) * 4 + h]; float f = log_sigmoidf(u[4 + h] + p.gate_b[(L * 2 + 1) * 4 + h]);
    for (int o = 1; o < 64; o <<= 1) { const float t = __shfl(f, lane - o >= 0 ? lane - o : lane); if (lane >= o) f += t; }
    fcum = f;
}
HD void ml_g1_unit(const P& p, int L, ldsp_t lw, int b, int h, int c, int lane_) {
    const int lane = opaque_i(lane_);
    const int row0 = b * SEQ + c * 64, cl = lane & 31, hi = lane >> 5;
    WAVE_SYNC();
    float ii, fcum; ml_gates(p, L, row0, h, lane, ii, fcum);
    const float F = __shfl(fcum, 63), g = ii - fcum, G = F + wave_max(g), wj = EXPF(F + g - G);
    float nacc = 0.f;
    float vtmp[64]; stage_vt_load(urow(p, row0) + (C_MV + h * 64), U_LD, lane, vtmp);
    const float* ku = p.ws + W_MK + (size_t)row0 * 256 + h * 64 + lane;
#pragma unroll 32
    for (int j = 0; j < 64; ++j) { const float v = ku[(size_t)j * 256] * __shfl(wj, j); nacc += v; *(LDSQ bf16_t*)(lw + GL_Q + sw128(lane, j >> 3) + (j & 7) * 2) = f2bf(v); }
    stage_vt_store(lw, lane, vtmp);
    WAVE_SYNC();
    f32x16 a[2][2];
    for (int x = 0; x < 4; ++x) for (int r = 0; r < 16; ++r) a[x >> 1][x & 1][r] = 0.f;
#pragma unroll
    for (int ks = 0; ks < 4; ++ks) {
        const bf16x8 v0 = ld_vt_nat(lw, cl, 4 * ks + 2 * hi), v1 = ld_vt_nat(lw, 32 + cl, 4 * ks + 2 * hi);
#pragma unroll
        for (int dt = 0; dt < 2; ++dt) { const bf16x8 kf = *(const LDSQ bf16x8*)(lw + GL_Q + sw128(32 * dt + cl, 2 * ks + hi));
            a[0][dt] = __builtin_amdgcn_mfma_f32_32x32x16_bf16(v0, kf, a[0][dt], 0, 0, 0); a[1][dt] = __builtin_amdgcn_mfma_f32_32x32x16_bf16(v1, kf, a[1][dt], 0, 0, 0); }
    }
    float* so = ml_cloc(p, b, h, c);
#pragma unroll
    for (int et = 0; et < 2; ++et)
#pragma unroll
        for (int dt = 0; dt < 2; ++dt)
#pragma unroll
            for (int r = 0; r < 16; ++r) so[(32 * et + (r & 3) + 8 * (r >> 2) + 4 * hi) * 64 + 32 * dt + cl] = a[et][dt][r];
    so[64 * 64 + lane] = nacc;
    if (lane == 0) { float* fg = ml_fg(p, b, h, c); fg[0] = F; fg[1] = G; }
}
HD void k_ml_scan(const P& p, int L, long it) {
    const int d = (int)(it % 64), e = (int)((it / 64) % 65), h = (int)((it / 4160) % 4), b = (int)(it / 16640); float S = 0.f, ms = 0.f;
    for (int c0 = 0; c0 < NQT; c0 += 16) { float loc[16], Fv[16], Gv[16];
#pragma unroll
        for (int k = 0; k < 16; ++k) { const int c = c0 + k < NQT ? c0 + k : NQT - 1; loc[k] = ml_cloc(p, b, h, c)[e * 64 + d]; const float* fg = ml_fg(p, b, h, c); Fv[k] = fg[0]; Gv[k] = fg[1]; }
#pragma unroll
        for (int k = 0; k < 16; ++k) if (c0 + k < NQT) { const float mn = fmaxf(Fv[k] + ms, Gv[k]), prev = S; S = EXPF(Fv[k] + ms - mn) * S + EXPF(Gv[k] - mn) * loc[k]; loc[k] = prev; Fv[k] = ms; ms = mn; }
#pragma unroll
        for (int k = 0; k < 16; ++k) if (c0 + k < NQT) { ml_cloc(p, b, h, c0 + k)[e * 64 + d] = loc[k]; if (e == 64 && d == 0) ml_fg(p, b, h, c0 + k)[2] = Fv[k]; } }
    const size_t sb = ((size_t)L * BATCH + b) * 4 + h;
    if (e < 64) p.out[O_PC + (sb * 64 + e) * 64 + d] = S; else { p.out[O_PN + sb * 64 + d] = S; if (d == 0) p.out[O_PM + sb] = ms; }
}
HD void ml_g2_unit(const P& p, int L, ldsp_t lw, LDSQ float* gx, int b, int h, int c, int lane_) {
    const int lane = opaque_i(lane_);
    const int row0 = b * SEQ + c * 64, cl = lane & 31, hi = lane >> 5;
    WAVE_SYNC();
    float ii, fcum; ml_gates(p, L, row0, h, lane, ii, fcum);
    const float ms = ml_fg(p, b, h, c)[2], g = ii - fcum;
    float M = fmaxf(g, ms);
    for (int o = 1; o < 64; o <<= 1) { const float t = __shfl(M, lane - o >= 0 ? lane - o : lane); if (lane >= o) M = fmaxf(M, t); }
    gx[lane] = g;
    { float vtmp[64]; stage_vt_load(urow(p, row0) + (C_MV + h * 64), U_LD, lane, vtmp);
      const float* ku = p.ws + W_MK + (size_t)row0 * 256 + h * 64 + lane;
#pragma unroll 32
      for (int j = 0; j < 64; ++j) *(LDSQ bf16_t*)(lw + GL_Q + sw128(j, lane >> 3) + (lane & 7) * 2) = f2bf(ku[(size_t)j * 256]);
      SCHED_FENCE();
      stage_vt_store(lw, lane, vtmp); }
    WAVE_SYNC();
    const float* cs = ml_cloc(p, b, h, c);
    const float* ng = p.ml_norm_g + L * 64;
#pragma unroll 1
    for (int it = 0; it < 2; ++it) {
        const int i = 32 * it + cl; const float Mi = __shfl(M, i), fi = __shfl(fcum, i), wint = EXPF(ms - Mi);
        const float* qr = p.ws + W_MQ + (size_t)(row0 + i) * 256 + h * 64;
        bf16x8 qf[4]; float nq = 0.f; float ca[4][8], cb[4][8];
#pragma unroll
        for (int ks = 0; ks < 4; ++ks) { ld8f(cs + cl * 64 + 16 * ks + 8 * hi, ca[ks]); ld8f(cs + (32 + cl) * 64 + 16 * ks + 8 * hi, cb[ks]); }
#pragma unroll
        for (int ks = 0; ks < 4; ++ks) { float qv8[8], nv8[8]; ld8f(qr + 16 * ks + 8 * hi, qv8); ld8f(cs + 64 * 64 + 16 * ks + 8 * hi, nv8);
#pragma unroll
            for (int jj = 0; jj < 8; ++jj) { qf[ks][jj] = (short)f2bf(qv8[jj]); nq += qv8[jj] * nv8[jj]; } }
        nq += __shfl_xor(nq, 32);
        f32x16 o0, o1;
        for (int r = 0; r < 16; ++r) { o0[r] = 0.f; o1[r] = 0.f; }
#pragma unroll
        for (int ks = 0; ks < 4; ++ks) { bf16x8 c0, c1;
#pragma unroll
            for (int jj = 0; jj < 8; ++jj) { c0[jj] = (short)f2bf(ca[ks][jj]); c1[jj] = (short)f2bf(cb[ks][jj]); }
            o0 = __builtin_amdgcn_mfma_f32_32x32x16_bf16(c0, qf[ks], o0, 0, 0, 0); o1 = __builtin_amdgcn_mfma_f32_32x32x16_bf16(c1, qf[ks], o1, 0, 0, 0); }
        bf16_t* mo = mixb(p) + (size_t)(row0 + i) * D + 768 + h * 64; const URow ur = urow(p, row0 + i);
        bf16x4 ga0[4], ga1[4], gz0[4], gz1[4];
#pragma unroll
        for (int q4 = 0; q4 < 4; ++q4) { const int e0 = 8 * q4 + 4 * hi; const bf16_t* uo = ur.q + C_MO + h * 64 + e0; const bf16_t* uz = ur.q + C_MZ + h * 64 + e0;
            ga0[q4] = *(const bf16x4*)uo; ga1[q4] = *(const bf16x4*)(uo + 32); gz0[q4] = *(const bf16x4*)uz; gz1[q4] = *(const bf16x4*)(uz + 32); }
        SCHED_FENCE();
#pragma unroll
        for (int r = 0; r < 16; ++r) { o0[r] *= wint; o1[r] *= wint; }
        float dsum = 0.f;
#pragma unroll 1
        for (int jt = 0; jt <= it; ++jt) {
            f32x16 st;
            for (int r = 0; r < 16; ++r) st[r] = 0.f;
#pragma unroll
            for (int ks = 0; ks < 4; ++ks) st = __builtin_amdgcn_mfma_f32_32x32x16_bf16(*(const LDSQ bf16x8*)(lw + GL_Q + sw128(32 * jt + cl, 2 * ks + hi)), qf[ks], st, 0, 0, 0);
            bf16x8 pf[2];
#pragma unroll
            for (int r = 0; r < 16; ++r) { const int jl = (r & 3) + 8 * (r >> 2) + 4 * hi;
                const float v = (jt < it || jl <= cl) ? st[r] * EXPF(gx[32 * jt + jl] - Mi) : 0.f; dsum += v; pf[r >> 3][r & 7] = (short)f2bf(v); }
#pragma unroll
            for (int s = 0; s < 2; ++s) { const int q = 8 * jt + 4 * s + hi;
                o0 = __builtin_amdgcn_mfma_f32_32x32x16_bf16(ld_vt_frag(lw, cl, q), pf[s], o0, 0, 0, 0);
                o1 = __builtin_amdgcn_mfma_f32_32x32x16_bf16(ld_vt_frag(lw, 32 + cl, q), pf[s], o1, 0, 0, 0); }
        }
        dsum += __shfl_xor(dsum, 32);
        const float den = wint * nq + dsum, hinv = RCPF(fmaxf(fabsf(den), EXPF(-(fi + Mi))));
        float ss = 0.f;
#pragma unroll
        for (int r = 0; r < 16; ++r) { o0[r] *= hinv; o1[r] *= hinv; ss += o0[r] * o0[r] + o1[r] * o1[r]; }
        ss += __shfl_xor(ss, 32);
        const float rs = RSQRTF(ss * (1.0f / 64) + 1e-6f);
#pragma unroll
        for (int q4 = 0; q4 < 4; ++q4) { const int e0 = 8 * q4 + 4 * hi;
            const bf16x4 a0 = ga0[q4], a1 = ga1[q4], z0 = gz0[q4], z1 = gz1[q4]; const f32x4 g0 = *(const f32x4*)(ng + e0), g1 = *(const f32x4*)(ng + 32 + e0); bf16x4 r0, r1;
#pragma unroll
            for (int k = 0; k < 4; ++k) { r0[k] = (short)f2bf(o0[4 * q4 + k] * rs * g0[k] * sigmoidf_(bf2f((bf16_t)a0[k])) * siluf(bf2f((bf16_t)z0[k])));
                r1[k] = (short)f2bf(o1[4 * q4 + k] * rs * g1[k] * sigmoidf_(bf2f((bf16_t)a1[k])) * siluf(bf2f((bf16_t)z1[k]))); }
            *(bf16x4*)(mo + e0) = r0; *(bf16x4*)(mo + 32 + e0) = r1; }
    }
}
HD void bphase_rec_g1(const P& p, int L, ldsp_t lds) {
    const int w = RFL(opaque_tid() >> 6); const ldsp_t lw = lds + w * GL_WAVE; constexpr int NU = BATCH * 4 * NQT;
#define lane (opaque_tid() & 63)
    for (int u2 = blockIdx.x * 8 + w; u2 < 2 * NU; u2 += gridDim.x * 8) { const int u = u2 % NU;
        if (u2 < NU) gla_g1_unit(p, L, lw, u / (4 * NQT), (u / NQT) % 4, u % NQT, lane); else ml_g1_unit(p, L, lw, u / (4 * NQT), (u / NQT) % 4, u % NQT, lane); }
#undef lane
}
HD void bphase_rec_g2(const P& p, int L, ldsp_t lds) {
    const int w = RFL(opaque_tid() >> 6); const ldsp_t lw = lds + w * GL_WAVE; LDSQ float* gx = (LDSQ float*)(lds + LDS_WX + w * 256); constexpr int NU = BATCH * 4 * NQT;
#define lane (opaque_tid() & 63)
    for (int u2 = blockIdx.x * 8 + w; u2 < 2 * NU; u2 += gridDim.x * 8) { const int u = u2 % NU;
        if (u2 < NU) gla_g2_unit(p, L, lw, u / (4 * NQT), (u / NQT) % 4, u % NQT, lane); else ml_g2_unit(p, L, lw, gx, u / (4 * NQT), (u / NQT) % 4, u % NQT, lane); }
#undef lane
}

constexpr int CS_STRIDE = 528, CS_BUF = 33 * CS_STRIDE, CS_GROUP = 2 * CS_BUF;
static_assert(2 * CS_GROUP + 32 * 256 * 4 <= LDS_MISC, "summary staging + partial-sum exchange fit the scratch region");
HD bf16_t* wctp(const P& p, int L, int kv) { return (bf16_t*)((char*)p.ws + WB_WCT) + ((size_t)(L * 2 + kv)) * 64 * 2048; }
HD void k_prep_wc(const P& p, int L, long it) {
    const int lane = (int)(it % 64), et = (int)((it / 64) % 2), ks = (int)((it / 128) % 4), hs = (int)((it / 512) % 2), r = (int)((it / 1024) % 16), kv = (int)((it / 16384) % 2), L2 = (int)(it / 32768);
    bf16_t* o = wctp(p, L2, kv) + (size_t)(it % 16384) * 8; const int e = 32 * et + (lane & 31), s = 16 * hs + r, d0 = 16 * ks + 8 * (lane >> 5);
    const float* w = p.cmp_w + (((size_t)(L2 * 2 + kv) * 32 + s) * 64 + d0) * 64 + e;
    for (int j = 0; j < 8; ++j) o[j] = f2bf(w[(size_t)j * 64]);
}
HD void k_cmp_pad(const P& p, int L, long it) {
    const int g = (int)(it % 2); const long q = it / 2; const int j = (int)(q % NCPAD), s = (int)(q / NCPAD);
    if (j < seq_ncmp(s)) return;
    bf16_t* kb = wsb(p, WB_KCB) + (((size_t)s * 2 + g) * NCPAD + j) * 64; bf16_t* vt = wsb(p, WB_VCT) + (((size_t)s * 2 + g) * (NCPAD / 64) + j / 64) * 4096 + (j % 64);
    for (int d = 0; d < 64; ++d) { kb[d] = 0; vt[(size_t)d * 64] = 0; }
}
HD void cs_stage_load(const float* const (&bp)[9], int r, f32x4 (&rg)[9]) {
#pragma unroll
    for (int q = 0; q < 9; ++q) { f32x4 v = {0.f, 0.f, 0.f, 0.f}; if (bp[q]) v = *(const f32x4*)(bp[q] + (size_t)r * 512); rg[q] = v; }
}
HD void cs_stage_store(ldsp_t lg, int buf, int tl, const f32x4 (&rg)[9]) {
#pragma unroll
    for (int q = 0; q < 9; ++q) { const int i = tl + q * 256; const int jj = i >> 6, c4 = i & 63;
        if (i < 33 * 64) { bf16x4 o; for (int e = 0; e < 4; ++e) o[e] = (short)f2bf(rg[q][e]); *(LDSQ bf16x4*)(lg + buf * CS_BUF + jj * CS_STRIDE + c4 * 8) = o; } }
}
template <int WHICH  > HD void bphase_cmp_sum_t(const P& p, int L, ldsp_t lds) {
    const int tid = opaque_tid(), lane = tid & 63, w = tid >> 6, grp = w >> 2, kv = (w >> 1) & 1, g = w & 1, tl = tid & 255, cl = lane & 31, hi = lane >> 5;
    constexpr int TP = (SEQ / 16 + 31) / 32, TS = ((PAST_LEN + DEC_SEQ) / 16 + 31) / 32, U0 = WHICH ? BATCH * TP : 0, NUNIT = WHICH ? DEC_BATCH * TS : BATCH * TP;
    constexpr bool SPLIT = (WHICH == 0);
    constexpr int NITER = SPLIT ? NUNIT : (NUNIT + 1) / 2, NSTEP = SPLIT ? 8 : 16;
    const ldsp_t lg = lds + grp * CS_GROUP;
    for (int itx = blockIdx.x; itx < NITER; itx += gridDim.x) {
        const int un = SPLIT ? U0 + itx : U0 + 2 * itx + grp; const bool live = SPLIT ? true : (2 * itx + grp < NUNIT); const int r0 = SPLIT ? 8 * grp : 0;
        int s = 0, t = 0;
        if (live) { if (un < BATCH * TP) { s = un / TP; t = un % TP; } else { s = BATCH + (un - BATCH * TP) / TS; t = (un - BATCH * TP) % TS; } }
        const int nhalf = live ? (s < BATCH ? SEQ / 16 : (PAST_LEN + DEC_SEQ) / 16) : 0, j0 = 32 * t;
        f32x4 rg[9]; f32x16 a0, a1; const float* bp[9];
        for (int r = 0; r < 16; ++r) { a0[r] = 0.f; a1[r] = 0.f; }
#pragma unroll
        for (int q = 0; q < 9; ++q) { const int i = tl + q * 256, jj = i >> 6, c4 = i & 63; bp[q] = (i < 33 * 64 && j0 + jj < nhalf) ? hist(p, L, s, 16 * (j0 + jj), 0, 0) + c4 * 4 : nullptr; }
        cs_stage_load(bp, r0, rg); cs_stage_store(lg, 0, tl, rg); cs_stage_load(bp, r0 + 1, rg); LDS_BARRIER();
        const bf16_t* wt = wctp(p, L, kv) + (size_t)lane * 8;
#define CS_WLOADH(R, HS, WF) { _Pragma("unroll") for (int ks = 0; ks < 4; ++ks) { const bf16_t* wp = wt + ((((R) * 2 + (HS)) * 4 + ks) * 2) * 512; \
            WF[ks][0] = *(const bf16x8*)wp; WF[ks][1] = *(const bf16x8*)(wp + 512); } }
#define CS_COMPUTEH(BUF, HS, WF) { const ldsp_t xb = lg + (BUF) * CS_BUF + cl * CS_STRIDE + (kv * 2 + g) * 128 + hi * 16; \
            _Pragma("unroll") for (int ks = 0; ks < 4; ++ks) { const bf16x8 xf = *(const LDSQ bf16x8*)(xb + (HS) * CS_STRIDE + ks * 32); \
                a0 = __builtin_amdgcn_mfma_f32_32x32x16_bf16(WF[ks][0], xf, a0, 0, 0, 0); \
                a1 = __builtin_amdgcn_mfma_f32_32x32x16_bf16(WF[ks][1], xf, a1, 0, 0, 0); } }
        bf16x8 wfa[4][2], wfb[4][2];
        CS_WLOADH(r0, 0, wfa) CS_WLOADH(r0, 1, wfb)
#pragma unroll 1
        for (int rr = 0; rr < NSTEP; ++rr) {
            const int r = r0 + rr;
            CS_COMPUTEH(rr & 1, 0, wfa)
            if (rr + 1 < NSTEP) CS_WLOADH(r + 1, 0, wfa)
            SCHED_FENCE();
            CS_COMPUTEH(rr & 1, 1, wfb)
            if (rr + 1 < NSTEP) CS_WLOADH(r + 1, 1, wfb)
            SCHED_FENCE();
            if (rr + 1 < NSTEP) cs_stage_store(lg, (rr + 1) & 1, tl, rg);
            if (rr + 2 < NSTEP) cs_stage_load(bp, r + 2, rg);
            LDS_BARRIER();
        }
        if (SPLIT) {
            LDSQ float* xs = (LDSQ float*)(lds + 2 * CS_GROUP) + tl;
            if (grp == 1) {
#pragma unroll
                for (int r = 0; r < 16; ++r) { xs[r * 256] = a0[r]; xs[(16 + r) * 256] = a1[r]; } }
            __syncthreads();
            if (grp == 0) {
#pragma unroll
                for (int r = 0; r < 16; ++r) { a0[r] += xs[r * 256]; a1[r] += xs[(16 + r) * 256]; } }
            __syncthreads();
        }
#undef CS_WLOADH
#undef CS_COMPUTEH
        const int j = j0 + cl; const bool ok = live && j < seq_ncmp(s) && (!SPLIT || grp == 0);
        const float* bias = p.ws + W_CBIAS + L * 128 + kv * 64;
        float ss = 0.f;
#pragma unroll
        for (int r = 0; r < 16; ++r) { const int e = (r & 3) + 8 * (r >> 2) + 4 * hi; a0[r] += bias[e]; a1[r] += bias[32 + e]; ss += a0[r] * a0[r] + a1[r] * a1[r]; }
        ss += __shfl_xor(ss, 32);
        const float rs = kv == 0 ? RSQRTF(ss * (1.0f / 64) + 1e-6f) : 1.0f; const float* kg = p.k_norm_g + (L * 3 + 0) * 64;
        if (ok) {
            bf16_t* kb = wsb(p, WB_KCB) + (((size_t)s * 2 + g) * NCPAD + j) * 64; bf16_t* vt = wsb(p, WB_VCT) + (((size_t)s * 2 + g) * (NCPAD / 64) + j / 64) * 4096 + (j % 64);
#pragma unroll
            for (int r = 0; r < 16; ++r) { const int e = (r & 3) + 8 * (r >> 2) + 4 * hi;
                const float v0 = kv == 0 ? a0[r] * rs * kg[e] : a0[r], v1 = kv == 0 ? a1[r] * rs * kg[32 + e] : a1[r];
                if (kv == 0) { kb[e] = f2bf(v0); kb[32 + e] = f2bf(v1); } else { vt[(size_t)e * 64] = f2bf(v0); vt[(size_t)(32 + e) * 64] = f2bf(v1); } }
        }
    }
}

HD void bphase_cmp_sum_p(const P& p, int L, ldsp_t lds) { bphase_cmp_sum_t<0>(p, L, lds); }
HD void bphase_cmp_sum_s(const P& p, int L, ldsp_t lds) { bphase_cmp_sum_t<1>(p, L, lds); }
constexpr int SP_NCMP = 8, SP_NITEM = 40, SP_STRIDE = 68, SP_WIN0 = 8, SP_NWIN = 3, SP_SLC0 = 11, SP_NSLC = 28, SL_MAX = 4 * SP_NSLC;
constexpr int NJ = NSELS - 1;
static_assert(PAST_LEN % 64 == 0 && NJ <= 128 && NJ >= 16 && WKEEP_S % 64 == 0 && (WKEEP_S + DEC_SEQ + 63) / 64 <= 3 * SP_NWIN, "sample NSA geometry");
HD float* spart(const P& p, int b, int g, int item) { return p.ws + W_SPART + ((((size_t)b * 2 + g) * SP_NITEM + item) * 32) * SP_STRIDE; }
HD int* slist(const P& p, int b, int g) { return (int*)(p.ws + W_SLIST) + ((size_t)b * 2 + g) * 2 * SL_MAX; }
template <bool MASK>
HD void wattn_tile(ldsp_t lw, const bf16x8 (&qf)[4], int lim2, int lo2, bool sel, AttnSt& st, bf16x8 (&pf)[4], int c, int hi) {
    f32x16 s0, s1;
    for (int r = 0; r < 16; ++r) { s0[r] = 0.f; s1[r] = 0.f; }
#pragma unroll
    for (int ks = 0; ks < 4; ++ks) {
        s0 = __builtin_amdgcn_mfma_f32_32x32x16_bf16(*(const LDSQ bf16x8*)(lw + sw128(c, 2 * ks + hi)), qf[ks], s0, 0, 0, 0);
        s1 = __builtin_amdgcn_mfma_f32_32x32x16_bf16(*(const LDSQ bf16x8*)(lw + sw128(32 + c, 2 * ks + hi)), qf[ks], s1, 0, 0, 0);
    }
    float alpha;
    if (softmax_tile<MASK>(s0, s1, lim2, lo2, sel, st, pf, alpha)) {
#pragma unroll
        for (int r = 0; r < 16; ++r) { st.o0[r] *= alpha; st.o1[r] *= alpha; } }
#pragma unroll
    for (int ks = 0; ks < 4; ++ks) {
        st.o0 = __builtin_amdgcn_mfma_f32_32x32x16_bf16(ld_vt_frag(lw, c, 4 * ks + hi), pf[ks], st.o0, 0, 0, 0);
        st.o1 = __builtin_amdgcn_mfma_f32_32x32x16_bf16(ld_vt_frag(lw, 32 + c, 4 * ks + hi), pf[ks], st.o1, 0, 0, 0);
    }
}
HD void wattn_probs(ldsp_t lw, const bf16x8 (&qf)[4], int lim2, float m, float inv, bf16x8 (&pf)[4], int c, int hi) {
    f32x16 s0, s1;
    for (int r = 0; r < 16; ++r) { s0[r] = 0.f; s1[r] = 0.f; }
#pragma unroll
    for (int ks = 0; ks < 4; ++ks) {
        s0 = __builtin_amdgcn_mfma_f32_32x32x16_bf16(*(const LDSQ bf16x8*)(lw + sw128(c, 2 * ks + hi)), qf[ks], s0, 0, 0, 0);
        s1 = __builtin_amdgcn_mfma_f32_32x32x16_bf16(*(const LDSQ bf16x8*)(lw + sw128(32 + c, 2 * ks + hi)), qf[ks], s1, 0, 0, 0);
    }
#pragma unroll
    for (int r = 0; r < 16; ++r) { const int kc = (r & 3) + 8 * (r >> 2);
        s0[r] = kc <= lim2 ? EXP2F(s0[r] - m) * inv : 0.f; s1[r] = kc + 32 <= lim2 ? EXP2F(s1[r] - m) * inv : 0.f; }
#pragma unroll
    for (int j = 0; j < 8; ++j) { pf[0][j] = bfbits(s0[j]); pf[1][j] = bfbits(s0[8 + j]); pf[2][j] = bfbits(s1[j]); pf[3][j] = bfbits(s1[8 + j]); }
}
HD void wimp_tile(const bf16x8 (&pf)[4], f32x16& acc, int nt, int jt, int c, int hi) {
#pragma unroll
    for (int ks = 0; ks < 4; ++ks) { const int base = nt * 64 + 16 * ks + 4 * hi - 4 * (jt * 32 + c); bf16x8 af;
#pragma unroll
        for (int jj = 0; jj < 8; ++jj) { const int dl = base + 8 * (jj >> 2) + (jj & 3); af[jj] = (dl == -1 || dl == 3) ? (short)0x3F80 : ((dl >= 0 && dl <= 2) ? (short)0x4000 : (short)0); }
        acc = __builtin_amdgcn_mfma_f32_32x32x16_bf16(af, pf[ks], acc, 0, 0, 0); }
}
HD void wstage_f32(ldsp_t lw, const float* kbase, const float* vbase, size_t rs, int nvalid, int lane_) {
    const int lane = opaque_i(lane_);
#pragma unroll 4
    for (int i = 0; i < 16; ++i) { const int row = 4 * i + (lane >> 4), c4 = lane & 15; f32x4 kv = {0.f, 0.f, 0.f, 0.f}, vv = {0.f, 0.f, 0.f, 0.f};
        if (row < nvalid) { kv = *(const f32x4*)(kbase + (size_t)row * rs + c4 * 4); vv = *(const f32x4*)(vbase + (size_t)row * rs + c4 * 4); }
        bf16x4 kb; for (int e = 0; e < 4; ++e) kb[e] = (short)f2bf(kv[e]);
        *(LDSQ bf16x4*)(lw + sw128(row, c4 >> 1) + (c4 & 1) * 8) = kb;
#pragma unroll
        for (int e = 0; e < 4; ++e) *(LDSQ bf16_t*)(lw + GL_V + swv(4 * c4 + e, row >> 2) + (row & 3) * 2) = f2bf(vv[e]); }
}
HD void wstage_bf16(ldsp_t lw, const bf16_t* k, const bf16_t* vt, int lane_) {
    const int lane = opaque_i(lane_);
#pragma unroll
    for (int i = 0; i < 8; ++i) { const int id = i * 64 + lane; *(LDSQ bf16x8*)(lw + sw128(id >> 3, id & 7)) = *(const bf16x8*)(k + id * 8); }
#pragma unroll
    for (int i = 0; i < 16; ++i) { const int id = i * 64 + lane; *(LDSQ bf16x4*)(lw + GL_V + swv(id >> 4, id & 15)) = *(const bf16x4*)(vt + id * 4); }
}
HD void wpart_store(const P& p, int b, int g, int item, const AttnSt& st, int c, int hi) {
    float* o = spart(p, b, g, item) + c * SP_STRIDE; const float lt = st.l + __shfl_xor(st.l, 32);
    if (hi == 0) { o[0] = st.m; o[1] = lt; }
#pragma unroll
    for (int r = 0; r < 16; ++r) { const int d = (r & 3) + 8 * (r >> 2) + 4 * hi; o[4 + d] = st.o0[r]; o[4 + 32 + d] = st.o1[r]; }
}
HD void wload_q(const P& p, size_t wb, int b, int g, int c, int hi, bf16x8 (&qf)[4]) {
    const bf16_t* qp = wsb(p, wb) + (size_t)(NP + b * DEC_SEQ + (c >> 2)) * 512 + (g * 4 + (c & 3)) * 64 + hi * 8;
#pragma unroll
    for (int ks = 0; ks < 4; ++ks) qf[ks] = *(const bf16x8*)(qp + ks * 16);
}
static_assert(NCPADS / 64 <= SP_NCMP && SP_NCMP == 8, "one compressed tile per wave");
HD void snsa_cmp_unit(const P& p, int L, ldsp_t lds, int b, int g) {
    const int tid = opaque_tid(), lane = tid & 63, w = RFL(tid >> 6), c = lane & 31, hi = lane >> 5, s = BATCH + b; const size_t sg = (size_t)s * 2 + g;
    const ldsp_t lw = lds + w * GL_WAVE; LDSQ float* mstat = (LDSQ float*)(lds + LDS_WX);
    LDSQ float* impw = (LDSQ float*)lds;
    bf16x8 qf[4], pf[4]; AttnSt st; attn_init(st); f32x16 ima, imb;
    for (int r = 0; r < 16; ++r) { ima[r] = 0.f; imb[r] = 0.f; }
    const bool live = w < NCPADS / 64;
    if (live) {
        wload_q(p, WB_QNB, b, g, c, hi, qf);
        const int nlim = (PAST_LEN + (c >> 2) - 31) >> 4;
        wstage_bf16(lw, wsb(p, WB_KCB) + sg * NCPAD * 64 + (size_t)w * 4096, wsb(p, WB_VCT) + sg * (NCPAD / 64) * 4096 + (size_t)w * 4096, lane); WAVE_SYNC();
        wattn_tile<true>(lw, qf, nlim - 64 * w - 4 * hi, -100000, true, st, pf, c, hi);
        wimp_tile(pf, ima, w, w >> 1, c, hi);
        if ((w & 1) && (w >> 1) + 1 < 4) wimp_tile(pf, imb, w, (w >> 1) + 1, c, hi);
    }
    wpart_store(p, b, g, w, st, c, hi);
    { const float lt = st.l + __shfl_xor(st.l, 32); if (hi == 0) { mstat[(w * 32 + c) * 2] = st.m; mstat[(w * 32 + c) * 2 + 1] = lt; } }
    __syncthreads();
    float f;
    { float M = NEG_BIG;
#pragma unroll
      for (int k = 0; k < 8; ++k) M = fmaxf(M, mstat[(k * 32 + c) * 2]);
      float Lt = 0.f;
#pragma unroll
      for (int k = 0; k < 8; ++k) Lt += mstat[(k * 32 + c) * 2 + 1] * EXP2F(mstat[(k * 32 + c) * 2] - M);
      f = Lt > 0.f ? EXP2F(st.m - M) * RCPF(Lt) : 0.f; }
    for (int i = tid; i < 1024; i += NTHREADS) impw[i] = 0.f;
    __syncthreads();
    if (live) {
#define SNSA_IMP_ADD(IM, JT) { _Pragma("unroll") for (int r = 0; r < 16; ++r) { const int j = (r & 3) + 8 * (r >> 2) + 4 * hi; float v0 = IM[r] * f; \
        v0 += __shfl_xor(v0, 1); v0 += __shfl_xor(v0, 2); if ((c & 3) == 0) LDS_ADDF(&impw[(c >> 2) * 128 + (JT) * 32 + j], v0); } }
        SNSA_IMP_ADD(ima, w >> 1)
        if ((w & 1) && (w >> 1) + 1 < 4) SNSA_IMP_ADD(imb, (w >> 1) + 1)
#undef SNSA_IMP_ADD
    }
    __syncthreads();
    if (w != 0) return;
    unsigned long long u0 = 0ull, u1 = 0ull; unsigned qa = 0u, qb = 0u;
#pragma unroll 1
    for (int q = 0; q < 8; ++q) {
        const int ja = lane, jb = 64 + lane;
        const float sa = (ja < NJ) ? ((ja == 0 || ja == NJ - 1) ? INFINITY : impw[q * 128 + ja]) : -INFINITY, sb = (jb < NJ) ? ((jb == NJ - 1) ? INFINITY : impw[q * 128 + jb]) : -INFINITY;
        int ra = 0, rb = 0;
#pragma unroll 8
        for (int i = 0; i < 64; ++i) { const float a = rlane(sa, i), bq = rlane(sb, i);
            ra += ((a > sa || (a == sa && i < lane)) ? 1 : 0) + ((bq > sa) ? 1 : 0);
            rb += ((a > sb || a == sb) ? 1 : 0) + ((bq > sb || (bq == sb && i < lane)) ? 1 : 0); }
        const bool sela = ra < 15 && ja < NJ, selb = rb < 15 && jb < NJ;
        u0 |= __ballot(sela); u1 |= __ballot(selb); qa |= sela ? (1u << q) : 0u; qb |= selb ? (1u << q) : 0u;
    }
    int* sl = slist(p, b, g);
    const unsigned long long below = (lane == 0) ? 0ull : (~0ull >> (64 - lane));
    const int n0 = __builtin_popcountll(u0), n1 = __builtin_popcountll(u1);
    if ((u0 >> lane) & 1ull) { const int idx = __builtin_popcountll(u0 & below); sl[idx] = lane; sl[SL_MAX + idx] = (int)qa; }
    if ((u1 >> lane) & 1ull) { const int idx = n0 + __builtin_popcountll(u1 & below); sl[idx] = 64 + lane; sl[SL_MAX + idx] = (int)qb; }
    for (int idx = n0 + n1 + lane; idx < SL_MAX; idx += 64) { sl[idx] = (idx == n0 + n1) ? NJ : -1; sl[SL_MAX + idx] = 0xFF; }
}
HD void snsa_win_item(const P& p, int L, ldsp_t lw, int b, int g, int wi, int lane_) {
    const int lane = opaque_i(lane_), c = lane & 31, hi = lane >> 5, t = c >> 2;
    bf16x8 qf[4], pf[4]; AttnSt st; attn_init(st);
    wload_q(p, WB_QRB, b, g, c, hi, qf);
    constexpr int NCT = (WKEEP_S + DEC_SEQ + 63) / 64;
    for (int k = 0; k < 3; ++k) { const int wt = wi * 3 + k; if (wt >= NCT) break;
        const int ci0 = 64 * wt; const float* kbase; int nvalid;
        if (ci0 < WKEEP_S) { kbase = p.state_win + (((size_t)L * DEC_BATCH + b) * WKEEP_S + ci0) * 256 + g * 64; nvalid = 64; }
        else { kbase = p.ws + W_WINNEW + ((size_t)NP + b * DEC_SEQ + (ci0 - WKEEP_S)) * 256 + g * 64; nvalid = WKEEP_S + DEC_SEQ - ci0; }
        WAVE_SYNC(); wstage_f32(lw, kbase, kbase + 128, 256, nvalid, lane); WAVE_SYNC();
        if (ci0 + 63 <= WKEEP_S && ci0 > WKEEP_S + DEC_SEQ - 1 - WIN) wattn_tile<false>(lw, qf, 0, 0, true, st, pf, c, hi);
        else wattn_tile<true>(lw, qf, WKEEP_S + t - ci0 - 4 * hi, WKEEP_S + t - WIN - ci0 - 4 * hi, true, st, pf, c, hi); }
    wpart_store(p, b, g, SP_WIN0 + wi, st, c, hi);
}
HD void snsa_slc_item(const P& p, int L, ldsp_t lw, int b, int g, int si, int lane_) {
    const int lane = opaque_i(lane_), c = lane & 31, hi = lane >> 5, t = c >> 2, s = BATCH + b;
    bf16x8 qf[4], pf[4]; AttnSt st; attn_init(st);
    wload_q(p, WB_QRB, b, g, c, hi, qf);
    const int* sl = slist(p, b, g);
    for (int k = 0; k < 4; ++k) { const int e = si * 4 + k, blk = sl[e]; if (blk < 0) break;
        const unsigned qm = (unsigned)sl[SL_MAX + e];
        const float* kbase = hist(p, L, s, 64 * blk, 2, g); const int nvalid = blk < NJ ? 64 : DEC_SEQ;
        WAVE_SYNC(); wstage_f32(lw, kbase, kbase + 128, 512, nvalid, lane); WAVE_SYNC();
        const bool sel = ((qm >> t) & 1u) != 0u;
        if (blk < NJ) wattn_tile<false>(lw, qf, 0, 0, sel, st, pf, c, hi); else wattn_tile<true>(lw, qf, sel ? PAST_LEN + t - 64 * blk - 4 * hi : -100000, -100000, true, st, pf, c, hi); }
    wpart_store(p, b, g, SP_SLC0 + si, st, c, hi);
}
HD void bphase_snsa_a(const P& p, int L, ldsp_t lds) {
    const int w = RFL(opaque_tid() >> 6); const ldsp_t lw = lds + w * GL_WAVE; const int rb = (int)gridDim.x - 1 - (int)blockIdx.x;
    for (int u = rb; u < DEC_BATCH * 2; u += gridDim.x) { snsa_cmp_unit(p, L, lds, u >> 1, u & 1); __syncthreads(); }
#define lane (opaque_tid() & 63)
    for (int u = blockIdx.x * 8 + w; u < DEC_BATCH * 2 * SP_NWIN; u += gridDim.x * 8) { const int bg = u / SP_NWIN, k = u % SP_NWIN; snsa_win_item(p, L, lw, bg >> 1, bg & 1, k, lane); }
#undef lane
}
HD void bphase_snsa_b(const P& p, int L, ldsp_t lds) {
    const int w = RFL(opaque_tid() >> 6); const ldsp_t lw = lds + w * GL_WAVE;
#define lane (opaque_tid() & 63)
    for (int u = blockIdx.x * 8 + w; u < DEC_BATCH * 2 * SP_NSLC; u += gridDim.x * 8) { const int bg = u / SP_NSLC, k = u % SP_NSLC; snsa_slc_item(p, L, lw, bg >> 1, bg & 1, k, lane); }
#undef lane
}
HD void k_snsa_combine(const P& p, int L, long it) {
    const int d = (int)(it % 64), head = (int)((it / 64) % 8), rs = (int)(it / 512), b = rs / DEC_SEQ, t = rs % DEC_SEQ, g = head >> 2, col = t * 4 + (head & 3), r = NP + rs;
    const URow u = urow(p, r); float o = 0.f;
    for (int br = 0; br < 3; ++br) { const int i0 = br == 0 ? 0 : br == 1 ? SP_SLC0 : SP_WIN0, n = br == 0 ? SP_NCMP : br == 1 ? SP_NSLC : SP_NWIN;
        float M = NEG_BIG; for (int i = 0; i < n; ++i) M = fmaxf(M, spart(p, b, g, i0 + i)[col * SP_STRIDE]);
        float Ls = 0.f, Os = 0.f;
        for (int i = 0; i < n; ++i) { const float* q = spart(p, b, g, i0 + i) + col * SP_STRIDE; const float wgt = EXP2F(q[0] - M); Ls += q[1] * wgt; Os += q[4 + d] * wgt; }
        if (Ls > 0.f) o += sigmoidf_(u[C_NG + br * 8 + head]) * Os * RCPF(Ls); }
    mixb(p)[(size_t)r * D + 256 + head * 64 + d] = f2bf(o * siluf(u[C_NZ + head * 64 + d]));
}

HD float sum8(float v) { v += __shfl_xor(v, 1); v += __shfl_xor(v, 2); v += __shfl_xor(v, 7); return v; }
HD float wave_sum(float v) { v = sum8(v); v += __shfl_xor(v, 15); return (rlane(v, 0) + rlane(v, 16)) + (rlane(v, 32) + rlane(v, 48)); }
HD void cvt8(const bf16x8& x, float (&f)[8]) {
#pragma unroll
    for (int j = 0; j < 8; ++j) f[j] = bf2f((bf16_t)x[j]); }
HD bf16x8 pack8(const float (&f)[8]) { bf16x8 o;
#pragma unroll
    for (int j = 0; j < 8; ++j) o[j] = (short)f2bf(f[j]);
    return o; }
HD void st8f(float* dst, const float (&f)[8]) { f32x4 a = {f[0], f[1], f[2], f[3]}, b = {f[4], f[5], f[6], f[7]}; *(f32x4*)dst = a; *(f32x4*)(dst + 4) = b; }
HD void bphase_xin(const P& p, int L, ldsp_t lds) {
    const int w = RFL(opaque_tid() >> 6), lane = opaque_tid() & 63; const int stride = (int)gridDim.x * 8;
#pragma unroll 1
    for (int r = blockIdx.x * 8 + w; r < NT; r += 2 * stride) {
        const int r2 = r + stride; const bool two = r2 < NT;
        const float* x = xrow(p, L, r); const float* x2 = xrow(p, L, two ? r2 : r); float ss = 0.f, ss2 = 0.f; f32x4 v[4], v2[4];
#pragma unroll
        for (int k = 0; k < 4; ++k) v[k] = *(const f32x4*)(x + k * 256 + lane * 4);
#pragma unroll
        for (int k = 0; k < 4; ++k) v2[k] = *(const f32x4*)(x2 + k * 256 + lane * 4);
#pragma unroll
        for (int k = 0; k < 4; ++k) { ss += v[k][0] * v[k][0] + v[k][1] * v[k][1] + v[k][2] * v[k][2] + v[k][3] * v[k][3]; ss2 += v2[k][0] * v2[k][0] + v2[k][1] * v2[k][1] + v2[k][2] * v2[k][2] + v2[k][3] * v2[k][3]; }
        ss = wave_sum(ss); ss2 = wave_sum(ss2);
        if (lane == 0) { p.ws[W_RSTD + r] = RSQRTF(ss * (1.0f / D) + 1e-6f); if (two) p.ws[W_RSTD + r2] = RSQRTF(ss2 * (1.0f / D) + 1e-6f); }
        bf16_t* o = xbp(p) + (size_t)r * D; bf16_t* o2 = xbp(p) + (size_t)r2 * D;
#pragma unroll
        for (int k = 0; k < 4; ++k) { bf16x4 b; for (int e = 0; e < 4; ++e) b[e] = (short)f2bf(v[k][e]); *(bf16x4*)(o + k * 256 + lane * 4) = b; }
        if (two) {
#pragma unroll
            for (int k = 0; k < 4; ++k) { bf16x4 b; for (int e = 0; e < 4; ++e) b[e] = (short)f2bf(v2[k][e]); *(bf16x4*)(o2 + k * 256 + lane * 4) = b; } }
    }
}
HD void bphase_cmp_bias(const P& p, int L, ldsp_t lds) {
    const int w = RFL(opaque_tid() >> 6), lane = opaque_tid() & 63;
    for (int o = blockIdx.x * 8 + w; o < DEPTH * 128; o += gridDim.x * 8) { const int e = o % 64, lk = o / 64; float s = 0.f;
#pragma unroll 8
        for (int i = 0; i < 32; ++i) { const int q = lane + 64 * i; s += p.cmp_pos[(size_t)lk * 2048 + q] * p.cmp_w[((size_t)lk * 2048 + q) * 64 + e]; }
        s = wave_sum(s);
        if (lane == 0) p.ws[W_CBIAS + o] = s; }
}
HD void bphase_win_copy(const P& p, int L, ldsp_t lds) {
    constexpr int NOLD = WKEEP_S - DEC_SEQ > 0 ? WKEEP_S - DEC_SEQ : 0; constexpr long NV = (long)DEC_BATCH * NOLD * 64;
    static_assert(O_SWIN % 4 == 0, "16-byte aligned window output");
    const int tid = opaque_tid(); const long stride = (long)gridDim.x * NTHREADS;
#pragma unroll 1
    for (long i0 = (long)blockIdx.x * NTHREADS + tid; i0 < NV; i0 += 4 * stride) {
        f32x4 a[4];
#pragma unroll
        for (int k = 0; k < 4; ++k) { const long i = i0 + k * stride; if (i < NV) { const int e4 = (int)(i % 64); const long q = i / 64; const int r = (int)(q % NOLD), b = (int)(q / NOLD);
            a[k] = *(const f32x4*)(p.state_win + (((size_t)L * DEC_BATCH + b) * WKEEP_S + r + DEC_SEQ) * 256 + 4 * e4); } }
#pragma unroll
        for (int k = 0; k < 4; ++k) { const long i = i0 + k * stride; if (i < NV) { const int e4 = (int)(i % 64); const long q = i / 64; const int r = (int)(q % NOLD), b = (int)(q / NOLD);
            *(f32x4*)(p.out + O_SWIN + (((size_t)L * DEC_BATCH + b) * WKEEP_S + r) * 256 + 4 * e4) = a[k]; } }
    }
}
template <int IN> HD void bphase_sgemm_t(const P& p, int L, ldsp_t lds) {
    static_assert(NP % 256 == 0, "prompt rows fill whole 256-row GEMM panels");
    constexpr int NTILE = IN ? 4 : 1, N = IN ? D_INP : D, NRT = (NS + 31) / 32, NCG = N / (32 * NTILE), NU = NRT * NCG;
    const int tid = opaque_tid(), w = RFL(tid >> 6), lane = tid & 63;
    const bf16_t* A = IN ? xbp(p) : mixb(p); const bf16_t* Bt = IN ? wintp(p, L) : wouttp(p, L);
    LDSQ float* red = (LDSQ float*)lds;
#pragma unroll 1
    for (int un = blockIdx.x; un < NU; un += gridDim.x) {
        const int rt = un % NRT, cg = un / NRT, row0 = NP + 32 * rt, col0 = cg * 32 * NTILE;
        f32x16 acc[NTILE];
#pragma unroll
        for (int j = 0; j < NTILE; ++j)
#pragma unroll
            for (int e = 0; e < 16; ++e) acc[j][e] = 0.f;
        const bf16_t* ap = A + (size_t)(row0 + (lane & 31)) * D + 128 * w + 8 * (lane >> 5);
        const bf16_t* bp = Bt + (size_t)(col0 + (lane & 31)) * D + 128 * w + 8 * (lane >> 5);
#pragma unroll
        for (int hh = 0; hh < 2; ++hh) {
            bf16x8 af[4], bfr[NTILE][4];
#pragma unroll
            for (int s = 0; s < 4; ++s) af[s] = *(const bf16x8*)(ap + 16 * (4 * hh + s));
#pragma unroll
            for (int j = 0; j < NTILE; ++j)
#pragma unroll
                for (int s = 0; s < 4; ++s) bfr[j][s] = *(const bf16x8*)(bp + (size_t)j * 32 * D + 16 * (4 * hh + s));
#pragma unroll
            for (int s = 0; s < 4; ++s)
#pragma unroll
                for (int j = 0; j < NTILE; ++j) acc[j] = __builtin_amdgcn_mfma_f32_32x32x16_bf16(af[s], bfr[j][s], acc[j], 0, 0, 0);
            SCHED_FENCE();
        }
#pragma unroll
        for (int j = 0; j < NTILE; ++j)
#pragma unroll
            for (int e = 0; e < 16; ++e) red[((w * NTILE + j) * 16 + e) * 64 + lane] = acc[j][e];
        __syncthreads();
        float rsr[2] = {0.f, 0.f};
        if (IN) {
#pragma unroll
            for (int k = 0; k < 2; ++k) { const int reg = w + 8 * k, row = row0 + (reg & 3) + 8 * (reg >> 2) + 4 * (lane >> 5);
                if (L == 0) rsr[k] = row < NT ? p.ws[W_RSTD + row] : 0.f;
                else { const f32x4* q = (const f32x4*)(p.ws + W_XN + (size_t)row * 32); f32x4 a = q[0];
#pragma unroll
                    for (int e = 1; e < 8; ++e) a += q[e];
                    rsr[k] = RSQRTF(((a[0] + a[1]) + (a[2] + a[3])) * (1.0f / D) + 1e-6f); } } }
#pragma unroll
        for (int i = 0; i < NTILE * 2; ++i) { const int idx = tid + 512 * i, ln = idx & 63, reg = (idx >> 6) & 15, j = idx >> 10; float sm = 0.f;
#pragma unroll
            for (int w2 = 0; w2 < 8; ++w2) sm += red[((w2 * NTILE + j) * 16 + reg) * 64 + ln];
            const int row = row0 + (reg & 3) + 8 * (reg >> 2) + 4 * (ln >> 5), col = col0 + 32 * j + (ln & 31);
            if (IN) { if (row < NT) ubase(p)[(size_t)row * U_LD + col] = f2bf(sm * rsr[i & 1]); }
            else { const float y = row < NT ? xrow(p, L, row)[col] + sm : 0.f;
                if (row < NT) (L == DEPTH - 1 ? p.out + O_Y : p.ws + W_Y0)[(size_t)row * D + col] = y;
                if (L + 1 < DEPTH) {
                    if (row < NT) xbp(p)[(size_t)row * D + col] = f2bf(y);
                    float ss = y * y; ss += __shfl_xor(ss, 1); ss += __shfl_xor(ss, 2); ss += __shfl_xor(ss, 4); ss += __shfl_xor(ss, 8); ss += __shfl_xor(ss, 16);
                    if ((ln & 31) == 0 && row < NTP) p.ws[W_XN + (size_t)row * 32 + cg] = ss; } } }
        __syncthreads();
    }
}
HD void bphase_sgemm_in(const P& p, int L, ldsp_t lds) { bphase_sgemm_t<1>(p, L, lds); }
HD void bphase_sgemm_out(const P& p, int L, ldsp_t lds) { bphase_sgemm_t<0>(p, L, lds); }
HD void rope8(float (&x)[8], int l7, const float (&rc)[8], const float (&rsn)[8]) {
#pragma unroll
    for (int j = 0; j < 8; ++j) { const float pt = __shfl_xor(x[j], 1); x[j] = l7 == 0 ? x[j] * rc[j] - pt * rsn[j] : (l7 == 1 ? x[j] * rc[j] + pt * rsn[j] : x[j]); }
}
HD void bphase_rows(const P& p, int L, ldsp_t lds) {
    const int w = RFL(opaque_tid() >> 6), lane = opaque_tid() & 63, l7 = lane & 7;
    constexpr int NGP = NP / 8, NUN = NGP + NS;
#pragma unroll 1
    for (int un = blockIdx.x * 8 + w; un < NUN; un += gridDim.x * 8) {
        const int r0 = un < NGP ? un * 8 : NP + (un - NGP), ntk = un < NGP ? 8 : 1, s = seq_of_row(r0), t0 = r0 - seq_row0(s);
        float pw[3][8];
#pragma unroll
        for (int i = 0; i < 3; ++i) { const int tp = t0 + i;
            if (tp < 3) {
#pragma unroll
                for (int j = 0; j < 8; ++j) pw[i][j] = s < BATCH ? 0.f : p.state_conv[(((size_t)L * DEC_BATCH + (s - BATCH)) * 3 + tp) * 512 + 8 * lane + j]; }
            else cvt8(*(const bf16x8*)(ubase(p) + (size_t)(r0 + i - 3) * U_LD + C_MQK + 8 * lane), pw[i]); }
        const ldsp_t vtl = lds + w * GL_WAVE + lane * 16;
        bf16x8 R1, R2, R3, R5, R7;
        { const bf16_t* ur = ubase(p) + (size_t)r0 * U_LD + 8 * lane;
          R1 = *(const bf16x8*)(ur + 512); R2 = *(const bf16x8*)(ur + 1024); R3 = *(const bf16x8*)(ur + 1536); R5 = *(const bf16x8*)(ur + 2560); R7 = *(const bf16x8*)(ur + 3584); }
#pragma unroll 1
        for (int ti = 0; ti < ntk; ++ti) { {
            const int r = r0 + ti, pos = row_pos(r);
            bf16x8 N1, N2, N3, N5, N7;
            { const bf16_t* ur = ubase(p) + (size_t)(ti + 1 < ntk ? r + 1 : r) * U_LD + 8 * lane;
              N1 = *(const bf16x8*)(ur + 512); N2 = *(const bf16x8*)(ur + 1024); N3 = *(const bf16x8*)(ur + 1536); N5 = *(const bf16x8*)(ur + 2560); N7 = *(const bf16x8*)(ur + 3584); }
            float rc[8], rsn[8];
            { const float ang = (float)pos * rope_inv(l7); float c, sn; SINCOSF(ang, sn, c);
#pragma unroll
              for (int j = 0; j < 8; ++j) { rc[j] = rlane(c, j); rsn[j] = rlane(sn, j); } }
            { float v[8]; cvt8(lane >= 32 ? R1 : R2, v); float ss = 0.f;
#pragma unroll
              for (int j = 0; j < 8; ++j) ss += v[j] * v[j];
              const float rs = RSQRTF(sum8(ss) * (1.0f / 64) + 1e-6f);
#pragma unroll
              for (int j = 0; j < 8; ++j) v[j] *= rs * p.q_norm_g[L * 64 + 8 * l7 + j] * C2LOG;
              const int head = lane >= 32 ? (lane - 32) >> 3 : 4 + (lane >> 3); const size_t qo = (size_t)r * 512 + head * 64 + 8 * l7;
              *(bf16x8*)(wsb(p, WB_QNB) + qo) = pack8(v); rope8(v, l7, rc, rsn); *(bf16x8*)(wsb(p, WB_QRB) + qo) = pack8(v); }
            float* nr = new_rows_ptr(p, L, r);
            if (lane >= 32) { float v[8]; cvt8(R2, v); st8f(nr + ((lane - 32) >> 4) * 128 + (((lane - 32) >> 3) & 1) * 64 + 8 * l7, v); }
            { const int role = lane >> 4, g = (lane >> 3) & 1; float v[8]; cvt8(R3, v); float ss = 0.f;
#pragma unroll
              for (int j = 0; j < 8; ++j) ss += v[j] * v[j];
              const float rs = RSQRTF(sum8(ss) * (1.0f / 64) + 1e-6f);
              float kn[8];
#pragma unroll
              for (int j = 0; j < 8; ++j) kn[j] = v[j] * rs * p.k_norm_g[(L * 3 + (role == 0 ? 1 : 2)) * 64 + 8 * l7 + j];
              rope8(kn, l7, rc, rsn);
              if ((role & 1) == 0) {
#pragma unroll
                  for (int j = 0; j < 8; ++j) v[j] = kn[j]; }
              const bf16x8 vb = pack8(v);
              if (r < NP && (role & 1)) {
#pragma unroll
                  for (int j = 0; j < 8; ++j) *(LDSQ bf16_t*)(vtl + j * 1024 + ti * 2) = (bf16_t)vb[j]; }
              if (role < 2) st8f(nr + (2 + role) * 128 + g * 64 + 8 * l7, v);
              else { st8f(p.ws + W_WINNEW + (size_t)r * 256 + (role - 2) * 128 + g * 64 + 8 * l7, v);
                  float* wo = nullptr; const int t = t0 + ti;
                  if (r < NP) { if (t >= SEQ - WKEEP_P) wo = p.out + O_PWIN + (((size_t)L * BATCH + s) * WKEEP_P + (t - (SEQ - WKEEP_P))) * 256; }
                  else { const int i = WKEEP_S - DEC_SEQ + t; if (i >= 0) wo = p.out + O_SWIN + (((size_t)L * DEC_BATCH + (s - BATCH)) * WKEEP_S + i) * 256; }
                  if (wo) st8f(wo + (role - 2) * 128 + g * 64 + 8 * l7, v); }
              if (r < NP && (role & 1) == 0) *(bf16x8*)(wsb(p, role == 0 ? WB_KSB : WB_KWB) + (((size_t)s * 2 + g) * SEQ + (t0 + ti)) * 64 + 8 * l7) = vb; }
            { float f7[8]; cvt8(R7, f7); float a0 = p.gla_b_gate[L * 128 + lane], a1 = p.gla_b_gate[L * 128 + 64 + lane];
#pragma unroll
              for (int q = 0; q < 16; ++q) { const float x = rlane(f7[q & 7], 32 + (q >> 3)); a0 += x * p.gla_w_gate[(L * 16 + q) * 128 + lane]; a1 += x * p.gla_w_gate[(L * 16 + q) * 128 + 64 + lane]; }
              p.ws[W_LOGA + (size_t)r * 128 + lane] = log_sigmoidf(a0) * (1.0f / 16.0f); p.ws[W_LOGA + (size_t)r * 128 + 64 + lane] = log_sigmoidf(a1) * (1.0f / 16.0f); }
            { float x0[8], o[8]; cvt8(R5, x0);
#pragma unroll
              for (int j = 0; j < 8; ++j) { const int ch = 8 * lane + j; const float* cwp = p.conv_w + (size_t)L * 2048 + ch; const float a = p.conv_b[L * 512 + ch] + pw[0][j] * cwp[0] + pw[1][j] * cwp[512] + pw[2][j] * cwp[1024] + x0[j] * cwp[1536]; o[j] = siluf(a) * (lane < 32 ? 1.0f : 0.125f);
                  pw[0][j] = pw[1][j]; pw[1][j] = pw[2][j]; pw[2][j] = x0[j]; }
              st8f(lane < 32 ? p.ws + W_MQ + (size_t)r * 256 + 8 * lane : p.ws + W_MK + (size_t)r * 256 + 8 * (lane - 32), o); }
            R1 = N1; R2 = N2; R3 = N3; R5 = N5; R7 = N7;
            } SCHED_FENCE();
        }
        if (r0 < NP && ((lane >> 4) & 1)) { const int role = lane >> 4, g = (lane >> 3) & 1;
            bf16_t* vt = wsb(p, role == 1 ? WB_VST : WB_VWT) + (((size_t)s * 2 + g) * NQT + t0 / 64) * 4096 + (size_t)(8 * l7) * 64 + (t0 % 64);
#pragma unroll
            for (int j = 0; j < 8; ++j) *(bf16x8*)(vt + (size_t)j * 64) = *(const LDSQ bf16x8*)(vtl + j * 1024); }
    }
}

typedef void (*ItemFn)(const P&, int, long);
typedef void (*BlockFn)(const P&, int, ldsp_t);
static P make_params(void* const* d_in, void* d_out, void* d_ws) {
    P p;
    p.x_prompt = (const float*)d_in[0]; p.x_sample = (const float*)d_in[1]; p.cache = (const float*)d_in[2]; p.state_win = (const float*)d_in[3];
    p.state_gla = (const float*)d_in[4]; p.state_C = (const float*)d_in[5]; p.state_n = (const float*)d_in[6]; p.state_m = (const float*)d_in[7];
    p.state_conv = (const float*)d_in[8]; p.page_table = (const int*)d_in[9]; p.norm_g = (const float*)d_in[10]; p.w_in = (const float*)d_in[11];
    p.w_out = (const float*)d_in[12]; p.gla_w_gate = (const float*)d_in[13]; p.gla_b_gate = (const float*)d_in[14]; p.gla_norm_g = (const float*)d_in[15];
    p.q_norm_g = (const float*)d_in[16]; p.k_norm_g = (const float*)d_in[17]; p.cmp_pos = (const float*)d_in[18]; p.cmp_w = (const float*)d_in[19];
    p.conv_w = (const float*)d_in[20]; p.conv_b = (const float*)d_in[21]; p.gate_b = (const float*)d_in[22]; p.ml_norm_g = (const float*)d_in[23];
    p.out = (float*)d_out; p.ws = (float*)d_ws;
    return p;
}
#define LAYER_PROGRAM(LL) { const int L = LL; \
        if (XIN_NEEDED(L)) { BLK(bphase_xin); GRID_BAR(); } \
        GEMM_IN(); \
        BLK(bphase_sgemm_in); \
        GRID_BAR(); \
        BLK(bphase_rows); \
        BLK(bphase_win_copy); \
        PH(k_conv_out, (long)NSEQ * 3 * 512); \
        GRID_BAR(); \
        BLK(bphase_rec_g1); \
        BLK(bphase_cmp_sum_s); \
        GRID_BAR(); \
        PH_MID(k_gla, (long)DEC_BATCH * 256, 5); \
        PH_MID(k_mlstm, (long)DEC_BATCH * 260, 4); \
        PH_MID(k_gla_scan, (long)BATCH * 8192, 1); \
        PH_MID(k_ml_scan, (long)BATCH * 16640, 0); \
        BLK(bphase_snsa_a); \
        BLK(bphase_cmp_sum_p); \
        GRID_BAR(); \
        BLK(bphase_nsa_prompt); \
        BLK(bphase_rec_g2); \
        BLK(bphase_snsa_b); \
        PH(k_mix_gla, (long)NS * 4); \
        PH(k_mix_ml, (long)NS * 4); \
        GRID_BAR(); \
        PH(k_snsa_combine, (long)NS * 512); \
        GRID_BAR(); \
        GEMM_OUT(); \
        BLK(bphase_sgemm_out); \
        GRID_BAR(); \
    }
constexpr int LDS_BYTES = LDS_MISC + 1024 + 2048;
static_assert(NSA_END <= NSA_COMB && NSA_COMB + 8 * 8192 <= LDS_MISC, "NSA unit LDS map");

#ifdef CPU_EMU
template <ItemFn F> static void run_items(const P& p, int L, long n) {
#pragma omp parallel for schedule(dynamic, 256)
    for (long i = 0; i < n; ++i) F(p, L, i);
}
struct EmuArgs { BlockFn f; const P* p; int L; };
static void emu_tramp(void* a) { EmuArgs* e = (EmuArgs*)a; e->f(*e->p, e->L, (ldsp_t)emu_lds); }
static void emu_phase(BlockFn f, const P& p, int L) {
    const int G = 8;
#pragma omp parallel for schedule(dynamic, 1)
    for (int bx = 0; bx < G; ++bx) { EmuArgs a{f, &p, L}; emu_run_block(NTHREADS, bx, G, LDS_BYTES, emu_tramp, &a); }
}
#define PH(F, n) run_items<F>(p, L, (long)(n))
#define PH_MID(F, n, ROT) run_items<F>(p, L, (long)(n))
#define XIN_NEEDED(L) true
#define BLK(F) emu_phase(F, p, L)
#define GRID_BAR() do {} while (0)
#define GEMM_IN() PH(k_gemm_in_emu, (long)NP * D_IN)
#define GEMM_OUT() PH(k_gemm_out_emu, (long)NP * D)
static void forward(const P& p) {
#else

namespace pg8 {
#define PG8_LAS __attribute__((address_space(3)))
typedef unsigned short bf16_t;
typedef short bf16x8 __attribute__((ext_vector_type(8)));
typedef float f32x4 __attribute__((ext_vector_type(4)));
typedef unsigned u32x4 __attribute__((ext_vector_type(4)));
constexpr int BM = 256, BK = 64, HALF = 128, HTB = HALF * BK * 2  , STAGE_BYTES = 8 * HTB, NXCD = 8, WGM = 8;

__host__ __device__ __forceinline__ int lds_byte(int r, int c) { const int st = (r >> 4) * 2 + (c >> 5), rr = r & 15, cc = c & 31, ob = rr * 64 + cc * 2; return st * 1024 + (ob ^ (((ob >> 9) & 1) << 5)); }
__host__ __device__ __forceinline__ void stage_rc(int b, int& R, int& C) { const int st = b / 1024, sb = b % 1024, swz = sb ^ (((sb >> 9) & 1) << 5); R = (st >> 1) * 16 + swz / 64; C = (st & 1) * 32 + (swz % 64) / 2; }
__host__ __device__ __forceinline__ int perm32(int rho) { const int n = rho >> 4, i = rho & 15; return 8 * (i >> 2) + 4 * n + (i & 3); }

struct Unit { int pm, pn; };
struct Gemm { const bf16_t* A; const bf16_t* Bt; int M, N, K; };

struct StaticOrder {
    int nM, nN, nwg, G, c;
    __host__ __device__ void init(int M, int N, int G_, int c_) { nM = M / BM; nN = N / BM; nwg = nM * nN; G = G_; c = c_; }
    __host__ __device__ bool next(int i, Unit& u) const {
        const long L = (long)i * G + c; if (L >= nwg) return false;
        int wgid = (int)L; { const int q = nwg / NXCD, r = nwg % NXCD, xcd = wgid % NXCD, off = wgid / NXCD; wgid = (xcd < r ? xcd * (q + 1) : r * (q + 1) + (xcd - r) * q) + off; }
        const int nig = WGM * nN, gid = wgid / nig, fm = gid * WGM, gsz = (nM - fm) < WGM ? (nM - fm) : WGM;
        u.pm = fm + ((wgid % nig) % gsz); u.pn = (wgid % nig) / gsz; return true;
    }
    __device__ __forceinline__ void a_ready(const Unit&) const {}
    __device__ __forceinline__ void done(const Unit&) const {}
};
__device__ __forceinline__ unsigned cvt_pk_bf16(float lo, float hi) { unsigned r; asm volatile("v_cvt_pk_bf16_f32 %0, %1, %2" : "=v"(r) : "v"(lo), "v"(hi)); return r; }
struct EpiInBf16 {
    static constexpr bool PERM = true, AFTER_DRAIN = false;
    bf16_t* U; const float* rstd; const float* pss;
    __device__ __forceinline__ void operator()(const f32x4 (&acc)[2][2][4][2], const Unit& u, int wr, int wc, int fr, int fq) const {
        const int row0 = u.pm * BM + wr * 64 + fr, col0 = u.pn * BM + wc * 32 + 8 * fq;
#pragma unroll
        for (int ai = 0; ai < 2; ++ai)
#pragma unroll
            for (int m = 0; m < 4; ++m) { const int row = row0 + ai * HALF + m * 16; if (row >= NT) continue; float rs;
                if (pss) { const f32x4* q = (const f32x4*)(pss + (size_t)row * 32); const f32x4 a = (q[0] + q[1]) + (q[2] + q[3]); rs = __builtin_amdgcn_rsqf(((a[0] + a[1]) + (a[2] + a[3])) * (1.0f / D) + 1e-6f); }
                else rs = rstd[row];
                bf16_t* rowp = U + (size_t)row * U_LD + col0;
#pragma unroll
                for (int bj = 0; bj < 2; ++bj) { const f32x4 v0 = acc[ai][bj][m][0] * rs, v1 = acc[ai][bj][m][1] * rs; u32x4 wv;
                    wv.x = cvt_pk_bf16(v0[0], v0[1]); wv.y = cvt_pk_bf16(v0[2], v0[3]); wv.z = cvt_pk_bf16(v1[0], v1[1]); wv.w = cvt_pk_bf16(v1[2], v1[3]);
                    *(u32x4*)(rowp + bj * HALF) = wv; } }
    }
};
struct EpiOutF32 {
    static constexpr bool PERM = true, AFTER_DRAIN = false;
    float* Y; const float* Xa; const float* Xb;
    bf16_t* XB; float* PSS;
    __device__ __forceinline__ void operator()(const f32x4 (&acc)[2][2][4][2], const Unit& u, int wr, int wc, int fr, int fq) const {
        const int row0 = u.pm * BM + wr * 64 + fr, col0 = u.pn * BM + wc * 32 + 8 * fq;
#pragma unroll
        for (int ai = 0; ai < 2; ++ai)
#pragma unroll
            for (int m = 0; m < 4; ++m) { const int row = row0 + ai * HALF + m * 16; if (row >= NT) continue;
                const float* xr = row < NP ? Xa + (size_t)row * D : Xb + (size_t)(row - NP) * D; float* rowp = Y + (size_t)row * D; float ss = 0.f;
#pragma unroll
                for (int bj = 0; bj < 2; ++bj) { const int c = col0 + bj * HALF;
                    const f32x4 y0 = acc[ai][bj][m][0] + *(const f32x4*)(xr + c), y1 = acc[ai][bj][m][1] + *(const f32x4*)(xr + c + 4);
                    *(f32x4*)(rowp + c) = y0; *(f32x4*)(rowp + c + 4) = y1;
                    if (XB) { ss += y0[0] * y0[0] + y0[1] * y0[1] + y0[2] * y0[2] + y0[3] * y0[3] + y1[0] * y1[0] + y1[1] * y1[1] + y1[2] * y1[2] + y1[3] * y1[3]; u32x4 wv;
                        wv.x = cvt_pk_bf16(y0[0], y0[1]); wv.y = cvt_pk_bf16(y0[2], y0[3]); wv.z = cvt_pk_bf16(y1[0], y1[1]); wv.w = cvt_pk_bf16(y1[2], y1[3]);
                        *(u32x4*)(XB + (size_t)row * D + c) = wv; } }
                if (XB) { ss += xl_shfl_xor(ss, 16); ss += xl_shfl_xor(ss, 32); if (fq == 0) PSS[(size_t)row * 32 + u.pn * 4 + wc] = ss; } }
    }
};
template <class Epi, class Sched, bool ALIGN_EPI = false, bool SP2 = false>
__device__ __forceinline__ void gemm_phase(PG8_LAS unsigned char* lds, const Gemm g, const Sched& S, const Epi& E) {
    const int tid = hw_tid(lds), wid = __builtin_amdgcn_readfirstlane(tid >> 6), lane = tid & 63, wr = wid >> 2, wc = wid & 3, fr = lane & 15, fq = lane >> 4;
    const int K = g.K, nt = K / BK;
    unsigned voffA[2], voffB[2];
#pragma unroll
    for (int i = 0; i < 2; ++i) { int R, C; stage_rc(tid * 16 + i * 8192, R, C); const int Rb = Epi::PERM ? ((R & ~31) + perm32(R & 31)) : R;
        voffA[i] = (unsigned)(R * K + C) * 2u; voffB[i] = (unsigned)(Rb * K + C) * 2u; }
    const size_t kstep = (size_t)(BK * 2);
    const size_t hstep = (size_t)HALF * K * 2;
    const size_t tstep = 2 * hstep;
    const unsigned ldsw = (unsigned)wid * 1024u;
    const int aoff = lds_byte(wr * 64 + fr, fq * 8), boff = lds_byte(wc * 32 + fr, fq * 8);
#define PG8_SA(b, h) (((b) * 2 + (h)) * HTB)
#define PG8_SB(b, h) ((4 + (b) * 2 + (h)) * HTB)
#define PG8_STAGE(bufoff, gbase, voff) do { _Pragma("unroll") for (int _i = 0; _i < 2; ++_i) \
        __builtin_amdgcn_global_load_lds((const unsigned*)((const char*)(gbase) + (voff)[_i]), (PG8_LAS unsigned*)(lds + (bufoff) + ldsw + _i * 8192), 16, 0, 0); } while (0)
#define PG8_LDA(dst, b, h) do { _Pragma("unroll") for (int m = 0; m < 4; ++m) _Pragma("unroll") for (int k = 0; k < 2; ++k) dst[m][k] = *(const PG8_LAS bf16x8*)(lds + PG8_SA(b, h) + aoff + m * 2048 + k * 1024); } while (0)
#define PG8_LDB(dst, b, h) do { _Pragma("unroll") for (int n = 0; n < 2; ++n) _Pragma("unroll") for (int k = 0; k < 2; ++k) dst[n][k] = *(const PG8_LAS bf16x8*)(lds + PG8_SB(b, h) + boff + n * 2048 + k * 1024); } while (0)
#define PG8_MMA(ai, bj, At, Bt) do { __builtin_amdgcn_s_setprio(1); _Pragma("unroll") for (int m = 0; m < 4; ++m) _Pragma("unroll") for (int n = 0; n < 2; ++n) _Pragma("unroll") for (int k = 0; k < 2; ++k) \
        acc[ai][bj][m][n] = __builtin_amdgcn_mfma_f32_16x16x32_bf16(Bt[n][k], At[m][k], acc[ai][bj][m][n], 0, 0, 0); __builtin_amdgcn_s_setprio(0); } while (0)
#define PG8_WAIT_V(n) asm volatile("s_waitcnt vmcnt(" #n ")" ::: "memory")
#define PG8_WAIT_L(n) asm volatile("s_waitcnt lgkmcnt(" #n ")" ::: "memory")
#define PG8_BAR __builtin_amdgcn_s_barrier()
#define PG8_SCHED __builtin_amdgcn_sched_barrier(0)
    Unit cur, nxt; int ui = 0;
    if (!S.next(0, cur)) return;
    f32x4 acc[2][2][4][2];
#pragma unroll
    for (int a = 0; a < 2; ++a)
#pragma unroll
        for (int b = 0; b < 2; ++b)
#pragma unroll
            for (int m = 0; m < 4; ++m)
#pragma unroll
                for (int n = 0; n < 2; ++n) acc[a][b][m][n] = (f32x4){0.f, 0.f, 0.f, 0.f};
    bf16x8 At[4][2], B0[2][2], B1[2][2];
    const char* cA = (const char*)g.A + (size_t)cur.pm * tstep; const char* cB = (const char*)g.Bt + (size_t)cur.pn * tstep;
    S.a_ready(cur);
    if constexpr (SP2) {
        PG8_STAGE(PG8_SB(0, 0), cB, voffB); PG8_STAGE(PG8_SB(0, 1), cB + hstep, voffB); PG8_STAGE(PG8_SA(0, 0), cA, voffA); PG8_STAGE(PG8_SA(0, 1), cA + hstep, voffA);
        if (wr == 1) PG8_BAR;
        PG8_WAIT_V(2); PG8_BAR;
        PG8_STAGE(PG8_SB(1, 0), cB + kstep, voffB); PG8_STAGE(PG8_SA(1, 0), cA + kstep, voffA); PG8_STAGE(PG8_SB(1, 1), cB + hstep + kstep, voffB);
        PG8_WAIT_V(6); PG8_BAR;
    } else {
        PG8_STAGE(PG8_SB(0, 0), cB, voffB); PG8_STAGE(PG8_SA(0, 0), cA, voffA); PG8_STAGE(PG8_SB(0, 1), cB + hstep, voffB); PG8_STAGE(PG8_SA(0, 1), cA + hstep, voffA);
        if (wr == 1) PG8_BAR;
        PG8_WAIT_V(4); PG8_BAR;
        PG8_STAGE(PG8_SB(1, 0), cB + kstep, voffB); PG8_STAGE(PG8_SA(1, 0), cA + kstep, voffA); PG8_STAGE(PG8_SB(1, 1), cB + hstep + kstep, voffB);
        PG8_WAIT_V(6); PG8_BAR;
    }
    for (;;) {
        const bool has_next = S.next(ui + 1, nxt);
        const char* nA = has_next ? (const char*)g.A + (size_t)nxt.pm * tstep : cA; const char* nB = has_next ? (const char*)g.Bt + (size_t)nxt.pn * tstep : cB;
        for (int t = 0; t < nt; t += 2) {
            const bool last = (t == nt - 2);
            const char* a1 = cA + (size_t)(t + 1) * kstep;
            const char* a2 = last ? nA : cA + (size_t)(t + 2) * kstep; const char* b2 = last ? nB : cB + (size_t)(t + 2) * kstep;
            const char* a3 = a2 + kstep; const char* b3 = b2 + kstep;
            if (last && has_next) S.a_ready(nxt);
            if constexpr (SP2) {
            PG8_LDB(B0, 0, 0); PG8_LDB(B1, 0, 1); PG8_SCHED; PG8_LDA(At, 0, 0); PG8_STAGE(PG8_SA(1, 1), a1 + hstep, voffA);
            PG8_WAIT_V(8); PG8_WAIT_L(0); PG8_BAR; PG8_MMA(0, 0, At, B0); PG8_MMA(0, 1, At, B1); PG8_BAR; PG8_SCHED;
            PG8_LDA(At, 0, 1); PG8_STAGE(PG8_SB(0, 0), b2, voffB); PG8_STAGE(PG8_SB(0, 1), b2 + hstep, voffB); PG8_STAGE(PG8_SA(0, 0), a2, voffA);
            PG8_WAIT_V(8); PG8_WAIT_L(0); PG8_BAR; PG8_MMA(1, 0, At, B0); PG8_MMA(1, 1, At, B1); PG8_BAR; PG8_SCHED;
            PG8_LDB(B0, 1, 0); PG8_LDB(B1, 1, 1); PG8_SCHED; PG8_LDA(At, 1, 0); PG8_STAGE(PG8_SA(0, 1), a2 + hstep, voffA);
            PG8_WAIT_V(8); PG8_WAIT_L(0); PG8_BAR; PG8_MMA(0, 0, At, B0); PG8_MMA(0, 1, At, B1); PG8_BAR; PG8_SCHED;
            PG8_LDA(At, 1, 1); PG8_STAGE(PG8_SB(1, 0), b3, voffB); PG8_STAGE(PG8_SB(1, 1), b3 + hstep, voffB); PG8_STAGE(PG8_SA(1, 0), a3, voffA);
            PG8_WAIT_V(8); PG8_WAIT_L(0); PG8_BAR; PG8_MMA(1, 0, At, B0); PG8_MMA(1, 1, At, B1); PG8_BAR; PG8_SCHED;
            } else {
            PG8_LDB(B0, 0, 0); PG8_SCHED; PG8_LDA(At, 0, 0); PG8_STAGE(PG8_SA(1, 1), a1 + hstep, voffA);
            PG8_WAIT_L(8); PG8_BAR; PG8_WAIT_L(0); PG8_MMA(0, 0, At, B0); PG8_BAR; PG8_SCHED;
            PG8_LDB(B1, 0, 1); PG8_STAGE(PG8_SB(0, 0), b2, voffB);
            PG8_BAR; PG8_WAIT_L(0); PG8_MMA(0, 1, At, B1); PG8_BAR;
            PG8_LDA(At, 0, 1); PG8_STAGE(PG8_SA(0, 0), a2, voffA);
            PG8_BAR; PG8_WAIT_L(0); PG8_MMA(1, 0, At, B0); PG8_BAR; PG8_SCHED;
            PG8_STAGE(PG8_SB(0, 1), b2 + hstep, voffB);
            PG8_WAIT_V(6); PG8_BAR; PG8_MMA(1, 1, At, B1); PG8_BAR;
            PG8_LDB(B0, 1, 0); PG8_SCHED; PG8_LDA(At, 1, 0); PG8_STAGE(PG8_SA(0, 1), a2 + hstep, voffA);
            PG8_WAIT_L(8); PG8_BAR; PG8_WAIT_L(0); PG8_MMA(0, 0, At, B0); PG8_BAR; PG8_SCHED;
            PG8_LDB(B1, 1, 1); PG8_STAGE(PG8_SB(1, 0), b3, voffB);
            PG8_BAR; PG8_WAIT_L(0); PG8_MMA(0, 1, At, B1); PG8_BAR;
            PG8_LDA(At, 1, 1); PG8_STAGE(PG8_SA(1, 0), a3, voffA);
            PG8_BAR; PG8_WAIT_L(0); PG8_MMA(1, 0, At, B0); PG8_BAR; PG8_SCHED;
            PG8_STAGE(PG8_SB(1, 1), b3 + hstep, voffB);
            PG8_WAIT_V(6); PG8_BAR; PG8_MMA(1, 1, At, B1); PG8_BAR;
            }
        }
        if constexpr (ALIGN_EPI) { if (wr == 0) PG8_BAR; }
        if constexpr (!Epi::AFTER_DRAIN) { E(acc, cur, wr, wc, fr, fq); S.done(cur); }
        if (!has_next) break;
#pragma unroll
        for (int a = 0; a < 2; ++a)
#pragma unroll
            for (int b = 0; b < 2; ++b)
#pragma unroll
                for (int m = 0; m < 4; ++m)
#pragma unroll
                    for (int n = 0; n < 2; ++n) acc[a][b][m][n] = (f32x4){0.f, 0.f, 0.f, 0.f};
        cur = nxt; cA = nA; cB = nB; ++ui;
        if constexpr (ALIGN_EPI) { if (wr == 1) PG8_BAR; }
    }
    PG8_WAIT_V(0);
    if constexpr (!ALIGN_EPI) { if (wr == 0) PG8_BAR; }
    PG8_BAR;
    if constexpr (Epi::AFTER_DRAIN) { E.fused(acc, cur, wr, wc, fr, fq, lds, wid, lane); S.done(cur); }
#undef PG8_SA
#undef PG8_SB
#undef PG8_STAGE
#undef PG8_LDA
#undef PG8_LDB
#undef PG8_MMA
#undef PG8_WAIT_V
#undef PG8_WAIT_L
#undef PG8_BAR
#undef PG8_SCHED
}
}
#define XB_TMO      128
#define XB_XCNT(j)  (256  + 64 * (j))
#define XB_XSUB(j)  (1280 + 64 * (j))
#define XB_XGEN(j)  (2304 + 64 * (j))
#define XB_TOP      3328
#define XB_TOPGEN   3392
#define XCD_BAR_WORDS 3456
#define XB_SPIN_CAP (1u << 22)
#define LAS __attribute__((address_space(3)))
__device__ __forceinline__ unsigned xb_ld(unsigned* p)              { return __hip_atomic_load(p, __ATOMIC_RELAXED, __HIP_MEMORY_SCOPE_AGENT); }
__device__ __forceinline__ unsigned xb_add(unsigned* p, unsigned v) { return __hip_atomic_fetch_add(p, v, __ATOMIC_RELAXED, __HIP_MEMORY_SCOPE_AGENT); }
__device__ __forceinline__ unsigned xb_xcc_id() { return (unsigned)__builtin_amdgcn_s_getreg((3 << 11) | 20) & 0xFu; }
#define XB_SPIN(cond, bar) do { unsigned _sp = 0; while (cond) { __builtin_amdgcn_s_sleep(1); \
    if ((++_sp & 255u) == 0u) { if (xb_ld(&(bar)[XB_TMO])) break; if (_sp > XB_SPIN_CAP) { atomicAdd(&(bar)[XB_TMO], 1u); break; } } } } while (0)
struct XcdBarrier { unsigned* bar; unsigned x; volatile LAS unsigned* st; };
#define XB_TID0() (hw_tid((LAS unsigned char*)b.st - LDS_MISC) == 0)
__device__ __forceinline__ XcdBarrier xcd_barrier_post(unsigned* bar, volatile LAS unsigned* st) {
    XcdBarrier b; b.bar = bar; b.x = xb_xcc_id(); b.st = st;
    if (XB_TID0()) (void)xb_add(&bar[XB_XCNT(b.x)], 1u);
    return b;
}
__device__ __forceinline__ void xcd_barrier_complete(unsigned* bar, unsigned x, unsigned& nloc, unsigned& nx) {
    const unsigned G = gridDim.x * gridDim.y * gridDim.z;
    unsigned sum, cnt, mine, sp = 0u;
    for (;;) {
        sum = 0u; cnt = 0u; mine = 0u;
#pragma unroll
        for (unsigned j = 0; j < 16; ++j) { const unsigned c = xb_ld(&bar[XB_XCNT(j)]); sum += c; cnt += (c > 0u) ? 1u : 0u; mine = (j == x) ? c : mine; }
        if (sum == G) break;
        __builtin_amdgcn_s_sleep(1);
        if ((++sp & 255u) == 0u) { if (xb_ld(&bar[XB_TMO])) break; if (sp > XB_SPIN_CAP) { atomicAdd(&bar[XB_TMO], 1u); break; } }
    }
    nloc = mine > 0u ? mine : 1u; nx = cnt > 0u ? cnt : 1u;
}
__device__ __forceinline__ void xcd_barrier(const XcdBarrier& b) {
    asm volatile("s_waitcnt vmcnt(0)" ::: "memory");
    __syncthreads();
    if (XB_TID0()) {
        unsigned* bar = b.bar;
        __builtin_amdgcn_s_waitcnt(0);
        unsigned nloc = b.st[0], nx = b.st[1];
        if (nloc == 0u) { xcd_barrier_complete(bar, b.x, nloc, nx); b.st[0] = nloc; b.st[1] = nx; }
        const unsigned old = xb_add(&bar[XB_XSUB(b.x)], 1u);
        const unsigned gen = old / nloc;
        if (old + 1u == (gen + 1u) * nloc) {
            __builtin_amdgcn_fence(__ATOMIC_RELEASE, "agent");
            asm volatile("s_waitcnt vmcnt(0)" ::: "memory");
            const unsigned og = xb_add(&bar[XB_TOP], 1u);
            const unsigned tg = og / nx;
            if (og + 1u == (tg + 1u) * nx) xb_add(&bar[XB_TOPGEN], 1u);
            else XB_SPIN(xb_ld(&bar[XB_TOPGEN]) == tg, bar);
            __builtin_amdgcn_fence(__ATOMIC_ACQUIRE, "agent");
            xb_add(&bar[XB_XGEN(b.x)], 1u);
            asm volatile("s_waitcnt vmcnt(0)" ::: "memory");
        } else {
            XB_SPIN(xb_ld(&bar[XB_XGEN(b.x)]) == gen, bar);
            __builtin_amdgcn_fence(__ATOMIC_ACQUIRE, "agent");
            asm volatile("s_waitcnt vmcnt(0)" ::: "memory");
        }
    }
    __syncthreads();
}

constexpr int LDS_PTAB = LDS_MISC + 64;
__device__ __forceinline__ P load_params(LAS unsigned char* ldsb) {
    unsigned off = LDS_PTAB; asm volatile("" : "+s"(off) :: "memory");
    LAS const unsigned long long* t = (LAS const unsigned long long*)(ldsb + off);
    union { P p; const void* v[NPTR]; } u;
#pragma unroll
    for (int i = 0; i < NPTR; ++i) { const unsigned long long x = t[i]; const unsigned lo = __builtin_amdgcn_readfirstlane((unsigned)x), hi = __builtin_amdgcn_readfirstlane((unsigned)(x >> 32));
        u.v[i] = (const void*)(__attribute__((address_space(1))) const void*)(((unsigned long long)hi << 32) | lo); }
    return u.p;
}
#define PH(F, n) do { const unsigned _t = (unsigned)hw_tid((LAS unsigned char*)lds); const long _G = (long)gridDim.x; const P _q = load_params((LAS unsigned char*)lds); \
        for (long _i = ((long)blockIdx.x + _G * (_t >> 6)) * 64 + (_t & 63); _i < (long)(n); _i += _G * NTHREADS) F(_q, L, _i); } while (0)
#define PH_MID(F, n, ROT) do { const unsigned _t = (unsigned)hw_tid((LAS unsigned char*)lds); const long _G = (long)gridDim.x, _b0 = _G / 8, _nb = _G - _b0 - _G / 4, _lb = (long)blockIdx.x - _b0; \
        const P _q = load_params((LAS unsigned char*)lds); \
        if (_lb >= 0 && _lb < _nb) for (long _i = (_lb + _nb * (long)(((_t >> 6) + (ROT)) & 7u)) * 64 + (_t & 63); _i < (long)(n); _i += _nb * NTHREADS) F(_q, L, _i); } while (0)
#define BLK(F) do { __syncthreads(); const P _q = load_params((LAS unsigned char*)lds); F(_q, L, (ldsp_t)lds); } while (0)
#define GRID_BAR() xcd_barrier(bar)
#define XIN_NEEDED(L) ((L) == 0)
#define GEMM_IN() do { const P p = load_params((LAS unsigned char*)lds); pg8::Gemm g{xbp(p), wintp(p, L), NP, D_INP, D}; pg8::StaticOrder S; S.init(NP, D_INP, (int)gridDim.x, (int)blockIdx.x); \
        pg8::EpiInBf16 E{ubase(p), p.ws + W_RSTD, L == 0 ? (const float*)nullptr : p.ws + W_XN}; pg8::gemm_phase<pg8::EpiInBf16, pg8::StaticOrder, true, true>((LAS unsigned char*)lds, g, S, E); } while (0)
#define GEMM_OUT() do { const P p = load_params((LAS unsigned char*)lds); pg8::Gemm g{mixb(p), wouttp(p, L), NP, D, D}; pg8::StaticOrder S; S.init(NP, D, (int)gridDim.x, (int)blockIdx.x); \
        pg8::EpiOutF32 E{L == DEPTH - 1 ? p.out + O_Y : p.ws + W_Y0, L == 0 ? p.x_prompt : p.ws + W_Y0, L == 0 ? p.x_sample : p.ws + W_Y0 + (size_t)NP * D, L + 1 < DEPTH ? xbp(p) : (bf16_t*)nullptr, p.ws + W_XN}; \
        pg8::gemm_phase<pg8::EpiOutF32, pg8::StaticOrder, true, true>((LAS unsigned char*)lds, g, S, E); } while (0)
__global__ void __launch_bounds__(NTHREADS, 2) mega(P parg, unsigned* barw) {
    extern __shared__ __attribute__((aligned(16))) unsigned char lds[];
    if (threadIdx.x < 16) ((LAS unsigned*)((LAS unsigned char*)lds + LDS_MISC))[threadIdx.x] = 0u;
    if ((threadIdx.x & 63) == 0) { const unsigned hw = (unsigned)__builtin_amdgcn_s_getreg((5 << 11) | 4) & 63u; *(LAS int*)((LAS unsigned char*)lds + LDS_WTAB + hw * 4) = (int)(threadIdx.x >> 6); }
    if (threadIdx.x == 64) { union { P p; unsigned long long v[NPTR]; } u; u.p = parg;
#pragma unroll
        for (int i = 0; i < NPTR; ++i) ((LAS unsigned long long*)((LAS unsigned char*)lds + LDS_PTAB))[i] = u.v[i]; }
    __syncthreads();
    XcdBarrier bar = xcd_barrier_post(barw, (volatile LAS unsigned*)((LAS unsigned char*)lds + LDS_MISC));
#endif
    { const int L = 0; PH(k_prep_win, (long)DEPTH * D_INP * (D / 8)); PH(k_prep_wout, (long)DEPTH * D * (D / 8)); PH(k_prep_wc, (long)DEPTH * 32768); PH(k_cmp_pad, (long)NSEQ * NCPAD * 2); BLK(bphase_cmp_bias); }
    static_assert(DEPTH == 2, "layer program is instantiated per layer");
    LAYER_PROGRAM(0)
    LAYER_PROGRAM(1)
}

#ifndef CPU_EMU
extern "C" void kernel_launch(void* const* d_in, const int* in_sizes, int n_in, void* d_out, int out_size, void* d_ws, size_t ws_size, hipStream_t stream) {
    P p = make_params(d_in, d_out, d_ws);
    static int grid = 0;
    if (!grid) {
        int dev = 0, cus = 0, per_cu = 0;
        hipGetDevice(&dev);
        hipDeviceGetAttribute(&cus, hipDeviceAttributeMultiprocessorCount, dev);
        (void)hipFuncSetAttribute((const void*)mega, hipFuncAttributeMaxDynamicSharedMemorySize, LDS_BYTES);
        (void)hipOccupancyMaxActiveBlocksPerMultiprocessor(&per_cu, (const void*)mega, NTHREADS, LDS_BYTES);
        (void)hipGetLastError(); grid = cus;
    }
    unsigned* barw = (unsigned*)((char*)d_ws + WB_BAR);
    hipMemsetAsync(barw, 0, 16384, stream);
    hipLaunchKernelGGL(mega, dim3(grid), dim3(NTHREADS), LDS_BYTES, stream, p, barw);
}
#endif
```

```cpp
#ifndef CPU_EMU
#include <hip/hip_runtime.h>
#define HD __host__ __device__ __forceinline__
#else
#include "emu.h"
#define HD inline
#endif
#include <stdint.h>
#include <math.h>

#ifndef CFG_BATCH
#define CFG_BATCH 4
#define CFG_SEQ 4096
#define CFG_DEC_BATCH 32
#define CFG_PAST_LEN 8192
#endif
constexpr int BATCH = CFG_BATCH, SEQ = CFG_SEQ, DEC_BATCH = CFG_DEC_BATCH, DEC_SEQ = 8, PAST_LEN = CFG_PAST_LEN, DEPTH = 2;
constexpr int D = 1024, D_IN = 3888, PAGE = 128;
constexpr int NP = BATCH * SEQ, NS = DEC_BATCH * DEC_SEQ, NT = NP + NS, NSEQ = BATCH + DEC_BATCH;
constexpr int NPAGES = PAST_LEN / PAGE, NUSED = DEC_BATCH * NPAGES, NPOOL = NUSED + (NUSED / 4 > 1 ? NUSED / 4 : 1);
constexpr int WIN = 512, WKEEP_P = SEQ < WIN ? SEQ : WIN, WKEEP_S = PAST_LEN < WIN ? PAST_LEN : WIN;
constexpr int NCP = SEQ / 16 - 1, NCS = (PAST_LEN + DEC_SEQ) / 16 - 1, NCMAX = NCP > NCS ? NCP : NCS;
constexpr int NSELP = (SEQ + 63) / 64, NSELS = (PAST_LEN + DEC_SEQ + 63) / 64, NSELMAX = NSELP > NSELS ? NSELP : NSELS;
constexpr int C_GQ = 0, C_GK = 128, C_GV = 256, C_GZ = 512, C_NQ = 768, C_NKV = 1280, C_NZ = 2048, C_MQK = 2560, C_MV = 3072, C_MO = 3328, C_MZ = 3584,
              C_GA = 3840, C_NG = 3856, C_MIF = 3880;
HD int orig_col(int n) { return n < 512 ? n : n < 768 ? 528 + (n - 512) : n < 1280 ? 784 + (n - 768) : n < 2048 ? 1296 + (n - 1280) : n < 2560 ? 2088 + (n - 2048) : n < 3072 ? 2600 + (n - 2560)
    : n < 3328 ? 3112 + (n - 3072) : n < 3584 ? 3376 + (n - 3328) : n < 3840 ? 3632 + (n - 3584) : n < 3856 ? 512 + (n - 3840) : n < 3880 ? 2064 + (n - 3856) : 3368 + (n - 3880); }
constexpr size_t O_Y = 0;
constexpr size_t O_PROWS = O_Y + (size_t)NT * D;
constexpr size_t O_SROWS = O_PROWS + (size_t)DEPTH * NP * 512;
constexpr size_t O_PWIN = O_SROWS + (size_t)DEPTH * NS * 512;
constexpr size_t O_SWIN = O_PWIN + (size_t)DEPTH * BATCH * WKEEP_P * 256;
constexpr size_t O_PGLA = O_SWIN + (size_t)DEPTH * DEC_BATCH * WKEEP_S * 256;
constexpr size_t O_SGLA = O_PGLA + (size_t)DEPTH * BATCH * 4 * 32 * 64;
constexpr size_t O_PC = O_SGLA + (size_t)DEPTH * DEC_BATCH * 4 * 32 * 64;
constexpr size_t O_SC = O_PC + (size_t)DEPTH * BATCH * 4 * 64 * 64;
constexpr size_t O_PN = O_SC + (size_t)DEPTH * DEC_BATCH * 4 * 64 * 64;
constexpr size_t O_SN = O_PN + (size_t)DEPTH * BATCH * 4 * 64;
constexpr size_t O_PM = O_SN + (size_t)DEPTH * DEC_BATCH * 4 * 64;
constexpr size_t O_SM = O_PM + (size_t)DEPTH * BATCH * 4;
constexpr size_t O_PCONV = O_SM + (size_t)DEPTH * DEC_BATCH * 4;
constexpr size_t O_SCONV = O_PCONV + (size_t)DEPTH * BATCH * 3 * 512;
constexpr size_t O_END = O_SCONV + (size_t)DEPTH * DEC_BATCH * 3 * 512;
constexpr size_t W_RSTD = 0;
constexpr size_t W_XN = W_RSTD + NT;
constexpr size_t W_U = W_XN + (size_t)NT * D;
constexpr size_t W_QN = W_U + (size_t)NT * D_IN;
constexpr size_t W_QR = W_QN + (size_t)NT * 512;
constexpr size_t W_WINNEW = W_QR + (size_t)NT * 512;
constexpr size_t W_LOGA = W_WINNEW + (size_t)NT * 256;
constexpr size_t W_MQ = W_LOGA + (size_t)NT * 128;
constexpr size_t W_MK = W_MQ + (size_t)NT * 256;
constexpr size_t W_CBIAS = W_MK + (size_t)NT * 256;
constexpr size_t W_KC = W_CBIAS + 256;
constexpr size_t W_VC = W_KC + (size_t)NSEQ * NCMAX * 128;
constexpr size_t W_PCMP = W_VC + (size_t)NSEQ * NCMAX * 128;
constexpr size_t W_OCMP = W_PCMP + (size_t)NT * 8 * NCMAX;
constexpr size_t W_IMP = W_OCMP + (size_t)NT * 512;
constexpr size_t W_SEL = W_IMP + (size_t)NT * 2 * NSELMAX;
constexpr size_t W_PSLC = W_SEL + (size_t)NT * 2 * 16;
constexpr size_t W_OSLC = W_PSLC + (size_t)NT * 8 * 1024;
constexpr size_t W_PWIN = W_OSLC + (size_t)NT * 512;
constexpr size_t W_OWIN = W_PWIN + (size_t)NT * 8 * 512;
constexpr size_t W_OA = W_OWIN + (size_t)NT * 512;
constexpr size_t W_H = W_OA + (size_t)NT * 256;
constexpr size_t W_MIXED = W_H + (size_t)NT * 256;
constexpr size_t W_Y0 = W_MIXED + (size_t)NT * D;
constexpr size_t W_DEN = W_Y0 + (size_t)NT * D;
constexpr size_t W_MT = W_DEN + (size_t)NT * 4;
constexpr size_t W_GSLOC = W_MT + (size_t)NT * 4;
constexpr size_t W_GSBL = W_GSLOC + (size_t)BATCH * 4 * (SEQ / 64) * 2048;
constexpr size_t W_MCLOC = W_GSBL + (size_t)BATCH * 4 * (SEQ / 64) * 32;
constexpr size_t W_MFG = W_MCLOC + (size_t)BATCH * 4 * (SEQ / 64) * 4160;
constexpr size_t W_SPART = W_MFG + (size_t)BATCH * 4 * (SEQ / 64) * 4;
constexpr size_t W_SLIST = W_SPART + (size_t)DEC_BATCH * 2 * 40 * 32 * 68;
constexpr size_t W_END = W_SLIST + (size_t)DEC_BATCH * 2 * 2 * 112;
constexpr int NTP = (NT + 255) / 256 * 256, D_INP = 4096;
constexpr size_t WB_WINT = (W_END * 4 + 255) / 256 * 256;
constexpr size_t WB_WOUTT = WB_WINT + (size_t)DEPTH * D_INP * D * 2;
constexpr size_t WB_XB = WB_WOUTT + (size_t)DEPTH * D * D * 2;
constexpr size_t WB_MIXB = WB_XB + (size_t)NTP * D * 2;
constexpr int NQT = SEQ / 64, NCPADP = (NCP + 63) / 64 * 64, NCPADS = (NCS + 63) / 64 * 64, NCPAD = NCPADP > NCPADS ? NCPADP : NCPADS;
constexpr size_t WB_QNB = WB_MIXB + (size_t)NTP * D * 2;
constexpr size_t WB_QRB = WB_QNB + (size_t)NT * 512 * 2;
constexpr size_t WB_KSB = WB_QRB + (size_t)NT * 512 * 2;
constexpr size_t WB_VST = WB_KSB + (size_t)BATCH * 2 * SEQ * 64 * 2;
constexpr size_t WB_KWB = WB_VST + (size_t)BATCH * 2 * SEQ * 64 * 2;
constexpr size_t WB_VWT = WB_KWB + (size_t)BATCH * 2 * SEQ * 64 * 2;
constexpr size_t WB_KCB = WB_VWT + (size_t)BATCH * 2 * SEQ * 64 * 2;
constexpr size_t WB_VCT = WB_KCB + (size_t)NSEQ * 2 * NCPAD * 64 * 2;
constexpr size_t WB_WCT = WB_VCT + (size_t)NSEQ * 2 * NCPAD * 64 * 2;
constexpr int U_LD = D_INP;
constexpr size_t WB_UB = WB_WCT + (size_t)DEPTH * 2 * 64 * 2048 * 2;
constexpr size_t WB_BAR = WB_UB + (size_t)NTP * U_LD * 2;
constexpr size_t WB_END = WB_BAR + 16384;
typedef unsigned short bf16_t;
#ifdef CPU_EMU
HD bf16_t f2bf(float f) { unsigned u = __builtin_bit_cast(unsigned, f); return (bf16_t)((u + 0x7fffu + ((u >> 16) & 1u)) >> 16); }
#else
__device__ __forceinline__ bf16_t f2bf(float f) { const __bf16 h = (__bf16)f; return __builtin_bit_cast(bf16_t, h); }
__host__ inline bf16_t f2bf_host(float f) { unsigned u = __builtin_bit_cast(unsigned, f); return (bf16_t)((u + 0x7fffu + ((u >> 16) & 1u)) >> 16); }
#endif
HD float bf2f(bf16_t h) { return __builtin_bit_cast(float, (unsigned)h << 16); }

constexpr int NPTR = 26;
struct P {
    const float *x_prompt, *x_sample, *cache, *state_win, *state_gla, *state_C, *state_n, *state_m, *state_conv;
    const int* page_table;
    const float *norm_g, *w_in, *w_out, *gla_w_gate, *gla_b_gate, *gla_norm_g, *q_norm_g, *k_norm_g, *cmp_pos, *cmp_w,
        *conv_w, *conv_b, *gate_b, *ml_norm_g;
    float* out;
    float* ws;
};
static_assert(sizeof(P) == NPTR * 8, "P is a table of NPTR pointers");

HD int seq_of_row(int r) { return r < NP ? r / SEQ : BATCH + (r - NP) / DEC_SEQ; }
HD int seq_row0(int s) { return s < BATCH ? s * SEQ : NP + (s - BATCH) * DEC_SEQ; }
HD int seq_len(int s) { return s < BATCH ? SEQ : DEC_SEQ; }
HD int seq_pos0(int s) { return s < BATCH ? 0 : PAST_LEN; }
HD int seq_ncmp(int s) { return s < BATCH ? NCP : NCS; }
HD int seq_nsel(int s) { return s < BATCH ? NSELP : NSELS; }
HD int row_pos(int r) { return r < NP ? r % SEQ : PAST_LEN + (r - NP) % DEC_SEQ; }
HD const float* xrow(const P& p, int L, int r) {
    if (L == 0) return r < NP ? p.x_prompt + (size_t)r * D : p.x_sample + (size_t)(r - NP) * D;
    return p.ws + W_Y0 + (size_t)r * D;
}
HD float* new_rows_ptr(const P& p, int L, int r) {
    return r < NP ? p.out + O_PROWS + ((size_t)L * NP + r) * 512 : p.out + O_SROWS + ((size_t)L * NS + (r - NP)) * 512;
}
HD const float* hist(const P& p, int L, int s, int r, int slot, int g) {
    if (s < BATCH) return p.out + O_PROWS + ((size_t)L * NP + (size_t)s * SEQ + r) * 512 + slot * 128 + g * 64;
    const int b = s - BATCH;
    if (r < PAST_LEN) { const int page = p.page_table[b * NPAGES + r / PAGE];
        return p.cache + (((size_t)L * NPOOL + page) * PAGE + (r % PAGE)) * 512 + slot * 128 + g * 64; }
    return p.out + O_SROWS + ((size_t)L * NS + b * DEC_SEQ + (r - PAST_LEN)) * 512 + slot * 128 + g * 64;
}
HD const float* ctxp(const P& p, int L, int s, int kpos, int kv, int g) {
    if (s < BATCH) return p.ws + W_WINNEW + ((size_t)s * SEQ + kpos) * 256 + kv * 128 + g * 64;
    const int b = s - BATCH;
    if (kpos < PAST_LEN) return p.state_win + (((size_t)L * DEC_BATCH + b) * WKEEP_S + (kpos - (PAST_LEN - WKEEP_S))) * 256 + kv * 128 + g * 64;
    return p.ws + W_WINNEW + ((size_t)NP + b * DEC_SEQ + (kpos - PAST_LEN)) * 256 + kv * 128 + g * 64;
}
HD bf16_t* wsb(const P& p, size_t off) { return (bf16_t*)((char*)p.ws + off); }
struct URow { const bf16_t* q; HD float operator[](size_t i) const { return bf2f(q[i]); } HD URow operator+(size_t k) const { return URow{q + k}; } };
HD bf16_t* ubase(const P& p) { return (bf16_t*)((char*)p.ws + WB_UB); }
HD URow urow(const P& p, int r) { return URow{ubase(p) + (size_t)r * U_LD}; }
HD bf16_t* mixb(const P& p) { return (bf16_t*)((char*)p.ws + WB_MIXB); }
HD bf16_t* xbp(const P& p) { return (bf16_t*)((char*)p.ws + WB_XB); }
HD bf16_t* wintp(const P& p, int L) { return (bf16_t*)((char*)p.ws + WB_WINT) + (size_t)L * D_INP * D; }
HD bf16_t* wouttp(const P& p, int L) { return (bf16_t*)((char*)p.ws + WB_WOUTT) + (size_t)L * D * D; }
#ifdef CPU_EMU
HD float EXPF(float x) { return expf(x); }
HD float RCPF(float x) { return 1.0f / x; }
HD float RSQRTF(float x) { return 1.0f / sqrtf(x); }
HD float LOG1PF(float e) { return log1pf(e); }
HD void SINCOSF(float a, float& sn, float& c) { sn = sinf(a); c = cosf(a); }
#else
__device__ __forceinline__ float EXPF(float x) { return __builtin_amdgcn_exp2f(x * 1.4426950408889634f); }
__device__ __forceinline__ float RCPF(float x) { return __builtin_amdgcn_rcpf(x); }
__device__ __forceinline__ float RSQRTF(float x) { return __builtin_amdgcn_rsqf(x); }
__device__ __forceinline__ float LOG1PF(float e) { return __builtin_amdgcn_logf(1.0f + e) * 0.6931471805599453f; }
__device__ __forceinline__ void SINCOSF(float a, float& sn, float& c) { const float fr = __builtin_amdgcn_fractf(a * 0.15915494309189535f); sn = __builtin_amdgcn_sinf(fr); c = __builtin_amdgcn_cosf(fr); }
#endif
HD float log_sigmoidf(float x) { return fminf(x, 0.f) - LOG1PF(EXPF(-fabsf(x))); }
HD float sigmoidf_(float x) { return RCPF(1.f + EXPF(-x)); }
HD float siluf(float x) { return x * RCPF(1.f + EXPF(-x)); }
HD float rope_inv(int i) { return EXPF(-logf(500000.0f) * (float)i * 2.0f / 16.0f); }

HD void k_prep_win(const P& p, int L, long it) {
    const int n = (int)(it % D_INP), kc = (int)((it / D_INP) % (D / 8)), L2 = (int)(it / ((long)D_INP * (D / 8)));
    bf16_t* o = wintp(p, L2) + (size_t)n * D + kc * 8;
    for (int j = 0; j < 8; ++j) { const int k = kc * 8 + j; o[j] = n < D_IN ? f2bf(p.norm_g[L2 * D + k] * p.w_in[((size_t)L2 * D + k) * D_IN + orig_col(n)]) : (bf16_t)0; }
}
HD void k_prep_wout(const P& p, int L, long it) {
    const int n = (int)(it % D), kc = (int)((it / D) % (D / 8)), L2 = (int)(it / ((long)D * (D / 8)));
    bf16_t* o = wouttp(p, L2) + (size_t)n * D + kc * 8;
    for (int j = 0; j < 8; ++j) { const int k = kc * 8 + j; o[j] = f2bf(p.w_out[((size_t)L2 * D + k) * D + n]); }
}
HD void k_gemm_in_emu(const P& p, int L, long it) {
    const int r = (int)(it / D_IN), c = (int)(it % D_IN);
    const bf16_t* a = xbp(p) + (size_t)r * D; const bf16_t* w = wintp(p, L) + (size_t)c * D; float s = 0.f;
    for (int k = 0; k < D; ++k) s += bf2f(a[k]) * bf2f(w[k]);
    ubase(p)[(size_t)r * U_LD + c] = f2bf(s * p.ws[W_RSTD + r]);
}
HD void k_win_copy(const P& p, int L, long it) {
    constexpr int NOLD = WKEEP_S - DEC_SEQ > 0 ? WKEEP_S - DEC_SEQ : 0;
    const int e = (int)(it % 256); const long q = it / 256; const int i = (int)(q % NOLD), b = (int)(q / NOLD);
    p.out[O_SWIN + (((size_t)L * DEC_BATCH + b) * WKEEP_S + i) * 256 + e] = p.state_win[(((size_t)L * DEC_BATCH + b) * WKEEP_S + i + DEC_SEQ) * 256 + e];
}
HD float conv_xp(const P& p, int L, int s, int tp, int ch) {
    if (tp < 3) return s < BATCH ? 0.f : p.state_conv[(((size_t)L * DEC_BATCH + (s - BATCH)) * 3 + tp) * 512 + ch];
    return urow(p, seq_row0(s) + tp - 3)[C_MQK + ch];
}
HD void k_conv_out(const P& p, int L, long it) {
    const int ch = (int)(it % 512), i = (int)((it / 512) % 3), s = (int)(it / 1536);
    const float v = conv_xp(p, L, s, seq_len(s) + i, ch);
    if (s < BATCH) p.out[O_PCONV + (((size_t)L * BATCH + s) * 3 + i) * 512 + ch] = v;
    else p.out[O_SCONV + (((size_t)L * DEC_BATCH + (s - BATCH)) * 3 + i) * 512 + ch] = v;
}
HD void k_cmp_sum(const P& p, int L, long it) {
    const int e = (int)(it % 64), g = (int)((it / 64) % 2), kv = (int)((it / 128) % 2); const long q = it / 256; const int j = (int)(q % NCMAX), s = (int)(q / NCMAX);
    if (j >= seq_ncmp(s)) return;
    float a = p.ws[W_CBIAS + kv * 64 + e];
    const float* w = p.cmp_w + ((size_t)(L * 2 + kv)) * 2048 * 64 + e;
    for (int t = 0; t < 32; ++t) { const float* x = hist(p, L, s, 16 * j + t, kv, g);
        for (int d = 0; d < 64; ++d) a += x[d] * w[(size_t)(t * 64 + d) * 64]; }
    p.ws[(kv ? W_VC : W_KC) + ((size_t)s * NCMAX + j) * 128 + g * 64 + e] = a;
}
HD void k_kc_norm(const P& p, int L, long it) {
    const int g = (int)(it % 2); const long q = it / 2; const int j = (int)(q % NCPAD), s = (int)(q / NCPAD);
    bf16_t* kb = wsb(p, WB_KCB) + (((size_t)s * 2 + g) * NCPAD + j) * 64; bf16_t* vt = wsb(p, WB_VCT) + (((size_t)s * 2 + g) * (NCPAD / 64) + j / 64) * 4096 + (j % 64);
    if (j >= seq_ncmp(s)) { for (int d = 0; d < 64; ++d) { kb[d] = 0; vt[(size_t)d * 64] = 0; } return; }
    float* k = p.ws + W_KC + ((size_t)s * NCMAX + j) * 128 + g * 64; const float* v = p.ws + W_VC + ((size_t)s * NCMAX + j) * 128 + g * 64; float ss = 0.f;
    for (int d = 0; d < 64; ++d) ss += k[d] * k[d];
    const float rs = RSQRTF(ss / 64 + 1e-6f);
    for (int d = 0; d < 64; ++d) { k[d] = k[d] * rs * p.k_norm_g[(L * 3 + 0) * 64 + d]; kb[d] = f2bf(k[d]); vt[(size_t)d * 64] = f2bf(v[d]); }
}
HD void k_cmp_score(const P& p, int L, long it) {
    const int n = (int)(it % NCMAX); const long q = it / NCMAX; const int h = (int)(q % 8), r = NP + (int)(q / 8), s = seq_of_row(r), pos = row_pos(r);
    if (n >= seq_ncmp(s)) return;
    float v = -INFINITY;
    if (16 * n + 31 <= pos) { const float* qq = p.ws + W_QN + (size_t)r * 512 + h * 64; const float* k = p.ws + W_KC + ((size_t)s * NCMAX + n) * 128 + (h / 4) * 64;
        float a = 0.f; for (int d = 0; d < 64; ++d) a += qq[d] * k[d]; v = a * 0.125f; }
    p.ws[W_PCMP + (size_t)NP * 8 * NCMAX + it] = v;
}
HD void softmax_row(float* x, int n) {
    float m = -INFINITY; for (int i = 0; i < n; ++i) m = fmaxf(m, x[i]);
    if (m == -INFINITY) m = 0.f;
    float sum = 0.f; for (int i = 0; i < n; ++i) { const float e = (x[i] == -INFINITY) ? 0.f : EXPF(x[i] - m); x[i] = e; sum += e; }
    const float inv = 1.0f / fmaxf(sum, 1e-30f);
    for (int i = 0; i < n; ++i) x[i] *= inv;
}
HD void k_cmp_softmax(const P& p, int L, long it) { const int r = NP + (int)(it / 8); softmax_row(p.ws + W_PCMP + ((size_t)NP * 8 + it) * NCMAX, seq_ncmp(seq_of_row(r))); }
HD void k_cmp_out(const P& p, int L, long it) {
    const int d = (int)(it % 64), h = (int)((it / 64) % 8), r = NP + (int)(it / 512), s = seq_of_row(r), nc = seq_ncmp(s);
    const float* pr = p.ws + W_PCMP + ((size_t)r * 8 + h) * NCMAX; const float* v = p.ws + W_VC + (size_t)s * NCMAX * 128 + (h / 4) * 64 + d; float a = 0.f;
    for (int n = 0; n < nc; ++n) a += pr[n] * v[(size_t)n * 128];
    p.ws[W_OCMP + (size_t)NP * 512 + it] = a;
}
HD void k_imp(const P& p, int L, long it) {
    const int j = (int)(it % NSELMAX), g = (int)((it / NSELMAX) % 2), r = NP + (int)(it / (2 * NSELMAX)), s = seq_of_row(r), nc = seq_ncmp(s);
    if (j >= seq_nsel(s)) return;
    float a = 0.f;
    for (int h = 0; h < 4; ++h) { const float* pr = p.ws + W_PCMP + ((size_t)r * 8 + g * 4 + h) * NCMAX;
        for (int q = 0; q < 5; ++q) { const int i = 4 * j - 1 + q; if (i >= 0 && i < nc) a += pr[i] * ((q == 0 || q == 4) ? 1.f : 2.f); } }
    p.ws[W_IMP + (size_t)NP * 2 * NSELMAX + it] = a;
}
HD void k_topk(const P& p, int L, long it) {
    const int g = (int)(it % 2), r = NP + (int)(it / 2), s = seq_of_row(r), pos = row_pos(r), ns = seq_nsel(s), cur = pos / 64;
    const float* imp = p.ws + W_IMP + ((size_t)r * 2 + g) * NSELMAX; int* sel = (int*)(p.ws + W_SEL) + ((size_t)r * 2 + g) * 16;
    unsigned long long c0 = 0, c1 = 0, c2 = 0, c3 = 0;
    const int nk = ns < 16 ? ns : 16;
    for (int k = 0; k < 16; ++k) {
        int bj = -1; float bs = 0.f;
        if (k < nk) for (int j = 0; j < ns; ++j) {
            const unsigned long long bit = 1ull << (j & 63); const unsigned long long cw = (j < 64) ? c0 : (j < 128) ? c1 : (j < 192) ? c2 : c3;
            if (cw & bit) continue;
            const bool forced = (j == 0) || (j == cur) || (j == cur - 1), valid = j * 64 <= pos;
            const float sc = forced ? INFINITY : (valid ? imp[j] : -INFINITY);
            if (bj < 0 || sc > bs) { bj = j; bs = sc; }
        }
        sel[k] = bj;
        if (bj >= 0) { const unsigned long long bit = 1ull << (bj & 63); if (bj < 64) c0 |= bit; else if (bj < 128) c1 |= bit; else if (bj < 192) c2 |= bit; else c3 |= bit; }
    }
}
HD void k_slc_score(const P& p, int L, long it) {
    const int ks = (int)(it % 1024), h = (int)((it / 1024) % 8), r = NP + (int)(it / 8192), s = seq_of_row(r), pos = row_pos(r), g = h / 4;
    const int blk = ((const int*)(p.ws + W_SEL))[((size_t)r * 2 + g) * 16 + ks / 64];
    float v = -INFINITY;
    if (blk >= 0) { const int kpos = blk * 64 + (ks % 64);
        if (kpos <= pos) { const float* qq = p.ws + W_QR + (size_t)r * 512 + h * 64; const float* k = hist(p, L, s, kpos, 2, g);
            float a = 0.f; for (int d = 0; d < 64; ++d) a += qq[d] * k[d]; v = a * 0.125f; } }
    p.ws[W_PSLC + (size_t)NP * 8 * 1024 + it] = v;
}
HD void k_slc_softmax(const P& p, int L, long it) { softmax_row(p.ws + W_PSLC + ((size_t)NP * 8 + it) * 1024, 1024); }
HD void k_slc_out(const P& p, int L, long it) {
    const int d = (int)(it % 64), h = (int)((it / 64) % 8), r = NP + (int)(it / 512), s = seq_of_row(r), g = h / 4;
    const float* pr = p.ws + W_PSLC + ((size_t)r * 8 + h) * 1024; const int* sel = (const int*)(p.ws + W_SEL) + ((size_t)r * 2 + g) * 16; float a = 0.f;
    for (int ks = 0; ks < 1024; ++ks) { const float pv = pr[ks]; if (pv != 0.f) a += pv * hist(p, L, s, sel[ks / 64] * 64 + (ks % 64), 3, g)[d]; }
    p.ws[W_OSLC + (size_t)NP * 512 + it] = a;
}
HD int seq_first_pos(int s) { return s < BATCH ? 0 : PAST_LEN - WKEEP_S; }
HD void k_win_score(const P& p, int L, long it) {
    const int w = (int)(it % 512), h = (int)((it / 512) % 8), r = NP + (int)(it / 4096), s = seq_of_row(r), pos = row_pos(r), g = h / 4, kpos = pos - w;
    float v = -INFINITY;
    if (kpos >= seq_first_pos(s)) { const float* qq = p.ws + W_QR + (size_t)r * 512 + h * 64; const float* k = ctxp(p, L, s, kpos, 0, g);
        float a = 0.f; for (int d = 0; d < 64; ++d) a += qq[d] * k[d]; v = a * 0.125f; }
    p.ws[W_PWIN + (size_t)NP * 8 * 512 + it] = v;
}
HD void k_win_softmax(const P& p, int L, long it) { softmax_row(p.ws + W_PWIN + ((size_t)NP * 8 + it) * 512, 512); }
HD void k_win_out(const P& p, int L, long it) {
    const int d = (int)(it % 64), h = (int)((it / 64) % 8), r = NP + (int)(it / 512), s = seq_of_row(r), pos = row_pos(r), g = h / 4;
    const float* pr = p.ws + W_PWIN + ((size_t)r * 8 + h) * 512; float a = 0.f;
    for (int w = 0; w < 512; ++w) { const float pv = pr[w]; if (pv != 0.f) a += pv * ctxp(p, L, s, pos - w, 1, g)[d]; }
    p.ws[W_OWIN + (size_t)NP * 512 + it] = a;
}
HD void k_gla(const P& p, int L, long it) {
    const int dv = (int)(it % 64), h = (int)((it / 64) % 4), s = BATCH + (int)(it / 256), r0 = seq_row0(s), len = seq_len(s);
    float S[32];
#pragma unroll
    for (int k = 0; k < 32; ++k) S[k] = s < BATCH ? 0.f : p.state_gla[((((size_t)L * DEC_BATCH + (s - BATCH)) * 4 + h) * 32 + k) * 64 + dv];
    for (int t = 0; t < len; ++t) {
        const int r = r0 + t; const URow u = urow(p, r); const float* la = p.ws + W_LOGA + (size_t)r * 128 + h * 32;
        const float v = u[C_GV + h * 64 + dv]; float o = 0.f;
#pragma unroll
        for (int k = 0; k < 32; ++k) { S[k] = EXPF(la[k]) * S[k] + u[C_GK + h * 32 + k] * v; o += u[C_GQ + h * 32 + k] * S[k]; }
        p.ws[W_OA + (size_t)r * 256 + h * 64 + dv] = o * 0.17677669529663687f;
    }
    float* so = s < BATCH ? p.out + O_PGLA + (((size_t)L * BATCH + s) * 4 + h) * 2048 : p.out + O_SGLA + (((size_t)L * DEC_BATCH + (s - BATCH)) * 4 + h) * 2048;
#pragma unroll
    for (int k = 0; k < 32; ++k) so[k * 64 + dv] = S[k];
}
HD void k_mlstm(const P& p, int L, long it) {
    const int e = (int)(it % 65), h = (int)((it / 65) % 4), s = BATCH + (int)(it / 260), r0 = seq_row0(s), len = seq_len(s);
    float C[64]; float m = s < BATCH ? 0.f : p.state_m[((size_t)L * DEC_BATCH + (s - BATCH)) * 4 + h];
#pragma unroll
    for (int d = 0; d < 64; ++d) C[d] = s < BATCH ? 0.f : (e < 64 ? p.state_C[((((size_t)L * DEC_BATCH + (s - BATCH)) * 4 + h) * 64 + e) * 64 + d]
                                                                  : p.state_n[(((size_t)L * DEC_BATCH + (s - BATCH)) * 4 + h) * 64 + d]);
    const float bi = p.gate_b[(L * 2 + 0) * 4 + h], bf = p.gate_b[(L * 2 + 1) * 4 + h];
    for (int t = 0; t < len; ++t) {
        const int r = r0 + t; const URow u = urow(p, r); const float* q = p.ws + W_MQ + (size_t)r * 256 + h * 64; const float* k = p.ws + W_MK + (size_t)r * 256 + h * 64;
        const float ip = u[C_MIF + h] + bi, lf = log_sigmoidf(u[C_MIF + 4 + h] + bf), mn = fmaxf(lf + m, ip), fp = EXPF(lf + m - mn), iq = EXPF(ip - mn), v = e < 64 ? u[C_MV + h * 64 + e] : 1.0f;
        float num = 0.f;
#pragma unroll
        for (int d = 0; d < 64; ++d) { C[d] = fp * C[d] + iq * v * k[d]; num += C[d] * q[d]; }
        m = mn;
        if (e < 64) p.ws[W_H + (size_t)r * 256 + h * 64 + e] = num;
        else { p.ws[W_DEN + (size_t)r * 4 + h] = num; p.ws[W_MT + (size_t)r * 4 + h] = m; }
    }
    const size_t sb = s < BATCH ? ((size_t)L * BATCH + s) * 4 + h : ((size_t)L * DEC_BATCH + (s - BATCH)) * 4 + h;
    float* co = e < 64 ? p.out + (s < BATCH ? O_PC : O_SC) + (sb * 64 + e) * 64 : p.out + (s < BATCH ? O_PN : O_SN) + sb * 64;
#pragma unroll
    for (int d = 0; d < 64; ++d) co[d] = C[d];
    if (e == 64) p.out[(s < BATCH ? O_PM : O_SM) + sb] = m;
}
HD void k_mix_gla(const P& p, int L, long it) {
    const int h = (int)(it % 4), r = NP + (int)(it / 4); const float* o = p.ws + W_OA + (size_t)r * 256 + h * 64; float ss = 0.f;
    for (int d = 0; d < 64; ++d) ss += o[d] * o[d];
    const float rs = RSQRTF(ss / 64 + 1e-6f); const URow u = urow(p, r) + (C_GZ + h * 64);
    for (int d = 0; d < 64; ++d) mixb(p)[(size_t)r * D + h * 64 + d] = f2bf(o[d] * rs * p.gla_norm_g[L * 64 + d] * siluf(u[d]));
}
HD void k_mix_ml(const P& p, int L, long it) {
    const int h = (int)(it % 4), r = NP + (int)(it / 4); const float* o = p.ws + W_H + (size_t)r * 256 + h * 64; float ss = 0.f;
    const float dinv = 1.0f / fmaxf(fabsf(p.ws[W_DEN + (size_t)NP * 4 + it]), EXPF(-p.ws[W_MT + (size_t)NP * 4 + it]));
    for (int d = 0; d < 64; ++d) ss += o[d] * dinv * o[d] * dinv;
    const float rs = dinv / sqrtf(ss / 64 + 1e-6f); const URow u = urow(p, r);
    for (int d = 0; d < 64; ++d) mixb(p)[(size_t)r * D + 768 + h * 64 + d] = f2bf(o[d] * rs * p.ml_norm_g[L * 64 + d] * sigmoidf_(u[C_MO + h * 64 + d]) * siluf(u[C_MZ + h * 64 + d]));
}
HD void k_gemm_out_emu(const P& p, int L, long it) {
    const int r = (int)(it / D), c = (int)(it % D);
    const bf16_t* a = mixb(p) + (size_t)r * D; const bf16_t* w = wouttp(p, L) + (size_t)c * D; float s = 0.f;
    for (int k = 0; k < D; ++k) s += bf2f(a[k]) * bf2f(w[k]);
    (L == DEPTH - 1 ? p.out + O_Y : p.ws + W_Y0)[it] = xrow(p, L, r)[c] + s;
}

#ifdef CPU_EMU
#define LDSQ
#define EXP2F(x) exp2f(x)
#else
#define LDSQ __attribute__((address_space(3)))
#define EXP2F(x) __builtin_amdgcn_exp2f(x)
typedef short bf16x8 __attribute__((ext_vector_type(8)));
typedef short bf16x4 __attribute__((ext_vector_type(4)));
typedef float f32x4 __attribute__((ext_vector_type(4)));
typedef float f32x16 __attribute__((ext_vector_type(16)));
#endif
typedef LDSQ unsigned char* ldsp_t;
#ifdef CPU_EMU
#define LDS_ADDF(ptr, v) (*(ptr) += (v))
#else
#define LDS_ADDF(ptr, v) ((void)__hip_atomic_fetch_add((ptr), (v), __ATOMIC_RELAXED, __HIP_MEMORY_SCOPE_WORKGROUP))
#endif
#ifdef CPU_EMU
#define LDS_BARRIER() emu_syncthreads()
#define SCHED_FENCE() do {} while (0)
#else
#define SCHED_FENCE() __builtin_amdgcn_sched_barrier(0)
#define LDS_BARRIER() asm volatile("s_waitcnt lgkmcnt(0)\n\ts_barrier" ::: "memory")
#endif
#ifndef CPU_EMU
__device__ __forceinline__ int lane_fresh() { int l = (int)__builtin_amdgcn_mbcnt_hi(~0u, __builtin_amdgcn_mbcnt_lo(~0u, 0u)); asm volatile("" : "+v"(l)); return l; }
__device__ __forceinline__ int xl_shfl_xor_i(int v, int m) {
    if (m == 1) return __builtin_amdgcn_update_dpp(0, v, 0xB1, 0xF, 0xF, true);
    if (m == 2) return __builtin_amdgcn_update_dpp(0, v, 0x4E, 0xF, 0xF, true);
    if (m == 7) return __builtin_amdgcn_update_dpp(0, v, 0x141, 0xF, 0xF, true);
    if (m == 15) return __builtin_amdgcn_update_dpp(0, v, 0x140, 0xF, 0xF, true);
    return __builtin_amdgcn_ds_bpermute((lane_fresh() ^ m) << 2, v);
}
__device__ __forceinline__ float xl_shfl_xor(float v, int m) { return __builtin_bit_cast(float, xl_shfl_xor_i(__builtin_bit_cast(int, v), m)); }
__device__ __forceinline__ int xl_shfl_xor(int v, int m) { return xl_shfl_xor_i(v, m); }
__device__ __forceinline__ float xl_shfl(float v, int src) { return __builtin_bit_cast(float, __builtin_amdgcn_ds_bpermute(src << 2, __builtin_bit_cast(int, v))); }
__device__ __forceinline__ int xl_shfl(int v, int src) { return __builtin_amdgcn_ds_bpermute(src << 2, v); }
#define __shfl_xor xl_shfl_xor
#define __shfl xl_shfl
#endif
constexpr int LDS_MISC = 8 * 19456;
#ifdef CPU_EMU
#define opaque_tid() ((int)threadIdx.x)
#define RFL(x) (x)
HD int opaque_i(int v) { return v; }
#else
__device__ __forceinline__ int opaque_i(int v) { asm volatile("" : "+v"(v)); return v; }
constexpr int LDS_WTAB = LDS_MISC + 320;
__device__ __forceinline__ int hw_tid(__attribute__((address_space(3))) unsigned char* ldsb) {
    const unsigned hw = (unsigned)__builtin_amdgcn_s_getreg((5 << 11) | 4) & 63u;
    const int wv = __builtin_amdgcn_readfirstlane(*(__attribute__((address_space(3))) const int*)(ldsb + LDS_WTAB + hw * 4));
    unsigned t = (unsigned)wv * 64u + __builtin_amdgcn_mbcnt_hi(~0u, __builtin_amdgcn_mbcnt_lo(~0u, 0u)); asm volatile("" : "+v"(t)); return (int)t;
}
#define RFL(x) __builtin_amdgcn_readfirstlane(x)
#define opaque_tid() hw_tid(lds)
#endif
constexpr int NTHREADS = 512;
constexpr int KT_STRIDE = 144, VT_STRIDE = 136, KT_BYTES = 64 * KT_STRIDE, VT_BYTES = 64 * VT_STRIDE;
constexpr int NSA_KT = 0, NSA_VT = 3 * KT_BYTES, NSA_IMP = NSA_VT + 3 * VT_BYTES, NSA_MASK = NSA_IMP + 8 * 8 * 64 * 4, NSA_END = NSA_MASK + 8 * 8 * 8;
constexpr int NSA_COMB = 73728;
constexpr float C2LOG = 0.125f * 1.4426950408889634f;
constexpr float NEG_BIG = -1.0e30f;

typedef unsigned u32x4_t __attribute__((ext_vector_type(4)));
#ifdef CPU_EMU
HD float rlane(float v, int i) { return __shfl(v, i); }
#else
__device__ __forceinline__ float rlane(float v, int i) { return __builtin_bit_cast(float, __builtin_amdgcn_readlane(__builtin_bit_cast(int, v), i)); }
#endif
#ifdef CPU_EMU
HD unsigned pack2bf(float lo, float hi) { return (unsigned)f2bf(lo) | ((unsigned)f2bf(hi) << 16); }
#else
typedef __bf16 hwbf16x2_t __attribute__((ext_vector_type(2)));
typedef float hwf32x2_t __attribute__((ext_vector_type(2)));
__device__ __forceinline__ unsigned pack2bf(float lo, float hi) { const hwf32x2_t v = {lo, hi}; const hwbf16x2_t b = __builtin_convertvector(v, hwbf16x2_t); return __builtin_bit_cast(unsigned, b); }
#endif
HD void ld8f(const float* q, float (&f)[8]) { const f32x4 a = *(const f32x4*)q, b = *(const f32x4*)(q + 4); f[0] = a[0]; f[1] = a[1]; f[2] = a[2]; f[3] = a[3]; f[4] = b[0]; f[5] = b[1]; f[6] = b[2]; f[7] = b[3]; }
struct AttnSt { f32x16 o0, o1; float m, l; };
template <bool MASK> HD bool softmax_tile(f32x16& s0, f32x16& s1, int lim2, int lo2, bool sel, AttnSt& st, bf16x8 (&pf)[4], float& alpha) {
    float tmax = NEG_BIG;
    if (MASK) {
#pragma unroll
        for (int r = 0; r < 16; ++r) { const int kc = (r & 3) + 8 * (r >> 2);
            s0[r] = (kc <= lim2 && kc > lo2) ? s0[r] : NEG_BIG; s1[r] = (kc + 32 <= lim2 && kc + 32 > lo2) ? s1[r] : NEG_BIG; tmax = fmaxf(tmax, fmaxf(s0[r], s1[r])); }
    } else {
#pragma unroll
        for (int r = 0; r < 16; ++r) tmax = fmaxf(tmax, fmaxf(s0[r], s1[r]));
        tmax = sel ? tmax : NEG_BIG;
    }
    tmax = fmaxf(tmax, __shfl_xor(tmax, 32));
    const float mn = fmaxf(st.m, tmax); const bool any = __ballot(mn > st.m) != 0ull;
    alpha = 1.0f;
    if (any) { alpha = EXP2F(st.m - mn); st.l *= alpha; }
    st.m = mn;
    float ls = 0.f;
#pragma unroll
    for (int r = 0; r < 16; ++r) { float p0 = EXP2F(s0[r] - mn), p1 = EXP2F(s1[r] - mn);
        if (MASK) { p0 = s0[r] > -1.0e29f ? p0 : 0.f; p1 = s1[r] > -1.0e29f ? p1 : 0.f; }
        s0[r] = p0; s1[r] = p1; ls += p0 + p1; }
    u32x4_t w0, w1, w2, w3;
#pragma unroll
    for (int i = 0; i < 4; ++i) { w0[i] = pack2bf(s0[2 * i], s0[2 * i + 1]); w1[i] = pack2bf(s0[8 + 2 * i], s0[8 + 2 * i + 1]); w2[i] = pack2bf(s1[2 * i], s1[2 * i + 1]); w3[i] = pack2bf(s1[8 + 2 * i], s1[8 + 2 * i + 1]); }
    if (!MASK) { const unsigned km = sel ? 0xffffffffu : 0u; w0 &= km; w1 &= km; w2 &= km; w3 &= km; ls = sel ? ls : 0.f; }
    st.l += ls;
    pf[0] = __builtin_bit_cast(bf16x8, w0); pf[1] = __builtin_bit_cast(bf16x8, w1); pf[2] = __builtin_bit_cast(bf16x8, w2); pf[3] = __builtin_bit_cast(bf16x8, w3);
    return any;
}
HD void attn_init(AttnSt& s) { for (int r = 0; r < 16; ++r) { s.o0[r] = 0.f; s.o1[r] = 0.f; } s.m = NEG_BIG; s.l = 0.f; }
HD short bfbits(float f) { return (short)f2bf(f); }
template <bool IMP, bool MASK>
HD void attn_tile(ldsp_t lds, int buf, const bf16x8 (&qf)[4], float mb, int lim2, int lo2, bool sel, AttnSt& st, f32x16& i0, f32x16& i1, int ntile64, int c, int hi) {
    f32x16 s0, s1;
    for (int r = 0; r < 16; ++r) { s0[r] = -mb; s1[r] = -mb; }
    const ldsp_t kt = lds + NSA_KT + buf * KT_BYTES + c * KT_STRIDE + hi * 16;
#pragma unroll
    for (int ks = 0; ks < 4; ++ks) {
        const bf16x8 k0 = *(const LDSQ bf16x8*)(kt + ks * 32), k1 = *(const LDSQ bf16x8*)(kt + 32 * KT_STRIDE + ks * 32);
        s0 = __builtin_amdgcn_mfma_f32_32x32x16_bf16(k0, qf[ks], s0, 0, 0, 0);
        s1 = __builtin_amdgcn_mfma_f32_32x32x16_bf16(k1, qf[ks], s1, 0, 0, 0);
    }
    float ls = 0.f;
#pragma unroll
    for (int r = 0; r < 16; ++r) { float p0 = EXP2F(s0[r]), p1 = EXP2F(s1[r]);
        if (MASK) { const int kc = (r & 3) + 8 * (r >> 2); p0 = (kc <= lim2 && kc > lo2) ? p0 : 0.f; p1 = (kc + 32 <= lim2 && kc + 32 > lo2) ? p1 : 0.f; }
        s0[r] = p0; s1[r] = p1; ls += p0 + p1; }
    u32x4_t w0, w1, w2, w3;
#pragma unroll
    for (int i = 0; i < 4; ++i) { w0[i] = pack2bf(s0[2 * i], s0[2 * i + 1]); w1[i] = pack2bf(s0[8 + 2 * i], s0[8 + 2 * i + 1]); w2[i] = pack2bf(s1[2 * i], s1[2 * i + 1]); w3[i] = pack2bf(s1[8 + 2 * i], s1[8 + 2 * i + 1]); }
    if (!MASK) { const unsigned km = sel ? 0xffffffffu : 0u; w0 &= km; w1 &= km; w2 &= km; w3 &= km; ls = sel ? ls : 0.f; }
    st.l += ls;
    bf16x8 pf[4];
    pf[0] = __builtin_bit_cast(bf16x8, w0); pf[1] = __builtin_bit_cast(bf16x8, w1); pf[2] = __builtin_bit_cast(bf16x8, w2); pf[3] = __builtin_bit_cast(bf16x8, w3);
    const ldsp_t vt = lds + NSA_VT + buf * VT_BYTES + c * VT_STRIDE + hi * 8;
#pragma unroll
    for (int ks = 0; ks < 4; ++ks) {
        const bf16x4 a0 = *(const LDSQ bf16x4*)(vt + ks * 32), a1 = *(const LDSQ bf16x4*)(vt + ks * 32 + 16);
        const bf16x4 b0 = *(const LDSQ bf16x4*)(vt + 32 * VT_STRIDE + ks * 32), b1 = *(const LDSQ bf16x4*)(vt + 32 * VT_STRIDE + ks * 32 + 16);
        bf16x8 v0, v1;
#pragma unroll
        for (int j = 0; j < 4; ++j) { v0[j] = a0[j]; v0[4 + j] = a1[j]; v1[j] = b0[j]; v1[4 + j] = b1[j]; }
        st.o0 = __builtin_amdgcn_mfma_f32_32x32x16_bf16(v0, pf[ks], st.o0, 0, 0, 0);
        st.o1 = __builtin_amdgcn_mfma_f32_32x32x16_bf16(v1, pf[ks], st.o1, 0, 0, 0);
        if (IMP) {
#pragma unroll
            for (int jt = 0; jt < 2; ++jt) { const int base = ntile64 * 64 + 16 * ks + 4 * hi - 4 * (jt * 32 + c); bf16x8 af;
#pragma unroll
                for (int jj = 0; jj < 8; ++jj) { const int dl = base + 8 * (jj >> 2) + (jj & 3); af[jj] = (dl == -1 || dl == 3) ? (short)0x3F80 : ((dl >= 0 && dl <= 2) ? (short)0x4000 : (short)0); }
                if (jt == 0) i0 = __builtin_amdgcn_mfma_f32_32x32x16_bf16(af, pf[ks], i0, 0, 0, 0); else i1 = __builtin_amdgcn_mfma_f32_32x32x16_bf16(af, pf[ks], i1, 0, 0, 0); }
        }
    }
}
HD void imp_tile(ldsp_t lds, int buf, const bf16x8 (&qf)[4], float mb, float inv, int lim2, f32x16& i0, f32x16& i1, int ntile64, int c, int hi) {
    f32x16 s0, s1;
    for (int r = 0; r < 16; ++r) { s0[r] = -mb; s1[r] = -mb; }
    const ldsp_t kt = lds + NSA_KT + buf * KT_BYTES + c * KT_STRIDE + hi * 16;
#pragma unroll
    for (int ks = 0; ks < 4; ++ks) {
        const bf16x8 k0 = *(const LDSQ bf16x8*)(kt + ks * 32), k1 = *(const LDSQ bf16x8*)(kt + 32 * KT_STRIDE + ks * 32);
        s0 = __builtin_amdgcn_mfma_f32_32x32x16_bf16(k0, qf[ks], s0, 0, 0, 0);
        s1 = __builtin_amdgcn_mfma_f32_32x32x16_bf16(k1, qf[ks], s1, 0, 0, 0);
    }
#pragma unroll
    for (int r = 0; r < 16; ++r) { const int kc = (r & 3) + 8 * (r >> 2); s0[r] = kc <= lim2 ? EXP2F(s0[r]) * inv : 0.f; s1[r] = kc + 32 <= lim2 ? EXP2F(s1[r]) * inv : 0.f; }
    u32x4_t w0, w1, w2, w3;
#pragma unroll
    for (int i = 0; i < 4; ++i) { w0[i] = pack2bf(s0[2 * i], s0[2 * i + 1]); w1[i] = pack2bf(s0[8 + 2 * i], s0[8 + 2 * i + 1]); w2[i] = pack2bf(s1[2 * i], s1[2 * i + 1]); w3[i] = pack2bf(s1[8 + 2 * i], s1[8 + 2 * i + 1]); }
    bf16x8 pf[4];
    pf[0] = __builtin_bit_cast(bf16x8, w0); pf[1] = __builtin_bit_cast(bf16x8, w1); pf[2] = __builtin_bit_cast(bf16x8, w2); pf[3] = __builtin_bit_cast(bf16x8, w3);
#pragma unroll
    for (int ks = 0; ks < 4; ++ks)
#pragma unroll
        for (int jt = 0; jt < 2; ++jt) { const int base = ntile64 * 64 + 16 * ks + 4 * hi - 4 * (jt * 32 + c); bf16x8 af;
            const int jlo = 16 * ntile64 + 4 * ks;
            if (jlo + 4 < 32 * jt || jlo > 32 * jt + 31) continue;
#pragma unroll
            for (int jj = 0; jj < 8; ++jj) { const int dl = base + 8 * (jj >> 2) + (jj & 3); af[jj] = (dl == -1 || dl == 3) ? (short)0x3F80 : ((dl >= 0 && dl <= 2) ? (short)0x4000 : (short)0); }
            if (jt == 0) i0 = __builtin_amdgcn_mfma_f32_32x32x16_bf16(af, pf[ks], i0, 0, 0, 0); else i1 = __builtin_amdgcn_mfma_f32_32x32x16_bf16(af, pf[ks], i1, 0, 0, 0); }
}
HD float score_bound(const bf16x8 (&qf)[4], const float* kgain, int lane) {
    float ss = 0.f;
#pragma unroll
    for (int ks = 0; ks < 4; ++ks)
#pragma unroll
        for (int j = 0; j < 8; ++j) { const float v = bf2f((bf16_t)qf[ks][j]); ss += v * v; }
    ss += __shfl_xor(ss, 32);
    float g = fabsf(kgain[lane]);
    g = fmaxf(g, __shfl_xor(g, 1)); g = fmaxf(g, __shfl_xor(g, 2)); g = fmaxf(g, __shfl_xor(g, 7)); g = fmaxf(g, __shfl_xor(g, 15));
    g = fmaxf(fmaxf(rlane(g, 0), rlane(g, 16)), fmaxf(rlane(g, 32), rlane(g, 48)));
    return sqrtf(ss) * 8.0f * g * 1.01f + 0.01f;
}
HD void tile_load(const bf16_t* k, const bf16_t* vt, int tid, bf16x8& rk, bf16x8& rv) { rk = *(const bf16x8*)(k + tid * 8); rv = *(const bf16x8*)(vt + tid * 8); }
HD void tile_store(ldsp_t lds, int buf, int tid, const bf16x8& rk, const bf16x8& rv) {
    const int row = tid >> 3, ch = tid & 7;
    *(LDSQ bf16x8*)(lds + NSA_KT + buf * KT_BYTES + row * KT_STRIDE + ch * 16) = rk;
    bf16x4 a, b;
    for (int j = 0; j < 4; ++j) { a[j] = rv[j]; b[j] = rv[4 + j]; }
    *(LDSQ bf16x4*)(lds + NSA_VT + buf * VT_BYTES + row * VT_STRIDE + ch * 16) = a; *(LDSQ bf16x4*)(lds + NSA_VT + buf * VT_BYTES + row * VT_STRIDE + ch * 16 + 8) = b;
}
HD void qk_tile(ldsp_t lds, int buf, const bf16x8 (&qf)[4], float mb, f32x16& s0, f32x16& s1, int c, int hi) {
    for (int r = 0; r < 16; ++r) { s0[r] = -mb; s1[r] = -mb; }
    const ldsp_t kt = lds + NSA_KT + buf * KT_BYTES + c * KT_STRIDE + hi * 16;
#pragma unroll
    for (int ks = 0; ks < 4; ++ks) {
        const bf16x8 k0 = *(const LDSQ bf16x8*)(kt + ks * 32), k1 = *(const LDSQ bf16x8*)(kt + 32 * KT_STRIDE + ks * 32);
        s0 = __builtin_amdgcn_mfma_f32_32x32x16_bf16(k0, qf[ks], s0, 0, 0, 0);
        s1 = __builtin_amdgcn_mfma_f32_32x32x16_bf16(k1, qf[ks], s1, 0, 0, 0);
    }
}
template <bool MASK> HD void sm_tile(f32x16& s0, f32x16& s1, int lim2, int lo2, bool sel, float& l, bf16x8 (&pf)[4]) {
    float ls = 0.f;
#pragma unroll
    for (int r = 0; r < 16; ++r) { float p0 = EXP2F(s0[r]), p1 = EXP2F(s1[r]);
        if (MASK) { const int kc = (r & 3) + 8 * (r >> 2); p0 = (kc <= lim2 && kc > lo2) ? p0 : 0.f; p1 = (kc + 32 <= lim2 && kc + 32 > lo2) ? p1 : 0.f; }
        s0[r] = p0; s1[r] = p1; ls += p0 + p1; }
    u32x4_t w0, w1, w2, w3;
#pragma unroll
    for (int i = 0; i < 4; ++i) { w0[i] = pack2bf(s0[2 * i], s0[2 * i + 1]); w1[i] = pack2bf(s0[8 + 2 * i], s0[8 + 2 * i + 1]); w2[i] = pack2bf(s1[2 * i], s1[2 * i + 1]); w3[i] = pack2bf(s1[8 + 2 * i], s1[8 + 2 * i + 1]); }
    if (!MASK) { const unsigned km = sel ? 0xffffffffu : 0u; w0 &= km; w1 &= km; w2 &= km; w3 &= km; ls = sel ? ls : 0.f; }
    l += ls;
    pf[0] = __builtin_bit_cast(bf16x8, w0); pf[1] = __builtin_bit_cast(bf16x8, w1); pf[2] = __builtin_bit_cast(bf16x8, w2); pf[3] = __builtin_bit_cast(bf16x8, w3);
}
HD void pv_tile(ldsp_t lds, int buf, const bf16x8 (&pf)[4], AttnSt& st, int c, int hi) {
    const ldsp_t vt = lds + NSA_VT + buf * VT_BYTES + c * VT_STRIDE + hi * 8;
#pragma unroll
    for (int ks = 0; ks < 4; ++ks) {
        const bf16x4 a0 = *(const LDSQ bf16x4*)(vt + ks * 32), a1 = *(const LDSQ bf16x4*)(vt + ks * 32 + 16);
        const bf16x4 b0 = *(const LDSQ bf16x4*)(vt + 32 * VT_STRIDE + ks * 32), b1 = *(const LDSQ bf16x4*)(vt + 32 * VT_STRIDE + ks * 32 + 16);
        bf16x8 v0, v1;
#pragma unroll
        for (int j = 0; j < 4; ++j) { v0[j] = a0[j]; v0[4 + j] = a1[j]; v1[j] = b0[j]; v1[4 + j] = b1[j]; }
        st.o0 = __builtin_amdgcn_mfma_f32_32x32x16_bf16(v0, pf[ks], st.o0, 0, 0, 0);
        st.o1 = __builtin_amdgcn_mfma_f32_32x32x16_bf16(v1, pf[ks], st.o1, 0, 0, 0);
    }
}
struct TilePipe { bf16x8 k1, v1; };
HD void tp_start(ldsp_t lds, int tid, const bf16_t* kb, const bf16_t* vb, int nt, TilePipe& tp) {
    bf16x8 rk, rv, rk2, rv2; tile_load(kb, vb, tid, rk, rv);
    if (1 < nt) tile_load(kb + 4096, vb + 4096, tid, rk2, rv2);
    if (2 < nt) tile_load(kb + 2 * 4096, vb + 2 * 4096, tid, tp.k1, tp.v1);
    tile_store(lds, 0, tid, rk, rv);
    if (1 < nt) tile_store(lds, 1, tid, rk2, rv2);
    LDS_BARRIER();
}
HD void tp_advance(ldsp_t lds, int tid, const bf16_t* kb, const bf16_t* vb, int t, int nt, TilePipe& tp) {
    if (t + 2 < nt) tile_store(lds, (t + 2) % 3, tid, tp.k1, tp.v1);
    if (t + 3 < nt) tile_load(kb + (size_t)(t + 3) * 4096, vb + (size_t)(t + 3) * 4096, tid, tp.k1, tp.v1);
    LDS_BARRIER();
}
struct TileParm { bool masked, sel, skip; int lim2, lo2; };
struct BranchCtx { int qt, pos, hi, nlim, nlim_min, kb0; unsigned long long selmask; };
template <int BR> HD TileParm tile_parm(int t, const BranchCtx& x) {
    TileParm q; q.skip = false; q.sel = true; q.lo2 = -100000; q.lim2 = 0;
    if (BR == 0) { q.masked = !(64 * t + 63 <= x.nlim_min); q.lim2 = x.nlim - 64 * t - 4 * x.hi; }
    else if (BR == 1) { const bool s = ((x.selmask >> t) & 1ull) != 0ull; q.masked = t >= x.qt;
        if (q.masked) q.lim2 = s ? x.pos - 64 * t - 4 * x.hi : -100000; else { q.sel = s; q.skip = __ballot(s) == 0ull; } }
    else { const int kbx = x.kb0 + t, off = 64 * kbx + 4 * x.hi; q.masked = !(kbx < x.qt && kbx > x.qt - 8); q.lim2 = x.pos - off; q.lo2 = x.pos - WIN - off; }
    return q;
}
HD void sm_pv(ldsp_t lds, int buf, const TileParm& q, f32x16& s0, f32x16& s1, AttnSt& st, int c, int hi) {
    bf16x8 pf[4];
    if (q.masked) sm_tile<true>(s0, s1, q.lim2, q.lo2, true, st.l, pf); else sm_tile<false>(s0, s1, 0, 0, q.sel, st.l, pf);
    pv_tile(lds, buf, pf, st, c, hi);
}
HD void qk_sm_int(ldsp_t lds, int bufn, const bf16x8 (&qf)[4], float mb, f32x16& n0, f32x16& n1, f32x16& c0, f32x16& c1, bool sel, float& l, bf16x8 (&pf)[4], int c, int hi) {
    for (int r = 0; r < 16; ++r) { n0[r] = -mb; n1[r] = -mb; }
    const ldsp_t kt = lds + NSA_KT + bufn * KT_BYTES + c * KT_STRIDE + hi * 16;
    bf16x8 k0 = *(const LDSQ bf16x8*)(kt), k1 = *(const LDSQ bf16x8*)(kt + 32 * KT_STRIDE);
    float ls = 0.f;
#pragma unroll
    for (int ks = 0; ks < 4; ++ks) {
        n0 = __builtin_amdgcn_mfma_f32_32x32x16_bf16(k0, qf[ks], n0, 0, 0, 0);
        n1 = __builtin_amdgcn_mfma_f32_32x32x16_bf16(k1, qf[ks], n1, 0, 0, 0);
        if (ks < 3) { k0 = *(const LDSQ bf16x8*)(kt + (ks + 1) * 32); k1 = *(const LDSQ bf16x8*)(kt + 32 * KT_STRIDE + (ks + 1) * 32); }
#pragma unroll
        for (int r = 4 * ks; r < 4 * ks + 4; ++r) { const float p0 = EXP2F(c0[r]), p1 = EXP2F(c1[r]); c0[r] = p0; c1[r] = p1; ls += p0 + p1; }
        SCHED_FENCE();
    }
    u32x4_t w0, w1, w2, w3;
#pragma unroll
    for (int i = 0; i < 4; ++i) { w0[i] = pack2bf(c0[2 * i], c0[2 * i + 1]); w1[i] = pack2bf(c0[8 + 2 * i], c0[8 + 2 * i + 1]); w2[i] = pack2bf(c1[2 * i], c1[2 * i + 1]); w3[i] = pack2bf(c1[8 + 2 * i], c1[8 + 2 * i + 1]); }
    const unsigned km = sel ? 0xffffffffu : 0u; w0 &= km; w1 &= km; w2 &= km; w3 &= km; l += sel ? ls : 0.f;
    pf[0] = __builtin_bit_cast(bf16x8, w0); pf[1] = __builtin_bit_cast(bf16x8, w1); pf[2] = __builtin_bit_cast(bf16x8, w2); pf[3] = __builtin_bit_cast(bf16x8, w3);
}
template <int BR> HD void nsa_branch(ldsp_t lds, int tid, const bf16_t* kb, const bf16_t* vb, int nt, int i0, int i1, const bf16x8 (&qf)[4], float mb, AttnSt& st, TilePipe& tp, const BranchCtx& x, int c, int hi) {
    tp_start(lds, tid, kb, vb, nt, tp);
    f32x16 a0, a1, b0, b1; bf16x8 pf[4];
    int t = 0;
#pragma unroll 1
    for (; t < i0; ++t) { const TileParm q = tile_parm<BR>(t, x); qk_tile(lds, t % 3, qf, mb, a0, a1, c, hi); sm_pv(lds, t % 3, q, a0, a1, st, c, hi); tp_advance(lds, tid, kb, vb, t, nt, tp); }
    bool pending = false;
    if (t < i1) {
        qk_tile(lds, t % 3, qf, mb, a0, a1, c, hi);
#pragma unroll 1
        for (; t < i1; ++t) {
            const bool sel = BR == 1 ? ((x.selmask >> t) & 1ull) != 0ull : true;
            qk_sm_int(lds, (t + 1) % 3, qf, mb, b0, b1, a0, a1, sel, st.l, pf, c, hi); pv_tile(lds, t % 3, pf, st, c, hi); tp_advance(lds, tid, kb, vb, t, nt, tp);
            a0 = b0; a1 = b1;
        }
        pending = t < nt;
    }
#pragma unroll 1
    for (; t < nt; ++t) { const TileParm q = tile_parm<BR>(t, x); if (!pending) qk_tile(lds, t % 3, qf, mb, a0, a1, c, hi); pending = false; sm_pv(lds, t % 3, q, a0, a1, st, c, hi); tp_advance(lds, tid, kb, vb, t, nt, tp); }
}
struct NsaIdx { int row, head, hi; };
HD NsaIdx nsa_idx(ldsp_t lds, int b, int g, int qt) { const int tid = opaque_tid(), lane = tid & 63, w = tid >> 6, c = lane & 31; NsaIdx x; x.row = b * SEQ + 64 * qt + 8 * w + (c >> 2); x.head = g * 4 + (c & 3); x.hi = lane >> 5; return x; }
HD float nsa_gate(const P& p, ldsp_t lds, int b, int g, int qt, int br) { const NsaIdx x = nsa_idx(lds, b, g, qt); return sigmoidf_(urow(p, x.row)[C_NG + br * 8 + x.head]); }
HD void nsa_load_q(const P& p, ldsp_t lds, int b, int g, int qt, size_t wb, bf16x8 (&qf)[4]) { const NsaIdx x = nsa_idx(lds, b, g, qt);
    const bf16_t* qp = wsb(p, wb) + (size_t)x.row * 512 + x.head * 64 + x.hi * 8;
#pragma unroll
    for (int ks = 0; ks < 4; ++ks) qf[ks] = *(const bf16x8*)(qp + ks * 16); }
HD float nsa_gate_raw(const P& p, ldsp_t lds, int b, int g, int qt, int br) { const NsaIdx x = nsa_idx(lds, b, g, qt); return urow(p, x.row)[C_NG + br * 8 + x.head]; }
HD void nsa_unit(const P& p, int L, ldsp_t lds, int b, int g, int qt) {
    const int tid = opaque_tid(), lane = tid & 63, w = RFL(tid >> 6), c = lane & 31, hi = lane >> 5;
    const int pos = 64 * qt + 8 * w + (c >> 2);
    const size_t bg = (size_t)b * 2 + g;
    bf16x8 qf[4]; TilePipe tp; AttnSt st; f32x16 i0, i1;
    LDSQ float* combl = (LDSQ float*)(lds + NSA_COMB + w * 8192) + lane;
    for (int r = 0; r < 16; ++r) { i0[r] = 0.f; i1[r] = 0.f; }
    bf16x8 qfr[4];
    nsa_load_q(p, lds, b, g, qt, WB_QNB, qf); nsa_load_q(p, lds, b, g, qt, WB_QRB, qfr);
    const float gr0 = nsa_gate_raw(p, lds, b, g, qt, 0), gr1 = nsa_gate_raw(p, lds, b, g, qt, 1), gr2 = nsa_gate_raw(p, lds, b, g, qt, 2);
    attn_init(st);
    {
        const float mb = score_bound(qf, p.k_norm_g + (L * 3 + 0) * 64, lane);
        const int nt_n = ((4 * qt + 2) >> 6) + 1;
        const bf16_t* kb = wsb(p, WB_KCB) + bg * NCPAD * 64; const bf16_t* vb = wsb(p, WB_VCT) + bg * (NCPAD / 64) * 4096;
        const int nlim = (pos - 31) >> 4, nlim_min = (64 * qt + 8 * w - 31) >> 4;
        BranchCtx bx; bx.qt = qt; bx.pos = pos; bx.hi = hi; bx.nlim = nlim; bx.nlim_min = nlim_min; bx.kb0 = 0; bx.selmask = 0ull;
        { int ni = (nlim_min + 1) >> 6; ni = ni < 0 ? 0 : (ni > nt_n ? nt_n : ni);
          nsa_branch<0>(lds, tid, kb, vb, nt_n, 0, ni, qf, mb, st, tp, bx, c, hi); }
        {
            const float lt1 = st.l + __shfl_xor(st.l, 32), inv1 = lt1 > 0.f ? RCPF(lt1) : 0.f;
            tp_start(lds, tid, kb, vb, nt_n, tp);
            for (int t = 0; t < nt_n; ++t) { imp_tile(lds, t % 3, qf, mb, inv1, nlim - 64 * t - 4 * hi, i0, i1, t, c, hi); tp_advance(lds, tid, kb, vb, t, nt_n, tp); }
        }
    }
    unsigned long long selmask;
    {
        const float lt = st.l + __shfl_xor(st.l, 32), inv = lt > 0.f ? RCPF(lt) : 0.f, gate = sigmoidf_(gr0) * inv;
        LDSQ float* impw = (LDSQ float*)(lds + NSA_IMP) + w * 512;
#pragma unroll
        for (int r = 0; r < 16; ++r) { combl[r * 64] = gate * st.o0[r]; combl[(16 + r) * 64] = gate * st.o1[r];
            float v0 = i0[r], v1 = i1[r];
            v0 += __shfl_xor(v0, 1); v0 += __shfl_xor(v0, 2); v1 += __shfl_xor(v1, 1); v1 += __shfl_xor(v1, 2);
            if ((c & 3) == 0) { const int j = (r & 3) + 8 * (r >> 2) + 4 * hi; impw[(c >> 2) * 64 + j] = v0; impw[(c >> 2) * 64 + 32 + j] = v1; } }
        __syncthreads();
        LDSQ unsigned long long* maskw = (LDSQ unsigned long long*)(lds + NSA_MASK) + w * 8;
#pragma unroll 1
        for (int q = 0; q < 8; ++q) {
            const int j = lane; const bool forced = (j == 0) || (j == qt) || (j == qt - 1), valid = j <= qt;
            const unsigned key = forced ? 0xFFFFFFFFu : (valid ? __builtin_bit_cast(unsigned, impw[q * 64 + j]) + 1u : 0u);
            unsigned thr = 0u;
#pragma unroll 4
            for (int bit = 31; bit >= 0; --bit) { const unsigned cand = thr | (1u << bit); if (__builtin_popcountll(__ballot(key >= cand)) >= 16) thr = cand; }
            const unsigned long long mgt = __ballot(key > thr), meq = __ballot(key == thr), below = (lane == 0) ? 0ull : (~0ull >> (64 - lane));
            const int need = 16 - __builtin_popcountll(mgt);
            const bool pick = key > thr || (key == thr && __builtin_popcountll(meq & below) < need);
            const unsigned long long mk = __ballot(pick);
            if (lane == 0) maskw[q] = mk;
        }
        __syncthreads();
        selmask = maskw[c >> 2];
    }
#pragma unroll
    for (int ks = 0; ks < 4; ++ks) qf[ks] = qfr[ks];
    attn_init(st);
    {
        const bf16_t* kb = wsb(p, WB_KSB) + bg * SEQ * 64; const bf16_t* vb = wsb(p, WB_VST) + bg * NQT * 4096;
        const int nt_n = qt + 1; const float mb = score_bound(qf, p.k_norm_g + (L * 3 + 1) * 64, lane);
        BranchCtx bx; bx.qt = qt; bx.pos = pos; bx.hi = hi; bx.nlim = 0; bx.nlim_min = 0; bx.kb0 = 0; bx.selmask = selmask;
        nsa_branch<1>(lds, tid, kb, vb, nt_n, 0, qt, qf, mb, st, tp, bx, c, hi);
        const float lt = st.l + __shfl_xor(st.l, 32), inv = lt > 0.f ? RCPF(lt) : 0.f, gate = sigmoidf_(gr1) * inv;
#pragma unroll
        for (int r = 0; r < 16; ++r) { combl[r * 64] += gate * st.o0[r]; combl[(16 + r) * 64] += gate * st.o1[r]; }
    }
    attn_init(st);
    {
        const bf16_t* kb = wsb(p, WB_KWB) + bg * SEQ * 64; const bf16_t* vb = wsb(p, WB_VWT) + bg * NQT * 4096;
        const int kb0 = qt - 8 > 0 ? qt - 8 : 0, nt_n = qt - kb0 + 1;
        const float mb = score_bound(qf, p.k_norm_g + (L * 3 + 2) * 64, lane);
        const bf16_t* kb2 = kb + (size_t)kb0 * 4096; const bf16_t* vb2 = vb + (size_t)kb0 * 4096;
        BranchCtx bx; bx.qt = qt; bx.pos = pos; bx.hi = hi; bx.nlim = 0; bx.nlim_min = 0; bx.kb0 = kb0; bx.selmask = 0ull;
        nsa_branch<2>(lds, tid, kb2, vb2, nt_n, qt >= 8 ? 1 : 0, nt_n - 1, qf, mb, st, tp, bx, c, hi);
        const float lt = st.l + __shfl_xor(st.l, 32), inv = lt > 0.f ? RCPF(lt) : 0.f, gate = sigmoidf_(gr2) * inv;
#pragma unroll
        for (int r = 0; r < 16; ++r) { st.o0[r] = combl[r * 64] + gate * st.o0[r]; st.o1[r] = combl[(16 + r) * 64] + gate * st.o1[r]; }
    }
    const NsaIdx xo = nsa_idx(lds, b, g, qt); const int hi2 = xo.hi;
    bf16_t* mo = mixb(p) + (size_t)xo.row * D + 256 + xo.head * 64; const URow nz = urow(p, xo.row) + (C_NZ + xo.head * 64);
#pragma unroll
    for (int q4 = 0; q4 < 4; ++q4) { const int d0 = 8 * q4 + 4 * hi2;
        const bf16x4 z0 = *(const bf16x4*)(nz.q + d0), z1 = *(const bf16x4*)(nz.q + 32 + d0); bf16x4 r0, r1;
#pragma unroll
        for (int e = 0; e < 4; ++e) { r0[e] = (short)f2bf(st.o0[4 * q4 + e] * siluf(bf2f((bf16_t)z0[e]))); r1[e] = (short)f2bf(st.o1[4 * q4 + e] * siluf(bf2f((bf16_t)z1[e]))); }
        *(bf16x4*)(mo + d0) = r0; *(bf16x4*)(mo + 32 + d0) = r1; }
}
HD void bphase_nsa_prompt(const P& p, int L, ldsp_t lds) {
    constexpr int NPAIR = BATCH * 2 * (NQT / 2);
    for (int pi0 = blockIdx.x; pi0 < NPAIR; pi0 += gridDim.x) {
        const int G = (int)gridDim.x, pi = (G % 8 == 0 && NPAIR % G == 0) ? ((pi0 % G) % 8) * (G / 8) + (pi0 % G) / 8 + (pi0 / G) * G : pi0;
        const int bgi = pi / (NQT / 2), q = pi % (NQT / 2);
        nsa_unit(p, L, lds, bgi >> 1, bgi & 1, NQT - 1 - q);
        nsa_unit(p, L, lds, bgi >> 1, bgi & 1, q);
    }
}

#ifdef CPU_EMU
#define WAVE_SYNC() emu_wave_sync()
#else
#define WAVE_SYNC() do { __builtin_amdgcn_fence(__ATOMIC_ACQ_REL, "wavefront"); __builtin_amdgcn_wave_barrier(); } while (0)
#endif
constexpr int GL_Q = 0, GL_K = 5120, GL_V = 10240, GL_WAVE = 19456;
HD int sw64(int row, int chunk) { return row * 80 + (chunk << 4); }
HD int sw128(int row, int chunk) { return row * 144 + (chunk << 4); }
HD int swv(int row, int q) { return row * 136 + (q << 3); }
static_assert(GL_V + 64 * 136 <= GL_WAVE && 64 * 144 <= GL_V, "per-wave LDS map");
HD float* gs_loc(const P& p, int b, int h, int c) { return p.ws + W_GSLOC + (((size_t)b * 4 + h) * NQT + c) * 2048; }
HD float* gs_bl(const P& p, int b, int h, int c) { return p.ws + W_GSBL + (((size_t)b * 4 + h) * NQT + c) * 32; }
template <class Src> HD void stage_vt_load(Src vsrc  , size_t row_stride, int lane, float (&tmp)[64]) {
#pragma unroll
    for (int j = 0; j < 64; ++j) tmp[j] = vsrc[(size_t)j * row_stride + lane];
}
HD void stage_vt_store(ldsp_t lw, int lane, const float (&tmp)[64]) {
#pragma unroll
    for (int j = 0; j < 64; ++j) *(LDSQ bf16_t*)(lw + GL_V + swv(lane, j >> 2) + (j & 3) * 2) = f2bf(tmp[j]);
    SCHED_FENCE();
}
HD bf16x8 ld_vt_frag(ldsp_t lw, int e, int q) {
    const bf16x4 a = *(const LDSQ bf16x4*)(lw + GL_V + swv(e, q)), b = *(const LDSQ bf16x4*)(lw + GL_V + swv(e, q + 2)); bf16x8 v;
    for (int j = 0; j < 4; ++j) { v[j] = a[j]; v[4 + j] = b[j]; } return v;
}
HD bf16x8 ld_vt_nat(ldsp_t lw, int e, int q) {
    const bf16x4 a = *(const LDSQ bf16x4*)(lw + GL_V + swv(e, q)), b = *(const LDSQ bf16x4*)(lw + GL_V + swv(e, q + 1)); bf16x8 v;
    for (int j = 0; j < 4; ++j) { v[j] = a[j]; v[4 + j] = b[j]; } return v;
}
HD void gla_cumsum(const P& p, int row0, int h, int lane, float (&bc)[32], float& tot0, float& blast) {
    const int dk = lane & 31, half = lane >> 5; const float* la = p.ws + W_LOGA + (size_t)(row0 + half * 32) * 128 + h * 32 + dk; float run = 0.f;
#pragma unroll
    for (int i = 0; i < 32; ++i) { run += la[(size_t)i * 128]; bc[i] = run; }
    tot0 = __shfl(run, dk); const float tot1 = __shfl(run, 32 + dk); blast = tot0 + tot1;
    if (half) {
#pragma unroll
        for (int i = 0; i < 32; ++i) bc[i] += tot0; }
}
HD void gla_g1_unit(const P& p, int L, ldsp_t lw, int b, int h, int c, int lane_) {
    const int lane = opaque_i(lane_);
    const int row0 = b * SEQ + c * 64, dk = lane & 31, half = lane >> 5, hi = half;
    WAVE_SYNC();
    float bc[32], tot0, blast; gla_cumsum(p, row0, h, lane, bc, tot0, blast);
    float vtmp[64]; stage_vt_load(urow(p, row0) + (C_GV + h * 64), U_LD, lane, vtmp);
    const URow ku = urow(p, row0 + half * 32) + (C_GK + h * 32 + dk);
#pragma unroll
    for (int i = 0; i < 32; ++i) { const int j = half * 32 + i;
        *(LDSQ bf16_t*)(lw + GL_Q + sw128(dk, j >> 3) + (j & 7) * 2) = f2bf(ku[(size_t)i * U_LD] * EXPF(blast - bc[i])); }
    stage_vt_store(lw, lane, vtmp);
    if (lane < 32) gs_bl(p, b, h, c)[lane] = blast;
    WAVE_SYNC();
    f32x16 a0, a1;
    for (int r = 0; r < 16; ++r) { a0[r] = 0.f; a1[r] = 0.f; }
#pragma unroll
    for (int ks = 0; ks < 4; ++ks) {
        const bf16x8 kf = *(const LDSQ bf16x8*)(lw + GL_Q + sw128(dk, 2 * ks + hi));
        a0 = __builtin_amdgcn_mfma_f32_32x32x16_bf16(ld_vt_nat(lw, dk, 4 * ks + 2 * hi), kf, a0, 0, 0, 0);
        a1 = __builtin_amdgcn_mfma_f32_32x32x16_bf16(ld_vt_nat(lw, 32 + dk, 4 * ks + 2 * hi), kf, a1, 0, 0, 0);
    }
    float* so = gs_loc(p, b, h, c);
#pragma unroll
    for (int r = 0; r < 16; ++r) { const int e = (r & 3) + 8 * (r >> 2) + 4 * hi; so[e * 32 + dk] = a0[r]; so[(32 + e) * 32 + dk] = a1[r]; }
}
HD void k_gla_scan(const P& p, int L, long it) {
    const int d = (int)(it % 32), e = (int)((it / 32) % 64), h = (int)((it / 2048) % 4), b = (int)(it / 8192); float S = 0.f;
    for (int c0 = 0; c0 < NQT; c0 += 16) { float loc[16], al[16];
#pragma unroll
        for (int k = 0; k < 16; ++k) { const int c = c0 + k < NQT ? c0 + k : NQT - 1; loc[k] = gs_loc(p, b, h, c)[e * 32 + d]; al[k] = gs_bl(p, b, h, c)[d]; }
#pragma unroll
        for (int k = 0; k < 16; ++k) if (c0 + k < NQT) { const float prev = S; S = EXPF(al[k]) * S + loc[k]; loc[k] = prev; }
#pragma unroll
        for (int k = 0; k < 16; ++k) if (c0 + k < NQT) gs_loc(p, b, h, c0 + k)[e * 32 + d] = loc[k]; }
    p.out[O_PGLA + (((size_t)L * BATCH + b) * 4 + h) * 2048 + d * 64 + e] = S;
}
HD void gla_g2_unit(const P& p, int L, ldsp_t lw, int b, int h, int c, int lane_) {
    const int lane = opaque_i(lane_);
    const int row0 = b * SEQ + c * 64, dk = lane & 31, half = lane >> 5, hi = half, cl = lane & 31;
    WAVE_SYNC();
    float bc[32], tot0, blast; gla_cumsum(p, row0, h, lane, bc, tot0, blast);
    float svr[2][2][8];
    { const float* ss = gs_loc(p, b, h, c);
#pragma unroll
      for (int et = 0; et < 2; ++et)
#pragma unroll
        for (int ks = 0; ks < 2; ++ks) ld8f(ss + (32 * et + cl) * 32 + 16 * ks + 8 * hi, svr[et][ks]); }
    float vtmp[64]; stage_vt_load(urow(p, row0) + (C_GV + h * 64), U_LD, lane, vtmp);
    const URow qu = urow(p, row0 + half * 32) + (C_GQ + h * 32 + dk); const URow ku = qu + (C_GK - C_GQ);
#pragma unroll
    for (int i = 0; i < 32; ++i) { const int j = half * 32 + i; const float dl = bc[i] - tot0;
        *(LDSQ bf16_t*)(lw + GL_Q + sw64(j, dk >> 3) + (dk & 7) * 2) = f2bf(qu[(size_t)i * U_LD] * 0.17677669529663687f * EXPF(dl));
        *(LDSQ bf16_t*)(lw + GL_K + sw64(j, dk >> 3) + (dk & 7) * 2) = f2bf(ku[(size_t)i * U_LD] * EXPF(-dl)); }
    stage_vt_store(lw, lane, vtmp);
    WAVE_SYNC();
    bf16x8 sf[2][2];
    {
#pragma unroll
      for (int et = 0; et < 2; ++et)
#pragma unroll
        for (int ks = 0; ks < 2; ++ks)
            {
#pragma unroll
              for (int jj = 0; jj < 8; ++jj) { const int d = 16 * ks + 8 * hi + jj; const float br = __shfl(tot0, d); sf[et][ks][jj] = (short)f2bf(svr[et][ks][jj] * EXPF(br)); } } }
    const URow gz = urow(p, row0) + (C_GZ + h * 64); const float* ng = p.gla_norm_g + L * 64;
#pragma unroll
    for (int it = 0; it < 2; ++it) {
        const int i = 32 * it + cl;
        bf16x8 qf[2];
        qf[0] = *(const LDSQ bf16x8*)(lw + GL_Q + sw64(i, hi)); qf[1] = *(const LDSQ bf16x8*)(lw + GL_Q + sw64(i, 2 + hi));
        f32x16 o0, o1;
        for (int r = 0; r < 16; ++r) { o0[r] = 0.f; o1[r] = 0.f; }
#pragma unroll
        for (int ks = 0; ks < 2; ++ks) { o0 = __builtin_amdgcn_mfma_f32_32x32x16_bf16(sf[0][ks], qf[ks], o0, 0, 0, 0); o1 = __builtin_amdgcn_mfma_f32_32x32x16_bf16(sf[1][ks], qf[ks], o1, 0, 0, 0); }
#pragma unroll
        for (int jt = 0; jt <= it; ++jt) {
            f32x16 at;
            for (int r = 0; r < 16; ++r) at[r] = 0.f;
#pragma unroll
            for (int ks = 0; ks < 2; ++ks) at = __builtin_amdgcn_mfma_f32_32x32x16_bf16(*(const LDSQ bf16x8*)(lw + GL_K + sw64(32 * jt + cl, 2 * ks + hi)), qf[ks], at, 0, 0, 0);
            bf16x8 pf[2];
#pragma unroll
            for (int r = 0; r < 16; ++r) { const int jl = (r & 3) + 8 * (r >> 2) + 4 * hi; const float v = (jt < it || jl <= cl) ? at[r] : 0.f; pf[r >> 3][r & 7] = (short)f2bf(v); }
#pragma unroll
            for (int s = 0; s < 2; ++s) { const int q = 8 * jt + 4 * s + hi;
                o0 = __builtin_amdgcn_mfma_f32_32x32x16_bf16(ld_vt_frag(lw, cl, q), pf[s], o0, 0, 0, 0);
                o1 = __builtin_amdgcn_mfma_f32_32x32x16_bf16(ld_vt_frag(lw, 32 + cl, q), pf[s], o1, 0, 0, 0); }
        }
        float ss = 0.f;
#pragma unroll
        for (int r = 0; r < 16; ++r) ss += o0[r] * o0[r] + o1[r] * o1[r];
        ss += __shfl_xor(ss, 32);
        const float rs = RSQRTF(ss * (1.0f / 64) + 1e-6f);
        bf16_t* mo = mixb(p) + (size_t)(row0 + i) * D + h * 64; const URow gzr = gz + (size_t)i * U_LD;
#pragma unroll
        for (int q4 = 0; q4 < 4; ++q4) { const int e0 = 8 * q4 + 4 * hi;
            const bf16x4 z0 = *(const bf16x4*)(gzr.q + e0), z1 = *(const bf16x4*)(gzr.q + 32 + e0); const f32x4 g0 = *(const f32x4*)(ng + e0), g1 = *(const f32x4*)(ng + 32 + e0); bf16x4 r0, r1;
#pragma unroll
            for (int k = 0; k < 4; ++k) { r0[k] = (short)f2bf(o0[4 * q4 + k] * rs * g0[k] * siluf(bf2f((bf16_t)z0[k]))); r1[k] = (short)f2bf(o1[4 * q4 + k] * rs * g1[k] * siluf(bf2f((bf16_t)z1[k]))); }
            *(bf16x4*)(mo + e0) = r0; *(bf16x4*)(mo + 32 + e0) = r1; }
    }
}
constexpr int LDS_WX = LDS_MISC + 1024;
HD float* ml_cloc(const P& p, int b, int h, int c) { return p.ws + W_MCLOC + (((size_t)b * 4 + h) * NQT + c) * 4160; }
HD float* ml_fg(const P& p, int b, int h, int c) { return p.ws + W_MFG + (((size_t)b * 4 + h) * NQT + c) * 4; }
HD float wave_max(float v) { for (int o = 1; o < 64; o <<= 1) v = fmaxf(v, __shfl_xor(v, o)); return v; }
HD void ml_gates(const P& p, int L, int row0, int h, int lane, float& ii, float& fcum) {
    const URow u = urow(p, row0 + lane) + C_MIF;
    ii = u[h] + p.gate_b[(L * 2 + 0) * 4 + h]; float f = log_sigmoidf(u[4 + h] + p.gate_b[(L * 2 + 1) * 4 + h]);
    for (int o = 1; o < 64; o <<= 1) { const float t = __shfl(f, lane - o >= 0 ? lane - o : lane); if (lane >= o) f += t; }
    fcum = f;
}
HD void ml_g1_unit(const P& p, int L, ldsp_t lw, int b, int h, int c, int lane_) {
    const int lane = opaque_i(lane_);
    const int row0 = b * SEQ + c * 64, cl = lane & 31, hi = lane >> 5;
    WAVE_SYNC();
    float ii, fcum; ml_gates(p, L, row0, h, lane, ii, fcum);
    const float F = __shfl(fcum, 63), g = ii - fcum, G = F + wave_max(g), wj = EXPF(F + g - G);
    float nacc = 0.f;
    float vtmp[64]; stage_vt_load(urow(p, row0) + (C_MV + h * 64), U_LD, lane, vtmp);
    const float* ku = p.ws + W_MK + (size_t)row0 * 256 + h * 64 + lane;
#pragma unroll 32
    for (int j = 0; j < 64; ++j) { const float v = ku[(size_t)j * 256] * __shfl(wj, j); nacc += v; *(LDSQ bf16_t*)(lw + GL_Q + sw128(lane, j >> 3) + (j & 7) * 2) = f2bf(v); }
    stage_vt_store(lw, lane, vtmp);
    WAVE_SYNC();
    f32x16 a[2][2];
    for (int x = 0; x < 4; ++x) for (int r = 0; r < 16; ++r) a[x >> 1][x & 1][r] = 0.f;
#pragma unroll
    for (int ks = 0; ks < 4; ++ks) {
        const bf16x8 v0 = ld_vt_nat(lw, cl, 4 * ks + 2 * hi), v1 = ld_vt_nat(lw, 32 + cl, 4 * ks + 2 * hi);
#pragma unroll
        for (int dt = 0; dt < 2; ++dt) { const bf16x8 kf = *(const LDSQ bf16x8*)(lw + GL_Q + sw128(32 * dt + cl, 2 * ks + hi));
            a[0][dt] = __builtin_amdgcn_mfma_f32_32x32x16_bf16(v0, kf, a[0][dt], 0, 0, 0); a[1][dt] = __builtin_amdgcn_mfma_f32_32x32x16_bf16(v1, kf, a[1][dt], 0, 0, 0); }
    }
    float* so = ml_cloc(p, b, h, c);
#pragma unroll
    for (int et = 0; et < 2; ++et)
#pragma unroll
        for (int dt = 0; dt < 2; ++dt)
#pragma unroll
            for (int r = 0; r < 16; ++r) so[(32 * et + (r & 3) + 8 * (r >> 2) + 4 * hi) * 64 + 32 * dt + cl] = a[et][dt][r];
    so[64 * 64 + lane] = nacc;
    if (lane == 0) { float* fg = ml_fg(p, b, h, c); fg[0] = F; fg[1] = G; }
}
HD void k_ml_scan(const P& p, int L, long it) {
    const int d = (int)(it % 64), e = (int)((it / 64) % 65), h = (int)((it / 4160) % 4), b = (int)(it / 16640); float S = 0.f, ms = 0.f;
    for (int c0 = 0; c0 < NQT; c0 += 16) { float loc[16], Fv[16], Gv[16];
#pragma unroll
        for (int k = 0; k < 16; ++k) { const int c = c0 + k < NQT ? c0 + k : NQT - 1; loc[k] = ml_cloc(p, b, h, c)[e * 64 + d]; const float* fg = ml_fg(p, b, h, c); Fv[k] = fg[0]; Gv[k] = fg[1]; }
#pragma unroll
        for (int k = 0; k < 16; ++k) if (c0 + k < NQT) { const float mn = fmaxf(Fv[k] + ms, Gv[k]), prev = S; S = EXPF(Fv[k] + ms - mn) * S + EXPF(Gv[k] - mn) * loc[k]; loc[k] = prev; Fv[k] = ms; ms = mn; }
#pragma unroll
        for (int k = 0; k < 16; ++k) if (c0 + k < NQT) { ml_cloc(p, b, h, c0 + k)[e * 64 + d] = loc[k]; if (e == 64 && d == 0) ml_fg(p, b, h, c0 + k)[2] = Fv[k]; } }
    const size_t sb = ((size_t)L * BATCH + b) * 4 + h;
    if (e < 64) p.out[O_PC + (sb * 64 + e) * 64 + d] = S; else { p.out[O_PN + sb * 64 + d] = S; if (d == 0) p.out[O_PM + sb] = ms; }
}
HD void ml_g2_unit(const P& p, int L, ldsp_t lw, LDSQ float* gx, int b, int h, int c, int lane_) {
    const int lane = opaque_i(lane_);
    const int row0 = b * SEQ + c * 64, cl = lane & 31, hi = lane >> 5;
    WAVE_SYNC();
    float ii, fcum; ml_gates(p, L, row0, h, lane, ii, fcum);
    const float ms = ml_fg(p, b, h, c)[2], g = ii - fcum;
    float M = fmaxf(g, ms);
    for (int o = 1; o < 64; o <<= 1) { const float t = __shfl(M, lane - o >= 0 ? lane - o : lane); if (lane >= o) M = fmaxf(M, t); }
    gx[lane] = g;
    { float vtmp[64]; stage_vt_load(urow(p, row0) + (C_MV + h * 64), U_LD, lane, vtmp);
      const float* ku = p.ws + W_MK + (size_t)row0 * 256 + h * 64 + lane;
#pragma unroll 32
      for (int j = 0; j < 64; ++j) *(LDSQ bf16_t*)(lw + GL_Q + sw128(j, lane >> 3) + (lane & 7) * 2) = f2bf(ku[(size_t)j * 256]);
      SCHED_FENCE();
      stage_vt_store(lw, lane, vtmp); }
    WAVE_SYNC();
    const float* cs = ml_cloc(p, b, h, c);
    const float* ng = p.ml_norm_g + L * 64;
#pragma unroll 1
    for (int it = 0; it < 2; ++it) {
        const int i = 32 * it + cl; const float Mi = __shfl(M, i), fi = __shfl(fcum, i), wint = EXPF(ms - Mi);
        const float* qr = p.ws + W_MQ + (size_t)(row0 + i) * 256 + h * 64;
        bf16x8 qf[4]; float nq = 0.f; float ca[4][8], cb[4][8];
#pragma unroll
        for (int ks = 0; ks < 4; ++ks) { ld8f(cs + cl * 64 + 16 * ks + 8 * hi, ca[ks]); ld8f(cs + (32 + cl) * 64 + 16 * ks + 8 * hi, cb[ks]); }
#pragma unroll
        for (int ks = 0; ks < 4; ++ks) { float qv8[8], nv8[8]; ld8f(qr + 16 * ks + 8 * hi, qv8); ld8f(cs + 64 * 64 + 16 * ks + 8 * hi, nv8);
#pragma unroll
            for (int jj = 0; jj < 8; ++jj) { qf[ks][jj] = (short)f2bf(qv8[jj]); nq += qv8[jj] * nv8[jj]; } }
        nq += __shfl_xor(nq, 32);
        f32x16 o0, o1;
        for (int r = 0; r < 16; ++r) { o0[r] = 0.f; o1[r] = 0.f; }
#pragma unroll
        for (int ks = 0; ks < 4; ++ks) { bf16x8 c0, c1;
#pragma unroll
            for (int jj = 0; jj < 8; ++jj) { c0[jj] = (short)f2bf(ca[ks][jj]); c1[jj] = (short)f2bf(cb[ks][jj]); }
            o0 = __builtin_amdgcn_mfma_f32_32x32x16_bf16(c0, qf[ks], o0, 0, 0, 0); o1 = __builtin_amdgcn_mfma_f32_32x32x16_bf16(c1, qf[ks], o1, 0, 0, 0); }
        bf16_t* mo = mixb(p) + (size_t)(row0 + i) * D + 768 + h * 64; const URow ur = urow(p, row0 + i);
        bf16x4 ga0[4], ga1[4], gz0[4], gz1[4];
#pragma unroll
        for (int q4 = 0; q4 < 4; ++q4) { const int e0 = 8 * q4 + 4 * hi; const bf16_t* uo = ur.q + C_MO + h * 64 + e0; const bf16_t* uz = ur.q + C_MZ + h * 64 + e0;
            ga0[q4] = *(const bf16x4*)uo; ga1[q4] = *(const bf16x4*)(uo + 32); gz0[q4] = *(const bf16x4*)uz; gz1[q4] = *(const bf16x4*)(uz + 32); }
        SCHED_FENCE();
#pragma unroll
        for (int r = 0; r < 16; ++r) { o0[r] *= wint; o1[r] *= wint; }
        float dsum = 0.f;
#pragma unroll 1
        for (int jt = 0; jt <= it; ++jt) {
            f32x16 st;
            for (int r = 0; r < 16; ++r) st[r] = 0.f;
#pragma unroll
            for (int ks = 0; ks < 4; ++ks) st = __builtin_amdgcn_mfma_f32_32x32x16_bf16(*(const LDSQ bf16x8*)(lw + GL_Q + sw128(32 * jt + cl, 2 * ks + hi)), qf[ks], st, 0, 0, 0);
            bf16x8 pf[2];
#pragma unroll
            for (int r = 0; r < 16; ++r) { const int jl = (r & 3) + 8 * (r >> 2) + 4 * hi;
                const float v = (jt < it || jl <= cl) ? st[r] * EXPF(gx[32 * jt + jl] - Mi) : 0.f; dsum += v; pf[r >> 3][r & 7] = (short)f2bf(v); }
#pragma unroll
            for (int s = 0; s < 2; ++s) { const int q = 8 * jt + 4 * s + hi;
                o0 = __builtin_amdgcn_mfma_f32_32x32x16_bf16(ld_vt_frag(lw, cl, q), pf[s], o0, 0, 0, 0);
                o1 = __builtin_amdgcn_mfma_f32_32x32x16_bf16(ld_vt_frag(lw, 32 + cl, q), pf[s], o1, 0, 0, 0); }
        }
        dsum += __shfl_xor(dsum, 32);
        const float den = wint * nq + dsum, hinv = RCPF(fmaxf(fabsf(den), EXPF(-(fi + Mi))));
        float ss = 0.f;
#pragma unroll
        for (int r = 0; r < 16; ++r) { o0[r] *= hinv; o1[r] *= hinv; ss += o0[r] * o0[r] + o1[r] * o1[r]; }
        ss += __shfl_xor(ss, 32);
        const float rs = RSQRTF(ss * (1.0f / 64) + 1e-6f);
#pragma unroll
        for (int q4 = 0; q4 < 4; ++q4) { const int e0 = 8 * q4 + 4 * hi;
            const bf16x4 a0 = ga0[q4], a1 = ga1[q4], z0 = gz0[q4], z1 = gz1[q4]; const f32x4 g0 = *(const f32x4*)(ng + e0), g1 = *(const f32x4*)(ng + 32 + e0); bf16x4 r0, r1;
#pragma unroll
            for (int k = 0; k < 4; ++k) { r0[k] = (short)f2bf(o0[4 * q4 + k] * rs * g0[k] * sigmoidf_(bf2f((bf16_t)a0[k])) * siluf(bf2f((bf16_t)z0[k])));
                r1[k] = (short)f2bf(o1[4 * q4 + k] * rs * g1[k] * sigmoidf_(bf2f((bf16_t)a1[k])) * siluf(bf2f((bf16_t)z1[k]))); }
            *(bf16x4*)(mo + e0) = r0; *(bf16x4*)(mo + 32 + e0) = r1; }
    }
}
HD void bphase_rec_g1(const P& p, int L, ldsp_t lds) {
    const int w = RFL(opaque_tid() >> 6); const ldsp_t lw = lds + w * GL_WAVE; constexpr int NU = BATCH * 4 * NQT;
#define lane (opaque_tid() & 63)
    for (int u2 = blockIdx.x * 8 + w; u2 < 2 * NU; u2 += gridDim.x * 8) { const int u = u2 % NU;
        if (u2 < NU) gla_g1_unit(p, L, lw, u / (4 * NQT), (u / NQT) % 4, u % NQT, lane); else ml_g1_unit(p, L, lw, u / (4 * NQT), (u / NQT) % 4, u % NQT, lane); }
#undef lane
}
HD void bphase_rec_g2(const P& p, int L, ldsp_t lds) {
    const int w = RFL(opaque_tid() >> 6); const ldsp_t lw = lds + w * GL_WAVE; LDSQ float* gx = (LDSQ float*)(lds + LDS_WX + w * 256); constexpr int NU = BATCH * 4 * NQT;
#define lane (opaque_tid() & 63)
    for (int u2 = blockIdx.x * 8 + w; u2 < 2 * NU; u2 += gridDim.x * 8) { const int u = u2 % NU;
        if (u2 < NU) gla_g2_unit(p, L, lw, u / (4 * NQT), (u / NQT) % 4, u % NQT, lane); else ml_g2_unit(p, L, lw, gx, u / (4 * NQT), (u / NQT) % 4, u % NQT, lane); }
#undef lane
}

constexpr int CS_STRIDE = 528, CS_BUF = 33 * CS_STRIDE, CS_GROUP = 2 * CS_BUF;
static_assert(2 * CS_GROUP + 32 * 256 * 4 <= LDS_MISC, "summary staging + partial-sum exchange fit the scratch region");
HD bf16_t* wctp(const P& p, int L, int kv) { return (bf16_t*)((char*)p.ws + WB_WCT) + ((size_t)(L * 2 + kv)) * 64 * 2048; }
HD void k_prep_wc(const P& p, int L, long it) {
    const int lane = (int)(it % 64), et = (int)((it / 64) % 2), ks = (int)((it / 128) % 4), hs = (int)((it / 512) % 2), r = (int)((it / 1024) % 16), kv = (int)((it / 16384) % 2), L2 = (int)(it / 32768);
    bf16_t* o = wctp(p, L2, kv) + (size_t)(it % 16384) * 8; const int e = 32 * et + (lane & 31), s = 16 * hs + r, d0 = 16 * ks + 8 * (lane >> 5);
    const float* w = p.cmp_w + (((size_t)(L2 * 2 + kv) * 32 + s) * 64 + d0) * 64 + e;
    for (int j = 0; j < 8; ++j) o[j] = f2bf(w[(size_t)j * 64]);
}
HD void k_cmp_pad(const P& p, int L, long it) {
    const int g = (int)(it % 2); const long q = it / 2; const int j = (int)(q % NCPAD), s = (int)(q / NCPAD);
    if (j < seq_ncmp(s)) return;
    bf16_t* kb = wsb(p, WB_KCB) + (((size_t)s * 2 + g) * NCPAD + j) * 64; bf16_t* vt = wsb(p, WB_VCT) + (((size_t)s * 2 + g) * (NCPAD / 64) + j / 64) * 4096 + (j % 64);
    for (int d = 0; d < 64; ++d) { kb[d] = 0; vt[(size_t)d * 64] = 0; }
}
HD void cs_stage_load(const float* const (&bp)[9], int r, f32x4 (&rg)[9]) {
#pragma unroll
    for (int q = 0; q < 9; ++q) { f32x4 v = {0.f, 0.f, 0.f, 0.f}; if (bp[q]) v = *(const f32x4*)(bp[q] + (size_t)r * 512); rg[q] = v; }
}
HD void cs_stage_store(ldsp_t lg, int buf, int tl, const f32x4 (&rg)[9]) {
#pragma unroll
    for (int q = 0; q < 9; ++q) { const int i = tl + q * 256; const int jj = i >> 6, c4 = i & 63;
        if (i < 33 * 64) { bf16x4 o; for (int e = 0; e < 4; ++e) o[e] = (short)f2bf(rg[q][e]); *(LDSQ bf16x4*)(lg + buf * CS_BUF + jj * CS_STRIDE + c4 * 8) = o; } }
}
template <int WHICH  > HD void bphase_cmp_sum_t(const P& p, int L, ldsp_t lds) {
    const int tid = opaque_tid(), lane = tid & 63, w = tid >> 6, grp = w >> 2, kv = (w >> 1) & 1, g = w & 1, tl = tid & 255, cl = lane & 31, hi = lane >> 5;
    constexpr int TP = (SEQ / 16 + 31) / 32, TS = ((PAST_LEN + DEC_SEQ) / 16 + 31) / 32, U0 = WHICH ? BATCH * TP : 0, NUNIT = WHICH ? DEC_BATCH * TS : BATCH * TP;
    constexpr bool SPLIT = (WHICH == 0);
    constexpr int NITER = SPLIT ? NUNIT : (NUNIT + 1) / 2, NSTEP = SPLIT ? 8 : 16;
    const ldsp_t lg = lds + grp * CS_GROUP;
    for (int itx = blockIdx.x; itx < NITER; itx += gridDim.x) {
        const int un = SPLIT ? U0 + itx : U0 + 2 * itx + grp; const bool live = SPLIT ? true : (2 * itx + grp < NUNIT); const int r0 = SPLIT ? 8 * grp : 0;
        int s = 0, t = 0;
        if (live) { if (un < BATCH * TP) { s = un / TP; t = un % TP; } else { s = BATCH + (un - BATCH * TP) / TS; t = (un - BATCH * TP) % TS; } }
        const int nhalf = live ? (s < BATCH ? SEQ / 16 : (PAST_LEN + DEC_SEQ) / 16) : 0, j0 = 32 * t;
        f32x4 rg[9]; f32x16 a0, a1; const float* bp[9];
        for (int r = 0; r < 16; ++r) { a0[r] = 0.f; a1[r] = 0.f; }
#pragma unroll
        for (int q = 0; q < 9; ++q) { const int i = tl + q * 256, jj = i >> 6, c4 = i & 63; bp[q] = (i < 33 * 64 && j0 + jj < nhalf) ? hist(p, L, s, 16 * (j0 + jj), 0, 0) + c4 * 4 : nullptr; }
        cs_stage_load(bp, r0, rg); cs_stage_store(lg, 0, tl, rg); cs_stage_load(bp, r0 + 1, rg); LDS_BARRIER();
        const bf16_t* wt = wctp(p, L, kv) + (size_t)lane * 8;
#define CS_WLOADH(R, HS, WF) { _Pragma("unroll") for (int ks = 0; ks < 4; ++ks) { const bf16_t* wp = wt + ((((R) * 2 + (HS)) * 4 + ks) * 2) * 512; \
            WF[ks][0] = *(const bf16x8*)wp; WF[ks][1] = *(const bf16x8*)(wp + 512); } }
#define CS_COMPUTEH(BUF, HS, WF) { const ldsp_t xb = lg + (BUF) * CS_BUF + cl * CS_STRIDE + (kv * 2 + g) * 128 + hi * 16; \
            _Pragma("unroll") for (int ks = 0; ks < 4; ++ks) { const bf16x8 xf = *(const LDSQ bf16x8*)(xb + (HS) * CS_STRIDE + ks * 32); \
                a0 = __builtin_amdgcn_mfma_f32_32x32x16_bf16(WF[ks][0], xf, a0, 0, 0, 0); \
                a1 = __builtin_amdgcn_mfma_f32_32x32x16_bf16(WF[ks][1], xf, a1, 0, 0, 0); } }
        bf16x8 wfa[4][2], wfb[4][2];
        CS_WLOADH(r0, 0, wfa) CS_WLOADH(r0, 1, wfb)
#pragma unroll 1
        for (int rr = 0; rr < NSTEP; ++rr) {
            const int r = r0 + rr;
            CS_COMPUTEH(rr & 1, 0, wfa)
            if (rr + 1 < NSTEP) CS_WLOADH(r + 1, 0, wfa)
            SCHED_FENCE();
            CS_COMPUTEH(rr & 1, 1, wfb)
            if (rr + 1 < NSTEP) CS_WLOADH(r + 1, 1, wfb)
            SCHED_FENCE();
            if (rr + 1 < NSTEP) cs_stage_store(lg, (rr + 1) & 1, tl, rg);
            if (rr + 2 < NSTEP) cs_stage_load(bp, r + 2, rg);
            LDS_BARRIER();
        }
        if (SPLIT) {
            LDSQ float* xs = (LDSQ float*)(lds + 2 * CS_GROUP) + tl;
            if (grp == 1) {
#pragma unroll
                for (int r = 0; r < 16; ++r) { xs[r * 256] = a0[r]; xs[(16 + r) * 256] = a1[r]; } }
            __syncthreads();
            if (grp == 0) {
#pragma unroll
                for (int r = 0; r < 16; ++r) { a0[r] += xs[r * 256]; a1[r] += xs[(16 + r) * 256]; } }
            __syncthreads();
        }
#undef CS_WLOADH
#undef CS_COMPUTEH
        const int j = j0 + cl; const bool ok = live && j < seq_ncmp(s) && (!SPLIT || grp == 0);
        const float* bias = p.ws + W_CBIAS + L * 128 + kv * 64;
        float ss = 0.f;
#pragma unroll
        for (int r = 0; r < 16; ++r) { const int e = (r & 3) + 8 * (r >> 2) + 4 * hi; a0[r] += bias[e]; a1[r] += bias[32 + e]; ss += a0[r] * a0[r] + a1[r] * a1[r]; }
        ss += __shfl_xor(ss, 32);
        const float rs = kv == 0 ? RSQRTF(ss * (1.0f / 64) + 1e-6f) : 1.0f; const float* kg = p.k_norm_g + (L * 3 + 0) * 64;
        if (ok) {
            bf16_t* kb = wsb(p, WB_KCB) + (((size_t)s * 2 + g) * NCPAD + j) * 64; bf16_t* vt = wsb(p, WB_VCT) + (((size_t)s * 2 + g) * (NCPAD / 64) + j / 64) * 4096 + (j % 64);
#pragma unroll
            for (int r = 0; r < 16; ++r) { const int e = (r & 3) + 8 * (r >> 2) + 4 * hi;
                const float v0 = kv == 0 ? a0[r] * rs * kg[e] : a0[r], v1 = kv == 0 ? a1[r] * rs * kg[32 + e] : a1[r];
                if (kv == 0) { kb[e] = f2bf(v0); kb[32 + e] = f2bf(v1); } else { vt[(size_t)e * 64] = f2bf(v0); vt[(size_t)(32 + e) * 64] = f2bf(v1); } }
        }
    }
}

HD void bphase_cmp_sum_p(const P& p, int L, ldsp_t lds) { bphase_cmp_sum_t<0>(p, L, lds); }
HD void bphase_cmp_sum_s(const P& p, int L, ldsp_t lds) { bphase_cmp_sum_t<1>(p, L, lds); }
constexpr int SP_NCMP = 8, SP_NITEM = 40, SP_STRIDE = 68, SP_WIN0 = 8, SP_NWIN = 3, SP_SLC0 = 11, SP_NSLC = 28, SL_MAX = 4 * SP_NSLC;
constexpr int NJ = NSELS - 1;
static_assert(PAST_LEN % 64 == 0 && NJ <= 128 && NJ >= 16 && WKEEP_S % 64 == 0 && (WKEEP_S + DEC_SEQ + 63) / 64 <= 3 * SP_NWIN, "sample NSA geometry");
HD float* spart(const P& p, int b, int g, int item) { return p.ws + W_SPART + ((((size_t)b * 2 + g) * SP_NITEM + item) * 32) * SP_STRIDE; }
HD int* slist(const P& p, int b, int g) { return (int*)(p.ws + W_SLIST) + ((size_t)b * 2 + g) * 2 * SL_MAX; }
template <bool MASK>
HD void wattn_tile(ldsp_t lw, const bf16x8 (&qf)[4], int lim2, int lo2, bool sel, AttnSt& st, bf16x8 (&pf)[4], int c, int hi) {
    f32x16 s0, s1;
    for (int r = 0; r < 16; ++r) { s0[r] = 0.f; s1[r] = 0.f; }
#pragma unroll
    for (int ks = 0; ks < 4; ++ks) {
        s0 = __builtin_amdgcn_mfma_f32_32x32x16_bf16(*(const LDSQ bf16x8*)(lw + sw128(c, 2 * ks + hi)), qf[ks], s0, 0, 0, 0);
        s1 = __builtin_amdgcn_mfma_f32_32x32x16_bf16(*(const LDSQ bf16x8*)(lw + sw128(32 + c, 2 * ks + hi)), qf[ks], s1, 0, 0, 0);
    }
    float alpha;
    if (softmax_tile<MASK>(s0, s1, lim2, lo2, sel, st, pf, alpha)) {
#pragma unroll
        for (int r = 0; r < 16; ++r) { st.o0[r] *= alpha; st.o1[r] *= alpha; } }
#pragma unroll
    for (int ks = 0; ks < 4; ++ks) {
        st.o0 = __builtin_amdgcn_mfma_f32_32x32x16_bf16(ld_vt_frag(lw, c, 4 * ks + hi), pf[ks], st.o0, 0, 0, 0);
        st.o1 = __builtin_amdgcn_mfma_f32_32x32x16_bf16(ld_vt_frag(lw, 32 + c, 4 * ks + hi), pf[ks], st.o1, 0, 0, 0);
    }
}
HD void wattn_probs(ldsp_t lw, const bf16x8 (&qf)[4], int lim2, float m, float inv, bf16x8 (&pf)[4], int c, int hi) {
    f32x16 s0, s1;
    for (int r = 0; r < 16; ++r) { s0[r] = 0.f; s1[r] = 0.f; }
#pragma unroll
    for (int ks = 0; ks < 4; ++ks) {
        s0 = __builtin_amdgcn_mfma_f32_32x32x16_bf16(*(const LDSQ bf16x8*)(lw + sw128(c, 2 * ks + hi)), qf[ks], s0, 0, 0, 0);
        s1 = __builtin_amdgcn_mfma_f32_32x32x16_bf16(*(const LDSQ bf16x8*)(lw + sw128(32 + c, 2 * ks + hi)), qf[ks], s1, 0, 0, 0);
    }
#pragma unroll
    for (int r = 0; r < 16; ++r) { const int kc = (r & 3) + 8 * (r >> 2);
        s0[r] = kc <= lim2 ? EXP2F(s0[r] - m) * inv : 0.f; s1[r] = kc + 32 <= lim2 ? EXP2F(s1[r] - m) * inv : 0.f; }
#pragma unroll
    for (int j = 0; j < 8; ++j) { pf[0][j] = bfbits(s0[j]); pf[1][j] = bfbits(s0[8 + j]); pf[2][j] = bfbits(s1[j]); pf[3][j] = bfbits(s1[8 + j]); }
}
HD void wimp_tile(const bf16x8 (&pf)[4], f32x16& acc, int nt, int jt, int c, int hi) {
#pragma unroll
    for (int ks = 0; ks < 4; ++ks) { const int base = nt * 64 + 16 * ks + 4 * hi - 4 * (jt * 32 + c); bf16x8 af;
#pragma unroll
        for (int jj = 0; jj < 8; ++jj) { const int dl = base + 8 * (jj >> 2) + (jj & 3); af[jj] = (dl == -1 || dl == 3) ? (short)0x3F80 : ((dl >= 0 && dl <= 2) ? (short)0x4000 : (short)0); }
        acc = __builtin_amdgcn_mfma_f32_32x32x16_bf16(af, pf[ks], acc, 0, 0, 0); }
}
HD void wstage_f32(ldsp_t lw, const float* kbase, const float* vbase, size_t rs, int nvalid, int lane_) {
    const int lane = opaque_i(lane_);
#pragma unroll 4
    for (int i = 0; i < 16; ++i) { const int row = 4 * i + (lane >> 4), c4 = lane & 15; f32x4 kv = {0.f, 0.f, 0.f, 0.f}, vv = {0.f, 0.f, 0.f, 0.f};
        if (row < nvalid) { kv = *(const f32x4*)(kbase + (size_t)row * rs + c4 * 4); vv = *(const f32x4*)(vbase + (size_t)row * rs + c4 * 4); }
        bf16x4 kb; for (int e = 0; e < 4; ++e) kb[e] = (short)f2bf(kv[e]);
        *(LDSQ bf16x4*)(lw + sw128(row, c4 >> 1) + (c4 & 1) * 8) = kb;
#pragma unroll
        for (int e = 0; e < 4; ++e) *(LDSQ bf16_t*)(lw + GL_V + swv(4 * c4 + e, row >> 2) + (row & 3) * 2) = f2bf(vv[e]); }
}
HD void wstage_bf16(ldsp_t lw, const bf16_t* k, const bf16_t* vt, int lane_) {
    const int lane = opaque_i(lane_);
#pragma unroll
    for (int i = 0; i < 8; ++i) { const int id = i * 64 + lane; *(LDSQ bf16x8*)(lw + sw128(id >> 3, id & 7)) = *(const bf16x8*)(k + id * 8); }
#pragma unroll
    for (int i = 0; i < 16; ++i) { const int id = i * 64 + lane; *(LDSQ bf16x4*)(lw + GL_V + swv(id >> 4, id & 15)) = *(const bf16x4*)(vt + id * 4); }
}
HD void wpart_store(const P& p, int b, int g, int item, const AttnSt& st, int c, int hi) {
    float* o = spart(p, b, g, item) + c * SP_STRIDE; const float lt = st.l + __shfl_xor(st.l, 32);
    if (hi == 0) { o[0] = st.m; o[1] = lt; }
#pragma unroll
    for (int r = 0; r < 16; ++r) { const int d = (r & 3) + 8 * (r >> 2) + 4 * hi; o[4 + d] = st.o0[r]; o[4 + 32 + d] = st.o1[r]; }
}
HD void wload_q(const P& p, size_t wb, int b, int g, int c, int hi, bf16x8 (&qf)[4]) {
    const bf16_t* qp = wsb(p, wb) + (size_t)(NP + b * DEC_SEQ + (c >> 2)) * 512 + (g * 4 + (c & 3)) * 64 + hi * 8;
#pragma unroll
    for (int ks = 0; ks < 4; ++ks) qf[ks] = *(const bf16x8*)(qp + ks * 16);
}
static_assert(NCPADS / 64 <= SP_NCMP && SP_NCMP == 8, "one compressed tile per wave");
HD void snsa_cmp_unit(const P& p, int L, ldsp_t lds, int b, int g) {
    const int tid = opaque_tid(), lane = tid & 63, w = RFL(tid >> 6), c = lane & 31, hi = lane >> 5, s = BATCH + b; const size_t sg = (size_t)s * 2 + g;
    const ldsp_t lw = lds + w * GL_WAVE; LDSQ float* mstat = (LDSQ float*)(lds + LDS_WX);
    LDSQ float* impw = (LDSQ float*)lds;
    bf16x8 qf[4], pf[4]; AttnSt st; attn_init(st); f32x16 ima, imb;
    for (int r = 0; r < 16; ++r) { ima[r] = 0.f; imb[r] = 0.f; }
    const bool live = w < NCPADS / 64;
    if (live) {
        wload_q(p, WB_QNB, b, g, c, hi, qf);
        const int nlim = (PAST_LEN + (c >> 2) - 31) >> 4;
        wstage_bf16(lw, wsb(p, WB_KCB) + sg * NCPAD * 64 + (size_t)w * 4096, wsb(p, WB_VCT) + sg * (NCPAD / 64) * 4096 + (size_t)w * 4096, lane); WAVE_SYNC();
        wattn_tile<true>(lw, qf, nlim - 64 * w - 4 * hi, -100000, true, st, pf, c, hi);
        wimp_tile(pf, ima, w, w >> 1, c, hi);
        if ((w & 1) && (w >> 1) + 1 < 4) wimp_tile(pf, imb, w, (w >> 1) + 1, c, hi);
    }
    wpart_store(p, b, g, w, st, c, hi);
    { const float lt = st.l + __shfl_xor(st.l, 32); if (hi == 0) { mstat[(w * 32 + c) * 2] = st.m; mstat[(w * 32 + c) * 2 + 1] = lt; } }
    __syncthreads();
    float f;
    { float M = NEG_BIG;
#pragma unroll
      for (int k = 0; k < 8; ++k) M = fmaxf(M, mstat[(k * 32 + c) * 2]);
      float Lt = 0.f;
#pragma unroll
      for (int k = 0; k < 8; ++k) Lt += mstat[(k * 32 + c) * 2 + 1] * EXP2F(mstat[(k * 32 + c) * 2] - M);
      f = Lt > 0.f ? EXP2F(st.m - M) * RCPF(Lt) : 0.f; }
    for (int i = tid; i < 1024; i += NTHREADS) impw[i] = 0.f;
    __syncthreads();
    if (live) {
#define SNSA_IMP_ADD(IM, JT) { _Pragma("unroll") for (int r = 0; r < 16; ++r) { const int j = (r & 3) + 8 * (r >> 2) + 4 * hi; float v0 = IM[r] * f; \
        v0 += __shfl_xor(v0, 1); v0 += __shfl_xor(v0, 2); if ((c & 3) == 0) LDS_ADDF(&impw[(c >> 2) * 128 + (JT) * 32 + j], v0); } }
        SNSA_IMP_ADD(ima, w >> 1)
        if ((w & 1) && (w >> 1) + 1 < 4) SNSA_IMP_ADD(imb, (w >> 1) + 1)
#undef SNSA_IMP_ADD
    }
    __syncthreads();
    if (w != 0) return;
    unsigned long long u0 = 0ull, u1 = 0ull; unsigned qa = 0u, qb = 0u;
#pragma unroll 1
    for (int q = 0; q < 8; ++q) {
        const int ja = lane, jb = 64 + lane;
        const float sa = (ja < NJ) ? ((ja == 0 || ja == NJ - 1) ? INFINITY : impw[q * 128 + ja]) : -INFINITY, sb = (jb < NJ) ? ((jb == NJ - 1) ? INFINITY : impw[q * 128 + jb]) : -INFINITY;
        int ra = 0, rb = 0;
#pragma unroll 8
        for (int i = 0; i < 64; ++i) { const float a = rlane(sa, i), bq = rlane(sb, i);
            ra += ((a > sa || (a == sa && i < lane)) ? 1 : 0) + ((bq > sa) ? 1 : 0);
            rb += ((a > sb || a == sb) ? 1 : 0) + ((bq > sb || (bq == sb && i < lane)) ? 1 : 0); }
        const bool sela = ra < 15 && ja < NJ, selb = rb < 15 && jb < NJ;
        u0 |= __ballot(sela); u1 |= __ballot(selb); qa |= sela ? (1u << q) : 0u; qb |= selb ? (1u << q) : 0u;
    }
    int* sl = slist(p, b, g);
    const unsigned long long below = (lane == 0) ? 0ull : (~0ull >> (64 - lane));
    const int n0 = __builtin_popcountll(u0), n1 = __builtin_popcountll(u1);
    if ((u0 >> lane) & 1ull) { const int idx = __builtin_popcountll(u0 & below); sl[idx] = lane; sl[SL_MAX + idx] = (int)qa; }
    if ((u1 >> lane) & 1ull) { const int idx = n0 + __builtin_popcountll(u1 & below); sl[idx] = 64 + lane; sl[SL_MAX + idx] = (int)qb; }
    for (int idx = n0 + n1 + lane; idx < SL_MAX; idx += 64) { sl[idx] = (idx == n0 + n1) ? NJ : -1; sl[SL_MAX + idx] = 0xFF; }
}
HD void snsa_win_item(const P& p, int L, ldsp_t lw, int b, int g, int wi, int lane_) {
    const int lane = opaque_i(lane_), c = lane & 31, hi = lane >> 5, t = c >> 2;
    bf16x8 qf[4], pf[4]; AttnSt st; attn_init(st);
    wload_q(p, WB_QRB, b, g, c, hi, qf);
    constexpr int NCT = (WKEEP_S + DEC_SEQ + 63) / 64;
    for (int k = 0; k < 3; ++k) { const int wt = wi * 3 + k; if (wt >= NCT) break;
        const int ci0 = 64 * wt; const float* kbase; int nvalid;
        if (ci0 < WKEEP_S) { kbase = p.state_win + (((size_t)L * DEC_BATCH + b) * WKEEP_S + ci0) * 256 + g * 64; nvalid = 64; }
        else { kbase = p.ws + W_WINNEW + ((size_t)NP + b * DEC_SEQ + (ci0 - WKEEP_S)) * 256 + g * 64; nvalid = WKEEP_S + DEC_SEQ - ci0; }
        WAVE_SYNC(); wstage_f32(lw, kbase, kbase + 128, 256, nvalid, lane); WAVE_SYNC();
        if (ci0 + 63 <= WKEEP_S && ci0 > WKEEP_S + DEC_SEQ - 1 - WIN) wattn_tile<false>(lw, qf, 0, 0, true, st, pf, c, hi);
        else wattn_tile<true>(lw, qf, WKEEP_S + t - ci0 - 4 * hi, WKEEP_S + t - WIN - ci0 - 4 * hi, true, st, pf, c, hi); }
    wpart_store(p, b, g, SP_WIN0 + wi, st, c, hi);
}
HD void snsa_slc_item(const P& p, int L, ldsp_t lw, int b, int g, int si, int lane_) {
    const int lane = opaque_i(lane_), c = lane & 31, hi = lane >> 5, t = c >> 2, s = BATCH + b;
    bf16x8 qf[4], pf[4]; AttnSt st; attn_init(st);
    wload_q(p, WB_QRB, b, g, c, hi, qf);
    const int* sl = slist(p, b, g);
    for (int k = 0; k < 4; ++k) { const int e = si * 4 + k, blk = sl[e]; if (blk < 0) break;
        const unsigned qm = (unsigned)sl[SL_MAX + e];
        const float* kbase = hist(p, L, s, 64 * blk, 2, g); const int nvalid = blk < NJ ? 64 : DEC_SEQ;
        WAVE_SYNC(); wstage_f32(lw, kbase, kbase + 128, 512, nvalid, lane); WAVE_SYNC();
        const bool sel = ((qm >> t) & 1u) != 0u;
        if (blk < NJ) wattn_tile<false>(lw, qf, 0, 0, sel, st, pf, c, hi); else wattn_tile<true>(lw, qf, sel ? PAST_LEN + t - 64 * blk - 4 * hi : -100000, -100000, true, st, pf, c, hi); }
    wpart_store(p, b, g, SP_SLC0 + si, st, c, hi);
}
HD void bphase_snsa_a(const P& p, int L, ldsp_t lds) {
    const int w = RFL(opaque_tid() >> 6); const ldsp_t lw = lds + w * GL_WAVE; const int rb = (int)gridDim.x - 1 - (int)blockIdx.x;
    for (int u = rb; u < DEC_BATCH * 2; u += gridDim.x) { snsa_cmp_unit(p, L, lds, u >> 1, u & 1); __syncthreads(); }
#define lane (opaque_tid() & 63)
    for (int u = blockIdx.x * 8 + w; u < DEC_BATCH * 2 * SP_NWIN; u += gridDim.x * 8) { const int bg = u / SP_NWIN, k = u % SP_NWIN; snsa_win_item(p, L, lw, bg >> 1, bg & 1, k, lane); }
#undef lane
}
HD void bphase_snsa_b(const P& p, int L, ldsp_t lds) {
    const int w = RFL(opaque_tid() >> 6); const ldsp_t lw = lds + w * GL_WAVE;
#define lane (opaque_tid() & 63)
    for (int u = blockIdx.x * 8 + w; u < DEC_BATCH * 2 * SP_NSLC; u += gridDim.x * 8) { const int bg = u / SP_NSLC, k = u % SP_NSLC; snsa_slc_item(p, L, lw, bg >> 1, bg & 1, k, lane); }
#undef lane
}
HD void k_snsa_combine(const P& p, int L, long it) {
    const int d = (int)(it % 64), head = (int)((it / 64) % 8), rs = (int)(it / 512), b = rs / DEC_SEQ, t = rs % DEC_SEQ, g = head >> 2, col = t * 4 + (head & 3), r = NP + rs;
    const URow u = urow(p, r); float o = 0.f;
    for (int br = 0; br < 3; ++br) { const int i0 = br == 0 ? 0 : br == 1 ? SP_SLC0 : SP_WIN0, n = br == 0 ? SP_NCMP : br == 1 ? SP_NSLC : SP_NWIN;
        float M = NEG_BIG; for (int i = 0; i < n; ++i) M = fmaxf(M, spart(p, b, g, i0 + i)[col * SP_STRIDE]);
        float Ls = 0.f, Os = 0.f;
        for (int i = 0; i < n; ++i) { const float* q = spart(p, b, g, i0 + i) + col * SP_STRIDE; const float wgt = EXP2F(q[0] - M); Ls += q[1] * wgt; Os += q[4 + d] * wgt; }
        if (Ls > 0.f) o += sigmoidf_(u[C_NG + br * 8 + head]) * Os * RCPF(Ls); }
    mixb(p)[(size_t)r * D + 256 + head * 64 + d] = f2bf(o * siluf(u[C_NZ + head * 64 + d]));
}

HD float sum8(float v) { v += __shfl_xor(v, 1); v += __shfl_xor(v, 2); v += __shfl_xor(v, 7); return v; }
HD float wave_sum(float v) { v = sum8(v); v += __shfl_xor(v, 15); return (rlane(v, 0) + rlane(v, 16)) + (rlane(v, 32) + rlane(v, 48)); }
HD void cvt8(const bf16x8& x, float (&f)[8]) {
#pragma unroll
    for (int j = 0; j < 8; ++j) f[j] = bf2f((bf16_t)x[j]); }
HD bf16x8 pack8(const float (&f)[8]) { bf16x8 o;
#pragma unroll
    for (int j = 0; j < 8; ++j) o[j] = (short)f2bf(f[j]);
    return o; }
HD void st8f(float* dst, const float (&f)[8]) { f32x4 a = {f[0], f[1], f[2], f[3]}, b = {f[4], f[5], f[6], f[7]}; *(f32x4*)dst = a; *(f32x4*)(dst + 4) = b; }
HD void bphase_xin(const P& p, int L, ldsp_t lds) {
    const int w = RFL(opaque_tid() >> 6), lane = opaque_tid() & 63; const int stride = (int)gridDim.x * 8;
#pragma unroll 1
    for (int r = blockIdx.x * 8 + w; r < NT; r += 2 * stride) {
        const int r2 = r + stride; const bool two = r2 < NT;
        const float* x = xrow(p, L, r); const float* x2 = xrow(p, L, two ? r2 : r); float ss = 0.f, ss2 = 0.f; f32x4 v[4], v2[4];
#pragma unroll
        for (int k = 0; k < 4; ++k) v[k] = *(const f32x4*)(x + k * 256 + lane * 4);
#pragma unroll
        for (int k = 0; k < 4; ++k) v2[k] = *(const f32x4*)(x2 + k * 256 + lane * 4);
#pragma unroll
        for (int k = 0; k < 4; ++k) { ss += v[k][0] * v[k][0] + v[k][1] * v[k][1] + v[k][2] * v[k][2] + v[k][3] * v[k][3]; ss2 += v2[k][0] * v2[k][0] + v2[k][1] * v2[k][1] + v2[k][2] * v2[k][2] + v2[k][3] * v2[k][3]; }
        ss = wave_sum(ss); ss2 = wave_sum(ss2);
        if (lane == 0) { p.ws[W_RSTD + r] = RSQRTF(ss * (1.0f / D) + 1e-6f); if (two) p.ws[W_RSTD + r2] = RSQRTF(ss2 * (1.0f / D) + 1e-6f); }
        bf16_t* o = xbp(p) + (size_t)r * D; bf16_t* o2 = xbp(p) + (size_t)r2 * D;
#pragma unroll
        for (int k = 0; k < 4; ++k) { bf16x4 b; for (int e = 0; e < 4; ++e) b[e] = (short)f2bf(v[k][e]); *(bf16x4*)(o + k * 256 + lane * 4) = b; }
        if (two) {
#pragma unroll
            for (int k = 0; k < 4; ++k) { bf16x4 b; for (int e = 0; e < 4; ++e) b[e] = (short)f2bf(v2[k][e]); *(bf16x4*)(o2 + k * 256 + lane * 4) = b; } }
    }
}
HD void bphase_cmp_bias(const P& p, int L, ldsp_t lds) {
    const int w = RFL(opaque_tid() >> 6), lane = opaque_tid() & 63;
    for (int o = blockIdx.x * 8 + w; o < DEPTH * 128; o += gridDim.x * 8) { const int e = o % 64, lk = o / 64; float s = 0.f;
#pragma unroll 8
        for (int i = 0; i < 32; ++i) { const int q = lane + 64 * i; s += p.cmp_pos[(size_t)lk * 2048 + q] * p.cmp_w[((size_t)lk * 2048 + q) * 64 + e]; }
        s = wave_sum(s);
        if (lane == 0) p.ws[W_CBIAS + o] = s; }
}
HD void bphase_prep_win(const P& p, int L, ldsp_t lds) {
    constexpr long NI = (long)DEPTH * D_INP * (D / 8);
    const int tid = opaque_tid(); const long stride = (long)gridDim.x * NTHREADS;
#pragma unroll 1
    for (long i0 = (long)blockIdx.x * NTHREADS + tid; i0 < NI; i0 += 4 * stride) {
        float v[4][8];
#pragma unroll
        for (int k = 0; k < 4; ++k) { const long it = i0 + k * stride; const int n = (int)(it % D_INP), kc = (int)((it / D_INP) % (D / 8)), L2 = (int)(it / ((long)D_INP * (D / 8)));
            if (it < NI && n < D_IN) { const float* wp = p.w_in + ((size_t)L2 * D + kc * 8) * D_IN + orig_col(n);
#pragma unroll
                for (int j = 0; j < 8; ++j) v[k][j] = wp[(size_t)j * D_IN]; }
            else {
#pragma unroll
                for (int j = 0; j < 8; ++j) v[k][j] = 0.f; } }
#pragma unroll
        for (int k = 0; k < 4; ++k) { const long it = i0 + k * stride; const int n = (int)(it % D_INP), kc = (int)((it / D_INP) % (D / 8)), L2 = (int)(it / ((long)D_INP * (D / 8)));
            if (it < NI) { float gn[8]; ld8f(p.norm_g + L2 * D + kc * 8, gn);
#pragma unroll
                for (int j = 0; j < 8; ++j) v[k][j] *= gn[j];
                *(bf16x8*)(wintp(p, L2) + (size_t)n * D + kc * 8) = pack8(v[k]); } }
    }
}
HD void bphase_win_copy(const P& p, int L, ldsp_t lds) {
    constexpr int NOLD = WKEEP_S - DEC_SEQ > 0 ? WKEEP_S - DEC_SEQ : 0; constexpr long NV = (long)DEC_BATCH * NOLD * 64;
    static_assert(O_SWIN % 4 == 0, "16-byte aligned window output");
    const int tid = opaque_tid(); const long stride = (long)gridDim.x * NTHREADS;
#pragma unroll 1
    for (long i0 = (long)blockIdx.x * NTHREADS + tid; i0 < NV; i0 += 4 * stride) {
        f32x4 a[4];
#pragma unroll
        for (int k = 0; k < 4; ++k) { const long i = i0 + k * stride; if (i < NV) { const int e4 = (int)(i % 64); const long q = i / 64; const int r = (int)(q % NOLD), b = (int)(q / NOLD);
            a[k] = *(const f32x4*)(p.state_win + (((size_t)L * DEC_BATCH + b) * WKEEP_S + r + DEC_SEQ) * 256 + 4 * e4); } }
#pragma unroll
        for (int k = 0; k < 4; ++k) { const long i = i0 + k * stride; if (i < NV) { const int e4 = (int)(i % 64); const long q = i / 64; const int r = (int)(q % NOLD), b = (int)(q / NOLD);
            *(f32x4*)(p.out + O_SWIN + (((size_t)L * DEC_BATCH + b) * WKEEP_S + r) * 256 + 4 * e4) = a[k]; } }
    }
}
template <int IN> HD void bphase_sgemm_t(const P& p, int L, ldsp_t lds) {
    static_assert(NP % 256 == 0, "prompt rows fill whole 256-row GEMM panels");
    constexpr int NTILE = IN ? 4 : 1, N = IN ? D_INP : D, NRT = (NS + 31) / 32, NCG = N / (32 * NTILE), NU = NRT * NCG;
    const int tid = opaque_tid(), w = RFL(tid >> 6), lane = tid & 63;
    const bf16_t* A = IN ? xbp(p) : mixb(p); const bf16_t* Bt = IN ? wintp(p, L) : wouttp(p, L);
    LDSQ float* red = (LDSQ float*)lds;
#pragma unroll 1
    for (int un = blockIdx.x; un < NU; un += gridDim.x) {
        const int rt = un % NRT, cg = un / NRT, row0 = NP + 32 * rt, col0 = cg * 32 * NTILE;
        f32x16 acc[NTILE];
#pragma unroll
        for (int j = 0; j < NTILE; ++j)
#pragma unroll
            for (int e = 0; e < 16; ++e) acc[j][e] = 0.f;
        const bf16_t* ap = A + (size_t)(row0 + (lane & 31)) * D + 128 * w + 8 * (lane >> 5);
        const bf16_t* bp = Bt + (size_t)(col0 + (lane & 31)) * D + 128 * w + 8 * (lane >> 5);
#pragma unroll
        for (int hh = 0; hh < 2; ++hh) {
            bf16x8 af[4], bfr[NTILE][4];
#pragma unroll
            for (int s = 0; s < 4; ++s) af[s] = *(const bf16x8*)(ap + 16 * (4 * hh + s));
#pragma unroll
            for (int j = 0; j < NTILE; ++j)
#pragma unroll
                for (int s = 0; s < 4; ++s) bfr[j][s] = *(const bf16x8*)(bp + (size_t)j * 32 * D + 16 * (4 * hh + s));
#pragma unroll
            for (int s = 0; s < 4; ++s)
#pragma unroll
                for (int j = 0; j < NTILE; ++j) acc[j] = __builtin_amdgcn_mfma_f32_32x32x16_bf16(af[s], bfr[j][s], acc[j], 0, 0, 0);
            SCHED_FENCE();
        }
#pragma unroll
        for (int j = 0; j < NTILE; ++j)
#pragma unroll
            for (int e = 0; e < 16; ++e) red[((w * NTILE + j) * 16 + e) * 64 + lane] = acc[j][e];
        __syncthreads();
        float rsr[2] = {0.f, 0.f};
        if (IN) {
#pragma unroll
            for (int k = 0; k < 2; ++k) { const int reg = w + 8 * k, row = row0 + (reg & 3) + 8 * (reg >> 2) + 4 * (lane >> 5);
                if (L == 0) rsr[k] = row < NT ? p.ws[W_RSTD + row] : 0.f;
                else { const f32x4* q = (const f32x4*)(p.ws + W_XN + (size_t)row * 32); f32x4 a = q[0];
#pragma unroll
                    for (int e = 1; e < 8; ++e) a += q[e];
                    rsr[k] = RSQRTF(((a[0] + a[1]) + (a[2] + a[3])) * (1.0f / D) + 1e-6f); } } }
#pragma unroll
        for (int i = 0; i < NTILE * 2; ++i) { const int idx = tid + 512 * i, ln = idx & 63, reg = (idx >> 6) & 15, j = idx >> 10; float sm = 0.f;
#pragma unroll
            for (int w2 = 0; w2 < 8; ++w2) sm += red[((w2 * NTILE + j) * 16 + reg) * 64 + ln];
            const int row = row0 + (reg & 3) + 8 * (reg >> 2) + 4 * (ln >> 5), col = col0 + 32 * j + (ln & 31);
            if (IN) { if (row < NT) ubase(p)[(size_t)row * U_LD + col] = f2bf(sm * rsr[i & 1]); }
            else { const float y = row < NT ? xrow(p, L, row)[col] + sm : 0.f;
                if (row < NT) (L == DEPTH - 1 ? p.out + O_Y : p.ws + W_Y0)[(size_t)row * D + col] = y;
                if (L + 1 < DEPTH) {
                    if (row < NT) xbp(p)[(size_t)row * D + col] = f2bf(y);
                    float ss = y * y; ss += __shfl_xor(ss, 1); ss += __shfl_xor(ss, 2); ss += __shfl_xor(ss, 4); ss += __shfl_xor(ss, 8); ss += __shfl_xor(ss, 16);
                    if ((ln & 31) == 0 && row < NTP) p.ws[W_XN + (size_t)row * 32 + cg] = ss; } } }
        __syncthreads();
    }
}
HD void bphase_sgemm_in(const P& p, int L, ldsp_t lds) { bphase_sgemm_t<1>(p, L, lds); }
HD void bphase_sgemm_out(const P& p, int L, ldsp_t lds) { bphase_sgemm_t<0>(p, L, lds); }
HD void rope8(float (&x)[8], int l7, const float (&rc)[8], const float (&rsn)[8]) {
#pragma unroll
    for (int j = 0; j < 8; ++j) { const float pt = __shfl_xor(x[j], 1); x[j] = l7 == 0 ? x[j] * rc[j] - pt * rsn[j] : (l7 == 1 ? x[j] * rc[j] + pt * rsn[j] : x[j]); }
}
HD void bphase_rows(const P& p, int L, ldsp_t lds) {
    const int w = RFL(opaque_tid() >> 6), lane = opaque_tid() & 63, l7 = lane & 7;
    constexpr int NGP = NP / 8, NUN = NGP + NS;
#pragma unroll 1
    for (int un = blockIdx.x * 8 + w; un < NUN; un += gridDim.x * 8) {
        const int r0 = un < NGP ? un * 8 : NP + (un - NGP), ntk = un < NGP ? 8 : 1, s = seq_of_row(r0), t0 = r0 - seq_row0(s);
        float pw[3][8];
#pragma unroll
        for (int i = 0; i < 3; ++i) { const int tp = t0 + i;
            if (tp < 3) {
#pragma unroll
                for (int j = 0; j < 8; ++j) pw[i][j] = s < BATCH ? 0.f : p.state_conv[(((size_t)L * DEC_BATCH + (s - BATCH)) * 3 + tp) * 512 + 8 * lane + j]; }
            else cvt8(*(const bf16x8*)(ubase(p) + (size_t)(r0 + i - 3) * U_LD + C_MQK + 8 * lane), pw[i]); }
        const ldsp_t vtl = lds + w * GL_WAVE + lane * 16;
        bf16x8 R1, R2, R3, R5, R7;
        { const bf16_t* ur = ubase(p) + (size_t)r0 * U_LD + 8 * lane;
          R1 = *(const bf16x8*)(ur + 512); R2 = *(const bf16x8*)(ur + 1024); R3 = *(const bf16x8*)(ur + 1536); R5 = *(const bf16x8*)(ur + 2560); R7 = *(const bf16x8*)(ur + 3584); }
#pragma unroll 1
        for (int ti = 0; ti < ntk; ++ti) { {
            const int r = r0 + ti, pos = row_pos(r);
            bf16x8 N1, N2, N3, N5, N7;
            { const bf16_t* ur = ubase(p) + (size_t)(ti + 1 < ntk ? r + 1 : r) * U_LD + 8 * lane;
              N1 = *(const bf16x8*)(ur + 512); N2 = *(const bf16x8*)(ur + 1024); N3 = *(const bf16x8*)(ur + 1536); N5 = *(const bf16x8*)(ur + 2560); N7 = *(const bf16x8*)(ur + 3584); }
            float rc[8], rsn[8];
            { const float ang = (float)pos * rope_inv(l7); float c, sn; SINCOSF(ang, sn, c);
#pragma unroll
              for (int j = 0; j < 8; ++j) { rc[j] = rlane(c, j); rsn[j] = rlane(sn, j); } }
            { float v[8]; cvt8(lane >= 32 ? R1 : R2, v); float ss = 0.f;
#pragma unroll
              for (int j = 0; j < 8; ++j) ss += v[j] * v[j];
              const float rs = RSQRTF(sum8(ss) * (1.0f / 64) + 1e-6f);
#pragma unroll
              for (int j = 0; j < 8; ++j) v[j] *= rs * p.q_norm_g[L * 64 + 8 * l7 + j] * C2LOG;
              const int head = lane >= 32 ? (lane - 32) >> 3 : 4 + (lane >> 3); const size_t qo = (size_t)r * 512 + head * 64 + 8 * l7;
              *(bf16x8*)(wsb(p, WB_QNB) + qo) = pack8(v); rope8(v, l7, rc, rsn); *(bf16x8*)(wsb(p, WB_QRB) + qo) = pack8(v); }
            float* nr = new_rows_ptr(p, L, r);
            if (lane >= 32) { float v[8]; cvt8(R2, v); st8f(nr + ((lane - 32) >> 4) * 128 + (((lane - 32) >> 3) & 1) * 64 + 8 * l7, v); }
            { const int role = lane >> 4, g = (lane >> 3) & 1; float v[8]; cvt8(R3, v); float ss = 0.f;
#pragma unroll
              for (int j = 0; j < 8; ++j) ss += v[j] * v[j];
              const float rs = RSQRTF(sum8(ss) * (1.0f / 64) + 1e-6f);
              float kn[8];
#pragma unroll
              for (int j = 0; j < 8; ++j) kn[j] = v[j] * rs * p.k_norm_g[(L * 3 + (role == 0 ? 1 : 2)) * 64 + 8 * l7 + j];
              rope8(kn, l7, rc, rsn);
              if ((role & 1) == 0) {
#pragma unroll
                  for (int j = 0; j < 8; ++j) v[j] = kn[j]; }
              const bf16x8 vb = pack8(v);
              if (r < NP && (role & 1)) {
#pragma unroll
                  for (int j = 0; j < 8; ++j) *(LDSQ bf16_t*)(vtl + j * 1024 + ti * 2) = (bf16_t)vb[j]; }
              if (role < 2) st8f(nr + (2 + role) * 128 + g * 64 + 8 * l7, v);
              else { st8f(p.ws + W_WINNEW + (size_t)r * 256 + (role - 2) * 128 + g * 64 + 8 * l7, v);
                  float* wo = nullptr; const int t = t0 + ti;
                  if (r < NP) { if (t >= SEQ - WKEEP_P) wo = p.out + O_PWIN + (((size_t)L * BATCH + s) * WKEEP_P + (t - (SEQ - WKEEP_P))) * 256; }
                  else { const int i = WKEEP_S - DEC_SEQ + t; if (i >= 0) wo = p.out + O_SWIN + (((size_t)L * DEC_BATCH + (s - BATCH)) * WKEEP_S + i) * 256; }
                  if (wo) st8f(wo + (role - 2) * 128 + g * 64 + 8 * l7, v); }
              if (r < NP && (role & 1) == 0) *(bf16x8*)(wsb(p, role == 0 ? WB_KSB : WB_KWB) + (((size_t)s * 2 + g) * SEQ + (t0 + ti)) * 64 + 8 * l7) = vb; }
            { float f7[8]; cvt8(R7, f7); float a0 = p.gla_b_gate[L * 128 + lane], a1 = p.gla_b_gate[L * 128 + 64 + lane];
#pragma unroll
              for (int q = 0; q < 16; ++q) { const float x = rlane(f7[q & 7], 32 + (q >> 3)); a0 += x * p.gla_w_gate[(L * 16 + q) * 128 + lane]; a1 += x * p.gla_w_gate[(L * 16 + q) * 128 + 64 + lane]; }
              p.ws[W_LOGA + (size_t)r * 128 + lane] = log_sigmoidf(a0) * (1.0f / 16.0f); p.ws[W_LOGA + (size_t)r * 128 + 64 + lane] = log_sigmoidf(a1) * (1.0f / 16.0f); }
            { float x0[8], o[8]; cvt8(R5, x0);
#pragma unroll
              for (int j = 0; j < 8; ++j) { const int ch = 8 * lane + j; const float* cwp = p.conv_w + (size_t)L * 2048 + ch; const float a = p.conv_b[L * 512 + ch] + pw[0][j] * cwp[0] + pw[1][j] * cwp[512] + pw[2][j] * cwp[1024] + x0[j] * cwp[1536]; o[j] = siluf(a) * (lane < 32 ? 1.0f : 0.125f);
                  pw[0][j] = pw[1][j]; pw[1][j] = pw[2][j]; pw[2][j] = x0[j]; }
              st8f(lane < 32 ? p.ws + W_MQ + (size_t)r * 256 + 8 * lane : p.ws + W_MK + (size_t)r * 256 + 8 * (lane - 32), o); }
            R1 = N1; R2 = N2; R3 = N3; R5 = N5; R7 = N7;
            } SCHED_FENCE();
        }
        if (r0 < NP && ((lane >> 4) & 1)) { const int role = lane >> 4, g = (lane >> 3) & 1;
            bf16_t* vt = wsb(p, role == 1 ? WB_VST : WB_VWT) + (((size_t)s * 2 + g) * NQT + t0 / 64) * 4096 + (size_t)(8 * l7) * 64 + (t0 % 64);
#pragma unroll
            for (int j = 0; j < 8; ++j) *(bf16x8*)(vt + (size_t)j * 64) = *(const LDSQ bf16x8*)(vtl + j * 1024); }
    }
}

typedef void (*ItemFn)(const P&, int, long);
typedef void (*BlockFn)(const P&, int, ldsp_t);
static P make_params(void* const* d_in, void* d_out, void* d_ws) {
    P p;
    p.x_prompt = (const float*)d_in[0]; p.x_sample = (const float*)d_in[1]; p.cache = (const float*)d_in[2]; p.state_win = (const float*)d_in[3];
    p.state_gla = (const float*)d_in[4]; p.state_C = (const float*)d_in[5]; p.state_n = (const float*)d_in[6]; p.state_m = (const float*)d_in[7];
    p.state_conv = (const float*)d_in[8]; p.page_table = (const int*)d_in[9]; p.norm_g = (const float*)d_in[10]; p.w_in = (const float*)d_in[11];
    p.w_out = (const float*)d_in[12]; p.gla_w_gate = (const float*)d_in[13]; p.gla_b_gate = (const float*)d_in[14]; p.gla_norm_g = (const float*)d_in[15];
    p.q_norm_g = (const float*)d_in[16]; p.k_norm_g = (const float*)d_in[17]; p.cmp_pos = (const float*)d_in[18]; p.cmp_w = (const float*)d_in[19];
    p.conv_w = (const float*)d_in[20]; p.conv_b = (const float*)d_in[21]; p.gate_b = (const float*)d_in[22]; p.ml_norm_g = (const float*)d_in[23];
    p.out = (float*)d_out; p.ws = (float*)d_ws;
    return p;
}
#define LAYER_PROGRAM(LL) { const int L = LL; \
        if (XIN_NEEDED(L)) { BLK(bphase_xin); GRID_BAR(); } \
        GEMM_IN(); \
        BLK(bphase_sgemm_in); \
        GRID_BAR(); \
        BLK(bphase_rows); \
        BLK(bphase_win_copy); \
        PH(k_conv_out, (long)NSEQ * 3 * 512); \
        GRID_BAR(); \
        BLK(bphase_rec_g1); \
        BLK(bphase_cmp_sum_s); \
        GRID_BAR(); \
        PH_MID(k_gla, (long)DEC_BATCH * 256, 5); \
        PH_MID(k_mlstm, (long)DEC_BATCH * 260, 4); \
        PH_MID(k_gla_scan, (long)BATCH * 8192, 1); \
        PH_MID(k_ml_scan, (long)BATCH * 16640, 0); \
        BLK(bphase_snsa_a); \
        BLK(bphase_cmp_sum_p); \
        GRID_BAR(); \
        BLK(bphase_nsa_prompt); \
        BLK(bphase_rec_g2); \
        BLK(bphase_snsa_b); \
        PH(k_mix_gla, (long)NS * 4); \
        PH(k_mix_ml, (long)NS * 4); \
        GRID_BAR(); \
        PH(k_snsa_combine, (long)NS * 512); \
        GRID_BAR(); \
        GEMM_OUT(); \
        BLK(bphase_sgemm_out); \
        GRID_BAR(); \
    }
constexpr int LDS_BYTES = LDS_MISC + 1024 + 2048;
static_assert(NSA_END <= NSA_COMB && NSA_COMB + 8 * 8192 <= LDS_MISC, "NSA unit LDS map");

#ifdef CPU_EMU
template <ItemFn F> static void run_items(const P& p, int L, long n) {
#pragma omp parallel for schedule(dynamic, 256)
    for (long i = 0; i < n; ++i) F(p, L, i);
}
struct EmuArgs { BlockFn f; const P* p; int L; };
static void emu_tramp(void* a) { EmuArgs* e = (EmuArgs*)a; e->f(*e->p, e->L, (ldsp_t)emu_lds); }
static void emu_phase(BlockFn f, const P& p, int L) {
    const int G = 8;
#pragma omp parallel for schedule(dynamic, 1)
    for (int bx = 0; bx < G; ++bx) { EmuArgs a{f, &p, L}; emu_run_block(NTHREADS, bx, G, LDS_BYTES, emu_tramp, &a); }
}
#define PH(F, n) run_items<F>(p, L, (long)(n))
#define PH_MID(F, n, ROT) run_items<F>(p, L, (long)(n))
#define XIN_NEEDED(L) true
#define BLK(F) emu_phase(F, p, L)
#define GRID_BAR() do {} while (0)
#define GEMM_IN() PH(k_gemm_in_emu, (long)NP * D_IN)
#define GEMM_OUT() PH(k_gemm_out_emu, (long)NP * D)
static void forward(const P& p) {
#else

namespace pg8 {
#define PG8_LAS __attribute__((address_space(3)))
typedef unsigned short bf16_t;
typedef short bf16x8 __attribute__((ext_vector_type(8)));
typedef float f32x4 __attribute__((ext_vector_type(4)));
typedef unsigned u32x4 __attribute__((ext_vector_type(4)));
constexpr int BM = 256, BK = 64, HALF = 128, HTB = HALF * BK * 2  , STAGE_BYTES = 8 * HTB, NXCD = 8, WGM = 8;

__host__ __device__ __forceinline__ int lds_byte(int r, int c) { const int st = (r >> 4) * 2 + (c >> 5), rr = r & 15, cc = c & 31, ob = rr * 64 + cc * 2; return st * 1024 + (ob ^ (((ob >> 9) & 1) << 5)); }
__host__ __device__ __forceinline__ void stage_rc(int b, int& R, int& C) { const int st = b / 1024, sb = b % 1024, swz = sb ^ (((sb >> 9) & 1) << 5); R = (st >> 1) * 16 + swz / 64; C = (st & 1) * 32 + (swz % 64) / 2; }
__host__ __device__ __forceinline__ int perm32(int rho) { const int n = rho >> 4, i = rho & 15; return 8 * (i >> 2) + 4 * n + (i & 3); }

struct Unit { int pm, pn; };
struct Gemm { const bf16_t* A; const bf16_t* Bt; int M, N, K; };

struct StaticOrder {
    int nM, nN, nwg, G, c;
    __host__ __device__ void init(int M, int N, int G_, int c_) { nM = M / BM; nN = N / BM; nwg = nM * nN; G = G_; c = c_; }
    __host__ __device__ bool next(int i, Unit& u) const {
        const long L = (long)i * G + c; if (L >= nwg) return false;
        int wgid = (int)L; { const int q = nwg / NXCD, r = nwg % NXCD, xcd = wgid % NXCD, off = wgid / NXCD; wgid = (xcd < r ? xcd * (q + 1) : r * (q + 1) + (xcd - r) * q) + off; }
        const int nig = WGM * nN, gid = wgid / nig, fm = gid * WGM, gsz = (nM - fm) < WGM ? (nM - fm) : WGM;
        u.pm = fm + ((wgid % nig) % gsz); u.pn = (wgid % nig) / gsz; return true;
    }
    __device__ __forceinline__ void a_ready(const Unit&) const {}
    __device__ __forceinline__ void done(const Unit&) const {}
};
__device__ __forceinline__ unsigned cvt_pk_bf16(float lo, float hi) { unsigned r; asm volatile("v_cvt_pk_bf16_f32 %0, %1, %2" : "=v"(r) : "v"(lo), "v"(hi)); return r; }
struct EpiInBf16 {
    static constexpr bool PERM = true, AFTER_DRAIN = false;
    bf16_t* U; const float* rstd; const float* pss;
    __device__ __forceinline__ void operator()(const f32x4 (&acc)[2][2][4][2], const Unit& u, int wr, int wc, int fr, int fq) const {
        const int row0 = u.pm * BM + wr * 64 + fr, col0 = u.pn * BM + wc * 32 + 8 * fq;
#pragma unroll
        for (int ai = 0; ai < 2; ++ai)
#pragma unroll
            for (int m = 0; m < 4; ++m) { const int row = row0 + ai * HALF + m * 16; if (row >= NT) continue; float rs;
                if (pss) { const f32x4* q = (const f32x4*)(pss + (size_t)row * 32); const f32x4 a = (q[0] + q[1]) + (q[2] + q[3]); rs = __builtin_amdgcn_rsqf(((a[0] + a[1]) + (a[2] + a[3])) * (1.0f / D) + 1e-6f); }
                else rs = rstd[row];
                bf16_t* rowp = U + (size_t)row * U_LD + col0;
#pragma unroll
                for (int bj = 0; bj < 2; ++bj) { const f32x4 v0 = acc[ai][bj][m][0] * rs, v1 = acc[ai][bj][m][1] * rs; u32x4 wv;
                    wv.x = cvt_pk_bf16(v0[0], v0[1]); wv.y = cvt_pk_bf16(v0[2], v0[3]); wv.z = cvt_pk_bf16(v1[0], v1[1]); wv.w = cvt_pk_bf16(v1[2], v1[3]);
                    *(u32x4*)(rowp + bj * HALF) = wv; } }
    }
};
struct EpiOutF32 {
    static constexpr bool PERM = true, AFTER_DRAIN = false;
    float* Y; const float* Xa; const float* Xb;
    bf16_t* XB; float* PSS;
    __device__ __forceinline__ void operator()(const f32x4 (&acc)[2][2][4][2], const Unit& u, int wr, int wc, int fr, int fq) const {
        const int row0 = u.pm * BM + wr * 64 + fr, col0 = u.pn * BM + wc * 32 + 8 * fq;
#pragma unroll
        for (int ai = 0; ai < 2; ++ai)
#pragma unroll
            for (int m = 0; m < 4; ++m) { const int row = row0 + ai * HALF + m * 16; if (row >= NT) continue;
                const float* xr = row < NP ? Xa + (size_t)row * D : Xb + (size_t)(row - NP) * D; float* rowp = Y + (size_t)row * D; float ss = 0.f;
#pragma unroll
                for (int bj = 0; bj < 2; ++bj) { const int c = col0 + bj * HALF;
                    const f32x4 y0 = acc[ai][bj][m][0] + *(const f32x4*)(xr + c), y1 = acc[ai][bj][m][1] + *(const f32x4*)(xr + c + 4);
                    *(f32x4*)(rowp + c) = y0; *(f32x4*)(rowp + c + 4) = y1;
                    if (XB) { ss += y0[0] * y0[0] + y0[1] * y0[1] + y0[2] * y0[2] + y0[3] * y0[3] + y1[0] * y1[0] + y1[1] * y1[1] + y1[2] * y1[2] + y1[3] * y1[3]; u32x4 wv;
                        wv.x = cvt_pk_bf16(y0[0], y0[1]); wv.y = cvt_pk_bf16(y0[2], y0[3]); wv.z = cvt_pk_bf16(y1[0], y1[1]); wv.w = cvt_pk_bf16(y1[2], y1[3]);
                        *(u32x4*)(XB + (size_t)row * D + c) = wv; } }
                if (XB) { ss += xl_shfl_xor(ss, 16); ss += xl_shfl_xor(ss, 32); if (fq == 0) PSS[(size_t)row * 32 + u.pn * 4 + wc] = ss; } }
    }
};
template <class Epi, class Sched, bool ALIGN_EPI = false, bool SP2 = false>
__device__ __forceinline__ void gemm_phase(PG8_LAS unsigned char* lds, const Gemm g, const Sched& S, const Epi& E) {
    const int tid = hw_tid(lds), wid = __builtin_amdgcn_readfirstlane(tid >> 6), lane = tid & 63, wr = wid >> 2, wc = wid & 3, fr = lane & 15, fq = lane >> 4;
    const int K = g.K, nt = K / BK;
    unsigned voffA[2], voffB[2];
#pragma unroll
    for (int i = 0; i < 2; ++i) { int R, C; stage_rc(tid * 16 + i * 8192, R, C); const int Rb = Epi::PERM ? ((R & ~31) + perm32(R & 31)) : R;
        voffA[i] = (unsigned)(R * K + C) * 2u; voffB[i] = (unsigned)(Rb * K + C) * 2u; }
    const size_t kstep = (size_t)(BK * 2);
    const size_t hstep = (size_t)HALF * K * 2;
    const size_t tstep = 2 * hstep;
    const unsigned ldsw = (unsigned)wid * 1024u;
    const int aoff = lds_byte(wr * 64 + fr, fq * 8), boff = lds_byte(wc * 32 + fr, fq * 8);
#define PG8_SA(b, h) (((b) * 2 + (h)) * HTB)
#define PG8_SB(b, h) ((4 + (b) * 2 + (h)) * HTB)
#define PG8_STAGE(bufoff, gbase, voff) do { _Pragma("unroll") for (int _i = 0; _i < 2; ++_i) \
        __builtin_amdgcn_global_load_lds((const unsigned*)((const char*)(gbase) + (voff)[_i]), (PG8_LAS unsigned*)(lds + (bufoff) + ldsw + _i * 8192), 16, 0, 0); } while (0)
#define PG8_LDA(dst, b, h) do { _Pragma("unroll") for (int m = 0; m < 4; ++m) _Pragma("unroll") for (int k = 0; k < 2; ++k) dst[m][k] = *(const PG8_LAS bf16x8*)(lds + PG8_SA(b, h) + aoff + m * 2048 + k * 1024); } while (0)
#define PG8_LDB(dst, b, h) do { _Pragma("unroll") for (int n = 0; n < 2; ++n) _Pragma("unroll") for (int k = 0; k < 2; ++k) dst[n][k] = *(const PG8_LAS bf16x8*)(lds + PG8_SB(b, h) + boff + n * 2048 + k * 1024); } while (0)
#define PG8_MMA(ai, bj, At, Bt) do { __builtin_amdgcn_s_setprio(1); _Pragma("unroll") for (int m = 0; m < 4; ++m) _Pragma("unroll") for (int n = 0; n < 2; ++n) _Pragma("unroll") for (int k = 0; k < 2; ++k) \
        acc[ai][bj][m][n] = __builtin_amdgcn_mfma_f32_16x16x32_bf16(Bt[n][k], At[m][k], acc[ai][bj][m][n], 0, 0, 0); __builtin_amdgcn_s_setprio(0); } while (0)
#define PG8_WAIT_V(n) asm volatile("s_waitcnt vmcnt(" #n ")" ::: "memory")
#define PG8_WAIT_L(n) asm volatile("s_waitcnt lgkmcnt(" #n ")" ::: "memory")
#define PG8_BAR __builtin_amdgcn_s_barrier()
#define PG8_SCHED __builtin_amdgcn_sched_barrier(0)
    Unit cur, nxt; int ui = 0;
    if (!S.next(0, cur)) return;
    f32x4 acc[2][2][4][2];
#pragma unroll
    for (int a = 0; a < 2; ++a)
#pragma unroll
        for (int b = 0; b < 2; ++b)
#pragma unroll
            for (int m = 0; m < 4; ++m)
#pragma unroll
                for (int n = 0; n < 2; ++n) acc[a][b][m][n] = (f32x4){0.f, 0.f, 0.f, 0.f};
    bf16x8 At[4][2], B0[2][2], B1[2][2];
    const char* cA = (const char*)g.A + (size_t)cur.pm * tstep; const char* cB = (const char*)g.Bt + (size_t)cur.pn * tstep;
    S.a_ready(cur);
    if constexpr (SP2) {
        PG8_STAGE(PG8_SB(0, 0), cB, voffB); PG8_STAGE(PG8_SB(0, 1), cB + hstep, voffB); PG8_STAGE(PG8_SA(0, 0), cA, voffA); PG8_STAGE(PG8_SA(0, 1), cA + hstep, voffA);
        if (wr == 1) PG8_BAR;
        PG8_WAIT_V(2); PG8_BAR;
        PG8_STAGE(PG8_SB(1, 0), cB + kstep, voffB); PG8_STAGE(PG8_SA(1, 0), cA + kstep, voffA); PG8_STAGE(PG8_SB(1, 1), cB + hstep + kstep, voffB);
        PG8_WAIT_V(6); PG8_BAR;
    } else {
        PG8_STAGE(PG8_SB(0, 0), cB, voffB); PG8_STAGE(PG8_SA(0, 0), cA, voffA); PG8_STAGE(PG8_SB(0, 1), cB + hstep, voffB); PG8_STAGE(PG8_SA(0, 1), cA + hstep, voffA);
        if (wr == 1) PG8_BAR;
        PG8_WAIT_V(4); PG8_BAR;
        PG8_STAGE(PG8_SB(1, 0), cB + kstep, voffB); PG8_STAGE(PG8_SA(1, 0), cA + kstep, voffA); PG8_STAGE(PG8_SB(1, 1), cB + hstep + kstep, voffB);
        PG8_WAIT_V(6); PG8_BAR;
    }
    for (;;) {
        const bool has_next = S.next(ui + 1, nxt);
        const char* nA = has_next ? (const char*)g.A + (size_t)nxt.pm * tstep : cA; const char* nB = has_next ? (const char*)g.Bt + (size_t)nxt.pn * tstep : cB;
        for (int t = 0; t < nt; t += 2) {
            const bool last = (t == nt - 2);
            const char* a1 = cA + (size_t)(t + 1) * kstep;
            const char* a2 = last ? nA : cA + (size_t)(t + 2) * kstep; const char* b2 = last ? nB : cB + (size_t)(t + 2) * kstep;
            const char* a3 = a2 + kstep; const char* b3 = b2 + kstep;
            if (last && has_next) S.a_ready(nxt);
            if constexpr (SP2) {
            PG8_LDB(B0, 0, 0); PG8_LDB(B1, 0, 1); PG8_SCHED; PG8_LDA(At, 0, 0); PG8_STAGE(PG8_SA(1, 1), a1 + hstep, voffA);
            PG8_WAIT_V(8); PG8_WAIT_L(0); PG8_BAR; PG8_MMA(0, 0, At, B0); PG8_MMA(0, 1, At, B1); PG8_BAR; PG8_SCHED;
            PG8_LDA(At, 0, 1); PG8_STAGE(PG8_SB(0, 0), b2, voffB); PG8_STAGE(PG8_SB(0, 1), b2 + hstep, voffB); PG8_STAGE(PG8_SA(0, 0), a2, voffA);
            PG8_WAIT_V(8); PG8_WAIT_L(0); PG8_BAR; PG8_MMA(1, 0, At, B0); PG8_MMA(1, 1, At, B1); PG8_BAR; PG8_SCHED;
            PG8_LDB(B0, 1, 0); PG8_LDB(B1, 1, 1); PG8_SCHED; PG8_LDA(At, 1, 0); PG8_STAGE(PG8_SA(0, 1), a2 + hstep, voffA);
            PG8_WAIT_V(8); PG8_WAIT_L(0); PG8_BAR; PG8_MMA(0, 0, At, B0); PG8_MMA(0, 1, At, B1); PG8_BAR; PG8_SCHED;
            PG8_LDA(At, 1, 1); PG8_STAGE(PG8_SB(1, 0), b3, voffB); PG8_STAGE(PG8_SB(1, 1), b3 + hstep, voffB); PG8_STAGE(PG8_SA(1, 0), a3, voffA);
            PG8_WAIT_V(8); PG8_WAIT_L(0); PG8_BAR; PG8_MMA(1, 0, At, B0); PG8_MMA(1, 1, At, B1); PG8_BAR; PG8_SCHED;
            } else {
            PG8_LDB(B0, 0, 0); PG8_SCHED; PG8_LDA(At, 0, 0); PG8_STAGE(PG8_SA(1, 1), a1 + hstep, voffA);
            PG8_WAIT_L(8); PG8_BAR; PG8_WAIT_L(0); PG8_MMA(0, 0, At, B0); PG8_BAR; PG8_SCHED;
            PG8_LDB(B1, 0, 1); PG8_STAGE(PG8_SB(0, 0), b2, voffB);
            PG8_BAR; PG8_WAIT_L(0); PG8_MMA(0, 1, At, B1); PG8_BAR;
            PG8_LDA(At, 0, 1); PG8_STAGE(PG8_SA(0, 0), a2, voffA);
            PG8_BAR; PG8_WAIT_L(0); PG8_MMA(1, 0, At, B0); PG8_BAR; PG8_SCHED;
            PG8_STAGE(PG8_SB(0, 1), b2 + hstep, voffB);
            PG8_WAIT_V(6); PG8_BAR; PG8_MMA(1, 1, At, B1); PG8_BAR;
            PG8_LDB(B0, 1, 0); PG8_SCHED; PG8_LDA(At, 1, 0); PG8_STAGE(PG8_SA(0, 1), a2 + hstep, voffA);
            PG8_WAIT_L(8); PG8_BAR; PG8_WAIT_L(0); PG8_MMA(0, 0, At, B0); PG8_BAR; PG8_SCHED;
            PG8_LDB(B1, 1, 1); PG8_STAGE(PG8_SB(1, 0), b3, voffB);
            PG8_BAR; PG8_WAIT_L(0); PG8_MMA(0, 1, At, B1); PG8_BAR;
            PG8_LDA(At, 1, 1); PG8_STAGE(PG8_SA(1, 0), a3, voffA);
            PG8_BAR; PG8_WAIT_L(0); PG8_MMA(1, 0, At, B0); PG8_BAR; PG8_SCHED;
            PG8_STAGE(PG8_SB(1, 1), b3 + hstep, voffB);
            PG8_WAIT_V(6); PG8_BAR; PG8_MMA(1, 1, At, B1); PG8_BAR;
            }
        }
        if constexpr (ALIGN_EPI) { if (wr == 0) PG8_BAR; }
        if constexpr (!Epi::AFTER_DRAIN) { E(acc, cur, wr, wc, fr, fq); S.done(cur); }
        if (!has_next) break;
#pragma unroll
        for (int a = 0; a < 2; ++a)
#pragma unroll
            for (int b = 0; b < 2; ++b)
#pragma unroll
                for (int m = 0; m < 4; ++m)
#pragma unroll
                    for (int n = 0; n < 2; ++n) acc[a][b][m][n] = (f32x4){0.f, 0.f, 0.f, 0.f};
        cur = nxt; cA = nA; cB = nB; ++ui;
        if constexpr (ALIGN_EPI) { if (wr == 1) PG8_BAR; }
    }
    PG8_WAIT_V(0);
    if constexpr (!ALIGN_EPI) { if (wr == 0) PG8_BAR; }
    PG8_BAR;
    if constexpr (Epi::AFTER_DRAIN) { E.fused(acc, cur, wr, wc, fr, fq, lds, wid, lane); S.done(cur); }
#undef PG8_SA
#undef PG8_SB
#undef PG8_STAGE
#undef PG8_LDA
#undef PG8_LDB
#undef PG8_MMA
#undef PG8_WAIT_V
#undef PG8_WAIT_L
#undef PG8_BAR
#undef PG8_SCHED
}
}
#define XB_TMO      128
#define XB_XCNT(j)  (256  + 64 * (j))
#define XB_XSUB(j)  (1280 + 64 * (j))
#define XB_XGEN(j)  (2304 + 64 * (j))
#define XB_TOP      3328
#define XB_TOPGEN   3392
#define XCD_BAR_WORDS 3456
#define XB_SPIN_CAP (1u << 22)
#define LAS __attribute__((address_space(3)))
__device__ __forceinline__ unsigned xb_ld(unsigned* p)              { return __hip_atomic_load(p, __ATOMIC_RELAXED, __HIP_MEMORY_SCOPE_AGENT); }
__device__ __forceinline__ unsigned xb_add(unsigned* p, unsigned v) { return __hip_atomic_fetch_add(p, v, __ATOMIC_RELAXED, __HIP_MEMORY_SCOPE_AGENT); }
__device__ __forceinline__ unsigned xb_xcc_id() { return (unsigned)__builtin_amdgcn_s_getreg((3 << 11) | 20) & 0xFu; }
#define XB_SPIN(cond, bar) do { unsigned _sp = 0; while (cond) { __builtin_amdgcn_s_sleep(1); \
    if ((++_sp & 255u) == 0u) { if (xb_ld(&(bar)[XB_TMO])) break; if (_sp > XB_SPIN_CAP) { atomicAdd(&(bar)[XB_TMO], 1u); break; } } } } while (0)
struct XcdBarrier { unsigned* bar; unsigned x; volatile LAS unsigned* st; };
#define XB_TID0() (hw_tid((LAS unsigned char*)b.st - LDS_MISC) == 0)
__device__ __forceinline__ XcdBarrier xcd_barrier_post(unsigned* bar, volatile LAS unsigned* st) {
    XcdBarrier b; b.bar = bar; b.x = xb_xcc_id(); b.st = st;
    if (XB_TID0()) (void)xb_add(&bar[XB_XCNT(b.x)], 1u);
    return b;
}
__device__ __forceinline__ void xcd_barrier_complete(unsigned* bar, unsigned x, unsigned& nloc, unsigned& nx) {
    const unsigned G = gridDim.x * gridDim.y * gridDim.z;
    unsigned sum, cnt, mine, sp = 0u;
    for (;;) {
        sum = 0u; cnt = 0u; mine = 0u;
#pragma unroll
        for (unsigned j = 0; j < 16; ++j) { const unsigned c = xb_ld(&bar[XB_XCNT(j)]); sum += c; cnt += (c > 0u) ? 1u : 0u; mine = (j == x) ? c : mine; }
        if (sum == G) break;
        __builtin_amdgcn_s_sleep(1);
        if ((++sp & 255u) == 0u) { if (xb_ld(&bar[XB_TMO])) break; if (sp > XB_SPIN_CAP) { atomicAdd(&bar[XB_TMO], 1u); break; } }
    }
    nloc = mine > 0u ? mine : 1u; nx = cnt > 0u ? cnt : 1u;
}
__device__ __forceinline__ void xcd_barrier(const XcdBarrier& b) {
    asm volatile("s_waitcnt vmcnt(0)" ::: "memory");
    __syncthreads();
    if (XB_TID0()) {
        unsigned* bar = b.bar;
        __builtin_amdgcn_s_waitcnt(0);
        unsigned nloc = b.st[0], nx = b.st[1];
        if (nloc == 0u) { xcd_barrier_complete(bar, b.x, nloc, nx); b.st[0] = nloc; b.st[1] = nx; }
        const unsigned old = xb_add(&bar[XB_XSUB(b.x)], 1u);
        const unsigned gen = old / nloc;
        if (old + 1u == (gen + 1u) * nloc) {
            __builtin_amdgcn_fence(__ATOMIC_RELEASE, "agent");
            asm volatile("s_waitcnt vmcnt(0)" ::: "memory");
            const unsigned og = xb_add(&bar[XB_TOP], 1u);
            const unsigned tg = og / nx;
            if (og + 1u == (tg + 1u) * nx) xb_add(&bar[XB_TOPGEN], 1u);
            else XB_SPIN(xb_ld(&bar[XB_TOPGEN]) == tg, bar);
            __builtin_amdgcn_fence(__ATOMIC_ACQUIRE, "agent");
            xb_add(&bar[XB_XGEN(b.x)], 1u);
            asm volatile("s_waitcnt vmcnt(0)" ::: "memory");
        } else {
            XB_SPIN(xb_ld(&bar[XB_XGEN(b.x)]) == gen, bar);
            __builtin_amdgcn_fence(__ATOMIC_ACQUIRE, "agent");
            asm volatile("s_waitcnt vmcnt(0)" ::: "memory");
        }
    }
    __syncthreads();
}

constexpr int LDS_PTAB = LDS_MISC + 64;
__device__ __forceinline__ P load_params(LAS unsigned char* ldsb) {
    unsigned off = LDS_PTAB; asm volatile("" : "+s"(off) :: "memory");
    LAS const unsigned long long* t = (LAS const unsigned long long*)(ldsb + off);
    union { P p; const void* v[NPTR]; } u;
#pragma unroll
    for (int i = 0; i < NPTR; ++i) { const unsigned long long x = t[i]; const unsigned lo = __builtin_amdgcn_readfirstlane((unsigned)x), hi = __builtin_amdgcn_readfirstlane((unsigned)(x >> 32));
        u.v[i] = (const void*)(__attribute__((address_space(1))) const void*)(((unsigned long long)hi << 32) | lo); }
    return u.p;
}
#define PH(F, n) do { const unsigned _t = (unsigned)hw_tid((LAS unsigned char*)lds); const long _G = (long)gridDim.x; const P _q = load_params((LAS unsigned char*)lds); \
        for (long _i = ((long)blockIdx.x + _G * (_t >> 6)) * 64 + (_t & 63); _i < (long)(n); _i += _G * NTHREADS) F(_q, L, _i); } while (0)
#define PH_MID(F, n, ROT) do { const unsigned _t = (unsigned)hw_tid((LAS unsigned char*)lds); const long _G = (long)gridDim.x, _b0 = _G / 8, _nb = _G - _b0 - _G / 4, _lb = (long)blockIdx.x - _b0; \
        const P _q = load_params((LAS unsigned char*)lds); \
        if (_lb >= 0 && _lb < _nb) for (long _i = (_lb + _nb * (long)(((_t >> 6) + (ROT)) & 7u)) * 64 + (_t & 63); _i < (long)(n); _i += _nb * NTHREADS) F(_q, L, _i); } while (0)
#define BLK(F) do { __syncthreads(); const P _q = load_params((LAS unsigned char*)lds); F(_q, L, (ldsp_t)lds); } while (0)
#define GRID_BAR() xcd_barrier(bar)
#define XIN_NEEDED(L) ((L) == 0)
#define GEMM_IN() do { const P p = load_params((LAS unsigned char*)lds); pg8::Gemm g{xbp(p), wintp(p, L), NP, D_INP, D}; pg8::StaticOrder S; S.init(NP, D_INP, (int)gridDim.x, (int)blockIdx.x); \
        pg8::EpiInBf16 E{ubase(p), p.ws + W_RSTD, L == 0 ? (const float*)nullptr : p.ws + W_XN}; pg8::gemm_phase<pg8::EpiInBf16, pg8::StaticOrder, true, true>((LAS unsigned char*)lds, g, S, E); } while (0)
#define GEMM_OUT() do { const P p = load_params((LAS unsigned char*)lds); pg8::Gemm g{mixb(p), wouttp(p, L), NP, D, D}; pg8::StaticOrder S; S.init(NP, D, (int)gridDim.x, (int)blockIdx.x); \
        pg8::EpiOutF32 E{L == DEPTH - 1 ? p.out + O_Y : p.ws + W_Y0, L == 0 ? p.x_prompt : p.ws + W_Y0, L == 0 ? p.x_sample : p.ws + W_Y0 + (size_t)NP * D, L + 1 < DEPTH ? xbp(p) : (bf16_t*)nullptr, p.ws + W_XN}; \
        pg8::gemm_phase<pg8::EpiOutF32, pg8::StaticOrder, true, true>((LAS unsigned char*)lds, g, S, E); } while (0)
__global__ void __launch_bounds__(NTHREADS, 2) mega(P parg, unsigned* barw) {
    extern __shared__ __attribute__((aligned(16))) unsigned char lds[];
    if (threadIdx.x < 16) ((LAS unsigned*)((LAS unsigned char*)lds + LDS_MISC))[threadIdx.x] = 0u;
    if ((threadIdx.x & 63) == 0) { const unsigned hw = (unsigned)__builtin_amdgcn_s_getreg((5 << 11) | 4) & 63u; *(LAS int*)((LAS unsigned char*)lds + LDS_WTAB + hw * 4) = (int)(threadIdx.x >> 6); }
    if (threadIdx.x == 64) { union { P p; unsigned long long v[NPTR]; } u; u.p = parg;
#pragma unroll
        for (int i = 0; i < NPTR; ++i) ((LAS unsigned long long*)((LAS unsigned char*)lds + LDS_PTAB))[i] = u.v[i]; }
    __syncthreads();
    XcdBarrier bar = xcd_barrier_post(barw, (volatile LAS unsigned*)((LAS unsigned char*)lds + LDS_MISC));
#endif
    { const int L = 0; BLK(bphase_prep_win); PH(k_prep_wout, (long)DEPTH * D * (D / 8)); PH(k_prep_wc, (long)DEPTH * 32768); PH(k_cmp_pad, (long)NSEQ * NCPAD * 2); BLK(bphase_cmp_bias); }
    static_assert(DEPTH == 2, "layer program is instantiated per layer");
    LAYER_PROGRAM(0)
    LAYER_PROGRAM(1)
}

#ifndef CPU_EMU
extern "C" void kernel_launch(void* const* d_in, const int* in_sizes, int n_in, void* d_out, int out_size, void* d_ws, size_t ws_size, hipStream_t stream) {
    P p = make_params(d_in, d_out, d_ws);
    static int grid = 0;
    if (!grid) {
        int dev = 0, cus = 0, per_cu = 0;
        hipGetDevice(&dev);
        hipDeviceGetAttribute(&cus, hipDeviceAttributeMultiprocessorCount, dev);
        (void)hipFuncSetAttribute((const void*)mega, hipFuncAttributeMaxDynamicSharedMemorySize, LDS_BYTES);
        (void)hipOccupancyMaxActiveBlocksPerMultiprocessor(&per_cu, (const void*)mega, NTHREADS, LDS_BYTES);
        (void)hipGetLastError(); grid = cus;
    }
    unsigned* barw = (unsigned*)((char*)d_ws + WB_BAR);
    hipMemsetAsync(barw, 0, 16384, stream);
    hipLaunchKernelGGL(mega, dim3(grid), dim3(NTHREADS), LDS_BYTES, stream, p, barw);
}
#endif
```

```cpp
#ifndef CPU_EMU
#include <hip/hip_runtime.h>
#define HD __host__ __device__ __forceinline__
#else
#include "emu.h"
#define HD inline
#endif
#include <stdint.h>
#include <math.h>

#ifndef CFG_BATCH
#define CFG_BATCH 4
#define CFG_SEQ 4096
#define CFG_DEC_BATCH 32
#define CFG_PAST_LEN 8192
#endif
constexpr int BATCH = CFG_BATCH, SEQ = CFG_SEQ, DEC_BATCH = CFG_DEC_BATCH, DEC_SEQ = 8, PAST_LEN = CFG_PAST_LEN, DEPTH = 2;
constexpr int D = 1024, D_IN = 3888, PAGE = 128;
constexpr int NP = BATCH * SEQ, NS = DEC_BATCH * DEC_SEQ, NT = NP + NS, NSEQ = BATCH + DEC_BATCH;
constexpr int NPAGES = PAST_LEN / PAGE, NUSED = DEC_BATCH * NPAGES, NPOOL = NUSED + (NUSED / 4 > 1 ? NUSED / 4 : 1);
constexpr int WIN = 512, WKEEP_P = SEQ < WIN ? SEQ : WIN, WKEEP_S = PAST_LEN < WIN ? PAST_LEN : WIN;
constexpr int NCP = SEQ / 16 - 1, NCS = (PAST_LEN + DEC_SEQ) / 16 - 1, NCMAX = NCP > NCS ? NCP : NCS;
constexpr int NSELP = (SEQ + 63) / 64, NSELS = (PAST_LEN + DEC_SEQ + 63) / 64, NSELMAX = NSELP > NSELS ? NSELP : NSELS;
constexpr int C_GQ = 0, C_GK = 128, C_GV = 256, C_GZ = 512, C_NQ = 768, C_NKV = 1280, C_NZ = 2048, C_MQK = 2560, C_MV = 3072, C_MO = 3328, C_MZ = 3584,
              C_GA = 3840, C_NG = 3856, C_MIF = 3880;
HD int orig_col(int n) { return n < 512 ? n : n < 768 ? 528 + (n - 512) : n < 1280 ? 784 + (n - 768) : n < 2048 ? 1296 + (n - 1280) : n < 2560 ? 2088 + (n - 2048) : n < 3072 ? 2600 + (n - 2560)
    : n < 3328 ? 3112 + (n - 3072) : n < 3584 ? 3376 + (n - 3328) : n < 3840 ? 3632 + (n - 3584) : n < 3856 ? 512 + (n - 3840) : n < 3880 ? 2064 + (n - 3856) : 3368 + (n - 3880); }
constexpr size_t O_Y = 0;
constexpr size_t O_PROWS = O_Y + (size_t)NT * D;
constexpr size_t O_SROWS = O_PROWS + (size_t)DEPTH * NP * 512;
constexpr size_t O_PWIN = O_SROWS + (size_t)DEPTH * NS * 512;
constexpr size_t O_SWIN = O_PWIN + (size_t)DEPTH * BATCH * WKEEP_P * 256;
constexpr size_t O_PGLA = O_SWIN + (size_t)DEPTH * DEC_BATCH * WKEEP_S * 256;
constexpr size_t O_SGLA = O_PGLA + (size_t)DEPTH * BATCH * 4 * 32 * 64;
constexpr size_t O_PC = O_SGLA + (size_t)DEPTH * DEC_BATCH * 4 * 32 * 64;
constexpr size_t O_SC = O_PC + (size_t)DEPTH * BATCH * 4 * 64 * 64;
constexpr size_t O_PN = O_SC + (size_t)DEPTH * DEC_BATCH * 4 * 64 * 64;
constexpr size_t O_SN = O_PN + (size_t)DEPTH * BATCH * 4 * 64;
constexpr size_t O_PM = O_SN + (size_t)DEPTH * DEC_BATCH * 4 * 64;
constexpr size_t O_SM = O_PM + (size_t)DEPTH * BATCH * 4;
constexpr size_t O_PCONV = O_SM + (size_t)DEPTH * DEC_BATCH * 4;
constexpr size_t O_SCONV = O_PCONV + (size_t)DEPTH * BATCH * 3 * 512;
constexpr size_t O_END = O_SCONV + (size_t)DEPTH * DEC_BATCH * 3 * 512;
constexpr size_t W_RSTD = 0;
constexpr size_t W_XN = W_RSTD + NT;
constexpr size_t W_U = W_XN + (size_t)NT * D;
constexpr size_t W_QN = W_U + (size_t)NT * D_IN;
constexpr size_t W_QR = W_QN + (size_t)NT * 512;
constexpr size_t W_WINNEW = W_QR + (size_t)NT * 512;
constexpr size_t W_LOGA = W_WINNEW + (size_t)NT * 256;
constexpr size_t W_MQ = W_LOGA + (size_t)NT * 128;
constexpr size_t W_MK = W_MQ + (size_t)NT * 256;
constexpr size_t W_CBIAS = W_MK + (size_t)NT * 256;
constexpr size_t W_KC = W_CBIAS + 256;
constexpr size_t W_VC = W_KC + (size_t)NSEQ * NCMAX * 128;
constexpr size_t W_PCMP = W_VC + (size_t)NSEQ * NCMAX * 128;
constexpr size_t W_OCMP = W_PCMP + (size_t)NT * 8 * NCMAX;
constexpr size_t W_IMP = W_OCMP + (size_t)NT * 512;
constexpr size_t W_SEL = W_IMP + (size_t)NT * 2 * NSELMAX;
constexpr size_t W_PSLC = W_SEL + (size_t)NT * 2 * 16;
constexpr size_t W_OSLC = W_PSLC + (size_t)NT * 8 * 1024;
constexpr size_t W_PWIN = W_OSLC + (size_t)NT * 512;
constexpr size_t W_OWIN = W_PWIN + (size_t)NT * 8 * 512;
constexpr size_t W_OA = W_OWIN + (size_t)NT * 512;
constexpr size_t W_H = W_OA + (size_t)NT * 256;
constexpr size_t W_MIXED = W_H + (size_t)NT * 256;
constexpr size_t W_Y0 = W_MIXED + (size_t)NT * D;
constexpr size_t W_DEN = W_Y0 + (size_t)NT * D;
constexpr size_t W_MT = W_DEN + (size_t)NT * 4;
constexpr size_t W_GSLOC = W_MT + (size_t)NT * 4;
constexpr size_t W_GSBL = W_GSLOC + (size_t)BATCH * 4 * (SEQ / 64) * 2048;
constexpr size_t W_MCLOC = W_GSBL + (size_t)BATCH * 4 * (SEQ / 64) * 32;
constexpr size_t W_MFG = W_MCLOC + (size_t)BATCH * 4 * (SEQ / 64) * 4160;
constexpr size_t W_SPART = W_MFG + (size_t)BATCH * 4 * (SEQ / 64) * 4;
constexpr size_t W_SLIST = W_SPART + (size_t)DEC_BATCH * 2 * 40 * 32 * 68;
constexpr size_t W_END = W_SLIST + (size_t)DEC_BATCH * 2 * 2 * 112;
constexpr int NTP = (NT + 255) / 256 * 256, D_INP = 4096;
constexpr size_t WB_WINT = (W_END * 4 + 255) / 256 * 256;
constexpr size_t WB_WOUTT = WB_WINT + (size_t)DEPTH * D_INP * D * 2;
constexpr size_t WB_XB = WB_WOUTT + (size_t)DEPTH * D * D * 2;
constexpr size_t WB_MIXB = WB_XB + (size_t)NTP * D * 2;
constexpr int NQT = SEQ / 64, NCPADP = (NCP + 63) / 64 * 64, NCPADS = (NCS + 63) / 64 * 64, NCPAD = NCPADP > NCPADS ? NCPADP : NCPADS;
constexpr size_t WB_QNB = WB_MIXB + (size_t)NTP * D * 2;
constexpr size_t WB_QRB = WB_QNB + (size_t)NT * 512 * 2;
constexpr size_t WB_KSB = WB_QRB + (size_t)NT * 512 * 2;
constexpr size_t WB_VST = WB_KSB + (size_t)BATCH * 2 * SEQ * 64 * 2;
constexpr size_t WB_KWB = WB_VST + (size_t)BATCH * 2 * SEQ * 64 * 2;
constexpr size_t WB_VWT = WB_KWB + (size_t)BATCH * 2 * SEQ * 64 * 2;
constexpr size_t WB_KCB = WB_VWT + (size_t)BATCH * 2 * SEQ * 64 * 2;
constexpr size_t WB_VCT = WB_KCB + (size_t)NSEQ * 2 * NCPAD * 64 * 2;
constexpr size_t WB_WCT = WB_VCT + (size_t)NSEQ * 2 * NCPAD * 64 * 2;
constexpr int U_LD = D_INP;
constexpr size_t WB_UB = WB_WCT + (size_t)DEPTH * 2 * 64 * 2048 * 2;
constexpr size_t WB_BAR = WB_UB + (size_t)NTP * U_LD * 2;
constexpr size_t WB_END = WB_BAR + 16384;
typedef unsigned short bf16_t;
#ifdef CPU_EMU
HD bf16_t f2bf(float f) { unsigned u = __builtin_bit_cast(unsigned, f); return (bf16_t)((u + 0x7fffu + ((u >> 16) & 1u)) >> 16); }
#else
__device__ __forceinline__ bf16_t f2bf(float f) { const __bf16 h = (__bf16)f; return __builtin_bit_cast(bf16_t, h); }
__host__ inline bf16_t f2bf_host(float f) { unsigned u = __builtin_bit_cast(unsigned, f); return (bf16_t)((u + 0x7fffu + ((u >> 16) & 1u)) >> 16); }
#endif
HD float bf2f(bf16_t h) { return __builtin_bit_cast(float, (unsigned)h << 16); }

constexpr int NPTR = 26;
struct P {
    const float *x_prompt, *x_sample, *cache, *state_win, *state_gla, *state_C, *state_n, *state_m, *state_conv;
    const int* page_table;
    const float *norm_g, *w_in, *w_out, *gla_w_gate, *gla_b_gate, *gla_norm_g, *q_norm_g, *k_norm_g, *cmp_pos, *cmp_w,
        *conv_w, *conv_b, *gate_b, *ml_norm_g;
    float* out;
    float* ws;
};
static_assert(sizeof(P) == NPTR * 8, "P is a table of NPTR pointers");

HD int seq_of_row(int r) { return r < NP ? r / SEQ : BATCH + (r - NP) / DEC_SEQ; }
HD int seq_row0(int s) { return s < BATCH ? s * SEQ : NP + (s - BATCH) * DEC_SEQ; }
HD int seq_len(int s) { return s < BATCH ? SEQ : DEC_SEQ; }
HD int seq_pos0(int s) { return s < BATCH ? 0 : PAST_LEN; }
HD int seq_ncmp(int s) { return s < BATCH ? NCP : NCS; }
HD int seq_nsel(int s) { return s < BATCH ? NSELP : NSELS; }
HD int row_pos(int r) { return r < NP ? r % SEQ : PAST_LEN + (r - NP) % DEC_SEQ; }
HD const float* xrow(const P& p, int L, int r) {
    if (L == 0) return r < NP ? p.x_prompt + (size_t)r * D : p.x_sample + (size_t)(r - NP) * D;
    return p.ws + W_Y0 + (size_t)r * D;
}
HD float* new_rows_ptr(const P& p, int L, int r) {
    return r < NP ? p.out + O_PROWS + ((size_t)L * NP + r) * 512 : p.out + O_SROWS + ((size_t)L * NS + (r - NP)) * 512;
}
HD const float* hist(const P& p, int L, int s, int r, int slot, int g) {
    if (s < BATCH) return p.out + O_PROWS + ((size_t)L * NP + (size_t)s * SEQ + r) * 512 + slot * 128 + g * 64;
    const int b = s - BATCH;
    if (r < PAST_LEN) { const int page = p.page_table[b * NPAGES + r / PAGE];
        return p.cache + (((size_t)L * NPOOL + page) * PAGE + (r % PAGE)) * 512 + slot * 128 + g * 64; }
    return p.out + O_SROWS + ((size_t)L * NS + b * DEC_SEQ + (r - PAST_LEN)) * 512 + slot * 128 + g * 64;
}
HD const float* ctxp(const P& p, int L, int s, int kpos, int kv, int g) {
    if (s < BATCH) return p.ws + W_WINNEW + ((size_t)s * SEQ + kpos) * 256 + kv * 128 + g * 64;
    const int b = s - BATCH;
    if (kpos < PAST_LEN) return p.state_win + (((size_t)L * DEC_BATCH + b) * WKEEP_S + (kpos - (PAST_LEN - WKEEP_S))) * 256 + kv * 128 + g * 64;
    return p.ws + W_WINNEW + ((size_t)NP + b * DEC_SEQ + (kpos - PAST_LEN)) * 256 + kv * 128 + g * 64;
}
HD bf16_t* wsb(const P& p, size_t off) { return (bf16_t*)((char*)p.ws + off); }
struct URow { const bf16_t* q; HD float operator[](size_t i) const { return bf2f(q[i]); } HD URow operator+(size_t k) const { return URow{q + k}; } };
HD bf16_t* ubase(const P& p) { return (bf16_t*)((char*)p.ws + WB_UB); }
HD URow urow(const P& p, int r) { return URow{ubase(p) + (size_t)r * U_LD}; }
HD bf16_t* mixb(const P& p) { return (bf16_t*)((char*)p.ws + WB_MIXB); }
HD bf16_t* xbp(const P& p) { return (bf16_t*)((char*)p.ws + WB_XB); }
HD bf16_t* wintp(const P& p, int L) { return (bf16_t*)((char*)p.ws + WB_WINT) + (size_t)L * D_INP * D; }
HD bf16_t* wouttp(const P& p, int L) { return (bf16_t*)((char*)p.ws + WB_WOUTT) + (size_t)L * D * D; }
#ifdef CPU_EMU
HD float EXPF(float x) { return expf(x); }
HD float RCPF(float x) { return 1.0f / x; }
HD float RSQRTF(float x) { return 1.0f / sqrtf(x); }
HD float LOG1PF(float e) { return log1pf(e); }
HD void SINCOSF(float a, float& sn, float& c) { sn = sinf(a); c = cosf(a); }
#else
__device__ __forceinline__ float EXPF(float x) { return __builtin_amdgcn_exp2f(x * 1.4426950408889634f); }
__device__ __forceinline__ float RCPF(float x) { return __builtin_amdgcn_rcpf(x); }
__device__ __forceinline__ float RSQRTF(float x) { return __builtin_amdgcn_rsqf(x); }
__device__ __forceinline__ float LOG1PF(float e) { return __builtin_amdgcn_logf(1.0f + e) * 0.6931471805599453f; }
__device__ __forceinline__ void SINCOSF(float a, float& sn, float& c) { const float fr = __builtin_amdgcn_fractf(a * 0.15915494309189535f); sn = __builtin_amdgcn_sinf(fr); c = __builtin_amdgcn_cosf(fr); }
#endif
HD float log_sigmoidf(float x) { return fminf(x, 0.f) - LOG1PF(EXPF(-fabsf(x))); }
HD float sigmoidf_(float x) { return RCPF(1.f + EXPF(-x)); }
HD float siluf(float x) { return x * RCPF(1.f + EXPF(-x)); }
HD float rope_inv(int i) { return EXPF(-logf(500000.0f) * (float)i * 2.0f / 16.0f); }

HD void k_prep_win(const P& p, int L, long it) {
    const int n = (int)(it % D_INP), kc = (int)((it / D_INP) % (D / 8)), L2 = (int)(it / ((long)D_INP * (D / 8)));
    bf16_t* o = wintp(p, L2) + (size_t)n * D + kc * 8;
    for (int j = 0; j < 8; ++j) { const int k = kc * 8 + j; o[j] = n < D_IN ? f2bf(p.norm_g[L2 * D + k] * p.w_in[((size_t)L2 * D + k) * D_IN + orig_col(n)]) : (bf16_t)0; }
}
HD void k_prep_wout(const P& p, int L, long it) {
    const int n = (int)(it % D), kc = (int)((it / D) % (D / 8)), L2 = (int)(it / ((long)D * (D / 8)));
    bf16_t* o = wouttp(p, L2) + (size_t)n * D + kc * 8;
    for (int j = 0; j < 8; ++j) { const int k = kc * 8 + j; o[j] = f2bf(p.w_out[((size_t)L2 * D + k) * D + n]); }
}
HD void k_gemm_in_emu(const P& p, int L, long it) {
    const int r = (int)(it / D_IN), c = (int)(it % D_IN);
    const bf16_t* a = xbp(p) + (size_t)r * D; const bf16_t* w = wintp(p, L) + (size_t)c * D; float s = 0.f;
    for (int k = 0; k < D; ++k) s += bf2f(a[k]) * bf2f(w[k]);
    ubase(p)[(size_t)r * U_LD + c] = f2bf(s * p.ws[W_RSTD + r]);
}
HD void k_win_copy(const P& p, int L, long it) {
    constexpr int NOLD = WKEEP_S - DEC_SEQ > 0 ? WKEEP_S - DEC_SEQ : 0;
    const int e = (int)(it % 256); const long q = it / 256; const int i = (int)(q % NOLD), b = (int)(q / NOLD);
    p.out[O_SWIN + (((size_t)L * DEC_BATCH + b) * WKEEP_S + i) * 256 + e] = p.state_win[(((size_t)L * DEC_BATCH + b) * WKEEP_S + i + DEC_SEQ) * 256 + e];
}
HD float conv_xp(const P& p, int L, int s, int tp, int ch) {
    if (tp < 3) return s < BATCH ? 0.f : p.state_conv[(((size_t)L * DEC_BATCH + (s - BATCH)) * 3 + tp) * 512 + ch];
    return urow(p, seq_row0(s) + tp - 3)[C_MQK + ch];
}
HD void k_conv_out(const P& p, int L, long it) {
    const int ch = (int)(it % 512), i = (int)((it / 512) % 3), s = (int)(it / 1536);
    const float v = conv_xp(p, L, s, seq_len(s) + i, ch);
    if (s < BATCH) p.out[O_PCONV + (((size_t)L * BATCH + s) * 3 + i) * 512 + ch] = v;
    else p.out[O_SCONV + (((size_t)L * DEC_BATCH + (s - BATCH)) * 3 + i) * 512 + ch] = v;
}
HD void k_cmp_sum(const P& p, int L, long it) {
    const int e = (int)(it % 64), g = (int)((it / 64) % 2), kv = (int)((it / 128) % 2); const long q = it / 256; const int j = (int)(q % NCMAX), s = (int)(q / NCMAX);
    if (j >= seq_ncmp(s)) return;
    float a = p.ws[W_CBIAS + kv * 64 + e];
    const float* w = p.cmp_w + ((size_t)(L * 2 + kv)) * 2048 * 64 + e;
    for (int t = 0; t < 32; ++t) { const float* x = hist(p, L, s, 16 * j + t, kv, g);
        for (int d = 0; d < 64; ++d) a += x[d] * w[(size_t)(t * 64 + d) * 64]; }
    p.ws[(kv ? W_VC : W_KC) + ((size_t)s * NCMAX + j) * 128 + g * 64 + e] = a;
}
HD void k_kc_norm(const P& p, int L, long it) {
    const int g = (int)(it % 2); const long q = it / 2; const int j = (int)(q % NCPAD), s = (int)(q / NCPAD);
    bf16_t* kb = wsb(p, WB_KCB) + (((size_t)s * 2 + g) * NCPAD + j) * 64; bf16_t* vt = wsb(p, WB_VCT) + (((size_t)s * 2 + g) * (NCPAD / 64) + j / 64) * 4096 + (j % 64);
    if (j >= seq_ncmp(s)) { for (int d = 0; d < 64; ++d) { kb[d] = 0; vt[(size_t)d * 64] = 0; } return; }
    float* k = p.ws + W_KC + ((size_t)s * NCMAX + j) * 128 + g * 64; const float* v = p.ws + W_VC + ((size_t)s * NCMAX + j) * 128 + g * 64; float ss = 0.f;
    for (int d = 0; d < 64; ++d) ss += k[d] * k[d];
    const float rs = RSQRTF(ss / 64 + 1e-6f);
    for (int d = 0; d < 64; ++d) { k[d] = k[d] * rs * p.k_norm_g[(L * 3 + 0) * 64 + d]; kb[d] = f2bf(k[d]); vt[(size_t)d * 64] = f2bf(v[d]); }
}
HD void k_cmp_score(const P& p, int L, long it) {
    const int n = (int)(it % NCMAX); const long q = it / NCMAX; const int h = (int)(q % 8), r = NP + (int)(q / 8), s = seq_of_row(r), pos = row_pos(r);
    if (n >= seq_ncmp(s)) return;
    float v = -INFINITY;
    if (16 * n + 31 <= pos) { const float* qq = p.ws + W_QN + (size_t)r * 512 + h * 64; const float* k = p.ws + W_KC + ((size_t)s * NCMAX + n) * 128 + (h / 4) * 64;
        float a = 0.f; for (int d = 0; d < 64; ++d) a += qq[d] * k[d]; v = a * 0.125f; }
    p.ws[W_PCMP + (size_t)NP * 8 * NCMAX + it] = v;
}
HD void softmax_row(float* x, int n) {
    float m = -INFINITY; for (int i = 0; i < n; ++i) m = fmaxf(m, x[i]);
    if (m == -INFINITY) m = 0.f;
    float sum = 0.f; for (int i = 0; i < n; ++i) { const float e = (x[i] == -INFINITY) ? 0.f : EXPF(x[i] - m); x[i] = e; sum += e; }
    const float inv = 1.0f / fmaxf(sum, 1e-30f);
    for (int i = 0; i < n; ++i) x[i] *= inv;
}
HD void k_cmp_softmax(const P& p, int L, long it) { const int r = NP + (int)(it / 8); softmax_row(p.ws + W_PCMP + ((size_t)NP * 8 + it) * NCMAX, seq_ncmp(seq_of_row(r))); }
HD void k_cmp_out(const P& p, int L, long it) {
    const int d = (int)(it % 64), h = (int)((it / 64) % 8), r = NP + (int)(it / 512), s = seq_of_row(r), nc = seq_ncmp(s);
    const float* pr = p.ws + W_PCMP + ((size_t)r * 8 + h) * NCMAX; const float* v = p.ws + W_VC + (size_t)s * NCMAX * 128 + (h / 4) * 64 + d; float a = 0.f;
    for (int n = 0; n < nc; ++n) a += pr[n] * v[(size_t)n * 128];
    p.ws[W_OCMP + (size_t)NP * 512 + it] = a;
}
HD void k_imp(const P& p, int L, long it) {
    const int j = (int)(it % NSELMAX), g = (int)((it / NSELMAX) % 2), r = NP + (int)(it / (2 * NSELMAX)), s = seq_of_row(r), nc = seq_ncmp(s);
    if (j >= seq_nsel(s)) return;
    float a = 0.f;
    for (int h = 0; h < 4; ++h) { const float* pr = p.ws + W_PCMP + ((size_t)r * 8 + g * 4 + h) * NCMAX;
        for (int q = 0; q < 5; ++q) { const int i = 4 * j - 1 + q; if (i >= 0 && i < nc) a += pr[i] * ((q == 0 || q == 4) ? 1.f : 2.f); } }
    p.ws[W_IMP + (size_t)NP * 2 * NSELMAX + it] = a;
}
HD void k_topk(const P& p, int L, long it) {
    const int g = (int)(it % 2), r = NP + (int)(it / 2), s = seq_of_row(r), pos = row_pos(r), ns = seq_nsel(s), cur = pos / 64;
    const float* imp = p.ws + W_IMP + ((size_t)r * 2 + g) * NSELMAX; int* sel = (int*)(p.ws + W_SEL) + ((size_t)r * 2 + g) * 16;
    unsigned long long c0 = 0, c1 = 0, c2 = 0, c3 = 0;
    const int nk = ns < 16 ? ns : 16;
    for (int k = 0; k < 16; ++k) {
        int bj = -1; float bs = 0.f;
        if (k < nk) for (int j = 0; j < ns; ++j) {
            const unsigned long long bit = 1ull << (j & 63); const unsigned long long cw = (j < 64) ? c0 : (j < 128) ? c1 : (j < 192) ? c2 : c3;
            if (cw & bit) continue;
            const bool forced = (j == 0) || (j == cur) || (j == cur - 1), valid = j * 64 <= pos;
            const float sc = forced ? INFINITY : (valid ? imp[j] : -INFINITY);
            if (bj < 0 || sc > bs) { bj = j; bs = sc; }
        }
        sel[k] = bj;
        if (bj >= 0) { const unsigned long long bit = 1ull << (bj & 63); if (bj < 64) c0 |= bit; else if (bj < 128) c1 |= bit; else if (bj < 192) c2 |= bit; else c3 |= bit; }
    }
}
HD void k_slc_score(const P& p, int L, long it) {
    const int ks = (int)(it % 1024), h = (int)((it / 1024) % 8), r = NP + (int)(it / 8192), s = seq_of_row(r), pos = row_pos(r), g = h / 4;
    const int blk = ((const int*)(p.ws + W_SEL))[((size_t)r * 2 + g) * 16 + ks / 64];
    float v = -INFINITY;
    if (blk >= 0) { const int kpos = blk * 64 + (ks % 64);
        if (kpos <= pos) { const float* qq = p.ws + W_QR + (size_t)r * 512 + h * 64; const float* k = hist(p, L, s, kpos, 2, g);
            float a = 0.f; for (int d = 0; d < 64; ++d) a += qq[d] * k[d]; v = a * 0.125f; } }
    p.ws[W_PSLC + (size_t)NP * 8 * 1024 + it] = v;
}
HD void k_slc_softmax(const P& p, int L, long it) { softmax_row(p.ws + W_PSLC + ((size_t)NP * 8 + it) * 1024, 1024); }
HD void k_slc_out(const P& p, int L, long it) {
    const int d = (int)(it % 64), h = (int)((it / 64) % 8), r = NP + (int)(it / 512), s = seq_of_row(r), g = h / 4;
    const float* pr = p.ws + W_PSLC + ((size_t)r * 8 + h) * 1024; const int* sel = (const int*)(p.ws + W_SEL) + ((size_t)r * 2 + g) * 16; float a = 0.f;
    for (int ks = 0; ks < 1024; ++ks) { const float pv = pr[ks]; if (pv != 0.f) a += pv * hist(p, L, s, sel[ks / 64] * 64 + (ks % 64), 3, g)[d]; }
    p.ws[W_OSLC + (size_t)NP * 512 + it] = a;
}
HD int seq_first_pos(int s) { return s < BATCH ? 0 : PAST_LEN - WKEEP_S; }
HD void k_win_score(const P& p, int L, long it) {
    const int w = (int)(it % 512), h = (int)((it / 512) % 8), r = NP + (int)(it / 4096), s = seq_of_row(r), pos = row_pos(r), g = h / 4, kpos = pos - w;
    float v = -INFINITY;
    if (kpos >= seq_first_pos(s)) { const float* qq = p.ws + W_QR + (size_t)r * 512 + h * 64; const float* k = ctxp(p, L, s, kpos, 0, g);
        float a = 0.f; for (int d = 0; d < 64; ++d) a += qq[d] * k[d]; v = a * 0.125f; }
    p.ws[W_PWIN + (size_t)NP * 8 * 512 + it] = v;
}
HD void k_win_softmax(const P& p, int L, long it) { softmax_row(p.ws + W_PWIN + ((size_t)NP * 8 + it) * 512, 512); }
HD void k_win_out(const P& p, int L, long it) {
    const int d = (int)(it % 64), h = (int)((it / 64) % 8), r = NP + (int)(it / 512), s = seq_of_row(r), pos = row_pos(r), g = h / 4;
    const float* pr = p.ws + W_PWIN + ((size_t)r * 8 + h) * 512; float a = 0.f;
    for (int w = 0; w < 512; ++w) { const float pv = pr[w]; if (pv != 0.f) a += pv * ctxp(p, L, s, pos - w, 1, g)[d]; }
    p.ws[W_OWIN + (size_t)NP * 512 + it] = a;
}
HD void k_gla(const P& p, int L, long it) {
    const int dv = (int)(it % 64), h = (int)((it / 64) % 4), s = BATCH + (int)(it / 256), r0 = seq_row0(s), len = seq_len(s);
    float S[32];
#pragma unroll
    for (int k = 0; k < 32; ++k) S[k] = s < BATCH ? 0.f : p.state_gla[((((size_t)L * DEC_BATCH + (s - BATCH)) * 4 + h) * 32 + k) * 64 + dv];
    for (int t = 0; t < len; ++t) {
        const int r = r0 + t; const URow u = urow(p, r); const float* la = p.ws + W_LOGA + (size_t)r * 128 + h * 32;
        const float v = u[C_GV + h * 64 + dv]; float o = 0.f;
#pragma unroll
        for (int k = 0; k < 32; ++k) { S[k] = EXPF(la[k]) * S[k] + u[C_GK + h * 32 + k] * v; o += u[C_GQ + h * 32 + k] * S[k]; }
        p.ws[W_OA + (size_t)r * 256 + h * 64 + dv] = o * 0.17677669529663687f;
    }
    float* so = s < BATCH ? p.out + O_PGLA + (((size_t)L * BATCH + s) * 4 + h) * 2048 : p.out + O_SGLA + (((size_t)L * DEC_BATCH + (s - BATCH)) * 4 + h) * 2048;
#pragma unroll
    for (int k = 0; k < 32; ++k) so[k * 64 + dv] = S[k];
}
HD void k_mlstm(const P& p, int L, long it) {
    const int e = (int)(it % 65), h = (int)((it / 65) % 4), s = BATCH + (int)(it / 260), r0 = seq_row0(s), len = seq_len(s);
    float C[64]; float m = s < BATCH ? 0.f : p.state_m[((size_t)L * DEC_BATCH + (s - BATCH)) * 4 + h];
#pragma unroll
    for (int d = 0; d < 64; ++d) C[d] = s < BATCH ? 0.f : (e < 64 ? p.state_C[((((size_t)L * DEC_BATCH + (s - BATCH)) * 4 + h) * 64 + e) * 64 + d]
                                                                  : p.state_n[(((size_t)L * DEC_BATCH + (s - BATCH)) * 4 + h) * 64 + d]);
    const float bi = p.gate_b[(L * 2 + 0) * 4 + h], bf = p.gate_b[(L * 2 + 1) * 4 + h];
    for (int t = 0; t < len; ++t) {
        const int r = r0 + t; const URow u = urow(p, r); const float* q = p.ws + W_MQ + (size_t)r * 256 + h * 64; const float* k = p.ws + W_MK + (size_t)r * 256 + h * 64;
        const float ip = u[C_MIF + h] + bi, lf = log_sigmoidf(u[C_MIF + 4 + h] + bf), mn = fmaxf(lf + m, ip), fp = EXPF(lf + m - mn), iq = EXPF(ip - mn), v = e < 64 ? u[C_MV + h * 64 + e] : 1.0f;
        float num = 0.f;
#pragma unroll
        for (int d = 0; d < 64; ++d) { C[d] = fp * C[d] + iq * v * k[d]; num += C[d] * q[d]; }
        m = mn;
        if (e < 64) p.ws[W_H + (size_t)r * 256 + h * 64 + e] = num;
        else { p.ws[W_DEN + (size_t)r * 4 + h] = num; p.ws[W_MT + (size_t)r * 4 + h] = m; }
    }
    const size_t sb = s < BATCH ? ((size_t)L * BATCH + s) * 4 + h : ((size_t)L * DEC_BATCH + (s - BATCH)) * 4 + h;
    float* co = e < 64 ? p.out + (s < BATCH ? O_PC : O_SC) + (sb * 64 + e) * 64 : p.out + (s < BATCH ? O_PN : O_SN) + sb * 64;
#pragma unroll
    for (int d = 0; d < 64; ++d) co[d] = C[d];
    if (e == 64) p.out[(s < BATCH ? O_PM : O_SM) + sb] = m;
}
HD void k_mix_gla(const P& p, int L, long it) {
    const int h = (int)(it % 4), r = NP + (int)(it / 4); const float* o = p.ws + W_OA + (size_t)r * 256 + h * 64; float ss = 0.f;
    for (int d = 0; d < 64; ++d) ss += o[d] * o[d];
    const float rs = RSQRTF(ss / 64 + 1e-6f); const URow u = urow(p, r) + (C_GZ + h * 64);
    for (int d = 0; d < 64; ++d) mixb(p)[(size_t)r * D + h * 64 + d] = f2bf(o[d] * rs * p.gla_norm_g[L * 64 + d] * siluf(u[d]));
}
HD void k_mix_ml(const P& p, int L, long it) {
    const int h = (int)(it % 4), r = NP + (int)(it / 4); const float* o = p.ws + W_H + (size_t)r * 256 + h * 64; float ss = 0.f;
    const float dinv = 1.0f / fmaxf(fabsf(p.ws[W_DEN + (size_t)NP * 4 + it]), EXPF(-p.ws[W_MT + (size_t)NP * 4 + it]));
    for (int d = 0; d < 64; ++d) ss += o[d] * dinv * o[d] * dinv;
    const float rs = dinv / sqrtf(ss / 64 + 1e-6f); const URow u = urow(p, r);
    for (int d = 0; d < 64; ++d) mixb(p)[(size_t)r * D + 768 + h * 64 + d] = f2bf(o[d] * rs * p.ml_norm_g[L * 64 + d] * sigmoidf_(u[C_MO + h * 64 + d]) * siluf(u[C_MZ + h * 64 + d]));
}
HD void k_gemm_out_emu(const P& p, int L, long it) {
    const int r = (int)(it / D), c = (int)(it % D);
    const bf16_t* a = mixb(p) + (size_t)r * D; const bf16_t* w = wouttp(p, L) + (size_t)c * D; float s = 0.f;
    for (int k = 0; k < D; ++k) s += bf2f(a[k]) * bf2f(w[k]);
    (L == DEPTH - 1 ? p.out + O_Y : p.ws + W_Y0)[it] = xrow(p, L, r)[c] + s;
}

#ifdef CPU_EMU
#define LDSQ
#define EXP2F(x) exp2f(x)
#else
#define LDSQ __attribute__((address_space(3)))
#define EXP2F(x) __builtin_amdgcn_exp2f(x)
typedef short bf16x8 __attribute__((ext_vector_type(8)));
typedef short bf16x4 __attribute__((ext_vector_type(4)));
typedef float f32x4 __attribute__((ext_vector_type(4)));
typedef float f32x16 __attribute__((ext_vector_type(16)));
#endif
typedef LDSQ unsigned char* ldsp_t;
#ifdef CPU_EMU
#define LDS_ADDF(ptr, v) (*(ptr) += (v))
#else
#define LDS_ADDF(ptr, v) ((void)__hip_atomic_fetch_add((ptr), (v), __ATOMIC_RELAXED, __HIP_MEMORY_SCOPE_WORKGROUP))
#endif
#ifdef CPU_EMU
#define LDS_BARRIER() emu_syncthreads()
#define SCHED_FENCE() do {} while (0)
#else
#define SCHED_FENCE() __builtin_amdgcn_sched_barrier(0)
#define LDS_BARRIER() asm volatile("s_waitcnt lgkmcnt(0)\n\ts_barrier" ::: "memory")
#endif
#ifndef CPU_EMU
__device__ __forceinline__ int lane_fresh() { int l = (int)__builtin_amdgcn_mbcnt_hi(~0u, __builtin_amdgcn_mbcnt_lo(~0u, 0u)); asm volatile("" : "+v"(l)); return l; }
__device__ __forceinline__ int xl_shfl_xor_i(int v, int m) {
    if (m == 1) return __builtin_amdgcn_update_dpp(0, v, 0xB1, 0xF, 0xF, true);
    if (m == 2) return __builtin_amdgcn_update_dpp(0, v, 0x4E, 0xF, 0xF, true);
    if (m == 7) return __builtin_amdgcn_update_dpp(0, v, 0x141, 0xF, 0xF, true);
    if (m == 15) return __builtin_amdgcn_update_dpp(0, v, 0x140, 0xF, 0xF, true);
    return __builtin_amdgcn_ds_bpermute((lane_fresh() ^ m) << 2, v);
}
__device__ __forceinline__ float xl_shfl_xor(float v, int m) { return __builtin_bit_cast(float, xl_shfl_xor_i(__builtin_bit_cast(int, v), m)); }
__device__ __forceinline__ int xl_shfl_xor(int v, int m) { return xl_shfl_xor_i(v, m); }
__device__ __forceinline__ float xl_shfl(float v, int src) { return __builtin_bit_cast(float, __builtin_amdgcn_ds_bpermute(src << 2, __builtin_bit_cast(int, v))); }
__device__ __forceinline__ int xl_shfl(int v, int src) { return __builtin_amdgcn_ds_bpermute(src << 2, v); }
#define __shfl_xor xl_shfl_xor
#define __shfl xl_shfl
#endif
constexpr int LDS_MISC = 8 * 19456;
#ifdef CPU_EMU
#define opaque_tid() ((int)threadIdx.x)
#define RFL(x) (x)
HD int opaque_i(int v) { return v; }
#else
__device__ __forceinline__ int opaque_i(int v) { asm volatile("" : "+v"(v)); return v; }
constexpr int LDS_WTAB = LDS_MISC + 320;
__device__ __forceinline__ int hw_tid(__attribute__((address_space(3))) unsigned char* ldsb) {
    const unsigned hw = (unsigned)__builtin_amdgcn_s_getreg((5 << 11) | 4) & 63u;
    const int wv = __builtin_amdgcn_readfirstlane(*(__attribute__((address_space(3))) const int*)(ldsb + LDS_WTAB + hw * 4));
    unsigned t = (unsigned)wv * 64u + __builtin_amdgcn_mbcnt_hi(~0u, __builtin_amdgcn_mbcnt_lo(~0u, 0u)); asm volatile("" : "+v"(t)); return (int)t;
}
#define RFL(x) __builtin_amdgcn_readfirstlane(x)
#define opaque_tid() hw_tid(lds)
#endif
constexpr int NTHREADS = 512;
constexpr int KT_STRIDE = 144, VT_STRIDE = 136, KT_BYTES = 64 * KT_STRIDE, VT_BYTES = 64 * VT_STRIDE;
constexpr int NSA_KT = 0, NSA_VT = 3 * KT_BYTES, NSA_IMP = NSA_VT + 3 * VT_BYTES, NSA_MASK = NSA_IMP + 8 * 8 * 64 * 4, NSA_END = NSA_MASK + 8 * 8 * 8;
constexpr int NSA_COMB = 73728;
constexpr float C2LOG = 0.125f * 1.4426950408889634f;
constexpr float NEG_BIG = -1.0e30f;

typedef unsigned u32x4_t __attribute__((ext_vector_type(4)));
#ifdef CPU_EMU
HD float rlane(float v, int i) { return __shfl(v, i); }
#else
__device__ __forceinline__ float rlane(float v, int i) { return __builtin_bit_cast(float, __builtin_amdgcn_readlane(__builtin_bit_cast(int, v), i)); }
#endif
#ifdef CPU_EMU
HD unsigned pack2bf(float lo, float hi) { return (unsigned)f2bf(lo) | ((unsigned)f2bf(hi) << 16); }
#else
typedef __bf16 hwbf16x2_t __attribute__((ext_vector_type(2)));
typedef float hwf32x2_t __attribute__((ext_vector_type(2)));
__device__ __forceinline__ unsigned pack2bf(float lo, float hi) { const hwf32x2_t v = {lo, hi}; const hwbf16x2_t b = __builtin_convertvector(v, hwbf16x2_t); return __builtin_bit_cast(unsigned, b); }
#endif
HD void ld8f(const float* q, float (&f)[8]) { const f32x4 a = *(const f32x4*)q, b = *(const f32x4*)(q + 4); f[0] = a[0]; f[1] = a[1]; f[2] = a[2]; f[3] = a[3]; f[4] = b[0]; f[5] = b[1]; f[6] = b[2]; f[7] = b[3]; }
struct AttnSt { f32x16 o0, o1; float m, l; };
template <bool MASK> HD bool softmax_tile(f32x16& s0, f32x16& s1, int lim2, int lo2, bool sel, AttnSt& st, bf16x8 (&pf)[4], float& alpha) {
    float tmax = NEG_BIG;
    if (MASK) {
#pragma unroll
        for (int r = 0; r < 16; ++r) { const int kc = (r & 3) + 8 * (r >> 2);
            s0[r] = (kc <= lim2 && kc > lo2) ? s0[r] : NEG_BIG; s1[r] = (kc + 32 <= lim2 && kc + 32 > lo2) ? s1[r] : NEG_BIG; tmax = fmaxf(tmax, fmaxf(s0[r], s1[r])); }
    } else {
#pragma unroll
        for (int r = 0; r < 16; ++r) tmax = fmaxf(tmax, fmaxf(s0[r], s1[r]));
        tmax = sel ? tmax : NEG_BIG;
    }
    tmax = fmaxf(tmax, __shfl_xor(tmax, 32));
    const float mn = fmaxf(st.m, tmax); const bool any = __ballot(mn > st.m) != 0ull;
    alpha = 1.0f;
    if (any) { alpha = EXP2F(st.m - mn); st.l *= alpha; }
    st.m = mn;
    float ls = 0.f;
#pragma unroll
    for (int r = 0; r < 16; ++r) { float p0 = EXP2F(s0[r] - mn), p1 = EXP2F(s1[r] - mn);
        if (MASK) { p0 = s0[r] > -1.0e29f ? p0 : 0.f; p1 = s1[r] > -1.0e29f ? p1 : 0.f; }
        s0[r] = p0; s1[r] = p1; ls += p0 + p1; }
    u32x4_t w0, w1, w2, w3;
#pragma unroll
    for (int i = 0; i < 4; ++i) { w0[i] = pack2bf(s0[2 * i], s0[2 * i + 1]); w1[i] = pack2bf(s0[8 + 2 * i], s0[8 + 2 * i + 1]); w2[i] = pack2bf(s1[2 * i], s1[2 * i + 1]); w3[i] = pack2bf(s1[8 + 2 * i], s1[8 + 2 * i + 1]); }
    if (!MASK) { const unsigned km = sel ? 0xffffffffu : 0u; w0 &= km; w1 &= km; w2 &= km; w3 &= km; ls = sel ? ls : 0.f; }
    st.l += ls;
    pf[0] = __builtin_bit_cast(bf16x8, w0); pf[1] = __builtin_bit_cast(bf16x8, w1); pf[2] = __builtin_bit_cast(bf16x8, w2); pf[3] = __builtin_bit_cast(bf16x8, w3);
    return any;
}
HD void attn_init(AttnSt& s) { for (int r = 0; r < 16; ++r) { s.o0[r] = 0.f; s.o1[r] = 0.f; } s.m = NEG_BIG; s.l = 0.f; }
HD short bfbits(float f) { return (short)f2bf(f); }
template <bool IMP, bool MASK>
HD void attn_tile(ldsp_t lds, int buf, const bf16x8 (&qf)[4], float mb, int lim2, int lo2, bool sel, AttnSt& st, f32x16& i0, f32x16& i1, int ntile64, int c, int hi) {
    f32x16 s0, s1;
    for (int r = 0; r < 16; ++r) { s0[r] = -mb; s1[r] = -mb; }
    const ldsp_t kt = lds + NSA_KT + buf * KT_BYTES + c * KT_STRIDE + hi * 16;
#pragma unroll
    for (int ks = 0; ks < 4; ++ks) {
        const bf16x8 k0 = *(const LDSQ bf16x8*)(kt + ks * 32), k1 = *(const LDSQ bf16x8*)(kt + 32 * KT_STRIDE + ks * 32);
        s0 = __builtin_amdgcn_mfma_f32_32x32x16_bf16(k0, qf[ks], s0, 0, 0, 0);
        s1 = __builtin_amdgcn_mfma_f32_32x32x16_bf16(k1, qf[ks], s1, 0, 0, 0);
    }
    float ls = 0.f;
#pragma unroll
    for (int r = 0; r < 16; ++r) { float p0 = EXP2F(s0[r]), p1 = EXP2F(s1[r]);
        if (MASK) { const int kc = (r & 3) + 8 * (r >> 2); p0 = (kc <= lim2 && kc > lo2) ? p0 : 0.f; p1 = (kc + 32 <= lim2 && kc + 32 > lo2) ? p1 : 0.f; }
        s0[r] = p0; s1[r] = p1; ls += p0 + p1; }
    u32x4_t w0, w1, w2, w3;
#pragma unroll
    for (int i = 0; i < 4; ++i) { w0[i] = pack2bf(s0[2 * i], s0[2 * i + 1]); w1[i] = pack2bf(s0[8 + 2 * i], s0[8 + 2 * i + 1]); w2[i] = pack2bf(s1[2 * i], s1[2 * i + 1]); w3[i] = pack2bf(s1[8 + 2 * i], s1[8 + 2 * i + 1]); }
    if (!MASK) { const unsigned km = sel ? 0xffffffffu : 0u; w0 &= km; w1 &= km; w2 &= km; w3 &= km; ls = sel ? ls : 0.f; }
    st.l += ls;
    bf16x8 pf[4];
    pf[0] = __builtin_bit_cast(bf16x8, w0); pf[1] = __builtin_bit_cast(bf16x8, w1); pf[2] = __builtin_bit_cast(bf16x8, w2); pf[3] = __builtin_bit_cast(bf16x8, w3);
    const ldsp_t vt = lds + NSA_VT + buf * VT_BYTES + c * VT_STRIDE + hi * 8;
#pragma unroll
    for (int ks = 0; ks < 4; ++ks) {
        const bf16x4 a0 = *(const LDSQ bf16x4*)(vt + ks * 32), a1 = *(const LDSQ bf16x4*)(vt + ks * 32 + 16);
        const bf16x4 b0 = *(const LDSQ bf16x4*)(vt + 32 * VT_STRIDE + ks * 32), b1 = *(const LDSQ bf16x4*)(vt + 32 * VT_STRIDE + ks * 32 + 16);
        bf16x8 v0, v1;
#pragma unroll
        for (int j = 0; j < 4; ++j) { v0[j] = a0[j]; v0[4 + j] = a1[j]; v1[j] = b0[j]; v1[4 + j] = b1[j]; }
        st.o0 = __builtin_amdgcn_mfma_f32_32x32x16_bf16(v0, pf[ks], st.o0, 0, 0, 0);
        st.o1 = __builtin_amdgcn_mfma_f32_32x32x16_bf16(v1, pf[ks], st.o1, 0, 0, 0);
        if (IMP) {
#pragma unroll
            for (int jt = 0; jt < 2; ++jt) { const int base = ntile64 * 64 + 16 * ks + 4 * hi - 4 * (jt * 32 + c); bf16x8 af;
#pragma unroll
                for (int jj = 0; jj < 8; ++jj) { const int dl = base + 8 * (jj >> 2) + (jj & 3); af[jj] = (dl == -1 || dl == 3) ? (short)0x3F80 : ((dl >= 0 && dl <= 2) ? (short)0x4000 : (short)0); }
                if (jt == 0) i0 = __builtin_amdgcn_mfma_f32_32x32x16_bf16(af, pf[ks], i0, 0, 0, 0); else i1 = __builtin_amdgcn_mfma_f32_32x32x16_bf16(af, pf[ks], i1, 0, 0, 0); }
        }
    }
}
HD void imp_tile(ldsp_t lds, int buf, const bf16x8 (&qf)[4], float mb, float inv, int lim2, f32x16& i0, f32x16& i1, int ntile64, int c, int hi) {
    f32x16 s0, s1;
    for (int r = 0; r < 16; ++r) { s0[r] = -mb; s1[r] = -mb; }
    const ldsp_t kt = lds + NSA_KT + buf * KT_BYTES + c * KT_STRIDE + hi * 16;
#pragma unroll
    for (int ks = 0; ks < 4; ++ks) {
        const bf16x8 k0 = *(const LDSQ bf16x8*)(kt + ks * 32), k1 = *(const LDSQ bf16x8*)(kt + 32 * KT_STRIDE + ks * 32);
        s0 = __builtin_amdgcn_mfma_f32_32x32x16_bf16(k0, qf[ks], s0, 0, 0, 0);
        s1 = __builtin_amdgcn_mfma_f32_32x32x16_bf16(k1, qf[ks], s1, 0, 0, 0);
    }
#pragma unroll
    for (int r = 0; r < 16; ++r) { const int kc = (r & 3) + 8 * (r >> 2); s0[r] = kc <= lim2 ? EXP2F(s0[r]) * inv : 0.f; s1[r] = kc + 32 <= lim2 ? EXP2F(s1[r]) * inv : 0.f; }
    u32x4_t w0, w1, w2, w3;
#pragma unroll
    for (int i = 0; i < 4; ++i) { w0[i] = pack2bf(s0[2 * i], s0[2 * i + 1]); w1[i] = pack2bf(s0[8 + 2 * i], s0[8 + 2 * i + 1]); w2[i] = pack2bf(s1[2 * i], s1[2 * i + 1]); w3[i] = pack2bf(s1[8 + 2 * i], s1[8 + 2 * i + 1]); }
    bf16x8 pf[4];
    pf[0] = __builtin_bit_cast(bf16x8, w0); pf[1] = __builtin_bit_cast(bf16x8, w1); pf[2] = __builtin_bit_cast(bf16x8, w2); pf[3] = __builtin_bit_cast(bf16x8, w3);
#pragma unroll
    for (int ks = 0; ks < 4; ++ks)
#pragma unroll
        for (int jt = 0; jt < 2; ++jt) { const int base = ntile64 * 64 + 16 * ks + 4 * hi - 4 * (jt * 32 + c); bf16x8 af;
            const int jlo = 16 * ntile64 + 4 * ks;
            if (jlo + 4 < 32 * jt || jlo > 32 * jt + 31) continue;
#pragma unroll
            for (int jj = 0; jj < 8; ++jj) { const int dl = base + 8 * (jj >> 2) + (jj & 3); af[jj] = (dl == -1 || dl == 3) ? (short)0x3F80 : ((dl >= 0 && dl <= 2) ? (short)0x4000 : (short)0); }
            if (jt == 0) i0 = __builtin_amdgcn_mfma_f32_32x32x16_bf16(af, pf[ks], i0, 0, 0, 0); else i1 = __builtin_amdgcn_mfma_f32_32x32x16_bf16(af, pf[ks], i1, 0, 0, 0); }
}
HD float score_bound(const bf16x8 (&qf)[4], const float* kgain, int lane) {
    float ss = 0.f;
#pragma unroll
    for (int ks = 0; ks < 4; ++ks)
#pragma unroll
        for (int j = 0; j < 8; ++j) { const float v = bf2f((bf16_t)qf[ks][j]); ss += v * v; }
    ss += __shfl_xor(ss, 32);
    float g = fabsf(kgain[lane]);
    g = fmaxf(g, __shfl_xor(g, 1)); g = fmaxf(g, __shfl_xor(g, 2)); g = fmaxf(g, __shfl_xor(g, 7)); g = fmaxf(g, __shfl_xor(g, 15));
    g = fmaxf(fmaxf(rlane(g, 0), rlane(g, 16)), fmaxf(rlane(g, 32), rlane(g, 48)));
    return sqrtf(ss) * 8.0f * g * 1.01f + 0.01f;
}
HD void tile_load(const bf16_t* k, const bf16_t* vt, int tid, bf16x8& rk, bf16x8& rv) { rk = *(const bf16x8*)(k + tid * 8); rv = *(const bf16x8*)(vt + tid * 8); }
HD void tile_store(ldsp_t lds, int buf, int tid, const bf16x8& rk, const bf16x8& rv) {
    const int row = tid >> 3, ch = tid & 7;
    *(LDSQ bf16x8*)(lds + NSA_KT + buf * KT_BYTES + row * KT_STRIDE + ch * 16) = rk;
    bf16x4 a, b;
    for (int j = 0; j < 4; ++j) { a[j] = rv[j]; b[j] = rv[4 + j]; }
    *(LDSQ bf16x4*)(lds + NSA_VT + buf * VT_BYTES + row * VT_STRIDE + ch * 16) = a; *(LDSQ bf16x4*)(lds + NSA_VT + buf * VT_BYTES + row * VT_STRIDE + ch * 16 + 8) = b;
}
HD void qk_tile(ldsp_t lds, int buf, const bf16x8 (&qf)[4], float mb, f32x16& s0, f32x16& s1, int c, int hi) {
    for (int r = 0; r < 16; ++r) { s0[r] = -mb; s1[r] = -mb; }
    const ldsp_t kt = lds + NSA_KT + buf * KT_BYTES + c * KT_STRIDE + hi * 16;
#pragma unroll
    for (int ks = 0; ks < 4; ++ks) {
        const bf16x8 k0 = *(const LDSQ bf16x8*)(kt + ks * 32), k1 = *(const LDSQ bf16x8*)(kt + 32 * KT_STRIDE + ks * 32);
        s0 = __builtin_amdgcn_mfma_f32_32x32x16_bf16(k0, qf[ks], s0, 0, 0, 0);
        s1 = __builtin_amdgcn_mfma_f32_32x32x16_bf16(k1, qf[ks], s1, 0, 0, 0);
    }
}
template <bool MASK> HD void sm_tile(f32x16& s0, f32x16& s1, int lim2, int lo2, bool sel, float& l, bf16x8 (&pf)[4]) {
    float ls = 0.f;
#pragma unroll
    for (int r = 0; r < 16; ++r) { float p0 = EXP2F(s0[r]), p1 = EXP2F(s1[r]);
        if (MASK) { const int kc = (r & 3) + 8 * (r >> 2); p0 = (kc <= lim2 && kc > lo2) ? p0 : 0.f; p1 = (kc + 32 <= lim2 && kc + 32 > lo2) ? p1 : 0.f; }
        s0[r] = p0; s1[r] = p1; ls += p0 + p1; }
    u32x4_t w0, w1, w2, w3;
#pragma unroll
    for (int i = 0; i < 4; ++i) { w0[i] = pack2bf(s0[2 * i], s0[2 * i + 1]); w1[i] = pack2bf(s0[8 + 2 * i], s0[8 + 2 * i + 1]); w2[i] = pack2bf(s1[2 * i], s1[2 * i + 1]); w3[i] = pack2bf(s1[8 + 2 * i], s1[8 + 2 * i + 1]); }
    if (!MASK) { const unsigned km = sel ? 0xffffffffu : 0u; w0 &= km; w1 &= km; w2 &= km; w3 &= km; ls = sel ? ls : 0.f; }
    l += ls;
    pf[0] = __builtin_bit_cast(bf16x8, w0); pf[1] = __builtin_bit_cast(bf16x8, w1); pf[2] = __builtin_bit_cast(bf16x8, w2); pf[3] = __builtin_bit_cast(bf16x8, w3);
}
HD void pv_tile(ldsp_t lds, int buf, const bf16x8 (&pf)[4], AttnSt& st, int c, int hi) {
    const ldsp_t vt = lds + NSA_VT + buf * VT_BYTES + c * VT_STRIDE + hi * 8;
#pragma unroll
    for (int ks = 0; ks < 4; ++ks) {
        const bf16x4 a0 = *(const LDSQ bf16x4*)(vt + ks * 32), a1 = *(const LDSQ bf16x4*)(vt + ks * 32 + 16);
        const bf16x4 b0 = *(const LDSQ bf16x4*)(vt + 32 * VT_STRIDE + ks * 32), b1 = *(const LDSQ bf16x4*)(vt + 32 * VT_STRIDE + ks * 32 + 16);
        bf16x8 v0, v1;
#pragma unroll
        for (int j = 0; j < 4; ++j) { v0[j] = a0[j]; v0[4 + j] = a1[j]; v1[j] = b0[j]; v1[4 + j] = b1[j]; }
        st.o0 = __builtin_amdgcn_mfma_f32_32x32x16_bf16(v0, pf[ks], st.o0, 0, 0, 0);
        st.o1 = __builtin_amdgcn_mfma_f32_32x32x16_bf16(v1, pf[ks], st.o1, 0, 0, 0);
    }
}
struct TilePipe { bf16x8 k1, v1; };
HD void tp_start(ldsp_t lds, int tid, const bf16_t* kb, const bf16_t* vb, int nt, TilePipe& tp) {
    bf16x8 rk, rv, rk2, rv2; tile_load(kb, vb, tid, rk, rv);
    if (1 < nt) tile_load(kb + 4096, vb + 4096, tid, rk2, rv2);
    if (2 < nt) tile_load(kb + 2 * 4096, vb + 2 * 4096, tid, tp.k1, tp.v1);
    tile_store(lds, 0, tid, rk, rv);
    if (1 < nt) tile_store(lds, 1, tid, rk2, rv2);
    LDS_BARRIER();
}
HD void tp_advance(ldsp_t lds, int tid, const bf16_t* kb, const bf16_t* vb, int t, int nt, TilePipe& tp) {
    if (t + 2 < nt) tile_store(lds, (t + 2) % 3, tid, tp.k1, tp.v1);
    if (t + 3 < nt) tile_load(kb + (size_t)(t + 3) * 4096, vb + (size_t)(t + 3) * 4096, tid, tp.k1, tp.v1);
    LDS_BARRIER();
}
struct TileParm { bool masked, sel, skip; int lim2, lo2; };
struct BranchCtx { int qt, pos, hi, nlim, nlim_min, kb0; unsigned long long selmask; };
template <int BR> HD TileParm tile_parm(int t, const BranchCtx& x) {
    TileParm q; q.skip = false; q.sel = true; q.lo2 = -100000; q.lim2 = 0;
    if (BR == 0) { q.masked = !(64 * t + 63 <= x.nlim_min); q.lim2 = x.nlim - 64 * t - 4 * x.hi; }
    else if (BR == 1) { const bool s = ((x.selmask >> t) & 1ull) != 0ull; q.masked = t >= x.qt;
        if (q.masked) q.lim2 = s ? x.pos - 64 * t - 4 * x.hi : -100000; else { q.sel = s; q.skip = __ballot(s) == 0ull; } }
    else { const int kbx = x.kb0 + t, off = 64 * kbx + 4 * x.hi; q.masked = !(kbx < x.qt && kbx > x.qt - 8); q.lim2 = x.pos - off; q.lo2 = x.pos - WIN - off; }
    return q;
}
HD void sm_pv(ldsp_t lds, int buf, const TileParm& q, f32x16& s0, f32x16& s1, AttnSt& st, int c, int hi) {
    bf16x8 pf[4];
    if (q.masked) sm_tile<true>(s0, s1, q.lim2, q.lo2, true, st.l, pf); else sm_tile<false>(s0, s1, 0, 0, q.sel, st.l, pf);
    pv_tile(lds, buf, pf, st, c, hi);
}
HD void qk_sm_int(ldsp_t lds, int bufn, const bf16x8 (&qf)[4], float mb, f32x16& n0, f32x16& n1, f32x16& c0, f32x16& c1, bool sel, float& l, bf16x8 (&pf)[4], int c, int hi) {
    for (int r = 0; r < 16; ++r) { n0[r] = -mb; n1[r] = -mb; }
    const ldsp_t kt = lds + NSA_KT + bufn * KT_BYTES + c * KT_STRIDE + hi * 16;
    bf16x8 k0 = *(const LDSQ bf16x8*)(kt), k1 = *(const LDSQ bf16x8*)(kt + 32 * KT_STRIDE);
    float ls = 0.f;
#pragma unroll
    for (int ks = 0; ks < 4; ++ks) {
        n0 = __builtin_amdgcn_mfma_f32_32x32x16_bf16(k0, qf[ks], n0, 0, 0, 0);
        n1 = __builtin_amdgcn_mfma_f32_32x32x16_bf16(k1, qf[ks], n1, 0, 0, 0);
        if (ks < 3) { k0 = *(const LDSQ bf16x8*)(kt + (ks + 1) * 32); k1 = *(const LDSQ bf16x8*)(kt + 32 * KT_STRIDE + (ks + 1) * 32); }
#pragma unroll
        for (int r = 4 * ks; r < 4 * ks + 4; ++r) { const float p0 = EXP2F(c0[r]), p1 = EXP2F(c1[r]); c0[r] = p0; c1[r] = p1; ls += p0 + p1; }
        SCHED_FENCE();
    }
    u32x4_t w0, w1, w2, w3;
#pragma unroll
    for (int i = 0; i < 4; ++i) { w0[i] = pack2bf(c0[2 * i], c0[2 * i + 1]); w1[i] = pack2bf(c0[8 + 2 * i], c0[8 + 2 * i + 1]); w2[i] = pack2bf(c1[2 * i], c1[2 * i + 1]); w3[i] = pack2bf(c1[8 + 2 * i], c1[8 + 2 * i + 1]); }
    const unsigned km = sel ? 0xffffffffu : 0u; w0 &= km; w1 &= km; w2 &= km; w3 &= km; l += sel ? ls : 0.f;
    pf[0] = __builtin_bit_cast(bf16x8, w0); pf[1] = __builtin_bit_cast(bf16x8, w1); pf[2] = __builtin_bit_cast(bf16x8, w2); pf[3] = __builtin_bit_cast(bf16x8, w3);
}
template <int BR> HD void nsa_branch(ldsp_t lds, int tid, const bf16_t* kb, const bf16_t* vb, int nt, int i0, int i1, const bf16x8 (&qf)[4], float mb, AttnSt& st, TilePipe& tp, const BranchCtx& x, int c, int hi) {
    tp_start(lds, tid, kb, vb, nt, tp);
    f32x16 a0, a1, b0, b1; bf16x8 pf[4];
    int t = 0;
#pragma unroll 1
    for (; t < i0; ++t) { const TileParm q = tile_parm<BR>(t, x); qk_tile(lds, t % 3, qf, mb, a0, a1, c, hi); sm_pv(lds, t % 3, q, a0, a1, st, c, hi); tp_advance(lds, tid, kb, vb, t, nt, tp); }
    bool pending = false;
    if (t < i1) {
        qk_tile(lds, t % 3, qf, mb, a0, a1, c, hi);
#pragma unroll 1
        for (; t < i1; ++t) {
            const bool sel = BR == 1 ? ((x.selmask >> t) & 1ull) != 0ull : true;
            qk_sm_int(lds, (t + 1) % 3, qf, mb, b0, b1, a0, a1, sel, st.l, pf, c, hi); pv_tile(lds, t % 3, pf, st, c, hi); tp_advance(lds, tid, kb, vb, t, nt, tp);
            a0 = b0; a1 = b1;
        }
        pending = t < nt;
    }
#pragma unroll 1
    for (; t < nt; ++t) { const TileParm q = tile_parm<BR>(t, x); if (!pending) qk_tile(lds, t % 3, qf, mb, a0, a1, c, hi); pending = false; sm_pv(lds, t % 3, q, a0, a1, st, c, hi); tp_advance(lds, tid, kb, vb, t, nt, tp); }
}
struct NsaIdx { int row, head, hi; };
HD NsaIdx nsa_idx(ldsp_t lds, int b, int g, int qt) { const int tid = opaque_tid(), lane = tid & 63, w = tid >> 6, c = lane & 31; NsaIdx x; x.row = b * SEQ + 64 * qt + 8 * w + (c >> 2); x.head = g * 4 + (c & 3); x.hi = lane >> 5; return x; }
HD float nsa_gate(const P& p, ldsp_t lds, int b, int g, int qt, int br) { const NsaIdx x = nsa_idx(lds, b, g, qt); return sigmoidf_(urow(p, x.row)[C_NG + br * 8 + x.head]); }
HD void nsa_load_q(const P& p, ldsp_t lds, int b, int g, int qt, size_t wb, bf16x8 (&qf)[4]) { const NsaIdx x = nsa_idx(lds, b, g, qt);
    const bf16_t* qp = wsb(p, wb) + (size_t)x.row * 512 + x.head * 64 + x.hi * 8;
#pragma unroll
    for (int ks = 0; ks < 4; ++ks) qf[ks] = *(const bf16x8*)(qp + ks * 16); }
HD float nsa_gate_raw(const P& p, ldsp_t lds, int b, int g, int qt, int br) { const NsaIdx x = nsa_idx(lds, b, g, qt); return urow(p, x.row)[C_NG + br * 8 + x.head]; }
HD void nsa_unit(const P& p, int L, ldsp_t lds, int b, int g, int qt) {
    const int tid = opaque_tid(), lane = tid & 63, w = RFL(tid >> 6), c = lane & 31, hi = lane >> 5;
    const int pos = 64 * qt + 8 * w + (c >> 2);
    const size_t bg = (size_t)b * 2 + g;
    bf16x8 qf[4]; TilePipe tp; AttnSt st; f32x16 i0, i1;
    LDSQ float* combl = (LDSQ float*)(lds + NSA_COMB + w * 8192) + lane;
    for (int r = 0; r < 16; ++r) { i0[r] = 0.f; i1[r] = 0.f; }
    bf16x8 qfr[4];
    nsa_load_q(p, lds, b, g, qt, WB_QNB, qf); nsa_load_q(p, lds, b, g, qt, WB_QRB, qfr);
    const float gr0 = nsa_gate_raw(p, lds, b, g, qt, 0), gr1 = nsa_gate_raw(p, lds, b, g, qt, 1), gr2 = nsa_gate_raw(p, lds, b, g, qt, 2);
    attn_init(st);
    {
        const float mb = score_bound(qf, p.k_norm_g + (L * 3 + 0) * 64, lane);
        const int nt_n = ((4 * qt + 2) >> 6) + 1;
        const bf16_t* kb = wsb(p, WB_KCB) + bg * NCPAD * 64; const bf16_t* vb = wsb(p, WB_VCT) + bg * (NCPAD / 64) * 4096;
        const int nlim = (pos - 31) >> 4, nlim_min = (64 * qt + 8 * w - 31) >> 4;
        BranchCtx bx; bx.qt = qt; bx.pos = pos; bx.hi = hi; bx.nlim = nlim; bx.nlim_min = nlim_min; bx.kb0 = 0; bx.selmask = 0ull;
        { int ni = (nlim_min + 1) >> 6; ni = ni < 0 ? 0 : (ni > nt_n ? nt_n : ni);
          nsa_branch<0>(lds, tid, kb, vb, nt_n, 0, ni, qf, mb, st, tp, bx, c, hi); }
        {
            const float lt1 = st.l + __shfl_xor(st.l, 32), inv1 = lt1 > 0.f ? RCPF(lt1) : 0.f;
            tp_start(lds, tid, kb, vb, nt_n, tp);
            for (int t = 0; t < nt_n; ++t) { imp_tile(lds, t % 3, qf, mb, inv1, nlim - 64 * t - 4 * hi, i0, i1, t, c, hi); tp_advance(lds, tid, kb, vb, t, nt_n, tp); }
        }
    }
    unsigned long long selmask;
    {
        const float lt = st.l + __shfl_xor(st.l, 32), inv = lt > 0.f ? RCPF(lt) : 0.f, gate = sigmoidf_(gr0) * inv;
        LDSQ float* impw = (LDSQ float*)(lds + NSA_IMP) + w * 512;
#pragma unroll
        for (int r = 0; r < 16; ++r) { combl[r * 64] = gate * st.o0[r]; combl[(16 + r) * 64] = gate * st.o1[r];
            float v0 = i0[r], v1 = i1[r];
            v0 += __shfl_xor(v0, 1); v0 += __shfl_xor(v0, 2); v1 += __shfl_xor(v1, 1); v1 += __shfl_xor(v1, 2);
            if ((c & 3) == 0) { const int j = (r & 3) + 8 * (r >> 2) + 4 * hi; impw[(c >> 2) * 64 + j] = v0; impw[(c >> 2) * 64 + 32 + j] = v1; } }
        __syncthreads();
        LDSQ unsigned long long* maskw = (LDSQ unsigned long long*)(lds + NSA_MASK) + w * 8;
#pragma unroll 1
        for (int q = 0; q < 8; ++q) {
            const int j = lane; const bool forced = (j == 0) || (j == qt) || (j == qt - 1), valid = j <= qt;
            const unsigned key = forced ? 0xFFFFFFFFu : (valid ? __builtin_bit_cast(unsigned, impw[q * 64 + j]) + 1u : 0u);
            unsigned thr = 0u;
#pragma unroll 4
            for (int bit = 31; bit >= 0; --bit) { const unsigned cand = thr | (1u << bit); if (__builtin_popcountll(__ballot(key >= cand)) >= 16) thr = cand; }
            const unsigned long long mgt = __ballot(key > thr), meq = __ballot(key == thr), below = (lane == 0) ? 0ull : (~0ull >> (64 - lane));
            const int need = 16 - __builtin_popcountll(mgt);
            const bool pick = key > thr || (key == thr && __builtin_popcountll(meq & below) < need);
            const unsigned long long mk = __ballot(pick);
            if (lane == 0) maskw[q] = mk;
        }
        __syncthreads();
        selmask = maskw[c >> 2];
    }
#pragma unroll
    for (int ks = 0; ks < 4; ++ks) qf[ks] = qfr[ks];
    attn_init(st);
    {
        const bf16_t* kb = wsb(p, WB_KSB) + bg * SEQ * 64; const bf16_t* vb = wsb(p, WB_VST) + bg * NQT * 4096;
        const int nt_n = qt + 1; const float mb = score_bound(qf, p.k_norm_g + (L * 3 + 1) * 64, lane);
        BranchCtx bx; bx.qt = qt; bx.pos = pos; bx.hi = hi; bx.nlim = 0; bx.nlim_min = 0; bx.kb0 = 0; bx.selmask = selmask;
        nsa_branch<1>(lds, tid, kb, vb, nt_n, 0, qt, qf, mb, st, tp, bx, c, hi);
        const float lt = st.l + __shfl_xor(st.l, 32), inv = lt > 0.f ? RCPF(lt) : 0.f, gate = sigmoidf_(gr1) * inv;
#pragma unroll
        for (int r = 0; r < 16; ++r) { combl[r * 64] += gate * st.o0[r]; combl[(16 + r) * 64] += gate * st.o1[r]; }
    }
    attn_init(st);
    {
        const bf16_t* kb = wsb(p, WB_KWB) + bg * SEQ * 64; const bf16_t* vb = wsb(p, WB_VWT) + bg * NQT * 4096;
        const int kb0 = qt - 8 > 0 ? qt - 8 : 0, nt_n = qt - kb0 + 1;
        const float mb = score_bound(qf, p.k_norm_g + (L * 3 + 2) * 64, lane);
        const bf16_t* kb2 = kb + (size_t)kb0 * 4096; const bf16_t* vb2 = vb + (size_t)kb0 * 4096;
        BranchCtx bx; bx.qt = qt; bx.pos = pos; bx.hi = hi; bx.nlim = 0; bx.nlim_min = 0; bx.kb0 = kb0; bx.selmask = 0ull;
        nsa_branch<2>(lds, tid, kb2, vb2, nt_n, qt >= 8 ? 1 : 0, nt_n - 1, qf, mb, st, tp, bx, c, hi);
        const float lt = st.l + __shfl_xor(st.l, 32), inv = lt > 0.f ? RCPF(lt) : 0.f, gate = sigmoidf_(gr2) * inv;
#pragma unroll
        for (int r = 0; r < 16; ++r) { st.o0[r] = combl[r * 64] + gate * st.o0[r]; st.o1[r] = combl[(16 + r) * 64] + gate * st.o1[r]; }
    }
    const NsaIdx xo = nsa_idx(lds, b, g, qt); const int hi2 = xo.hi;
    bf16_t* mo = mixb(p) + (size_t)xo.row * D + 256 + xo.head * 64; const URow nz = urow(p, xo.row) + (C_NZ + xo.head * 64);
#pragma unroll
    for (int q4 = 0; q4 < 4; ++q4) { const int d0 = 8 * q4 + 4 * hi2;
        const bf16x4 z0 = *(const bf16x4*)(nz.q + d0), z1 = *(const bf16x4*)(nz.q + 32 + d0); bf16x4 r0, r1;
#pragma unroll
        for (int e = 0; e < 4; ++e) { r0[e] = (short)f2bf(st.o0[4 * q4 + e] * siluf(bf2f((bf16_t)z0[e]))); r1[e] = (short)f2bf(st.o1[4 * q4 + e] * siluf(bf2f((bf16_t)z1[e]))); }
        *(bf16x4*)(mo + d0) = r0; *(bf16x4*)(mo + 32 + d0) = r1; }
}
HD void bphase_nsa_prompt(const P& p, int L, ldsp_t lds) {
    constexpr int NPAIR = BATCH * 2 * (NQT / 2);
    for (int pi0 = blockIdx.x; pi0 < NPAIR; pi0 += gridDim.x) {
        const int G = (int)gridDim.x, pi = (G % 8 == 0 && NPAIR % G == 0) ? ((pi0 % G) % 8) * (G / 8) + (pi0 % G) / 8 + (pi0 / G) * G : pi0;
        const int bgi = pi / (NQT / 2), q = pi % (NQT / 2);
        nsa_unit(p, L, lds, bgi >> 1, bgi & 1, NQT - 1 - q);
        nsa_unit(p, L, lds, bgi >> 1, bgi & 1, q);
    }
}

#ifdef CPU_EMU
#define WAVE_SYNC() emu_wave_sync()
#else
#define WAVE_SYNC() do { __builtin_amdgcn_fence(__ATOMIC_ACQ_REL, "wavefront"); __builtin_amdgcn_wave_barrier(); } while (0)
#endif
constexpr int GL_Q = 0, GL_K = 5120, GL_V = 10240, GL_WAVE = 19456;
HD int sw64(int row, int chunk) { return row * 80 + (chunk << 4); }
HD int sw128(int row, int chunk) { return row * 144 + (chunk << 4); }
HD int swv(int row, int q) { return row * 136 + (q << 3); }
static_assert(GL_V + 64 * 136 <= GL_WAVE && 64 * 144 <= GL_V, "per-wave LDS map");
HD float* gs_loc(const P& p, int b, int h, int c) { return p.ws + W_GSLOC + (((size_t)b * 4 + h) * NQT + c) * 2048; }
HD float* gs_bl(const P& p, int b, int h, int c) { return p.ws + W_GSBL + (((size_t)b * 4 + h) * NQT + c) * 32; }
template <class Src> HD void stage_vt_load(Src vsrc  , size_t row_stride, int lane, float (&tmp)[64]) {
#pragma unroll
    for (int j = 0; j < 64; ++j) tmp[j] = vsrc[(size_t)j * row_stride + lane];
}
HD void stage_vt_store(ldsp_t lw, int lane, const float (&tmp)[64]) {
#pragma unroll
    for (int j = 0; j < 64; ++j) *(LDSQ bf16_t*)(lw + GL_V + swv(lane, j >> 2) + (j & 3) * 2) = f2bf(tmp[j]);
    SCHED_FENCE();
}
HD bf16x8 ld_vt_frag(ldsp_t lw, int e, int q) {
    const bf16x4 a = *(const LDSQ bf16x4*)(lw + GL_V + swv(e, q)), b = *(const LDSQ bf16x4*)(lw + GL_V + swv(e, q + 2)); bf16x8 v;
    for (int j = 0; j < 4; ++j) { v[j] = a[j]; v[4 + j] = b[j]; } return v;
}
HD bf16x8 ld_vt_nat(ldsp_t lw, int e, int q) {
    const bf16x4 a = *(const LDSQ bf16x4*)(lw + GL_V + swv(e, q)), b = *(const LDSQ bf16x4*)(lw + GL_V + swv(e, q + 1)); bf16x8 v;
    for (int j = 0; j < 4; ++j) { v[j] = a[j]; v[4 + j] = b[j]; } return v;
}
HD void gla_cumsum(const P& p, int row0, int h, int lane, float (&bc)[32], float& tot0, float& blast) {
    const int dk = lane & 31, half = lane >> 5; const float* la = p.ws + W_LOGA + (size_t)(row0 + half * 32) * 128 + h * 32 + dk; float run = 0.f;
#pragma unroll
    for (int i = 0; i < 32; ++i) { run += la[(size_t)i * 128]; bc[i] = run; }
    tot0 = __shfl(run, dk); const float tot1 = __shfl(run, 32 + dk); blast = tot0 + tot1;
    if (half) {
#pragma unroll
        for (int i = 0; i < 32; ++i) bc[i] += tot0; }
}
HD void gla_g1_unit(const P& p, int L, ldsp_t lw, int b, int h, int c, int lane_) {
    const int lane = opaque_i(lane_);
    const int row0 = b * SEQ + c * 64, dk = lane & 31, half = lane >> 5, hi = half;
    WAVE_SYNC();
    float bc[32], tot0, blast; gla_cumsum(p, row0, h, lane, bc, tot0, blast);
    float vtmp[64]; stage_vt_load(urow(p, row0) + (C_GV + h * 64), U_LD, lane, vtmp);
    const URow ku = urow(p, row0 + half * 32) + (C_GK + h * 32 + dk);
#pragma unroll
    for (int i = 0; i < 32; ++i) { const int j = half * 32 + i;
        *(LDSQ bf16_t*)(lw + GL_Q + sw128(dk, j >> 3) + (j & 7) * 2) = f2bf(ku[(size_t)i * U_LD] * EXPF(blast - bc[i])); }
    stage_vt_store(lw, lane, vtmp);
    if (lane < 32) gs_bl(p, b, h, c)[lane] = blast;
    WAVE_SYNC();
    f32x16 a0, a1;
    for (int r = 0; r < 16; ++r) { a0[r] = 0.f; a1[r] = 0.f; }
#pragma unroll
    for (int ks = 0; ks < 4; ++ks) {
        const bf16x8 kf = *(const LDSQ bf16x8*)(lw + GL_Q + sw128(dk, 2 * ks + hi));
        a0 = __builtin_amdgcn_mfma_f32_32x32x16_bf16(ld_vt_nat(lw, dk, 4 * ks + 2 * hi), kf, a0, 0, 0, 0);
        a1 = __builtin_amdgcn_mfma_f32_32x32x16_bf16(ld_vt_nat(lw, 32 + dk, 4 * ks + 2 * hi), kf, a1, 0, 0, 0);
    }
    float* so = gs_loc(p, b, h, c);
#pragma unroll
    for (int r = 0; r < 16; ++r) { const int e = (r & 3) + 8 * (r >> 2) + 4 * hi; so[e * 32 + dk] = a0[r]; so[(32 + e) * 32 + dk] = a1[r]; }
}
HD void k_gla_scan(const P& p, int L, long it) {
    const int d = (int)(it % 32), e = (int)((it / 32) % 64), h = (int)((it / 2048) % 4), b = (int)(it / 8192); float S = 0.f;
    for (int c0 = 0; c0 < NQT; c0 += 16) { float loc[16], al[16];
#pragma unroll
        for (int k = 0; k < 16; ++k) { const int c = c0 + k < NQT ? c0 + k : NQT - 1; loc[k] = gs_loc(p, b, h, c)[e * 32 + d]; al[k] = gs_bl(p, b, h, c)[d]; }
#pragma unroll
        for (int k = 0; k < 16; ++k) if (c0 + k < NQT) { const float prev = S; S = EXPF(al[k]) * S + loc[k]; loc[k] = prev; }
#pragma unroll
        for (int k = 0; k < 16; ++k) if (c0 + k < NQT) gs_loc(p, b, h, c0 + k)[e * 32 + d] = loc[k]; }
    p.out[O_PGLA + (((size_t)L * BATCH + b) * 4 + h) * 2048 + d * 64 + e] = S;
}
HD void gla_g2_unit(const P& p, int L, ldsp_t lw, int b, int h, int c, int lane_) {
    const int lane = opaque_i(lane_);
    const int row0 = b * SEQ + c * 64, dk = lane & 31, half = lane >> 5, hi = half, cl = lane & 31;
    WAVE_SYNC();
    float bc[32], tot0, blast; gla_cumsum(p, row0, h, lane, bc, tot0, blast);
    float svr[2][2][8];
    { const float* ss = gs_loc(p, b, h, c);
#pragma unroll
      for (int et = 0; et < 2; ++et)
#pragma unroll
        for (int ks = 0; ks < 2; ++ks) ld8f(ss + (32 * et + cl) * 32 + 16 * ks + 8 * hi, svr[et][ks]); }
    float vtmp[64]; stage_vt_load(urow(p, row0) + (C_GV + h * 64), U_LD, lane, vtmp);
    const URow qu = urow(p, row0 + half * 32) + (C_GQ + h * 32 + dk); const URow ku = qu + (C_GK - C_GQ);
#pragma unroll
    for (int i = 0; i < 32; ++i) { const int j = half * 32 + i; const float dl = bc[i] - tot0;
        *(LDSQ bf16_t*)(lw + GL_Q + sw64(j, dk >> 3) + (dk & 7) * 2) = f2bf(qu[(size_t)i * U_LD] * 0.17677669529663687f * EXPF(dl));
        *(LDSQ bf16_t*)(lw + GL_K + sw64(j, dk >> 3) + (dk & 7) * 2) = f2bf(ku[(size_t)i * U_LD] * EXPF(-dl)); }
    stage_vt_store(lw, lane, vtmp);
    WAVE_SYNC();
    bf16x8 sf[2][2];
    {
#pragma unroll
      for (int et = 0; et < 2; ++et)
#pragma unroll
        for (int ks = 0; ks < 2; ++ks)
            {
#pragma unroll
              for (int jj = 0; jj < 8; ++jj) { const int d = 16 * ks + 8 * hi + jj; const float br = __shfl(tot0, d); sf[et][ks][jj] = (short)f2bf(svr[et][ks][jj] * EXPF(br)); } } }
    const URow gz = urow(p, row0) + (C_GZ + h * 64); const float* ng = p.gla_norm_g + L * 64;
#pragma unroll
    for (int it = 0; it < 2; ++it) {
        const int i = 32 * it + cl;
        bf16x8 qf[2];
        qf[0] = *(const LDSQ bf16x8*)(lw + GL_Q + sw64(i, hi)); qf[1] = *(const LDSQ bf16x8*)(lw + GL_Q + sw64(i, 2 + hi));
        f32x16 o0, o1;
        for (int r = 0; r < 16; ++r) { o0[r] = 0.f; o1[r] = 0.f; }
#pragma unroll
        for (int ks = 0; ks < 2; ++ks) { o0 = __builtin_amdgcn_mfma_f32_32x32x16_bf16(sf[0][ks], qf[ks], o0, 0, 0, 0); o1 = __builtin_amdgcn_mfma_f32_32x32x16_bf16(sf[1][ks], qf[ks], o1, 0, 0, 0); }
#pragma unroll
        for (int jt = 0; jt <= it; ++jt) {
            f32x16 at;
            for (int r = 0; r < 16; ++r) at[r] = 0.f;
#pragma unroll
            for (int ks = 0; ks < 2; ++ks) at = __builtin_amdgcn_mfma_f32_32x32x16_bf16(*(const LDSQ bf16x8*)(lw + GL_K + sw64(32 * jt + cl, 2 * ks + hi)), qf[ks], at, 0, 0, 0);
            bf16x8 pf[2];
#pragma unroll
            for (int r = 0; r < 16; ++r) { const int jl = (r & 3) + 8 * (r >> 2) + 4 * hi; const float v = (jt < it || jl <= cl) ? at[r] : 0.f; pf[r >> 3][r & 7] = (short)f2bf(v); }
#pragma unroll
            for (int s = 0; s < 2; ++s) { const int q = 8 * jt + 4 * s + hi;
                o0 = __builtin_amdgcn_mfma_f32_32x32x16_bf16(ld_vt_frag(lw, cl, q), pf[s], o0, 0, 0, 0);
                o1 = __builtin_amdgcn_mfma_f32_32x32x16_bf16(ld_vt_frag(lw, 32 + cl, q), pf[s], o1, 0, 0, 0); }
        }
        float ss = 0.f;
#pragma unroll
        for (int r = 0; r < 16; ++r) ss += o0[r] * o0[r] + o1[r] * o1[r];
        ss += __shfl_xor(ss, 32);
        const float rs = RSQRTF(ss * (1.0f / 64) + 1e-6f);
        bf16_t* mo = mixb(p) + (size_t)(row0 + i) * D + h * 64; const URow gzr = gz + (size_t)i * U_LD;
#pragma unroll
        for (int q4 = 0; q4 < 4; ++q4) { const int e0 = 8 * q4 + 4 * hi;
            const bf16x4 z0 = *(const bf16x4*)(gzr.q + e0), z1 = *(const bf16x4*)(gzr.q + 32 + e0); const f32x4 g0 = *(const f32x4*)(ng + e0), g1 = *(const f32x4*)(ng + 32 + e0); bf16x4 r0, r1;
#pragma unroll
            for (int k = 0; k < 4; ++k) { r0[k] = (short)f2bf(o0[4 * q4 + k] * rs * g0[k] * siluf(bf2f((bf16_t)z0[k]))); r1[k] = (short)f2bf(o1[4 * q4 + k] * rs * g1[k] * siluf(bf2f((bf16_t)z1[k]))); }
            *(bf16x4*)(mo + e0) = r0; *(bf16x4*)(mo + 32 + e0) = r1; }
    }
}
constexpr int LDS_WX = LDS_MISC + 1024;
HD float* ml_cloc(const P& p, int b, int h, int c) { return p.ws + W_MCLOC + (((size_t)b * 4 + h) * NQT + c) * 4160; }
HD float* ml_fg(const P& p, int b, int h, int c) { return p.ws + W_MFG + (((size_t)b * 4 + h) * NQT + c) * 4; }
HD float wave_max(float v) { for (int o = 1; o < 64; o <<= 1) v = fmaxf(v, __shfl_xor(v, o)); return v; }
HD void ml_gates(const P& p, int L, int row0, int h, int lane, float& ii, float& fcum) {
    const URow u = urow(p, row0 + lane) + C_MIF;
    ii = u[h] + p.gate_b[(L * 2 + 0) * 4 + h]; float f = log_sigmoidf(u[4 + h] + p.gate_b[(L * 2 + 1) * 4 + h]);
    for (int o = 1; o < 64; o <<= 1) { const float t = __shfl(f, lane - o >= 0 ? lane - o : lane); if (lane >= o) f += t; }
    fcum = f;
}
HD void ml_g1_unit(const P& p, int L, ldsp_t lw, int b, int h, int c, int lane_) {
    const int lane = opaque_i(lane_);
    const int row0 = b * SEQ + c * 64, cl = lane & 31, hi = lane >> 5;
    WAVE_SYNC();
    float ii, fcum; ml_gates(p, L, row0, h, lane, ii, fcum);
    const float F = __shfl(fcum, 63), g = ii - fcum, G = F + wave_max(g), wj = EXPF(F + g - G);
    float nacc = 0.f;
    float vtmp[64]; stage_vt_load(urow(p, row0) + (C_MV + h * 64), U_LD, lane, vtmp);
    const float* ku = p.ws + W_MK + (size_t)row0 * 256 + h * 64 + lane;
#pragma unroll 32
    for (int j = 0; j < 64; ++j) { const float v = ku[(size_t)j * 256] * __shfl(wj, j); nacc += v; *(LDSQ bf16_t*)(lw + GL_Q + sw128(lane, j >> 3) + (j & 7) * 2) = f2bf(v); }
    stage_vt_store(lw, lane, vtmp);
    WAVE_SYNC();
    f32x16 a[2][2];
    for (int x = 0; x < 4; ++x) for (int r = 0; r < 16; ++r) a[x >> 1][x & 1][r] = 0.f;
#pragma unroll
    for (int ks = 0; ks < 4; ++ks) {
        const bf16x8 v0 = ld_vt_nat(lw, cl, 4 * ks + 2 * hi), v1 = ld_vt_nat(lw, 32 + cl, 4 * ks + 2 * hi);
#pragma unroll
        for (int dt = 0; dt < 2; ++dt) { const bf16x8 kf = *(const LDSQ bf16x8*)(lw + GL_Q + sw128(32 * dt + cl, 2 * ks + hi));
            a[0][dt] = __builtin_amdgcn_mfma_f32_32x32x16_bf16(v0, kf, a[0][dt], 0, 0, 0); a[1][dt] = __builtin_amdgcn_mfma_f32_32x32x16_bf16(v1, kf, a[1][dt], 0, 0, 0); }
    }
    float* so = ml_cloc(p, b, h, c);
#pragma unroll
    for (int et = 0; et < 2; ++et)
#pragma unroll
        for (int dt = 0; dt < 2; ++dt)
#pragma unroll
            for (int r = 0; r < 16; ++r) so[(32 * et + (r & 3) + 8 * (r >> 2) + 4 * hi) * 64 + 32 * dt + cl] = a[et][dt][r];
    so[64 * 64 + lane] = nacc;
    if (lane == 0) { float* fg = ml_fg(p, b, h, c); fg[0] = F; fg[1] = G; }
}
HD void k_ml_scan(const P& p, int L, long it) {
    const int d = (int)(it % 64), e = (int)((it / 64) % 65), h = (int)((it / 4160) % 4), b = (int)(it / 16640); float S = 0.f, ms = 0.f;
    for (int c0 = 0; c0 < NQT; c0 += 16) { float loc[16], Fv[16], Gv[16];
#pragma unroll
        for (int k = 0; k < 16; ++k) { const int c = c0 + k < NQT ? c0 + k : NQT - 1; loc[k] = ml_cloc(p, b, h, c)[e * 64 + d]; const float* fg = ml_fg(p, b, h, c); Fv[k] = fg[0]; Gv[k] = fg[1]; }
#pragma unroll
        for (int k = 0; k < 16; ++k) if (c0 + k < NQT) { const float mn = fmaxf(Fv[k] + ms, Gv[k]), prev = S; S = EXPF(Fv[k] + ms - mn) * S + EXPF(Gv[k] - mn) * loc[k]; loc[k] = prev; Fv[k] = ms; ms = mn; }
#pragma unroll
        for (int k = 0; k < 16; ++k) if (c0 + k < NQT) { ml_cloc(p, b, h, c0 + k)[e * 64 + d] = loc[k]; if (e == 64 && d == 0) ml_fg(p, b, h, c0 + k)[2] = Fv[k]; } }
    const size_t sb = ((size_t)L * BATCH + b) * 4 + h;
    if (e < 64) p.out[O_PC + (sb * 64 + e) * 64 + d] = S; else { p.out[O_PN + sb * 64 + d] = S; if (d == 0) p.out[O_PM + sb] = ms; }
}
HD void ml_g2_unit(const P& p, int L, ldsp_t lw, LDSQ float* gx, int b, int h, int c, int lane_) {
    const int lane = opaque_i(lane_);
    const int row0 = b * SEQ + c * 64, cl = lane & 31, hi = lane >> 5;
    WAVE_SYNC();
    float ii, fcum; ml_gates(p, L, row0, h, lane, ii, fcum);
    const float ms = ml_fg(p, b, h, c)[2], g = ii - fcum;
    float M = fmaxf(g, ms);
    for (int o = 1; o < 64; o <<= 1) { const float t = __shfl(M, lane - o >= 0 ? lane - o : lane); if (lane >= o) M = fmaxf(M, t); }
    gx[lane] = g;
    { float vtmp[64]; stage_vt_load(urow(p, row0) + (C_MV + h * 64), U_LD, lane, vtmp);
      const float* ku = p.ws + W_MK + (size_t)row0 * 256 + h * 64 + lane;
#pragma unroll 32
      for (int j = 0; j < 64; ++j) *(LDSQ bf16_t*)(lw + GL_Q + sw128(j, lane >> 3) + (lane & 7) * 2) = f2bf(ku[(size_t)j * 256]);
      SCHED_FENCE();
      stage_vt_store(lw, lane, vtmp); }
    WAVE_SYNC();
    const float* cs = ml_cloc(p, b, h, c);
    const float* ng = p.ml_norm_g + L * 64;
#pragma unroll 1
    for (int it = 0; it < 2; ++it) {
        const int i = 32 * it + cl; const float Mi = __shfl(M, i), fi = __shfl(fcum, i), wint = EXPF(ms - Mi);
        const float* qr = p.ws + W_MQ + (size_t)(row0 + i) * 256 + h * 64;
        bf16x8 qf[4]; float nq = 0.f; float ca[4][8], cb[4][8];
#pragma unroll
        for (int ks = 0; ks < 4; ++ks) { ld8f(cs + cl * 64 + 16 * ks + 8 * hi, ca[ks]); ld8f(cs + (32 + cl) * 64 + 16 * ks + 8 * hi, cb[ks]); }
#pragma unroll
        for (int ks = 0; ks < 4; ++ks) { float qv8[8], nv8[8]; ld8f(qr + 16 * ks + 8 * hi, qv8); ld8f(cs + 64 * 64 + 16 * ks + 8 * hi, nv8);
#pragma unroll
            for (int jj = 0; jj < 8; ++jj) { qf[ks][jj] = (short)f2bf(qv8[jj]); nq += qv8[jj] * nv8[jj]; } }
        nq += __shfl_xor(nq, 32);
        f32x16 o0, o1;
        for (int r = 0; r < 16; ++r) { o0[r] = 0.f; o1[r] = 0.f; }
#pragma unroll
        for (int ks = 0; ks < 4; ++ks) { bf16x8 c0, c1;
#pragma unroll
            for (int jj = 0; jj < 8; ++jj) { c0[jj] = (short)f2bf(ca[ks][jj]); c1[jj] = (short)f2bf(cb[ks][jj]); }
            o0 = __builtin_amdgcn_mfma_f32_32x32x16_bf16(c0, qf[ks], o0, 0, 0, 0); o1 = __builtin_amdgcn_mfma_f32_32x32x16_bf16(c1, qf[ks], o1, 0, 0, 0); }
        bf16_t* mo = mixb(p) + (size_t)(row0 + i) * D + 768 + h * 64; const URow ur = urow(p, row0 + i);
        bf16x4 ga0[4], ga1[4], gz0[4], gz1[4];
#pragma unroll
        for (int q4 = 0; q4 < 4; ++q4) { const int e0 = 8 * q4 + 4 * hi; const bf16_t* uo = ur.q + C_MO + h * 64 + e0; const bf16_t* uz = ur.q + C_MZ + h * 64 + e0;
            ga0[q4] = *(const bf16x4*)uo; ga1[q4] = *(const bf16x4*)(uo + 32); gz0[q4] = *(const bf16x4*)uz; gz1[q4] = *(const bf16x4*)(uz + 32); }
        SCHED_FENCE();
#pragma unroll
        for (int r = 0; r < 16; ++r) { o0[r] *= wint; o1[r] *= wint; }
        float dsum = 0.f;
#pragma unroll 1
        for (int jt = 0; jt <= it; ++jt) {
            f32x16 st;
            for (int r = 0; r < 16; ++r) st[r] = 0.f;
#pragma unroll
            for (int ks = 0; ks < 4; ++ks) st = __builtin_amdgcn_mfma_f32_32x32x16_bf16(*(const LDSQ bf16x8*)(lw + GL_Q + sw128(32 * jt + cl, 2 * ks + hi)), qf[ks], st, 0, 0, 0);
            bf16x8 pf[2];
#pragma unroll
            for (int r = 0; r < 16; ++r) { const int jl = (r & 3) + 8 * (r >> 2) + 4 * hi;
                const float v = (jt < it || jl <= cl) ? st[r] * EXPF(gx[32 * jt + jl] - Mi) : 0.f; dsum += v; pf[r >> 3][r & 7] = (short)f2bf(v); }
#pragma unroll
            for (int s = 0; s < 2; ++s) { const int q = 8 * jt + 4 * s + hi;
                o0 = __builtin_amdgcn_mfma_f32_32x32x16_bf16(ld_vt_frag(lw, cl, q), pf[s], o0, 0, 0, 0);
                o1 = __builtin_amdgcn_mfma_f32_32x32x16_bf16(ld_vt_frag(lw, 32 + cl, q), pf[s], o1, 0, 0, 0); }
        }
        dsum += __shfl_xor(dsum, 32);
        const float den = wint * nq + dsum, hinv = RCPF(fmaxf(fabsf(den), EXPF(-(fi + Mi))));
        float ss = 0.f;
#pragma unroll
        for (int r = 0; r < 16; ++r) { o0[r] *= hinv; o1[r] *= hinv; ss += o0[r] * o0[r] + o1[r] * o1[r]; }
        ss += __shfl_xor(ss, 32);
        const float rs = RSQRTF(ss * (1.0f / 64) + 1e-6f);
#pragma unroll
        for (int q4 = 0; q4 < 4; ++q4) { const int e0 = 8 * q4 + 4 * hi;
            const bf16x4 a0 = ga0[q4], a1 = ga1[q4], z0 = gz0[q4], z1 = gz1[q4]; const f32x4 g0 = *(const f32x4*)(ng + e0), g1 = *(const f32x4*)(ng + 32 + e0); bf16x4 r0, r1;
#pragma unroll
            for (int k = 0; k < 4; ++k) { r0[k] = (short)f2bf(o0[4 * q4 + k] * rs * g0[k] * sigmoidf_(bf2f((bf16_t)a0[k])) * siluf(bf2f((bf16_t)z0[k])));
                r1[k] = (short)f2bf(o1[4 * q4 + k] * rs * g1[k] * sigmoidf_(bf2f((bf16_t)a1[k])) * siluf(bf2f((bf16_t)z1[k]))); }
            *(bf16x4*)(mo + e0) = r0; *(bf16x4*)(mo + 32 + e0) = r1; }
    }
}
HD void bphase_rec_g1(const P& p, int L, ldsp_t lds) {
    const int w = RFL(opaque_tid() >> 6); const ldsp_t lw = lds + w * GL_WAVE; constexpr int NU = BATCH * 4 * NQT;
#define lane (opaque_tid() & 63)
    for (int u2 = blockIdx.x * 8 + w; u2 < 2 * NU; u2 += gridDim.x * 8) { const int u = u2 % NU;
        if (u2 < NU) gla_g1_unit(p, L, lw, u / (4 * NQT), (u / NQT) % 4, u % NQT, lane); else ml_g1_unit(p, L, lw, u / (4 * NQT), (u / NQT) % 4, u % NQT, lane); }
#undef lane
}
HD void bphase_rec_g2(const P& p, int L, ldsp_t lds) {
    const int w = RFL(opaque_tid() >> 6); const ldsp_t lw = lds + w * GL_WAVE; LDSQ float* gx = (LDSQ float*)(lds + LDS_WX + w * 256); constexpr int NU = BATCH * 4 * NQT;
#define lane (opaque_tid() & 63)
    for (int u2 = blockIdx.x * 8 + w; u2 < 2 * NU; u2 += gridDim.x * 8) { const int u = u2 % NU;
        if (u2 < NU) gla_g2_unit(p, L, lw, u / (4 * NQT), (u / NQT) % 4, u % NQT, lane); else ml_g2_unit(p, L, lw, gx, u / (4 * NQT), (u / NQT) % 4, u % NQT, lane); }
#undef lane
}

constexpr int CS_STRIDE = 528, CS_BUF = 33 * CS_STRIDE, CS_GROUP = 2 * CS_BUF;
static_assert(2 * CS_GROUP + 32 * 256 * 4 <= LDS_MISC, "summary staging + partial-sum exchange fit the scratch region");
HD bf16_t* wctp(const P& p, int L, int kv) { return (bf16_t*)((char*)p.ws + WB_WCT) + ((size_t)(L * 2 + kv)) * 64 * 2048; }
HD void k_prep_wc(const P& p, int L, long it) {
    const int lane = (int)(it % 64), et = (int)((it / 64) % 2), ks = (int)((it / 128) % 4), hs = (int)((it / 512) % 2), r = (int)((it / 1024) % 16), kv = (int)((it / 16384) % 2), L2 = (int)(it / 32768);
    bf16_t* o = wctp(p, L2, kv) + (size_t)(it % 16384) * 8; const int e = 32 * et + (lane & 31), s = 16 * hs + r, d0 = 16 * ks + 8 * (lane >> 5);
    const float* w = p.cmp_w + (((size_t)(L2 * 2 + kv) * 32 + s) * 64 + d0) * 64 + e;
    for (int j = 0; j < 8; ++j) o[j] = f2bf(w[(size_t)j * 64]);
}
HD void k_cmp_pad(const P& p, int L, long it) {
    const int g = (int)(it % 2); const long q = it / 2; const int j = (int)(q % NCPAD), s = (int)(q / NCPAD);
    if (j < seq_ncmp(s)) return;
    bf16_t* kb = wsb(p, WB_KCB) + (((size_t)s * 2 + g) * NCPAD + j) * 64; bf16_t* vt = wsb(p, WB_VCT) + (((size_t)s * 2 + g) * (NCPAD / 64) + j / 64) * 4096 + (j % 64);
    for (int d = 0; d < 64; ++d) { kb[d] = 0; vt[(size_t)d * 64] = 0; }
}
HD void cs_stage_load(const float* const (&bp)[9], int r, f32x4 (&rg)[9]) {
#pragma unroll
    for (int q = 0; q < 9; ++q) { f32x4 v = {0.f, 0.f, 0.f, 0.f}; if (bp[q]) v = *(const f32x4*)(bp[q] + (size_t)r * 512); rg[q] = v; }
}
HD void cs_stage_store(ldsp_t lg, int buf, int tl, const f32x4 (&rg)[9]) {
#pragma unroll
    for (int q = 0; q < 9; ++q) { const int i = tl + q * 256; const int jj = i >> 6, c4 = i & 63;
        if (i < 33 * 64) { bf16x4 o; for (int e = 0; e < 4; ++e) o[e] = (short)f2bf(rg[q][e]); *(LDSQ bf16x4*)(lg + buf * CS_BUF + jj * CS_STRIDE + c4 * 8) = o; } }
}
template <int WHICH  > HD void bphase_cmp_sum_t(const P& p, int L, ldsp_t lds) {
    const int tid = opaque_tid(), lane = tid & 63, w = tid >> 6, grp = w >> 2, kv = (w >> 1) & 1, g = w & 1, tl = tid & 255, cl = lane & 31, hi = lane >> 5;
    constexpr int TP = (SEQ / 16 + 31) / 32, TS = ((PAST_LEN + DEC_SEQ) / 16 + 31) / 32, U0 = WHICH ? BATCH * TP : 0, NUNIT = WHICH ? DEC_BATCH * TS : BATCH * TP;
    constexpr bool SPLIT = (WHICH == 0);
    constexpr int NITER = SPLIT ? NUNIT : (NUNIT + 1) / 2, NSTEP = SPLIT ? 8 : 16;
    const ldsp_t lg = lds + grp * CS_GROUP;
    for (int itx = blockIdx.x; itx < NITER; itx += gridDim.x) {
        const int un = SPLIT ? U0 + itx : U0 + 2 * itx + grp; const bool live = SPLIT ? true : (2 * itx + grp < NUNIT); const int r0 = SPLIT ? 8 * grp : 0;
        int s = 0, t = 0;
        if (live) { if (un < BATCH * TP) { s = un / TP; t = un % TP; } else { s = BATCH + (un - BATCH * TP) / TS; t = (un - BATCH * TP) % TS; } }
        const int nhalf = live ? (s < BATCH ? SEQ / 16 : (PAST_LEN + DEC_SEQ) / 16) : 0, j0 = 32 * t;
        f32x4 rg[9]; f32x16 a0, a1; const float* bp[9];
        for (int r = 0; r < 16; ++r) { a0[r] = 0.f; a1[r] = 0.f; }
#pragma unroll
        for (int q = 0; q < 9; ++q) { const int i = tl + q * 256, jj = i >> 6, c4 = i & 63; bp[q] = (i < 33 * 64 && j0 + jj < nhalf) ? hist(p, L, s, 16 * (j0 + jj), 0, 0) + c4 * 4 : nullptr; }
        cs_stage_load(bp, r0, rg); cs_stage_store(lg, 0, tl, rg); cs_stage_load(bp, r0 + 1, rg); LDS_BARRIER();
        const bf16_t* wt = wctp(p, L, kv) + (size_t)lane * 8;
#define CS_WLOADH(R, HS, WF) { _Pragma("unroll") for (int ks = 0; ks < 4; ++ks) { const bf16_t* wp = wt + ((((R) * 2 + (HS)) * 4 + ks) * 2) * 512; \
            WF[ks][0] = *(const bf16x8*)wp; WF[ks][1] = *(const bf16x8*)(wp + 512); } }
#define CS_COMPUTEH(BUF, HS, WF) { const ldsp_t xb = lg + (BUF) * CS_BUF + cl * CS_STRIDE + (kv * 2 + g) * 128 + hi * 16; \
            _Pragma("unroll") for (int ks = 0; ks < 4; ++ks) { const bf16x8 xf = *(const LDSQ bf16x8*)(xb + (HS) * CS_STRIDE + ks * 32); \
                a0 = __builtin_amdgcn_mfma_f32_32x32x16_bf16(WF[ks][0], xf, a0, 0, 0, 0); \
                a1 = __builtin_amdgcn_mfma_f32_32x32x16_bf16(WF[ks][1], xf, a1, 0, 0, 0); } }
        bf16x8 wfa[4][2], wfb[4][2];
        CS_WLOADH(r0, 0, wfa) CS_WLOADH(r0, 1, wfb)
#pragma unroll 1
        for (int rr = 0; rr < NSTEP; ++rr) {
            const int r = r0 + rr;
            CS_COMPUTEH(rr & 1, 0, wfa)
            if (rr + 1 < NSTEP) CS_WLOADH(r + 1, 0, wfa)
            SCHED_FENCE();
            CS_COMPUTEH(rr & 1, 1, wfb)
            if (rr + 1 < NSTEP) CS_WLOADH(r + 1, 1, wfb)
            SCHED_FENCE();
            if (rr + 1 < NSTEP) cs_stage_store(lg, (rr + 1) & 1, tl, rg);
            if (rr + 2 < NSTEP) cs_stage_load(bp, r + 2, rg);
            LDS_BARRIER();
        }
        if (SPLIT) {
            LDSQ float* xs = (LDSQ float*)(lds + 2 * CS_GROUP) + tl;
            if (grp == 1) {
#pragma unroll
                for (int r = 0; r < 16; ++r) { xs[r * 256] = a0[r]; xs[(16 + r) * 256] = a1[r]; } }
            __syncthreads();
            if (grp == 0) {
#pragma unroll
                for (int r = 0; r < 16; ++r) { a0[r] += xs[r * 256]; a1[r] += xs[(16 + r) * 256]; } }
            __syncthreads();
        }
#undef CS_WLOADH
#undef CS_COMPUTEH
        const int j = j0 + cl; const bool ok = live && j < seq_ncmp(s) && (!SPLIT || grp == 0);
        const float* bias = p.ws + W_CBIAS + L * 128 + kv * 64;
        float ss = 0.f;
#pragma unroll
        for (int r = 0; r < 16; ++r) { const int e = (r & 3) + 8 * (r >> 2) + 4 * hi; a0[r] += bias[e]; a1[r] += bias[32 + e]; ss += a0[r] * a0[r] + a1[r] * a1[r]; }
        ss += __shfl_xor(ss, 32);
        const float rs = kv == 0 ? RSQRTF(ss * (1.0f / 64) + 1e-6f) : 1.0f; const float* kg = p.k_norm_g + (L * 3 + 0) * 64;
        if (ok) {
            bf16_t* kb = wsb(p, WB_KCB) + (((size_t)s * 2 + g) * NCPAD + j) * 64; bf16_t* vt = wsb(p, WB_VCT) + (((size_t)s * 2 + g) * (NCPAD / 64) + j / 64) * 4096 + (j % 64);
#pragma unroll
            for (int r = 0; r < 16; ++r) { const int e = (r & 3) + 8 * (r >> 2) + 4 * hi;
                const float v0 = kv == 0 ? a0[r] * rs * kg[e] : a0[r], v1 = kv == 0 ? a1[r] * rs * kg[32 + e] : a1[r];
                if (kv == 0) { kb[e] = f2bf(v0); kb[32 + e] = f2bf(v1); } else { vt[(size_t)e * 64] = f2bf(v0); vt[(size_t)(32 + e) * 64] = f2bf(v1); } }
        }
    }
}

HD void bphase_cmp_sum_p(const P& p, int L, ldsp_t lds) { bphase_cmp_sum_t<0>(p, L, lds); }
HD void bphase_cmp_sum_s(const P& p, int L, ldsp_t lds) { bphase_cmp_sum_t<1>(p, L, lds); }
constexpr int SP_NCMP = 8, SP_NITEM = 40, SP_STRIDE = 68, SP_WIN0 = 8, SP_NWIN = 3, SP_SLC0 = 11, SP_NSLC = 28, SL_MAX = 4 * SP_NSLC;
constexpr int NJ = NSELS - 1;
static_assert(PAST_LEN % 64 == 0 && NJ <= 128 && NJ >= 16 && WKEEP_S % 64 == 0 && (WKEEP_S + DEC_SEQ + 63) / 64 <= 3 * SP_NWIN, "sample NSA geometry");
HD float* spart(const P& p, int b, int g, int item) { return p.ws + W_SPART + ((((size_t)b * 2 + g) * SP_NITEM + item) * 32) * SP_STRIDE; }
HD int* slist(const P& p, int b, int g) { return (int*)(p.ws + W_SLIST) + ((size_t)b * 2 + g) * 2 * SL_MAX; }
template <bool MASK>
HD void wattn_tile(ldsp_t lw, const bf16x8 (&qf)[4], int lim2, int lo2, bool sel, AttnSt& st, bf16x8 (&pf)[4], int c, int hi) {
    f32x16 s0, s1;
    for (int r = 0; r < 16; ++r) { s0[r] = 0.f; s1[r] = 0.f; }
#pragma unroll
    for (int ks = 0; ks < 4; ++ks) {
        s0 = __builtin_amdgcn_mfma_f32_32x32x16_bf16(*(const LDSQ bf16x8*)(lw + sw128(c, 2 * ks + hi)), qf[ks], s0, 0, 0, 0);
        s1 = __builtin_amdgcn_mfma_f32_32x32x16_bf16(*(const LDSQ bf16x8*)(lw + sw128(32 + c, 2 * ks + hi)), qf[ks], s1, 0, 0, 0);
    }
    float alpha;
    if (softmax_tile<MASK>(s0, s1, lim2, lo2, sel, st, pf, alpha)) {
#pragma unroll
        for (int r = 0; r < 16; ++r) { st.o0[r] *= alpha; st.o1[r] *= alpha; } }
#pragma unroll
    for (int ks = 0; ks < 4; ++ks) {
        st.o0 = __builtin_amdgcn_mfma_f32_32x32x16_bf16(ld_vt_frag(lw, c, 4 * ks + hi), pf[ks], st.o0, 0, 0, 0);
        st.o1 = __builtin_amdgcn_mfma_f32_32x32x16_bf16(ld_vt_frag(lw, 32 + c, 4 * ks + hi), pf[ks], st.o1, 0, 0, 0);
    }
}
HD void wattn_probs(ldsp_t lw, const bf16x8 (&qf)[4], int lim2, float m, float inv, bf16x8 (&pf)[4], int c, int hi) {
    f32x16 s0, s1;
    for (int r = 0; r < 16; ++r) { s0[r] = 0.f; s1[r] = 0.f; }
#pragma unroll
    for (int ks = 0; ks < 4; ++ks) {
        s0 = __builtin_amdgcn_mfma_f32_32x32x16_bf16(*(const LDSQ bf16x8*)(lw + sw128(c, 2 * ks + hi)), qf[ks], s0, 0, 0, 0);
        s1 = __builtin_amdgcn_mfma_f32_32x32x16_bf16(*(const LDSQ bf16x8*)(lw + sw128(32 + c, 2 * ks + hi)), qf[ks], s1, 0, 0, 0);
    }
#pragma unroll
    for (int r = 0; r < 16; ++r) { const int kc = (r & 3) + 8 * (r >> 2);
        s0[r] = kc <= lim2 ? EXP2F(s0[r] - m) * inv : 0.f; s1[r] = kc + 32 <= lim2 ? EXP2F(s1[r] - m) * inv : 0.f; }
#pragma unroll
    for (int j = 0; j < 8; ++j) { pf[0][j] = bfbits(s0[j]); pf[1][j] = bfbits(s0[8 + j]); pf[2][j] = bfbits(s1[j]); pf[3][j] = bfbits(s1[8 + j]); }
}
HD void wimp_tile(const bf16x8 (&pf)[4], f32x16& acc, int nt, int jt, int c, int hi) {
#pragma unroll
    for (int ks = 0; ks < 4; ++ks) { const int base = nt * 64 + 16 * ks + 4 * hi - 4 * (jt * 32 + c); bf16x8 af;
#pragma unroll
        for (int jj = 0; jj < 8; ++jj) { const int dl = base + 8 * (jj >> 2) + (jj & 3); af[jj] = (dl == -1 || dl == 3) ? (short)0x3F80 : ((dl >= 0 && dl <= 2) ? (short)0x4000 : (short)0); }
        acc = __builtin_amdgcn_mfma_f32_32x32x16_bf16(af, pf[ks], acc, 0, 0, 0); }
}
HD void wstage_f32(ldsp_t lw, const float* kbase, const float* vbase, size_t rs, int nvalid, int lane_) {
    const int lane = opaque_i(lane_);
#pragma unroll 4
    for (int i = 0; i < 16; ++i) { const int row = 4 * i + (lane >> 4), c4 = lane & 15; f32x4 kv = {0.f, 0.f, 0.f, 0.f}, vv = {0.f, 0.f, 0.f, 0.f};
        if (row < nvalid) { kv = *(const f32x4*)(kbase + (size_t)row * rs + c4 * 4); vv = *(const f32x4*)(vbase + (size_t)row * rs + c4 * 4); }
        bf16x4 kb; for (int e = 0; e < 4; ++e) kb[e] = (short)f2bf(kv[e]);
        *(LDSQ bf16x4*)(lw + sw128(row, c4 >> 1) + (c4 & 1) * 8) = kb;
#pragma unroll
        for (int e = 0; e < 4; ++e) *(LDSQ bf16_t*)(lw + GL_V + swv(4 * c4 + e, row >> 2) + (row & 3) * 2) = f2bf(vv[e]); }
}
HD void wstage_bf16(ldsp_t lw, const bf16_t* k, const bf16_t* vt, int lane_) {
    const int lane = opaque_i(lane_);
#pragma unroll
    for (int i = 0; i < 8; ++i) { const int id = i * 64 + lane; *(LDSQ bf16x8*)(lw + sw128(id >> 3, id & 7)) = *(const bf16x8*)(k + id * 8); }
#pragma unroll
    for (int i = 0; i < 16; ++i) { const int id = i * 64 + lane; *(LDSQ bf16x4*)(lw + GL_V + swv(id >> 4, id & 15)) = *(const bf16x4*)(vt + id * 4); }
}
HD void wpart_store(const P& p, int b, int g, int item, const AttnSt& st, int c, int hi) {
    float* o = spart(p, b, g, item) + c * SP_STRIDE; const float lt = st.l + __shfl_xor(st.l, 32);
    if (hi == 0) { o[0] = st.m; o[1] = lt; }
#pragma unroll
    for (int r = 0; r < 16; ++r) { const int d = (r & 3) + 8 * (r >> 2) + 4 * hi; o[4 + d] = st.o0[r]; o[4 + 32 + d] = st.o1[r]; }
}
HD void wload_q(const P& p, size_t wb, int b, int g, int c, int hi, bf16x8 (&qf)[4]) {
    const bf16_t* qp = wsb(p, wb) + (size_t)(NP + b * DEC_SEQ + (c >> 2)) * 512 + (g * 4 + (c & 3)) * 64 + hi * 8;
#pragma unroll
    for (int ks = 0; ks < 4; ++ks) qf[ks] = *(const bf16x8*)(qp + ks * 16);
}
static_assert(NCPADS / 64 <= SP_NCMP && SP_NCMP == 8, "one compressed tile per wave");
HD void snsa_cmp_unit(const P& p, int L, ldsp_t lds, int b, int g) {
    const int tid = opaque_tid(), lane = tid & 63, w = RFL(tid >> 6), c = lane & 31, hi = lane >> 5, s = BATCH + b; const size_t sg = (size_t)s * 2 + g;
    const ldsp_t lw = lds + w * GL_WAVE; LDSQ float* mstat = (LDSQ float*)(lds + LDS_WX);
    LDSQ float* impw = (LDSQ float*)lds;
    bf16x8 qf[4], pf[4]; AttnSt st; attn_init(st); f32x16 ima, imb;
    for (int r = 0; r < 16; ++r) { ima[r] = 0.f; imb[r] = 0.f; }
    const bool live = w < NCPADS / 64;
    if (live) {
        wload_q(p, WB_QNB, b, g, c, hi, qf);
        const int nlim = (PAST_LEN + (c >> 2) - 31) >> 4;
        wstage_bf16(lw, wsb(p, WB_KCB) + sg * NCPAD * 64 + (size_t)w * 4096, wsb(p, WB_VCT) + sg * (NCPAD / 64) * 4096 + (size_t)w * 4096, lane); WAVE_SYNC();
        wattn_tile<true>(lw, qf, nlim - 64 * w - 4 * hi, -100000, true, st, pf, c, hi);
        wimp_tile(pf, ima, w, w >> 1, c, hi);
        if ((w & 1) && (w >> 1) + 1 < 4) wimp_tile(pf, imb, w, (w >> 1) + 1, c, hi);
    }
    wpart_store(p, b, g, w, st, c, hi);
    { const float lt = st.l + __shfl_xor(st.l, 32); if (hi == 0) { mstat[(w * 32 + c) * 2] = st.m; mstat[(w * 32 + c) * 2 + 1] = lt; } }
    __syncthreads();
    float f;
    { float M = NEG_BIG;
#pragma unroll
      for (int k = 0; k < 8; ++k) M = fmaxf(M, mstat[(k * 32 + c) * 2]);
      float Lt = 0.f;
#pragma unroll
      for (int k = 0; k < 8; ++k) Lt += mstat[(k * 32 + c) * 2 + 1] * EXP2F(mstat[(k * 32 + c) * 2] - M);
      f = Lt > 0.f ? EXP2F(st.m - M) * RCPF(Lt) : 0.f; }
    for (int i = tid; i < 1024; i += NTHREADS) impw[i] = 0.f;
    __syncthreads();
    if (live) {
#define SNSA_IMP_ADD(IM, JT) { _Pragma("unroll") for (int r = 0; r < 16; ++r) { const int j = (r & 3) + 8 * (r >> 2) + 4 * hi; float v0 = IM[r] * f; \
        v0 += __shfl_xor(v0, 1); v0 += __shfl_xor(v0, 2); if ((c & 3) == 0) LDS_ADDF(&impw[(c >> 2) * 128 + (JT) * 32 + j], v0); } }
        SNSA_IMP_ADD(ima, w >> 1)
        if ((w & 1) && (w >> 1) + 1 < 4) SNSA_IMP_ADD(imb, (w >> 1) + 1)
#undef SNSA_IMP_ADD
    }
    __syncthreads();
    if (w != 0) return;
    unsigned long long u0 = 0ull, u1 = 0ull; unsigned qa = 0u, qb = 0u;
#pragma unroll 1
    for (int q = 0; q < 8; ++q) {
        const int ja = lane, jb = 64 + lane;
        const float sa = (ja < NJ) ? ((ja == 0 || ja == NJ - 1) ? INFINITY : impw[q * 128 + ja]) : -INFINITY, sb = (jb < NJ) ? ((jb == NJ - 1) ? INFINITY : impw[q * 128 + jb]) : -INFINITY;
        int ra = 0, rb = 0;
#pragma unroll 8
        for (int i = 0; i < 64; ++i) { const float a = rlane(sa, i), bq = rlane(sb, i);
            ra += ((a > sa || (a == sa && i < lane)) ? 1 : 0) + ((bq > sa) ? 1 : 0);
            rb += ((a > sb || a == sb) ? 1 : 0) + ((bq > sb || (bq == sb && i < lane)) ? 1 : 0); }
        const bool sela = ra < 15 && ja < NJ, selb = rb < 15 && jb < NJ;
        u0 |= __ballot(sela); u1 |= __ballot(selb); qa |= sela ? (1u << q) : 0u; qb |= selb ? (1u << q) : 0u;
    }
    int* sl = slist(p, b, g);
    const unsigned long long below = (lane == 0) ? 0ull : (~0ull >> (64 - lane));
    const int n0 = __builtin_popcountll(u0), n1 = __builtin_popcountll(u1);
    if ((u0 >> lane) & 1ull) { const int idx = __builtin_popcountll(u0 & below); sl[idx] = lane; sl[SL_MAX + idx] = (int)qa; }
    if ((u1 >> lane) & 1ull) { const int idx = n0 + __builtin_popcountll(u1 & below); sl[idx] = 64 + lane; sl[SL_MAX + idx] = (int)qb; }
    for (int idx = n0 + n1 + lane; idx < SL_MAX; idx += 64) { sl[idx] = (idx == n0 + n1) ? NJ : -1; sl[SL_MAX + idx] = 0xFF; }
}
HD void snsa_win_item(const P& p, int L, ldsp_t lw, int b, int g, int wi, int lane_) {
    const int lane = opaque_i(lane_), c = lane & 31, hi = lane >> 5, t = c >> 2;
    bf16x8 qf[4], pf[4]; AttnSt st; attn_init(st);
    wload_q(p, WB_QRB, b, g, c, hi, qf);
    constexpr int NCT = (WKEEP_S + DEC_SEQ + 63) / 64;
    for (int k = 0; k < 3; ++k) { const int wt = wi * 3 + k; if (wt >= NCT) break;
        const int ci0 = 64 * wt; const float* kbase; int nvalid;
        if (ci0 < WKEEP_S) { kbase = p.state_win + (((size_t)L * DEC_BATCH + b) * WKEEP_S + ci0) * 256 + g * 64; nvalid = 64; }
        else { kbase = p.ws + W_WINNEW + ((size_t)NP + b * DEC_SEQ + (ci0 - WKEEP_S)) * 256 + g * 64; nvalid = WKEEP_S + DEC_SEQ - ci0; }
        WAVE_SYNC(); wstage_f32(lw, kbase, kbase + 128, 256, nvalid, lane); WAVE_SYNC();
        if (ci0 + 63 <= WKEEP_S && ci0 > WKEEP_S + DEC_SEQ - 1 - WIN) wattn_tile<false>(lw, qf, 0, 0, true, st, pf, c, hi);
        else wattn_tile<true>(lw, qf, WKEEP_S + t - ci0 - 4 * hi, WKEEP_S + t - WIN - ci0 - 4 * hi, true, st, pf, c, hi); }
    wpart_store(p, b, g, SP_WIN0 + wi, st, c, hi);
}
HD void snsa_slc_item(const P& p, int L, ldsp_t lw, int b, int g, int si, int lane_) {
    const int lane = opaque_i(lane_), c = lane & 31, hi = lane >> 5, t = c >> 2, s = BATCH + b;
    bf16x8 qf[4], pf[4]; AttnSt st; attn_init(st);
    wload_q(p, WB_QRB, b, g, c, hi, qf);
    const int* sl = slist(p, b, g);
    for (int k = 0; k < 4; ++k) { const int e = si * 4 + k, blk = sl[e]; if (blk < 0) break;
        const unsigned qm = (unsigned)sl[SL_MAX + e];
        const float* kbase = hist(p, L, s, 64 * blk, 2, g); const int nvalid = blk < NJ ? 64 : DEC_SEQ;
        WAVE_SYNC(); wstage_f32(lw, kbase, kbase + 128, 512, nvalid, lane); WAVE_SYNC();
        const bool sel = ((qm >> t) & 1u) != 0u;
        if (blk < NJ) wattn_tile<false>(lw, qf, 0, 0, sel, st, pf, c, hi); else wattn_tile<true>(lw, qf, sel ? PAST_LEN + t - 64 * blk - 4 * hi : -100000, -100000, true, st, pf, c, hi); }
    wpart_store(p, b, g, SP_SLC0 + si, st, c, hi);
}
HD void bphase_snsa_a(const P& p, int L, ldsp_t lds) {
    const int w = RFL(opaque_tid() >> 6); const ldsp_t lw = lds + w * GL_WAVE; const int rb = (int)gridDim.x - 1 - (int)blockIdx.x;
    for (int u = rb; u < DEC_BATCH * 2; u += gridDim.x) { snsa_cmp_unit(p, L, lds, u >> 1, u & 1); __syncthreads(); }
#define lane (opaque_tid() & 63)
    for (int u = blockIdx.x * 8 + w; u < DEC_BATCH * 2 * SP_NWIN; u += gridDim.x * 8) { const int bg = u / SP_NWIN, k = u % SP_NWIN; snsa_win_item(p, L, lw, bg >> 1, bg & 1, k, lane); }
#undef lane
}
HD void bphase_snsa_b(const P& p, int L, ldsp_t lds) {
    const int w = RFL(opaque_tid() >> 6); const ldsp_t lw = lds + w * GL_WAVE;
#define lane (opaque_tid() & 63)
    for (int u = blockIdx.x * 8 + w; u < DEC_BATCH * 2 * SP_NSLC; u += gridDim.x * 8) { const int bg = u / SP_NSLC, k = u % SP_NSLC; snsa_slc_item(p, L, lw, bg >> 1, bg & 1, k, lane); }
#undef lane
}
HD void k_snsa_combine(const P& p, int L, long it) {
    const int d = (int)(it % 64), head = (int)((it / 64) % 8), rs = (int)(it / 512), b = rs / DEC_SEQ, t = rs % DEC_SEQ, g = head >> 2, col = t * 4 + (head & 3), r = NP + rs;
    const URow u = urow(p, r); float o = 0.f;
    for (int br = 0; br < 3; ++br) { const int i0 = br == 0 ? 0 : br == 1 ? SP_SLC0 : SP_WIN0, n = br == 0 ? SP_NCMP : br == 1 ? SP_NSLC : SP_NWIN;
        float M = NEG_BIG; for (int i = 0; i < n; ++i) M = fmaxf(M, spart(p, b, g, i0 + i)[col * SP_STRIDE]);
        float Ls = 0.f, Os = 0.f;
        for (int i = 0; i < n; ++i) { const float* q = spart(p, b, g, i0 + i) + col * SP_STRIDE; const float wgt = EXP2F(q[0] - M); Ls += q[1] * wgt; Os += q[4 + d] * wgt; }
        if (Ls > 0.f) o += sigmoidf_(u[C_NG + br * 8 + head]) * Os * RCPF(Ls); }
    mixb(p)[(size_t)r * D + 256 + head * 64 + d] = f2bf(o * siluf(u[C_NZ + head * 64 + d]));
}

HD float sum8(float v) { v += __shfl_xor(v, 1); v += __shfl_xor(v, 2); v += __shfl_xor(v, 7); return v; }
HD float wave_sum(float v) { v = sum8(v); v += __shfl_xor(v, 15); return (rlane(v, 0) + rlane(v, 16)) + (rlane(v, 32) + rlane(v, 48)); }
HD void cvt8(const bf16x8& x, float (&f)[8]) {
#pragma unroll
    for (int j = 0; j < 8; ++j) f[j] = bf2f((bf16_t)x[j]); }
HD bf16x8 pack8(const float (&f)[8]) { bf16x8 o;
#pragma unroll
    for (int j = 0; j < 8; ++j) o[j] = (short)f2bf(f[j]);
    return o; }
HD void st8f(float* dst, const float (&f)[8]) { f32x4 a = {f[0], f[1], f[2], f[3]}, b = {f[4], f[5], f[6], f[7]}; *(f32x4*)dst = a; *(f32x4*)(dst + 4) = b; }
HD void bphase_xin(const P& p, int L, ldsp_t lds) {
    const int w = RFL(opaque_tid() >> 6), lane = opaque_tid() & 63; const int stride = (int)gridDim.x * 8;
#pragma unroll 1
    for (int r = blockIdx.x * 8 + w; r < NT; r += 2 * stride) {
        const int r2 = r + stride; const bool two = r2 < NT;
        const float* x = xrow(p, L, r); const float* x2 = xrow(p, L, two ? r2 : r); float ss = 0.f, ss2 = 0.f; f32x4 v[4], v2[4];
#pragma unroll
        for (int k = 0; k < 4; ++k) v[k] = *(const f32x4*)(x + k * 256 + lane * 4);
#pragma unroll
        for (int k = 0; k < 4; ++k) v2[k] = *(const f32x4*)(x2 + k * 256 + lane * 4);
#pragma unroll
        for (int k = 0; k < 4; ++k) { ss += v[k][0] * v[k][0] + v[k][1] * v[k][1] + v[k][2] * v[k][2] + v[k][3] * v[k][3]; ss2 += v2[k][0] * v2[k][0] + v2[k][1] * v2[k][1] + v2[k][2] * v2[k][2] + v2[k][3] * v2[k][3]; }
        ss = wave_sum(ss); ss2 = wave_sum(ss2);
        if (lane == 0) { p.ws[W_RSTD + r] = RSQRTF(ss * (1.0f / D) + 1e-6f); if (two) p.ws[W_RSTD + r2] = RSQRTF(ss2 * (1.0f / D) + 1e-6f); }
        bf16_t* o = xbp(p) + (size_t)r * D; bf16_t* o2 = xbp(p) + (size_t)r2 * D;
#pragma unroll
        for (int k = 0; k < 4; ++k) { bf16x4 b; for (int e = 0; e < 4; ++e) b[e] = (short)f2bf(v[k][e]); *(bf16x4*)(o + k * 256 + lane * 4) = b; }
        if (two) {
#pragma unroll
            for (int k = 0; k < 4; ++k) { bf16x4 b; for (int e = 0; e < 4; ++e) b[e] = (short)f2bf(v2[k][e]); *(bf16x4*)(o2 + k * 256 + lane * 4) = b; } }
    }
}
HD void bphase_cmp_bias(const P& p, int L, ldsp_t lds) {
    const int w = RFL(opaque_tid() >> 6), lane = opaque_tid() & 63;
    for (int o = blockIdx.x * 8 + w; o < DEPTH * 128; o += gridDim.x * 8) { const int e = o % 64, lk = o / 64; float s = 0.f;
#pragma unroll 8
        for (int i = 0; i < 32; ++i) { const int q = lane + 64 * i; s += p.cmp_pos[(size_t)lk * 2048 + q] * p.cmp_w[((size_t)lk * 2048 + q) * 64 + e]; }
        s = wave_sum(s);
        if (lane == 0) p.ws[W_CBIAS + o] = s; }
}
HD void bphase_mix(const P& p, int L, ldsp_t lds) {
    const int w = RFL(opaque_tid() >> 6), lane = opaque_tid() & 63;
#pragma unroll 1
    for (int un = blockIdx.x * 8 + w; un < NS * 8; un += gridDim.x * 8) { const int kind = un >= NS * 4 ? 1 : 0, it = un - kind * NS * 4, h = it % 4, r = NP + it / 4; const URow u = urow(p, r);
        if (kind == 0) { const float o = p.ws[W_OA + (size_t)r * 256 + h * 64 + lane]; const float z = u[C_GZ + h * 64 + lane], gn = p.gla_norm_g[L * 64 + lane];
            const float rs = RSQRTF(wave_sum(o * o) * (1.0f / 64) + 1e-6f);
            mixb(p)[(size_t)r * D + h * 64 + lane] = f2bf(o * rs * gn * siluf(z)); }
        else { const float dinv = 1.0f / fmaxf(fabsf(p.ws[W_DEN + (size_t)NP * 4 + it]), EXPF(-p.ws[W_MT + (size_t)NP * 4 + it]));
            const float o = p.ws[W_H + (size_t)r * 256 + h * 64 + lane] * dinv; const float og = u[C_MO + h * 64 + lane], z = u[C_MZ + h * 64 + lane], gn = p.ml_norm_g[L * 64 + lane];
            const float rs = RSQRTF(wave_sum(o * o) * (1.0f / 64) + 1e-6f);
            mixb(p)[(size_t)r * D + 768 + h * 64 + lane] = f2bf(o * rs * gn * sigmoidf_(og) * siluf(z)); }
    }
}
HD void bphase_prep_win(const P& p, int L, ldsp_t lds) {
    constexpr long NI = (long)DEPTH * D_INP * (D / 8);
    const int tid = opaque_tid(); const long stride = (long)gridDim.x * NTHREADS;
#pragma unroll 1
    for (long i0 = (long)blockIdx.x * NTHREADS + tid; i0 < NI; i0 += 4 * stride) {
        float v[4][8];
#pragma unroll
        for (int k = 0; k < 4; ++k) { const long it = i0 + k * stride; const int n = (int)(it % D_INP), kc = (int)((it / D_INP) % (D / 8)), L2 = (int)(it / ((long)D_INP * (D / 8)));
            if (it < NI && n < D_IN) { const float* wp = p.w_in + ((size_t)L2 * D + kc * 8) * D_IN + orig_col(n);
#pragma unroll
                for (int j = 0; j < 8; ++j) v[k][j] = wp[(size_t)j * D_IN]; }
            else {
#pragma unroll
                for (int j = 0; j < 8; ++j) v[k][j] = 0.f; } }
#pragma unroll
        for (int k = 0; k < 4; ++k) { const long it = i0 + k * stride; const int n = (int)(it % D_INP), kc = (int)((it / D_INP) % (D / 8)), L2 = (int)(it / ((long)D_INP * (D / 8)));
            if (it < NI) { float gn[8]; ld8f(p.norm_g + L2 * D + kc * 8, gn);
#pragma unroll
                for (int j = 0; j < 8; ++j) v[k][j] *= gn[j];
                *(bf16x8*)(wintp(p, L2) + (size_t)n * D + kc * 8) = pack8(v[k]); } }
    }
}
HD void bphase_win_copy(const P& p, int L, ldsp_t lds) {
    constexpr int NOLD = WKEEP_S - DEC_SEQ > 0 ? WKEEP_S - DEC_SEQ : 0; constexpr long NV = (long)DEC_BATCH * NOLD * 64;
    static_assert(O_SWIN % 4 == 0, "16-byte aligned window output");
    const int tid = opaque_tid(); const long stride = (long)gridDim.x * NTHREADS;
#pragma unroll 1
    for (long i0 = (long)blockIdx.x * NTHREADS + tid; i0 < NV; i0 += 4 * stride) {
        f32x4 a[4];
#pragma unroll
        for (int k = 0; k < 4; ++k) { const long i = i0 + k * stride; if (i < NV) { const int e4 = (int)(i % 64); const long q = i / 64; const int r = (int)(q % NOLD), b = (int)(q / NOLD);
            a[k] = *(const f32x4*)(p.state_win + (((size_t)L * DEC_BATCH + b) * WKEEP_S + r + DEC_SEQ) * 256 + 4 * e4); } }
#pragma unroll
        for (int k = 0; k < 4; ++k) { const long i = i0 + k * stride; if (i < NV) { const int e4 = (int)(i % 64); const long q = i / 64; const int r = (int)(q % NOLD), b = (int)(q / NOLD);
            *(f32x4*)(p.out + O_SWIN + (((size_t)L * DEC_BATCH + b) * WKEEP_S + r) * 256 + 4 * e4) = a[k]; } }
    }
}
template <int IN> HD void bphase_sgemm_t(const P& p, int L, ldsp_t lds) {
    static_assert(NP % 256 == 0, "prompt rows fill whole 256-row GEMM panels");
    constexpr int NTILE = IN ? 4 : 1, N = IN ? D_INP : D, NRT = (NS + 31) / 32, NCG = N / (32 * NTILE), NU = NRT * NCG;
    const int tid = opaque_tid(), w = RFL(tid >> 6), lane = tid & 63;
    const bf16_t* A = IN ? xbp(p) : mixb(p); const bf16_t* Bt = IN ? wintp(p, L) : wouttp(p, L);
    LDSQ float* red = (LDSQ float*)lds;
#pragma unroll 1
    for (int un = blockIdx.x; un < NU; un += gridDim.x) {
        const int rt = un % NRT, cg = un / NRT, row0 = NP + 32 * rt, col0 = cg * 32 * NTILE;
        f32x16 acc[NTILE];
#pragma unroll
        for (int j = 0; j < NTILE; ++j)
#pragma unroll
            for (int e = 0; e < 16; ++e) acc[j][e] = 0.f;
        const bf16_t* ap = A + (size_t)(row0 + (lane & 31)) * D + 128 * w + 8 * (lane >> 5);
        const bf16_t* bp = Bt + (size_t)(col0 + (lane & 31)) * D + 128 * w + 8 * (lane >> 5);
#pragma unroll
        for (int hh = 0; hh < 2; ++hh) {
            bf16x8 af[4], bfr[NTILE][4];
#pragma unroll
            for (int s = 0; s < 4; ++s) af[s] = *(const bf16x8*)(ap + 16 * (4 * hh + s));
#pragma unroll
            for (int j = 0; j < NTILE; ++j)
#pragma unroll
                for (int s = 0; s < 4; ++s) bfr[j][s] = *(const bf16x8*)(bp + (size_t)j * 32 * D + 16 * (4 * hh + s));
#pragma unroll
            for (int s = 0; s < 4; ++s)
#pragma unroll
                for (int j = 0; j < NTILE; ++j) acc[j] = __builtin_amdgcn_mfma_f32_32x32x16_bf16(af[s], bfr[j][s], acc[j], 0, 0, 0);
            SCHED_FENCE();
        }
#pragma unroll
        for (int j = 0; j < NTILE; ++j)
#pragma unroll
            for (int e = 0; e < 16; ++e) red[((w * NTILE + j) * 16 + e) * 64 + lane] = acc[j][e];
        __syncthreads();
        float rsr[2] = {0.f, 0.f};
        if (IN) {
#pragma unroll
            for (int k = 0; k < 2; ++k) { const int reg = w + 8 * k, row = row0 + (reg & 3) + 8 * (reg >> 2) + 4 * (lane >> 5);
                if (L == 0) rsr[k] = row < NT ? p.ws[W_RSTD + row] : 0.f;
                else { const f32x4* q = (const f32x4*)(p.ws + W_XN + (size_t)row * 32); f32x4 a = q[0];
#pragma unroll
                    for (int e = 1; e < 8; ++e) a += q[e];
                    rsr[k] = RSQRTF(((a[0] + a[1]) + (a[2] + a[3])) * (1.0f / D) + 1e-6f); } } }
#pragma unroll
        for (int i = 0; i < NTILE * 2; ++i) { const int idx = tid + 512 * i, ln = idx & 63, reg = (idx >> 6) & 15, j = idx >> 10; float sm = 0.f;
#pragma unroll
            for (int w2 = 0; w2 < 8; ++w2) sm += red[((w2 * NTILE + j) * 16 + reg) * 64 + ln];
            const int row = row0 + (reg & 3) + 8 * (reg >> 2) + 4 * (ln >> 5), col = col0 + 32 * j + (ln & 31);
            if (IN) { if (row < NT) ubase(p)[(size_t)row * U_LD + col] = f2bf(sm * rsr[i & 1]); }
            else { const float y = row < NT ? xrow(p, L, row)[col] + sm : 0.f;
                if (row < NT) (L == DEPTH - 1 ? p.out + O_Y : p.ws + W_Y0)[(size_t)row * D + col] = y;
                if (L + 1 < DEPTH) {
                    if (row < NT) xbp(p)[(size_t)row * D + col] = f2bf(y);
                    float ss = y * y; ss += __shfl_xor(ss, 1); ss += __shfl_xor(ss, 2); ss += __shfl_xor(ss, 4); ss += __shfl_xor(ss, 8); ss += __shfl_xor(ss, 16);
                    if ((ln & 31) == 0 && row < NTP) p.ws[W_XN + (size_t)row * 32 + cg] = ss; } } }
        __syncthreads();
    }
}
HD void bphase_sgemm_in(const P& p, int L, ldsp_t lds) { bphase_sgemm_t<1>(p, L, lds); }
HD void bphase_sgemm_out(const P& p, int L, ldsp_t lds) { bphase_sgemm_t<0>(p, L, lds); }
HD void rope8(float (&x)[8], int l7, const float (&rc)[8], const float (&rsn)[8]) {
#pragma unroll
    for (int j = 0; j < 8; ++j) { const float pt = __shfl_xor(x[j], 1); x[j] = l7 == 0 ? x[j] * rc[j] - pt * rsn[j] : (l7 == 1 ? x[j] * rc[j] + pt * rsn[j] : x[j]); }
}
HD void bphase_rows(const P& p, int L, ldsp_t lds) {
    const int w = RFL(opaque_tid() >> 6), lane = opaque_tid() & 63, l7 = lane & 7;
    constexpr int NGP = NP / 8, NUN = NGP + NS;
#pragma unroll 1
    for (int un = blockIdx.x * 8 + w; un < NUN; un += gridDim.x * 8) {
        const int r0 = un < NGP ? un * 8 : NP + (un - NGP), ntk = un < NGP ? 8 : 1, s = seq_of_row(r0), t0 = r0 - seq_row0(s);
        float pw[3][8];
#pragma unroll
        for (int i = 0; i < 3; ++i) { const int tp = t0 + i;
            if (tp < 3) {
#pragma unroll
                for (int j = 0; j < 8; ++j) pw[i][j] = s < BATCH ? 0.f : p.state_conv[(((size_t)L * DEC_BATCH + (s - BATCH)) * 3 + tp) * 512 + 8 * lane + j]; }
            else cvt8(*(const bf16x8*)(ubase(p) + (size_t)(r0 + i - 3) * U_LD + C_MQK + 8 * lane), pw[i]); }
        const ldsp_t vtl = lds + w * GL_WAVE + lane * 16;
        bf16x8 R1, R2, R3, R5, R7;
        { const bf16_t* ur = ubase(p) + (size_t)r0 * U_LD + 8 * lane;
          R1 = *(const bf16x8*)(ur + 512); R2 = *(const bf16x8*)(ur + 1024); R3 = *(const bf16x8*)(ur + 1536); R5 = *(const bf16x8*)(ur + 2560); R7 = *(const bf16x8*)(ur + 3584); }
#pragma unroll 1
        for (int ti = 0; ti < ntk; ++ti) { {
            const int r = r0 + ti, pos = row_pos(r);
            bf16x8 N1, N2, N3, N5, N7;
            { const bf16_t* ur = ubase(p) + (size_t)(ti + 1 < ntk ? r + 1 : r) * U_LD + 8 * lane;
              N1 = *(const bf16x8*)(ur + 512); N2 = *(const bf16x8*)(ur + 1024); N3 = *(const bf16x8*)(ur + 1536); N5 = *(const bf16x8*)(ur + 2560); N7 = *(const bf16x8*)(ur + 3584); }
            float rc[8], rsn[8];
            { const float ang = (float)pos * rope_inv(l7); float c, sn; SINCOSF(ang, sn, c);
#pragma unroll
              for (int j = 0; j < 8; ++j) { rc[j] = rlane(c, j); rsn[j] = rlane(sn, j); } }
            { float v[8]; cvt8(lane >= 32 ? R1 : R2, v); float ss = 0.f;
#pragma unroll
              for (int j = 0; j < 8; ++j) ss += v[j] * v[j];
              const float rs = RSQRTF(sum8(ss) * (1.0f / 64) + 1e-6f);
#pragma unroll
              for (int j = 0; j < 8; ++j) v[j] *= rs * p.q_norm_g[L * 64 + 8 * l7 + j] * C2LOG;
              const int head = lane >= 32 ? (lane - 32) >> 3 : 4 + (lane >> 3); const size_t qo = (size_t)r * 512 + head * 64 + 8 * l7;
              *(bf16x8*)(wsb(p, WB_QNB) + qo) = pack8(v); rope8(v, l7, rc, rsn); *(bf16x8*)(wsb(p, WB_QRB) + qo) = pack8(v); }
            float* nr = new_rows_ptr(p, L, r);
            if (lane >= 32) { float v[8]; cvt8(R2, v); st8f(nr + ((lane - 32) >> 4) * 128 + (((lane - 32) >> 3) & 1) * 64 + 8 * l7, v); }
            { const int role = lane >> 4, g = (lane >> 3) & 1; float v[8]; cvt8(R3, v); float ss = 0.f;
#pragma unroll
              for (int j = 0; j < 8; ++j) ss += v[j] * v[j];
              const float rs = RSQRTF(sum8(ss) * (1.0f / 64) + 1e-6f);
              float kn[8];
#pragma unroll
              for (int j = 0; j < 8; ++j) kn[j] = v[j] * rs * p.k_norm_g[(L * 3 + (role == 0 ? 1 : 2)) * 64 + 8 * l7 + j];
              rope8(kn, l7, rc, rsn);
              if ((role & 1) == 0) {
#pragma unroll
                  for (int j = 0; j < 8; ++j) v[j] = kn[j]; }
              const bf16x8 vb = pack8(v);
              if (r < NP && (role & 1)) {
#pragma unroll
                  for (int j = 0; j < 8; ++j) *(LDSQ bf16_t*)(vtl + j * 1024 + ti * 2) = (bf16_t)vb[j]; }
              if (role < 2) st8f(nr + (2 + role) * 128 + g * 64 + 8 * l7, v);
              else { st8f(p.ws + W_WINNEW + (size_t)r * 256 + (role - 2) * 128 + g * 64 + 8 * l7, v);
                  float* wo = nullptr; const int t = t0 + ti;
                  if (r < NP) { if (t >= SEQ - WKEEP_P) wo = p.out + O_PWIN + (((size_t)L * BATCH + s) * WKEEP_P + (t - (SEQ - WKEEP_P))) * 256; }
                  else { const int i = WKEEP_S - DEC_SEQ + t; if (i >= 0) wo = p.out + O_SWIN + (((size_t)L * DEC_BATCH + (s - BATCH)) * WKEEP_S + i) * 256; }
                  if (wo) st8f(wo + (role - 2) * 128 + g * 64 + 8 * l7, v); }
              if (r < NP && (role & 1) == 0) *(bf16x8*)(wsb(p, role == 0 ? WB_KSB : WB_KWB) + (((size_t)s * 2 + g) * SEQ + (t0 + ti)) * 64 + 8 * l7) = vb; }
            { float f7[8]; cvt8(R7, f7); float a0 = p.gla_b_gate[L * 128 + lane], a1 = p.gla_b_gate[L * 128 + 64 + lane];
#pragma unroll
              for (int q = 0; q < 16; ++q) { const float x = rlane(f7[q & 7], 32 + (q >> 3)); a0 += x * p.gla_w_gate[(L * 16 + q) * 128 + lane]; a1 += x * p.gla_w_gate[(L * 16 + q) * 128 + 64 + lane]; }
              p.ws[W_LOGA + (size_t)r * 128 + lane] = log_sigmoidf(a0) * (1.0f / 16.0f); p.ws[W_LOGA + (size_t)r * 128 + 64 + lane] = log_sigmoidf(a1) * (1.0f / 16.0f); }
            { float x0[8], o[8]; cvt8(R5, x0);
#pragma unroll
              for (int j = 0; j < 8; ++j) { const int ch = 8 * lane + j; const float* cwp = p.conv_w + (size_t)L * 2048 + ch; const float a = p.conv_b[L * 512 + ch] + pw[0][j] * cwp[0] + pw[1][j] * cwp[512] + pw[2][j] * cwp[1024] + x0[j] * cwp[1536]; o[j] = siluf(a) * (lane < 32 ? 1.0f : 0.125f);
                  pw[0][j] = pw[1][j]; pw[1][j] = pw[2][j]; pw[2][j] = x0[j]; }
              st8f(lane < 32 ? p.ws + W_MQ + (size_t)r * 256 + 8 * lane : p.ws + W_MK + (size_t)r * 256 + 8 * (lane - 32), o); }
            R1 = N1; R2 = N2; R3 = N3; R5 = N5; R7 = N7;
            } SCHED_FENCE();
        }
        if (r0 < NP && ((lane >> 4) & 1)) { const int role = lane >> 4, g = (lane >> 3) & 1;
            bf16_t* vt = wsb(p, role == 1 ? WB_VST : WB_VWT) + (((size_t)s * 2 + g) * NQT + t0 / 64) * 4096 + (size_t)(8 * l7) * 64 + (t0 % 64);
#pragma unroll
            for (int j = 0; j < 8; ++j) *(bf16x8*)(vt + (size_t)j * 64) = *(const LDSQ bf16x8*)(vtl + j * 1024); }
    }
}

typedef void (*ItemFn)(const P&, int, long);
typedef void (*BlockFn)(const P&, int, ldsp_t);
static P make_params(void* const* d_in, void* d_out, void* d_ws) {
    P p;
    p.x_prompt = (const float*)d_in[0]; p.x_sample = (const float*)d_in[1]; p.cache = (const float*)d_in[2]; p.state_win = (const float*)d_in[3];
    p.state_gla = (const float*)d_in[4]; p.state_C = (const float*)d_in[5]; p.state_n = (const float*)d_in[6]; p.state_m = (const float*)d_in[7];
    p.state_conv = (const float*)d_in[8]; p.page_table = (const int*)d_in[9]; p.norm_g = (const float*)d_in[10]; p.w_in = (const float*)d_in[11];
    p.w_out = (const float*)d_in[12]; p.gla_w_gate = (const float*)d_in[13]; p.gla_b_gate = (const float*)d_in[14]; p.gla_norm_g = (const float*)d_in[15];
    p.q_norm_g = (const float*)d_in[16]; p.k_norm_g = (const float*)d_in[17]; p.cmp_pos = (const float*)d_in[18]; p.cmp_w = (const float*)d_in[19];
    p.conv_w = (const float*)d_in[20]; p.conv_b = (const float*)d_in[21]; p.gate_b = (const float*)d_in[22]; p.ml_norm_g = (const float*)d_in[23];
    p.out = (float*)d_out; p.ws = (float*)d_ws;
    return p;
}
#define LAYER_PROGRAM(LL) { const int L = LL; \
        if (XIN_NEEDED(L)) { BLK(bphase_xin); GRID_BAR(); } \
        GEMM_IN(); \
        BLK(bphase_sgemm_in); \
        GRID_BAR(); \
        BLK(bphase_rows); \
        BLK(bphase_win_copy); \
        PH(k_conv_out, (long)NSEQ * 3 * 512); \
        GRID_BAR(); \
        BLK(bphase_rec_g1); \
        BLK(bphase_cmp_sum_s); \
        GRID_BAR(); \
        PH_MID(k_gla, (long)DEC_BATCH * 256, 5); \
        PH_MID(k_mlstm, (long)DEC_BATCH * 260, 4); \
        PH_MID(k_gla_scan, (long)BATCH * 8192, 1); \
        PH_MID(k_ml_scan, (long)BATCH * 16640, 0); \
        BLK(bphase_snsa_a); \
        BLK(bphase_cmp_sum_p); \
        GRID_BAR(); \
        BLK(bphase_nsa_prompt); \
        BLK(bphase_rec_g2); \
        BLK(bphase_snsa_b); \
        BLK(bphase_mix); \
        GRID_BAR(); \
        PH(k_snsa_combine, (long)NS * 512); \
        GRID_BAR(); \
        GEMM_OUT(); \
        BLK(bphase_sgemm_out); \
        GRID_BAR(); \
    }
constexpr int LDS_BYTES = LDS_MISC + 1024 + 2048;
static_assert(NSA_END <= NSA_COMB && NSA_COMB + 8 * 8192 <= LDS_MISC, "NSA unit LDS map");

#ifdef CPU_EMU
template <ItemFn F> static void run_items(const P& p, int L, long n) {
#pragma omp parallel for schedule(dynamic, 256)
    for (long i = 0; i < n; ++i) F(p, L, i);
}
struct EmuArgs { BlockFn f; const P* p; int L; };
static void emu_tramp(void* a) { EmuArgs* e = (EmuArgs*)a; e->f(*e->p, e->L, (ldsp_t)emu_lds); }
static void emu_phase(BlockFn f, const P& p, int L) {
    const int G = 8;
#pragma omp parallel for schedule(dynamic, 1)
    for (int bx = 0; bx < G; ++bx) { EmuArgs a{f, &p, L}; emu_run_block(NTHREADS, bx, G, LDS_BYTES, emu_tramp, &a); }
}
#define PH(F, n) run_items<F>(p, L, (long)(n))
#define PH_MID(F, n, ROT) run_items<F>(p, L, (long)(n))
#define XIN_NEEDED(L) true
#define BLK(F) emu_phase(F, p, L)
#define GRID_BAR() do {} while (0)
#define GEMM_IN() PH(k_gemm_in_emu, (long)NP * D_IN)
#define GEMM_OUT() PH(k_gemm_out_emu, (long)NP * D)
static void forward(const P& p) {
#else

namespace pg8 {
#define PG8_LAS __attribute__((address_space(3)))
typedef unsigned short bf16_t;
typedef short bf16x8 __attribute__((ext_vector_type(8)));
typedef float f32x4 __attribute__((ext_vector_type(4)));
typedef unsigned u32x4 __attribute__((ext_vector_type(4)));
constexpr int BM = 256, BK = 64, HALF = 128, HTB = HALF * BK * 2  , STAGE_BYTES = 8 * HTB, NXCD = 8, WGM = 8;

__host__ __device__ __forceinline__ int lds_byte(int r, int c) { const int st = (r >> 4) * 2 + (c >> 5), rr = r & 15, cc = c & 31, ob = rr * 64 + cc * 2; return st * 1024 + (ob ^ (((ob >> 9) & 1) << 5)); }
__host__ __device__ __forceinline__ void stage_rc(int b, int& R, int& C) { const int st = b / 1024, sb = b % 1024, swz = sb ^ (((sb >> 9) & 1) << 5); R = (st >> 1) * 16 + swz / 64; C = (st & 1) * 32 + (swz % 64) / 2; }
__host__ __device__ __forceinline__ int perm32(int rho) { const int n = rho >> 4, i = rho & 15; return 8 * (i >> 2) + 4 * n + (i & 3); }

struct Unit { int pm, pn; };
struct Gemm { const bf16_t* A; const bf16_t* Bt; int M, N, K; };

struct StaticOrder {
    int nM, nN, nwg, G, c;
    __host__ __device__ void init(int M, int N, int G_, int c_) { nM = M / BM; nN = N / BM; nwg = nM * nN; G = G_; c = c_; }
    __host__ __device__ bool next(int i, Unit& u) const {
        const long L = (long)i * G + c; if (L >= nwg) return false;
        int wgid = (int)L; { const int q = nwg / NXCD, r = nwg % NXCD, xcd = wgid % NXCD, off = wgid / NXCD; wgid = (xcd < r ? xcd * (q + 1) : r * (q + 1) + (xcd - r) * q) + off; }
        const int nig = WGM * nN, gid = wgid / nig, fm = gid * WGM, gsz = (nM - fm) < WGM ? (nM - fm) : WGM;
        u.pm = fm + ((wgid % nig) % gsz); u.pn = (wgid % nig) / gsz; return true;
    }
    __device__ __forceinline__ void a_ready(const Unit&) const {}
    __device__ __forceinline__ void done(const Unit&) const {}
};
__device__ __forceinline__ unsigned cvt_pk_bf16(float lo, float hi) { unsigned r; asm volatile("v_cvt_pk_bf16_f32 %0, %1, %2" : "=v"(r) : "v"(lo), "v"(hi)); return r; }
struct EpiInBf16 {
    static constexpr bool PERM = true, AFTER_DRAIN = false;
    bf16_t* U; const float* rstd; const float* pss;
    __device__ __forceinline__ void operator()(const f32x4 (&acc)[2][2][4][2], const Unit& u, int wr, int wc, int fr, int fq) const {
        const int row0 = u.pm * BM + wr * 64 + fr, col0 = u.pn * BM + wc * 32 + 8 * fq;
#pragma unroll
        for (int ai = 0; ai < 2; ++ai)
#pragma unroll
            for (int m = 0; m < 4; ++m) { const int row = row0 + ai * HALF + m * 16; if (row >= NT) continue; float rs;
                if (pss) { const f32x4* q = (const f32x4*)(pss + (size_t)row * 32); const f32x4 a = (q[0] + q[1]) + (q[2] + q[3]); rs = __builtin_amdgcn_rsqf(((a[0] + a[1]) + (a[2] + a[3])) * (1.0f / D) + 1e-6f); }
                else rs = rstd[row];
                bf16_t* rowp = U + (size_t)row * U_LD + col0;
#pragma unroll
                for (int bj = 0; bj < 2; ++bj) { const f32x4 v0 = acc[ai][bj][m][0] * rs, v1 = acc[ai][bj][m][1] * rs; u32x4 wv;
                    wv.x = cvt_pk_bf16(v0[0], v0[1]); wv.y = cvt_pk_bf16(v0[2], v0[3]); wv.z = cvt_pk_bf16(v1[0], v1[1]); wv.w = cvt_pk_bf16(v1[2], v1[3]);
                    *(u32x4*)(rowp + bj * HALF) = wv; } }
    }
};
struct EpiOutF32 {
    static constexpr bool PERM = true, AFTER_DRAIN = false;
    float* Y; const float* Xa; const float* Xb;
    bf16_t* XB; float* PSS;
    __device__ __forceinline__ void operator()(const f32x4 (&acc)[2][2][4][2], const Unit& u, int wr, int wc, int fr, int fq) const {
        const int row0 = u.pm * BM + wr * 64 + fr, col0 = u.pn * BM + wc * 32 + 8 * fq;
#pragma unroll
        for (int ai = 0; ai < 2; ++ai)
#pragma unroll
            for (int m = 0; m < 4; ++m) { const int row = row0 + ai * HALF + m * 16; if (row >= NT) continue;
                const float* xr = row < NP ? Xa + (size_t)row * D : Xb + (size_t)(row - NP) * D; float* rowp = Y + (size_t)row * D; float ss = 0.f;
#pragma unroll
                for (int bj = 0; bj < 2; ++bj) { const int c = col0 + bj * HALF;
                    const f32x4 y0 = acc[ai][bj][m][0] + *(const f32x4*)(xr + c), y1 = acc[ai][bj][m][1] + *(const f32x4*)(xr + c + 4);
                    *(f32x4*)(rowp + c) = y0; *(f32x4*)(rowp + c + 4) = y1;
                    if (XB) { ss += y0[0] * y0[0] + y0[1] * y0[1] + y0[2] * y0[2] + y0[3] * y0[3] + y1[0] * y1[0] + y1[1] * y1[1] + y1[2] * y1[2] + y1[3] * y1[3]; u32x4 wv;
                        wv.x = cvt_pk_bf16(y0[0], y0[1]); wv.y = cvt_pk_bf16(y0[2], y0[3]); wv.z = cvt_pk_bf16(y1[0], y1[1]); wv.w = cvt_pk_bf16(y1[2], y1[3]);
                        *(u32x4*)(XB + (size_t)row * D + c) = wv; } }
                if (XB) { ss += xl_shfl_xor(ss, 16); ss += xl_shfl_xor(ss, 32); if (fq == 0) PSS[(size_t)row * 32 + u.pn * 4 + wc] = ss; } }
    }
};
template <class Epi, class Sched, bool ALIGN_EPI = false, bool SP2 = false>
__device__ __forceinline__ void gemm_phase(PG8_LAS unsigned char* lds, const Gemm g, const Sched& S, const Epi& E) {
    const int tid = hw_tid(lds), wid = __builtin_amdgcn_readfirstlane(tid >> 6), lane = tid & 63, wr = wid >> 2, wc = wid & 3, fr = lane & 15, fq = lane >> 4;
    const int K = g.K, nt = K / BK;
    unsigned voffA[2], voffB[2];
#pragma unroll
    for (int i = 0; i < 2; ++i) { int R, C; stage_rc(tid * 16 + i * 8192, R, C); const int Rb = Epi::PERM ? ((R & ~31) + perm32(R & 31)) : R;
        voffA[i] = (unsigned)(R * K + C) * 2u; voffB[i] = (unsigned)(Rb * K + C) * 2u; }
    const size_t kstep = (size_t)(BK * 2);
    const size_t hstep = (size_t)HALF * K * 2;
    const size_t tstep = 2 * hstep;
    const unsigned ldsw = (unsigned)wid * 1024u;
    const int aoff = lds_byte(wr * 64 + fr, fq * 8), boff = lds_byte(wc * 32 + fr, fq * 8);
#define PG8_SA(b, h) (((b) * 2 + (h)) * HTB)
#define PG8_SB(b, h) ((4 + (b) * 2 + (h)) * HTB)
#define PG8_STAGE(bufoff, gbase, voff) do { _Pragma("unroll") for (int _i = 0; _i < 2; ++_i) \
        __builtin_amdgcn_global_load_lds((const unsigned*)((const char*)(gbase) + (voff)[_i]), (PG8_LAS unsigned*)(lds + (bufoff) + ldsw + _i * 8192), 16, 0, 0); } while (0)
#define PG8_LDA(dst, b, h) do { _Pragma("unroll") for (int m = 0; m < 4; ++m) _Pragma("unroll") for (int k = 0; k < 2; ++k) dst[m][k] = *(const PG8_LAS bf16x8*)(lds + PG8_SA(b, h) + aoff + m * 2048 + k * 1024); } while (0)
#define PG8_LDB(dst, b, h) do { _Pragma("unroll") for (int n = 0; n < 2; ++n) _Pragma("unroll") for (int k = 0; k < 2; ++k) dst[n][k] = *(const PG8_LAS bf16x8*)(lds + PG8_SB(b, h) + boff + n * 2048 + k * 1024); } while (0)
#define PG8_MMA(ai, bj, At, Bt) do { __builtin_amdgcn_s_setprio(1); _Pragma("unroll") for (int m = 0; m < 4; ++m) _Pragma("unroll") for (int n = 0; n < 2; ++n) _Pragma("unroll") for (int k = 0; k < 2; ++k) \
        acc[ai][bj][m][n] = __builtin_amdgcn_mfma_f32_16x16x32_bf16(Bt[n][k], At[m][k], acc[ai][bj][m][n], 0, 0, 0); __builtin_amdgcn_s_setprio(0); } while (0)
#define PG8_WAIT_V(n) asm volatile("s_waitcnt vmcnt(" #n ")" ::: "memory")
#define PG8_WAIT_L(n) asm volatile("s_waitcnt lgkmcnt(" #n ")" ::: "memory")
#define PG8_BAR __builtin_amdgcn_s_barrier()
#define PG8_SCHED __builtin_amdgcn_sched_barrier(0)
    Unit cur, nxt; int ui = 0;
    if (!S.next(0, cur)) return;
    f32x4 acc[2][2][4][2];
#pragma unroll
    for (int a = 0; a < 2; ++a)
#pragma unroll
        for (int b = 0; b < 2; ++b)
#pragma unroll
            for (int m = 0; m < 4; ++m)
#pragma unroll
                for (int n = 0; n < 2; ++n) acc[a][b][m][n] = (f32x4){0.f, 0.f, 0.f, 0.f};
    bf16x8 At[4][2], B0[2][2], B1[2][2];
    const char* cA = (const char*)g.A + (size_t)cur.pm * tstep; const char* cB = (const char*)g.Bt + (size_t)cur.pn * tstep;
    S.a_ready(cur);
    if constexpr (SP2) {
        PG8_STAGE(PG8_SB(0, 0), cB, voffB); PG8_STAGE(PG8_SB(0, 1), cB + hstep, voffB); PG8_STAGE(PG8_SA(0, 0), cA, voffA); PG8_STAGE(PG8_SA(0, 1), cA + hstep, voffA);
        if (wr == 1) PG8_BAR;
        PG8_WAIT_V(2); PG8_BAR;
        PG8_STAGE(PG8_SB(1, 0), cB + kstep, voffB); PG8_STAGE(PG8_SA(1, 0), cA + kstep, voffA); PG8_STAGE(PG8_SB(1, 1), cB + hstep + kstep, voffB);
        PG8_WAIT_V(6); PG8_BAR;
    } else {
        PG8_STAGE(PG8_SB(0, 0), cB, voffB); PG8_STAGE(PG8_SA(0, 0), cA, voffA); PG8_STAGE(PG8_SB(0, 1), cB + hstep, voffB); PG8_STAGE(PG8_SA(0, 1), cA + hstep, voffA);
        if (wr == 1) PG8_BAR;
        PG8_WAIT_V(4); PG8_BAR;
        PG8_STAGE(PG8_SB(1, 0), cB + kstep, voffB); PG8_STAGE(PG8_SA(1, 0), cA + kstep, voffA); PG8_STAGE(PG8_SB(1, 1), cB + hstep + kstep, voffB);
        PG8_WAIT_V(6); PG8_BAR;
    }
    for (;;) {
        const bool has_next = S.next(ui + 1, nxt);
        const char* nA = has_next ? (const char*)g.A + (size_t)nxt.pm * tstep : cA; const char* nB = has_next ? (const char*)g.Bt + (size_t)nxt.pn * tstep : cB;
        for (int t = 0; t < nt; t += 2) {
            const bool last = (t == nt - 2);
            const char* a1 = cA + (size_t)(t + 1) * kstep;
            const char* a2 = last ? nA : cA + (size_t)(t + 2) * kstep; const char* b2 = last ? nB : cB + (size_t)(t + 2) * kstep;
            const char* a3 = a2 + kstep; const char* b3 = b2 + kstep;
            if (last && has_next) S.a_ready(nxt);
            if constexpr (SP2) {
            PG8_LDB(B0, 0, 0); PG8_LDB(B1, 0, 1); PG8_SCHED; PG8_LDA(At, 0, 0); PG8_STAGE(PG8_SA(1, 1), a1 + hstep, voffA);
            PG8_WAIT_V(8); PG8_WAIT_L(0); PG8_BAR; PG8_MMA(0, 0, At, B0); PG8_MMA(0, 1, At, B1); PG8_BAR; PG8_SCHED;
            PG8_LDA(At, 0, 1); PG8_STAGE(PG8_SB(0, 0), b2, voffB); PG8_STAGE(PG8_SB(0, 1), b2 + hstep, voffB); PG8_STAGE(PG8_SA(0, 0), a2, voffA);
            PG8_WAIT_V(8); PG8_WAIT_L(0); PG8_BAR; PG8_MMA(1, 0, At, B0); PG8_MMA(1, 1, At, B1); PG8_BAR; PG8_SCHED;
            PG8_LDB(B0, 1, 0); PG8_LDB(B1, 1, 1); PG8_SCHED; PG8_LDA(At, 1, 0); PG8_STAGE(PG8_SA(0, 1), a2 + hstep, voffA);
            PG8_WAIT_V(8); PG8_WAIT_L(0); PG8_BAR; PG8_MMA(0, 0, At, B0); PG8_MMA(0, 1, At, B1); PG8_BAR; PG8_SCHED;
            PG8_LDA(At, 1, 1); PG8_STAGE(PG8_SB(1, 0), b3, voffB); PG8_STAGE(PG8_SB(1, 1), b3 + hstep, voffB); PG8_STAGE(PG8_SA(1, 0), a3, voffA);
            PG8_WAIT_V(8); PG8_WAIT_L(0); PG8_BAR; PG8_MMA(1, 0, At, B0); PG8_MMA(1, 1, At, B1); PG8_BAR; PG8_SCHED;
            } else {
            PG8_LDB(B0, 0, 0); PG8_SCHED; PG8_LDA(At, 0, 0); PG8_STAGE(PG8_SA(1, 1), a1 + hstep, voffA);
            PG8_WAIT_L(8); PG8_BAR; PG8_WAIT_L(0); PG8_MMA(0, 0, At, B0); PG8_BAR; PG8_SCHED;
            PG8_LDB(B1, 0, 1); PG8_STAGE(PG8_SB(0, 0), b2, voffB);
            PG8_BAR; PG8_WAIT_L(0); PG8_MMA(0, 1, At, B1); PG8_BAR;
            PG8_LDA(At, 0, 1); PG8_STAGE(PG8_SA(0, 0), a2, voffA);
            PG8_BAR; PG8_WAIT_L(0); PG8_MMA(1, 0, At, B0); PG8_BAR; PG8_SCHED;
            PG8_STAGE(PG8_SB(0, 1), b2 + hstep, voffB);
            PG8_WAIT_V(6); PG8_BAR; PG8_MMA(1, 1, At, B1); PG8_BAR;
            PG8_LDB(B0, 1, 0); PG8_SCHED; PG8_LDA(At, 1, 0); PG8_STAGE(PG8_SA(0, 1), a2 + hstep, voffA);
            PG8_WAIT_L(8); PG8_BAR; PG8_WAIT_L(0); PG8_MMA(0, 0, At, B0); PG8_BAR; PG8_SCHED;
            PG8_LDB(B1, 1, 1); PG8_STAGE(PG8_SB(1, 0), b3, voffB);
            PG8_BAR; PG8_WAIT_L(0); PG8_MMA(0, 1, At, B1); PG8_BAR;
            PG8_LDA(At, 1, 1); PG8_STAGE(PG8_SA(1, 0), a3, voffA);
            PG8_BAR; PG8_WAIT_L(0); PG8_MMA(1, 0, At, B0); PG8_BAR; PG8_SCHED;
            PG8_STAGE(PG8_SB(1, 1), b3 + hstep, voffB);
            PG8_WAIT_V(6); PG8_BAR; PG8_MMA(1, 1, At, B1); PG8_BAR;
            }
        }
        if constexpr (ALIGN_EPI) { if (wr == 0) PG8_BAR; }
        if constexpr (!Epi::AFTER_DRAIN) { E(acc, cur, wr, wc, fr, fq); S.done(cur); }
        if (!has_next) break;
#pragma unroll
        for (int a = 0; a < 2; ++a)
#pragma unroll
            for (int b = 0; b < 2; ++b)
#pragma unroll
                for (int m = 0; m < 4; ++m)
#pragma unroll
                    for (int n = 0; n < 2; ++n) acc[a][b][m][n] = (f32x4){0.f, 0.f, 0.f, 0.f};
        cur = nxt; cA = nA; cB = nB; ++ui;
        if constexpr (ALIGN_EPI) { if (wr == 1) PG8_BAR; }
    }
    PG8_WAIT_V(0);
    if constexpr (!ALIGN_EPI) { if (wr == 0) PG8_BAR; }
    PG8_BAR;
    if constexpr (Epi::AFTER_DRAIN) { E.fused(acc, cur, wr, wc, fr, fq, lds, wid, lane); S.done(cur); }
#undef PG8_SA
#undef PG8_SB
#undef PG8_STAGE
#undef PG8_LDA
#undef PG8_LDB
#undef PG8_MMA
#undef PG8_WAIT_V
#undef PG8_WAIT_L
#undef PG8_BAR
#undef PG8_SCHED
}
}
#define XB_TMO      128
#define XB_XCNT(j)  (256  + 64 * (j))
#define XB_XSUB(j)  (1280 + 64 * (j))
#define XB_XGEN(j)  (2304 + 64 * (j))
#define XB_TOP      3328
#define XB_TOPGEN   3392
#define XCD_BAR_WORDS 3456
#define XB_SPIN_CAP (1u << 22)
#define LAS __attribute__((address_space(3)))
__device__ __forceinline__ unsigned xb_ld(unsigned* p)              { return __hip_atomic_load(p, __ATOMIC_RELAXED, __HIP_MEMORY_SCOPE_AGENT); }
__device__ __forceinline__ unsigned xb_add(unsigned* p, unsigned v) { return __hip_atomic_fetch_add(p, v, __ATOMIC_RELAXED, __HIP_MEMORY_SCOPE_AGENT); }
__device__ __forceinline__ unsigned xb_xcc_id() { return (unsigned)__builtin_amdgcn_s_getreg((3 << 11) | 20) & 0xFu; }
#define XB_SPIN(cond, bar) do { unsigned _sp = 0; while (cond) { __builtin_amdgcn_s_sleep(1); \
    if ((++_sp & 255u) == 0u) { if (xb_ld(&(bar)[XB_TMO])) break; if (_sp > XB_SPIN_CAP) { atomicAdd(&(bar)[XB_TMO], 1u); break; } } } } while (0)
struct XcdBarrier { unsigned* bar; unsigned x; volatile LAS unsigned* st; };
#define XB_TID0() (hw_tid((LAS unsigned char*)b.st - LDS_MISC) == 0)
__device__ __forceinline__ XcdBarrier xcd_barrier_post(unsigned* bar, volatile LAS unsigned* st) {
    XcdBarrier b; b.bar = bar; b.x = xb_xcc_id(); b.st = st;
    if (XB_TID0()) (void)xb_add(&bar[XB_XCNT(b.x)], 1u);
    return b;
}
__device__ __forceinline__ void xcd_barrier_complete(unsigned* bar, unsigned x, unsigned& nloc, unsigned& nx) {
    const unsigned G = gridDim.x * gridDim.y * gridDim.z;
    unsigned sum, cnt, mine, sp = 0u;
    for (;;) {
        sum = 0u; cnt = 0u; mine = 0u;
#pragma unroll
        for (unsigned j = 0; j < 16; ++j) { const unsigned c = xb_ld(&bar[XB_XCNT(j)]); sum += c; cnt += (c > 0u) ? 1u : 0u; mine = (j == x) ? c : mine; }
        if (sum == G) break;
        __builtin_amdgcn_s_sleep(1);
        if ((++sp & 255u) == 0u) { if (xb_ld(&bar[XB_TMO])) break; if (sp > XB_SPIN_CAP) { atomicAdd(&bar[XB_TMO], 1u); break; } }
    }
    nloc = mine > 0u ? mine : 1u; nx = cnt > 0u ? cnt : 1u;
}
__device__ __forceinline__ void xcd_barrier(const XcdBarrier& b) {
    asm volatile("s_waitcnt vmcnt(0)" ::: "memory");
    __syncthreads();
    if (XB_TID0()) {
        unsigned* bar = b.bar;
        __builtin_amdgcn_s_waitcnt(0);
        unsigned nloc = b.st[0], nx = b.st[1];
        if (nloc == 0u) { xcd_barrier_complete(bar, b.x, nloc, nx); b.st[0] = nloc; b.st[1] = nx; }
        const unsigned old = xb_add(&bar[XB_XSUB(b.x)], 1u);
        const unsigned gen = old / nloc;
        if (old + 1u == (gen + 1u) * nloc) {
            __builtin_amdgcn_fence(__ATOMIC_RELEASE, "agent");
            asm volatile("s_waitcnt vmcnt(0)" ::: "memory");
            const unsigned og = xb_add(&bar[XB_TOP], 1u);
            const unsigned tg = og / nx;
            if (og + 1u == (tg + 1u) * nx) xb_add(&bar[XB_TOPGEN], 1u);
            else XB_SPIN(xb_ld(&bar[XB_TOPGEN]) == tg, bar);
            __builtin_amdgcn_fence(__ATOMIC_ACQUIRE, "agent");
            xb_add(&bar[XB_XGEN(b.x)], 1u);
            asm volatile("s_waitcnt vmcnt(0)" ::: "memory");
        } else {
            XB_SPIN(xb_ld(&bar[XB_XGEN(b.x)]) == gen, bar);
            __builtin_amdgcn_fence(__ATOMIC_ACQUIRE, "agent");
            asm volatile("s_waitcnt vmcnt(0)" ::: "memory");
        }
    }
    __syncthreads();
}

constexpr int LDS_PTAB = LDS_MISC + 64;
__device__ __forceinline__ P load_params(LAS unsigned char* ldsb) {
    unsigned off = LDS_PTAB; asm volatile("" : "+s"(off) :: "memory");
    LAS const unsigned long long* t = (LAS const unsigned long long*)(ldsb + off);
    union { P p; const void* v[NPTR]; } u;
#pragma unroll
    for (int i = 0; i < NPTR; ++i) { const unsigned long long x = t[i]; const unsigned lo = __builtin_amdgcn_readfirstlane((unsigned)x), hi = __builtin_amdgcn_readfirstlane((unsigned)(x >> 32));
        u.v[i] = (const void*)(__attribute__((address_space(1))) const void*)(((unsigned long long)hi << 32) | lo); }
    return u.p;
}
#define PH(F, n) do { const unsigned _t = (unsigned)hw_tid((LAS unsigned char*)lds); const long _G = (long)gridDim.x; const P _q = load_params((LAS unsigned char*)lds); \
        for (long _i = ((long)blockIdx.x + _G * (_t >> 6)) * 64 + (_t & 63); _i < (long)(n); _i += _G * NTHREADS) F(_q, L, _i); } while (0)
#define PH_MID(F, n, ROT) do { const unsigned _t = (unsigned)hw_tid((LAS unsigned char*)lds); const long _G = (long)gridDim.x, _b0 = _G / 8, _nb = _G - _b0 - _G / 4, _lb = (long)blockIdx.x - _b0; \
        const P _q = load_params((LAS unsigned char*)lds); \
        if (_lb >= 0 && _lb < _nb) for (long _i = (_lb + _nb * (long)(((_t >> 6) + (ROT)) & 7u)) * 64 + (_t & 63); _i < (long)(n); _i += _nb * NTHREADS) F(_q, L, _i); } while (0)
#define BLK(F) do { __syncthreads(); const P _q = load_params((LAS unsigned char*)lds); F(_q, L, (ldsp_t)lds); } while (0)
#define GRID_BAR() xcd_barrier(bar)
#define XIN_NEEDED(L) ((L) == 0)
#define GEMM_IN() do { const P p = load_params((LAS unsigned char*)lds); pg8::Gemm g{xbp(p), wintp(p, L), NP, D_INP, D}; pg8::StaticOrder S; S.init(NP, D_INP, (int)gridDim.x, (int)blockIdx.x); \
        pg8::EpiInBf16 E{ubase(p), p.ws + W_RSTD, L == 0 ? (const float*)nullptr : p.ws + W_XN}; pg8::gemm_phase<pg8::EpiInBf16, pg8::StaticOrder, true, true>((LAS unsigned char*)lds, g, S, E); } while (0)
#define GEMM_OUT() do { const P p = load_params((LAS unsigned char*)lds); pg8::Gemm g{mixb(p), wouttp(p, L), NP, D, D}; pg8::StaticOrder S; S.init(NP, D, (int)gridDim.x, (int)blockIdx.x); \
        pg8::EpiOutF32 E{L == DEPTH - 1 ? p.out + O_Y : p.ws + W_Y0, L == 0 ? p.x_prompt : p.ws + W_Y0, L == 0 ? p.x_sample : p.ws + W_Y0 + (size_t)NP * D, L + 1 < DEPTH ? xbp(p) : (bf16_t*)nullptr, p.ws + W_XN}; \
        pg8::gemm_phase<pg8::EpiOutF32, pg8::StaticOrder, true, true>((LAS unsigned char*)lds, g, S, E); } while (0)
__global__ void __launch_bounds__(NTHREADS, 2) mega(P parg, unsigned* barw) {
    extern __shared__ __attribute__((aligned(16))) unsigned char lds[];
    if (threadIdx.x < 16) ((LAS unsigned*)((LAS unsigned char*)lds + LDS_MISC))[threadIdx.x] = 0u;
    if ((threadIdx.x & 63) == 0) { const unsigned hw = (unsigned)__builtin_amdgcn_s_getreg((5 << 11) | 4) & 63u; *(LAS int*)((LAS unsigned char*)lds + LDS_WTAB + hw * 4) = (int)(threadIdx.x >> 6); }
    if (threadIdx.x == 64) { union { P p; unsigned long long v[NPTR]; } u; u.p = parg;
#pragma unroll
        for (int i = 0; i < NPTR; ++i) ((LAS unsigned long long*)((LAS unsigned char*)lds + LDS_PTAB))[i] = u.v[i]; }
    __syncthreads();
    XcdBarrier bar = xcd_barrier_post(barw, (volatile LAS unsigned*)((LAS unsigned char*)lds + LDS_MISC));
#endif
    { const int L = 0; BLK(bphase_prep_win); PH(k_prep_wout, (long)DEPTH * D * (D / 8)); PH(k_prep_wc, (long)DEPTH * 32768); PH(k_cmp_pad, (long)NSEQ * NCPAD * 2); BLK(bphase_cmp_bias); }
    static_assert(DEPTH == 2, "layer program is instantiated per layer");
    LAYER_PROGRAM(0)
    LAYER_PROGRAM(1)
}

#ifndef CPU_EMU
extern "C" void kernel_launch(void* const* d_in, const int* in_sizes, int n_in, void* d_out, int out_size, void* d_ws, size_t ws_size, hipStream_t stream) {
    P p = make_params(d_in, d_out, d_ws);
    static int grid = 0;
    if (!grid) {
        int dev = 0, cus = 0, per_cu = 0;
        hipGetDevice(&dev);
        hipDeviceGetAttribute(&cus, hipDeviceAttributeMultiprocessorCount, dev);
        (void)hipFuncSetAttribute((const void*)mega, hipFuncAttributeMaxDynamicSharedMemorySize, LDS_BYTES);
        (void)hipOccupancyMaxActiveBlocksPerMultiprocessor(&per_cu, (const void*)mega, NTHREADS, LDS_BYTES);
        (void)hipGetLastError(); grid = cus;
    }
    unsigned* barw = (unsigned*)((char*)d_ws + WB_BAR);
    hipMemsetAsync(barw, 0, 16384, stream);
    hipLaunchKernelGGL(mega, dim3(grid), dim3(NTHREADS), LDS_BYTES, stream, p, barw);
}
#endif
```

```cpp
#ifndef CPU_EMU
#include <hip/hip_runtime.h>
#define HD __host__ __device__ __forceinline__
#else
#include "emu.h"
#define HD inline
#endif
#include <stdint.h>
#include <math.h>

#ifndef CFG_BATCH
#define CFG_BATCH 4
#define CFG_SEQ 4096
#define CFG_DEC_BATCH 32
#define CFG_PAST_LEN 8192
#endif
constexpr int BATCH = CFG_BATCH, SEQ = CFG_SEQ, DEC_BATCH = CFG_DEC_BATCH, DEC_SEQ = 8, PAST_LEN = CFG_PAST_LEN, DEPTH = 2;
constexpr int D = 1024, D_IN = 3888, PAGE = 128;
constexpr int NP = BATCH * SEQ, NS = DEC_BATCH * DEC_SEQ, NT = NP + NS, NSEQ = BATCH + DEC_BATCH;
constexpr int NPAGES = PAST_LEN / PAGE, NUSED = DEC_BATCH * NPAGES, NPOOL = NUSED + (NUSED / 4 > 1 ? NUSED / 4 : 1);
constexpr int WIN = 512, WKEEP_P = SEQ < WIN ? SEQ : WIN, WKEEP_S = PAST_LEN < WIN ? PAST_LEN : WIN;
constexpr int NCP = SEQ / 16 - 1, NCS = (PAST_LEN + DEC_SEQ) / 16 - 1, NCMAX = NCP > NCS ? NCP : NCS;
constexpr int NSELP = (SEQ + 63) / 64, NSELS = (PAST_LEN + DEC_SEQ + 63) / 64, NSELMAX = NSELP > NSELS ? NSELP : NSELS;
constexpr int C_GQ = 0, C_GK = 128, C_GV = 256, C_GZ = 512, C_NQ = 768, C_NKV = 1280, C_NZ = 2048, C_MQK = 2560, C_MV = 3072, C_MO = 3328, C_MZ = 3584,
              C_GA = 3840, C_NG = 3856, C_MIF = 3880;
HD int orig_col(int n) { return n < 512 ? n : n < 768 ? 528 + (n - 512) : n < 1280 ? 784 + (n - 768) : n < 2048 ? 1296 + (n - 1280) : n < 2560 ? 2088 + (n - 2048) : n < 3072 ? 2600 + (n - 2560)
    : n < 3328 ? 3112 + (n - 3072) : n < 3584 ? 3376 + (n - 3328) : n < 3840 ? 3632 + (n - 3584) : n < 3856 ? 512 + (n - 3840) : n < 3880 ? 2064 + (n - 3856) : 3368 + (n - 3880); }
constexpr size_t O_Y = 0;
constexpr size_t O_PROWS = O_Y + (size_t)NT * D;
constexpr size_t O_SROWS = O_PROWS + (size_t)DEPTH * NP * 512;
constexpr size_t O_PWIN = O_SROWS + (size_t)DEPTH * NS * 512;
constexpr size_t O_SWIN = O_PWIN + (size_t)DEPTH * BATCH * WKEEP_P * 256;
constexpr size_t O_PGLA = O_SWIN + (size_t)DEPTH * DEC_BATCH * WKEEP_S * 256;
constexpr size_t O_SGLA = O_PGLA + (size_t)DEPTH * BATCH * 4 * 32 * 64;
constexpr size_t O_PC = O_SGLA + (size_t)DEPTH * DEC_BATCH * 4 * 32 * 64;
constexpr size_t O_SC = O_PC + (size_t)DEPTH * BATCH * 4 * 64 * 64;
constexpr size_t O_PN = O_SC + (size_t)DEPTH * DEC_BATCH * 4 * 64 * 64;
constexpr size_t O_SN = O_PN + (size_t)DEPTH * BATCH * 4 * 64;
constexpr size_t O_PM = O_SN + (size_t)DEPTH * DEC_BATCH * 4 * 64;
constexpr size_t O_SM = O_PM + (size_t)DEPTH * BATCH * 4;
constexpr size_t O_PCONV = O_SM + (size_t)DEPTH * DEC_BATCH * 4;
constexpr size_t O_SCONV = O_PCONV + (size_t)DEPTH * BATCH * 3 * 512;
constexpr size_t O_END = O_SCONV + (size_t)DEPTH * DEC_BATCH * 3 * 512;
constexpr size_t W_RSTD = 0;
constexpr size_t W_XN = W_RSTD + NT;
constexpr size_t W_U = W_XN + (size_t)NT * D;
constexpr size_t W_QN = W_U + (size_t)NT * D_IN;
constexpr size_t W_QR = W_QN + (size_t)NT * 512;
constexpr size_t W_WINNEW = W_QR + (size_t)NT * 512;
constexpr size_t W_LOGA = W_WINNEW + (size_t)NT * 256;
constexpr size_t W_MQ = W_LOGA + (size_t)NT * 128;
constexpr size_t W_MK = W_MQ + (size_t)NT * 256;
constexpr size_t W_CBIAS = W_MK + (size_t)NT * 256;
constexpr size_t W_KC = W_CBIAS + 256;
constexpr size_t W_VC = W_KC + (size_t)NSEQ * NCMAX * 128;
constexpr size_t W_PCMP = W_VC + (size_t)NSEQ * NCMAX * 128;
constexpr size_t W_OCMP = W_PCMP + (size_t)NT * 8 * NCMAX;
constexpr size_t W_IMP = W_OCMP + (size_t)NT * 512;
constexpr size_t W_SEL = W_IMP + (size_t)NT * 2 * NSELMAX;
constexpr size_t W_PSLC = W_SEL + (size_t)NT * 2 * 16;
constexpr size_t W_OSLC = W_PSLC + (size_t)NT * 8 * 1024;
constexpr size_t W_PWIN = W_OSLC + (size_t)NT * 512;
constexpr size_t W_OWIN = W_PWIN + (size_t)NT * 8 * 512;
constexpr size_t W_OA = W_OWIN + (size_t)NT * 512;
constexpr size_t W_H = W_OA + (size_t)NT * 256;
constexpr size_t W_MIXED = W_H + (size_t)NT * 256;
constexpr size_t W_Y0 = W_MIXED + (size_t)NT * D;
constexpr size_t W_DEN = W_Y0 + (size_t)NT * D;
constexpr size_t W_MT = W_DEN + (size_t)NT * 4;
constexpr size_t W_GSLOC = W_MT + (size_t)NT * 4;
constexpr size_t W_GSBL = W_GSLOC + (size_t)BATCH * 4 * (SEQ / 64) * 2048;
constexpr size_t W_MCLOC = W_GSBL + (size_t)BATCH * 4 * (SEQ / 64) * 32;
constexpr size_t W_MFG = W_MCLOC + (size_t)BATCH * 4 * (SEQ / 64) * 4160;
constexpr size_t W_SPART = W_MFG + (size_t)BATCH * 4 * (SEQ / 64) * 4;
constexpr size_t W_SLIST = W_SPART + (size_t)DEC_BATCH * 2 * 40 * 32 * 68;
constexpr size_t W_END = W_SLIST + (size_t)DEC_BATCH * 2 * 2 * 112;
constexpr int NTP = (NT + 255) / 256 * 256, D_INP = 4096;
constexpr size_t WB_WINT = (W_END * 4 + 255) / 256 * 256;
constexpr size_t WB_WOUTT = WB_WINT + (size_t)DEPTH * D_INP * D * 2;
constexpr size_t WB_XB = WB_WOUTT + (size_t)DEPTH * D * D * 2;
constexpr size_t WB_MIXB = WB_XB + (size_t)NTP * D * 2;
constexpr int NQT = SEQ / 64, NCPADP = (NCP + 63) / 64 * 64, NCPADS = (NCS + 63) / 64 * 64, NCPAD = NCPADP > NCPADS ? NCPADP : NCPADS;
constexpr size_t WB_QNB = WB_MIXB + (size_t)NTP * D * 2;
constexpr size_t WB_QRB = WB_QNB + (size_t)NT * 512 * 2;
constexpr size_t WB_KSB = WB_QRB + (size_t)NT * 512 * 2;
constexpr size_t WB_VST = WB_KSB + (size_t)BATCH * 2 * SEQ * 64 * 2;
constexpr size_t WB_KWB = WB_VST + (size_t)BATCH * 2 * SEQ * 64 * 2;
constexpr size_t WB_VWT = WB_KWB + (size_t)BATCH * 2 * SEQ * 64 * 2;
constexpr size_t WB_KCB = WB_VWT + (size_t)BATCH * 2 * SEQ * 64 * 2;
constexpr size_t WB_VCT = WB_KCB + (size_t)NSEQ * 2 * NCPAD * 64 * 2;
constexpr size_t WB_WCT = WB_VCT + (size_t)NSEQ * 2 * NCPAD * 64 * 2;
constexpr int U_LD = D_INP;
constexpr size_t WB_UB = WB_WCT + (size_t)DEPTH * 2 * 64 * 2048 * 2;
constexpr size_t WB_BAR = WB_UB + (size_t)NTP * U_LD * 2;
constexpr size_t WB_END = WB_BAR + 16384;
typedef unsigned short bf16_t;
#ifdef CPU_EMU
HD bf16_t f2bf(float f) { unsigned u = __builtin_bit_cast(unsigned, f); return (bf16_t)((u + 0x7fffu + ((u >> 16) & 1u)) >> 16); }
#else
__device__ __forceinline__ bf16_t f2bf(float f) { const __bf16 h = (__bf16)f; return __builtin_bit_cast(bf16_t, h); }
__host__ inline bf16_t f2bf_host(float f) { unsigned u = __builtin_bit_cast(unsigned, f); return (bf16_t)((u + 0x7fffu + ((u >> 16) & 1u)) >> 16); }
#endif
HD float bf2f(bf16_t h) { return __builtin_bit_cast(float, (unsigned)h << 16); }

constexpr int NPTR = 26;
struct P {
    const float *x_prompt, *x_sample, *cache, *state_win, *state_gla, *state_C, *state_n, *state_m, *state_conv;
    const int* page_table;
    const float *norm_g, *w_in, *w_out, *gla_w_gate, *gla_b_gate, *gla_norm_g, *q_norm_g, *k_norm_g, *cmp_pos, *cmp_w,
        *conv_w, *conv_b, *gate_b, *ml_norm_g;
    float* out;
    float* ws;
};
static_assert(sizeof(P) == NPTR * 8, "P is a table of NPTR pointers");

HD int seq_of_row(int r) { return r < NP ? r / SEQ : BATCH + (r - NP) / DEC_SEQ; }
HD int seq_row0(int s) { return s < BATCH ? s * SEQ : NP + (s - BATCH) * DEC_SEQ; }
HD int seq_len(int s) { return s < BATCH ? SEQ : DEC_SEQ; }
HD int seq_pos0(int s) { return s < BATCH ? 0 : PAST_LEN; }
HD int seq_ncmp(int s) { return s < BATCH ? NCP : NCS; }
HD int seq_nsel(int s) { return s < BATCH ? NSELP : NSELS; }
HD int row_pos(int r) { return r < NP ? r % SEQ : PAST_LEN + (r - NP) % DEC_SEQ; }
HD const float* xrow(const P& p, int L, int r) {
    if (L == 0) return r < NP ? p.x_prompt + (size_t)r * D : p.x_sample + (size_t)(r - NP) * D;
    return p.ws + W_Y0 + (size_t)r * D;
}
HD float* new_rows_ptr(const P& p, int L, int r) {
    return r < NP ? p.out + O_PROWS + ((size_t)L * NP + r) * 512 : p.out + O_SROWS + ((size_t)L * NS + (r - NP)) * 512;
}
HD const float* hist(const P& p, int L, int s, int r, int slot, int g) {
    if (s < BATCH) return p.out + O_PROWS + ((size_t)L * NP + (size_t)s * SEQ + r) * 512 + slot * 128 + g * 64;
    const int b = s - BATCH;
    if (r < PAST_LEN) { const int page = p.page_table[b * NPAGES + r / PAGE];
        return p.cache + (((size_t)L * NPOOL + page) * PAGE + (r % PAGE)) * 512 + slot * 128 + g * 64; }
    return p.out + O_SROWS + ((size_t)L * NS + b * DEC_SEQ + (r - PAST_LEN)) * 512 + slot * 128 + g * 64;
}
HD const float* ctxp(const P& p, int L, int s, int kpos, int kv, int g) {
    if (s < BATCH) return p.ws + W_WINNEW + ((size_t)s * SEQ + kpos) * 256 + kv * 128 + g * 64;
    const int b = s - BATCH;
    if (kpos < PAST_LEN) return p.state_win + (((size_t)L * DEC_BATCH + b) * WKEEP_S + (kpos - (PAST_LEN - WKEEP_S))) * 256 + kv * 128 + g * 64;
    return p.ws + W_WINNEW + ((size_t)NP + b * DEC_SEQ + (kpos - PAST_LEN)) * 256 + kv * 128 + g * 64;
}
HD bf16_t* wsb(const P& p, size_t off) { return (bf16_t*)((char*)p.ws + off); }
struct URow { const bf16_t* q; HD float operator[](size_t i) const { return bf2f(q[i]); } HD URow operator+(size_t k) const { return URow{q + k}; } };
HD bf16_t* ubase(const P& p) { return (bf16_t*)((char*)p.ws + WB_UB); }
HD URow urow(const P& p, int r) { return URow{ubase(p) + (size_t)r * U_LD}; }
HD bf16_t* mixb(const P& p) { return (bf16_t*)((char*)p.ws + WB_MIXB); }
HD bf16_t* xbp(const P& p) { return (bf16_t*)((char*)p.ws + WB_XB); }
HD bf16_t* wintp(const P& p, int L) { return (bf16_t*)((char*)p.ws + WB_WINT) + (size_t)L * D_INP * D; }
HD bf16_t* wouttp(const P& p, int L) { return (bf16_t*)((char*)p.ws + WB_WOUTT) + (size_t)L * D * D; }
#ifdef CPU_EMU
HD float EXPF(float x) { return expf(x); }
HD float RCPF(float x) { return 1.0f / x; }
HD float RSQRTF(float x) { return 1.0f / sqrtf(x); }
HD float LOG1PF(float e) { return log1pf(e); }
HD void SINCOSF(float a, float& sn, float& c) { sn = sinf(a); c = cosf(a); }
#else
__device__ __forceinline__ float EXPF(float x) { return __builtin_amdgcn_exp2f(x * 1.4426950408889634f); }
__device__ __forceinline__ float RCPF(float x) { return __builtin_amdgcn_rcpf(x); }
__device__ __forceinline__ float RSQRTF(float x) { return __builtin_amdgcn_rsqf(x); }
__device__ __forceinline__ float LOG1PF(float e) { return __builtin_amdgcn_logf(1.0f + e) * 0.6931471805599453f; }
__device__ __forceinline__ void SINCOSF(float a, float& sn, float& c) { const float fr = __builtin_amdgcn_fractf(a * 0.15915494309189535f); sn = __builtin_amdgcn_sinf(fr); c = __builtin_amdgcn_cosf(fr); }
#endif
HD float log_sigmoidf(float x) { return fminf(x, 0.f) - LOG1PF(EXPF(-fabsf(x))); }
HD float sigmoidf_(float x) { return RCPF(1.f + EXPF(-x)); }
HD float siluf(float x) { return x * RCPF(1.f + EXPF(-x)); }
HD float rope_inv(int i) { return EXPF(-logf(500000.0f) * (float)i * 2.0f / 16.0f); }

HD void k_prep_win(const P& p, int L, long it) {
    const int n = (int)(it % D_INP), kc = (int)((it / D_INP) % (D / 8)), L2 = (int)(it / ((long)D_INP * (D / 8)));
    bf16_t* o = wintp(p, L2) + (size_t)n * D + kc * 8;
    for (int j = 0; j < 8; ++j) { const int k = kc * 8 + j; o[j] = n < D_IN ? f2bf(p.norm_g[L2 * D + k] * p.w_in[((size_t)L2 * D + k) * D_IN + orig_col(n)]) : (bf16_t)0; }
}
HD void k_prep_wout(const P& p, int L, long it) {
    const int n = (int)(it % D), kc = (int)((it / D) % (D / 8)), L2 = (int)(it / ((long)D * (D / 8)));
    bf16_t* o = wouttp(p, L2) + (size_t)n * D + kc * 8;
    for (int j = 0; j < 8; ++j) { const int k = kc * 8 + j; o[j] = f2bf(p.w_out[((size_t)L2 * D + k) * D + n]); }
}
HD void k_gemm_in_emu(const P& p, int L, long it) {
    const int r = (int)(it / D_IN), c = (int)(it % D_IN);
    const bf16_t* a = xbp(p) + (size_t)r * D; const bf16_t* w = wintp(p, L) + (size_t)c * D; float s = 0.f;
    for (int k = 0; k < D; ++k) s += bf2f(a[k]) * bf2f(w[k]);
    ubase(p)[(size_t)r * U_LD + c] = f2bf(s * p.ws[W_RSTD + r]);
}
HD void k_win_copy(const P& p, int L, long it) {
    constexpr int NOLD = WKEEP_S - DEC_SEQ > 0 ? WKEEP_S - DEC_SEQ : 0;
    const int e = (int)(it % 256); const long q = it / 256; const int i = (int)(q % NOLD), b = (int)(q / NOLD);
    p.out[O_SWIN + (((size_t)L * DEC_BATCH + b) * WKEEP_S + i) * 256 + e] = p.state_win[(((size_t)L * DEC_BATCH + b) * WKEEP_S + i + DEC_SEQ) * 256 + e];
}
HD float conv_xp(const P& p, int L, int s, int tp, int ch) {
    if (tp < 3) return s < BATCH ? 0.f : p.state_conv[(((size_t)L * DEC_BATCH + (s - BATCH)) * 3 + tp) * 512 + ch];
    return urow(p, seq_row0(s) + tp - 3)[C_MQK + ch];
}
HD void k_conv_out(const P& p, int L, long it) {
    const int ch = (int)(it % 512), i = (int)((it / 512) % 3), s = (int)(it / 1536);
    const float v = conv_xp(p, L, s, seq_len(s) + i, ch);
    if (s < BATCH) p.out[O_PCONV + (((size_t)L * BATCH + s) * 3 + i) * 512 + ch] = v;
    else p.out[O_SCONV + (((size_t)L * DEC_BATCH + (s - BATCH)) * 3 + i) * 512 + ch] = v;
}
HD void k_cmp_sum(const P& p, int L, long it) {
    const int e = (int)(it % 64), g = (int)((it / 64) % 2), kv = (int)((it / 128) % 2); const long q = it / 256; const int j = (int)(q % NCMAX), s = (int)(q / NCMAX);
    if (j >= seq_ncmp(s)) return;
    float a = p.ws[W_CBIAS + kv * 64 + e];
    const float* w = p.cmp_w + ((size_t)(L * 2 + kv)) * 2048 * 64 + e;
    for (int t = 0; t < 32; ++t) { const float* x = hist(p, L, s, 16 * j + t, kv, g);
        for (int d = 0; d < 64; ++d) a += x[d] * w[(size_t)(t * 64 + d) * 64]; }
    p.ws[(kv ? W_VC : W_KC) + ((size_t)s * NCMAX + j) * 128 + g * 64 + e] = a;
}
HD void k_kc_norm(const P& p, int L, long it) {
    const int g = (int)(it % 2); const long q = it / 2; const int j = (int)(q % NCPAD), s = (int)(q / NCPAD);
    bf16_t* kb = wsb(p, WB_KCB) + (((size_t)s * 2 + g) * NCPAD + j) * 64; bf16_t* vt = wsb(p, WB_VCT) + (((size_t)s * 2 + g) * (NCPAD / 64) + j / 64) * 4096 + (j % 64);
    if (j >= seq_ncmp(s)) { for (int d = 0; d < 64; ++d) { kb[d] = 0; vt[(size_t)d * 64] = 0; } return; }
    float* k = p.ws + W_KC + ((size_t)s * NCMAX + j) * 128 + g * 64; const float* v = p.ws + W_VC + ((size_t)s * NCMAX + j) * 128 + g * 64; float ss = 0.f;
    for (int d = 0; d < 64; ++d) ss += k[d] * k[d];
    const float rs = RSQRTF(ss / 64 + 1e-6f);
    for (int d = 0; d < 64; ++d) { k[d] = k[d] * rs * p.k_norm_g[(L * 3 + 0) * 64 + d]; kb[d] = f2bf(k[d]); vt[(size_t)d * 64] = f2bf(v[d]); }
}
HD void k_cmp_score(const P& p, int L, long it) {
    const int n = (int)(it % NCMAX); const long q = it / NCMAX; const int h = (int)(q % 8), r = NP + (int)(q / 8), s = seq_of_row(r), pos = row_pos(r);
    if (n >= seq_ncmp(s)) return;
    float v = -INFINITY;
    if (16 * n + 31 <= pos) { const float* qq = p.ws + W_QN + (size_t)r * 512 + h * 64; const float* k = p.ws + W_KC + ((size_t)s * NCMAX + n) * 128 + (h / 4) * 64;
        float a = 0.f; for (int d = 0; d < 64; ++d) a += qq[d] * k[d]; v = a * 0.125f; }
    p.ws[W_PCMP + (size_t)NP * 8 * NCMAX + it] = v;
}
HD void softmax_row(float* x, int n) {
    float m = -INFINITY; for (int i = 0; i < n; ++i) m = fmaxf(m, x[i]);
    if (m == -INFINITY) m = 0.f;
    float sum = 0.f; for (int i = 0; i < n; ++i) { const float e = (x[i] == -INFINITY) ? 0.f : EXPF(x[i] - m); x[i] = e; sum += e; }
    const float inv = 1.0f / fmaxf(sum, 1e-30f);
    for (int i = 0; i < n; ++i) x[i] *= inv;
}
HD void k_cmp_softmax(const P& p, int L, long it) { const int r = NP + (int)(it / 8); softmax_row(p.ws + W_PCMP + ((size_t)NP * 8 + it) * NCMAX, seq_ncmp(seq_of_row(r))); }
HD void k_cmp_out(const P& p, int L, long it) {
    const int d = (int)(it % 64), h = (int)((it / 64) % 8), r = NP + (int)(it / 512), s = seq_of_row(r), nc = seq_ncmp(s);
    const float* pr = p.ws + W_PCMP + ((size_t)r * 8 + h) * NCMAX; const float* v = p.ws + W_VC + (size_t)s * NCMAX * 128 + (h / 4) * 64 + d; float a = 0.f;
    for (int n = 0; n < nc; ++n) a += pr[n] * v[(size_t)n * 128];
    p.ws[W_OCMP + (size_t)NP * 512 + it] = a;
}
HD void k_imp(const P& p, int L, long it) {
    const int j = (int)(it % NSELMAX), g = (int)((it / NSELMAX) % 2), r = NP + (int)(it / (2 * NSELMAX)), s = seq_of_row(r), nc = seq_ncmp(s);
    if (j >= seq_nsel(s)) return;
    float a = 0.f;
    for (int h = 0; h < 4; ++h) { const float* pr = p.ws + W_PCMP + ((size_t)r * 8 + g * 4 + h) * NCMAX;
        for (int q = 0; q < 5; ++q) { const int i = 4 * j - 1 + q; if (i >= 0 && i < nc) a += pr[i] * ((q == 0 || q == 4) ? 1.f : 2.f); } }
    p.ws[W_IMP + (size_t)NP * 2 * NSELMAX + it] = a;
}
HD void k_topk(const P& p, int L, long it) {
    const int g = (int)(it % 2), r = NP + (int)(it / 2), s = seq_of_row(r), pos = row_pos(r), ns = seq_nsel(s), cur = pos / 64;
    const float* imp = p.ws + W_IMP + ((size_t)r * 2 + g) * NSELMAX; int* sel = (int*)(p.ws + W_SEL) + ((size_t)r * 2 + g) * 16;
    unsigned long long c0 = 0, c1 = 0, c2 = 0, c3 = 0;
    const int nk = ns < 16 ? ns : 16;
    for (int k = 0; k < 16; ++k) {
        int bj = -1; float bs = 0.f;
        if (k < nk) for (int j = 0; j < ns; ++j) {
            const unsigned long long bit = 1ull << (j & 63); const unsigned long long cw = (j < 64) ? c0 : (j < 128) ? c1 : (j < 192) ? c2 : c3;
            if (cw & bit) continue;
            const bool forced = (j == 0) || (j == cur) || (j == cur - 1), valid = j * 64 <= pos;
            const float sc = forced ? INFINITY : (valid ? imp[j] : -INFINITY);
            if (bj < 0 || sc > bs) { bj = j; bs = sc; }
        }
        sel[k] = bj;
        if (bj >= 0) { const unsigned long long bit = 1ull << (bj & 63); if (bj < 64) c0 |= bit; else if (bj < 128) c1 |= bit; else if (bj < 192) c2 |= bit; else c3 |= bit; }
    }
}
HD void k_slc_score(const P& p, int L, long it) {
    const int ks = (int)(it % 1024), h = (int)((it / 1024) % 8), r = NP + (int)(it / 8192), s = seq_of_row(r), pos = row_pos(r), g = h / 4;
    const int blk = ((const int*)(p.ws + W_SEL))[((size_t)r * 2 + g) * 16 + ks / 64];
    float v = -INFINITY;
    if (blk >= 0) { const int kpos = blk * 64 + (ks % 64);
        if (kpos <= pos) { const float* qq = p.ws + W_QR + (size_t)r * 512 + h * 64; const float* k = hist(p, L, s, kpos, 2, g);
            float a = 0.f; for (int d = 0; d < 64; ++d) a += qq[d] * k[d]; v = a * 0.125f; } }
    p.ws[W_PSLC + (size_t)NP * 8 * 1024 + it] = v;
}
HD void k_slc_softmax(const P& p, int L, long it) { softmax_row(p.ws + W_PSLC + ((size_t)NP * 8 + it) * 1024, 1024); }
HD void k_slc_out(const P& p, int L, long it) {
    const int d = (int)(it % 64), h = (int)((it / 64) % 8), r = NP + (int)(it / 512), s = seq_of_row(r), g = h / 4;
    const float* pr = p.ws + W_PSLC + ((size_t)r * 8 + h) * 1024; const int* sel = (const int*)(p.ws + W_SEL) + ((size_t)r * 2 + g) * 16; float a = 0.f;
    for (int ks = 0; ks < 1024; ++ks) { const float pv = pr[ks]; if (pv != 0.f) a += pv * hist(p, L, s, sel[ks / 64] * 64 + (ks % 64), 3, g)[d]; }
    p.ws[W_OSLC + (size_t)NP * 512 + it] = a;
}
HD int seq_first_pos(int s) { return s < BATCH ? 0 : PAST_LEN - WKEEP_S; }
HD void k_win_score(const P& p, int L, long it) {
    const int w = (int)(it % 512), h = (int)((it / 512) % 8), r = NP + (int)(it / 4096), s = seq_of_row(r), pos = row_pos(r), g = h / 4, kpos = pos - w;
    float v = -INFINITY;
    if (kpos >= seq_first_pos(s)) { const float* qq = p.ws + W_QR + (size_t)r * 512 + h * 64; const float* k = ctxp(p, L, s, kpos, 0, g);
        float a = 0.f; for (int d = 0; d < 64; ++d) a += qq[d] * k[d]; v = a * 0.125f; }
    p.ws[W_PWIN + (size_t)NP * 8 * 512 + it] = v;
}
HD void k_win_softmax(const P& p, int L, long it) { softmax_row(p.ws + W_PWIN + ((size_t)NP * 8 + it) * 512, 512); }
HD void k_win_out(const P& p, int L, long it) {
    const int d = (int)(it % 64), h = (int)((it / 64) % 8), r = NP + (int)(it / 512), s = seq_of_row(r), pos = row_pos(r), g = h / 4;
    const float* pr = p.ws + W_PWIN + ((size_t)r * 8 + h) * 512; float a = 0.f;
    for (int w = 0; w < 512; ++w) { const float pv = pr[w]; if (pv != 0.f) a += pv * ctxp(p, L, s, pos - w, 1, g)[d]; }
    p.ws[W_OWIN + (size_t)NP * 512 + it] = a;
}
HD void k_gla(const P& p, int L, long it) {
    const int dv = (int)(it % 64), h = (int)((it / 64) % 4), s = BATCH + (int)(it / 256), r0 = seq_row0(s), len = seq_len(s);
    float S[32];
#pragma unroll
    for (int k = 0; k < 32; ++k) S[k] = s < BATCH ? 0.f : p.state_gla[((((size_t)L * DEC_BATCH + (s - BATCH)) * 4 + h) * 32 + k) * 64 + dv];
    for (int t = 0; t < len; ++t) {
        const int r = r0 + t; const URow u = urow(p, r); const float* la = p.ws + W_LOGA + (size_t)r * 128 + h * 32;
        const float v = u[C_GV + h * 64 + dv]; float o = 0.f;
#pragma unroll
        for (int k = 0; k < 32; ++k) { S[k] = EXPF(la[k]) * S[k] + u[C_GK + h * 32 + k] * v; o += u[C_GQ + h * 32 + k] * S[k]; }
        p.ws[W_OA + (size_t)r * 256 + h * 64 + dv] = o * 0.17677669529663687f;
    }
    float* so = s < BATCH ? p.out + O_PGLA + (((size_t)L * BATCH + s) * 4 + h) * 2048 : p.out + O_SGLA + (((size_t)L * DEC_BATCH + (s - BATCH)) * 4 + h) * 2048;
#pragma unroll
    for (int k = 0; k < 32; ++k) so[k * 64 + dv] = S[k];
}
HD void k_mlstm(const P& p, int L, long it) {
    const int e = (int)(it % 65), h = (int)((it / 65) % 4), s = BATCH + (int)(it / 260), r0 = seq_row0(s), len = seq_len(s);
    float C[64]; float m = s < BATCH ? 0.f : p.state_m[((size_t)L * DEC_BATCH + (s - BATCH)) * 4 + h];
#pragma unroll
    for (int d = 0; d < 64; ++d) C[d] = s < BATCH ? 0.f : (e < 64 ? p.state_C[((((size_t)L * DEC_BATCH + (s - BATCH)) * 4 + h) * 64 + e) * 64 + d]
                                                                  : p.state_n[(((size_t)L * DEC_BATCH + (s - BATCH)) * 4 + h) * 64 + d]);
    const float bi = p.gate_b[(L * 2 + 0) * 4 + h], bf = p.gate_b[(L * 2 + 1) * 4 + h];
    for (int t = 0; t < len; ++t) {
        const int r = r0 + t; const URow u = urow(p, r); const float* q = p.ws + W_MQ + (size_t)r * 256 + h * 64; const float* k = p.ws + W_MK + (size_t)r * 256 + h * 64;
        const float ip = u[C_MIF + h] + bi, lf = log_sigmoidf(u[C_MIF + 4 + h] + bf), mn = fmaxf(lf + m, ip), fp = EXPF(lf + m - mn), iq = EXPF(ip - mn), v = e < 64 ? u[C_MV + h * 64 + e] : 1.0f;
        float num = 0.f;
#pragma unroll
        for (int d = 0; d < 64; ++d) { C[d] = fp * C[d] + iq * v * k[d]; num += C[d] * q[d]; }
        m = mn;
        if (e < 64) p.ws[W_H + (size_t)r * 256 + h * 64 + e] = num;
        else { p.ws[W_DEN + (size_t)r * 4 + h] = num; p.ws[W_MT + (size_t)r * 4 + h] = m; }
    }
    const size_t sb = s < BATCH ? ((size_t)L * BATCH + s) * 4 + h : ((size_t)L * DEC_BATCH + (s - BATCH)) * 4 + h;
    float* co = e < 64 ? p.out + (s < BATCH ? O_PC : O_SC) + (sb * 64 + e) * 64 : p.out + (s < BATCH ? O_PN : O_SN) + sb * 64;
#pragma unroll
    for (int d = 0; d < 64; ++d) co[d] = C[d];
    if (e == 64) p.out[(s < BATCH ? O_PM : O_SM) + sb] = m;
}
HD void k_mix_gla(const P& p, int L, long it) {
    const int h = (int)(it % 4), r = NP + (int)(it / 4); const float* o = p.ws + W_OA + (size_t)r * 256 + h * 64; float ss = 0.f;
    for (int d = 0; d < 64; ++d) ss += o[d] * o[d];
    const float rs = RSQRTF(ss / 64 + 1e-6f); const URow u = urow(p, r) + (C_GZ + h * 64);
    for (int d = 0; d < 64; ++d) mixb(p)[(size_t)r * D + h * 64 + d] = f2bf(o[d] * rs * p.gla_norm_g[L * 64 + d] * siluf(u[d]));
}
HD void k_mix_ml(const P& p, int L, long it) {
    const int h = (int)(it % 4), r = NP + (int)(it / 4); const float* o = p.ws + W_H + (size_t)r * 256 + h * 64; float ss = 0.f;
    const float dinv = 1.0f / fmaxf(fabsf(p.ws[W_DEN + (size_t)NP * 4 + it]), EXPF(-p.ws[W_MT + (size_t)NP * 4 + it]));
    for (int d = 0; d < 64; ++d) ss += o[d] * dinv * o[d] * dinv;
    const float rs = dinv / sqrtf(ss / 64 + 1e-6f); const URow u = urow(p, r);
    for (int d = 0; d < 64; ++d) mixb(p)[(size_t)r * D + 768 + h * 64 + d] = f2bf(o[d] * rs * p.ml_norm_g[L * 64 + d] * sigmoidf_(u[C_MO + h * 64 + d]) * siluf(u[C_MZ + h * 64 + d]));
}
HD void k_gemm_out_emu(const P& p, int L, long it) {
    const int r = (int)(it / D), c = (int)(it % D);
    const bf16_t* a = mixb(p) + (size_t)r * D; const bf16_t* w = wouttp(p, L) + (size_t)c * D; float s = 0.f;
    for (int k = 0; k < D; ++k) s += bf2f(a[k]) * bf2f(w[k]);
    (L == DEPTH - 1 ? p.out + O_Y : p.ws + W_Y0)[it] = xrow(p, L, r)[c] + s;
}

#ifdef CPU_EMU
#define LDSQ
#define EXP2F(x) exp2f(x)
#else
#define LDSQ __attribute__((address_space(3)))
#define EXP2F(x) __builtin_amdgcn_exp2f(x)
typedef short bf16x8 __attribute__((ext_vector_type(8)));
typedef short bf16x4 __attribute__((ext_vector_type(4)));
typedef float f32x4 __attribute__((ext_vector_type(4)));
typedef float f32x16 __attribute__((ext_vector_type(16)));
#endif
typedef LDSQ unsigned char* ldsp_t;
#ifdef CPU_EMU
#define LDS_ADDF(ptr, v) (*(ptr) += (v))
#else
#define LDS_ADDF(ptr, v) ((void)__hip_atomic_fetch_add((ptr), (v), __ATOMIC_RELAXED, __HIP_MEMORY_SCOPE_WORKGROUP))
#endif
#ifdef CPU_EMU
#define LDS_BARRIER() emu_syncthreads()
#define SCHED_FENCE() do {} while (0)
#else
#define SCHED_FENCE() __builtin_amdgcn_sched_barrier(0)
#define LDS_BARRIER() asm volatile("s_waitcnt lgkmcnt(0)\n\ts_barrier" ::: "memory")
#endif
#ifndef CPU_EMU
__device__ __forceinline__ int lane_fresh() { int l = (int)__builtin_amdgcn_mbcnt_hi(~0u, __builtin_amdgcn_mbcnt_lo(~0u, 0u)); asm volatile("" : "+v"(l)); return l; }
__device__ __forceinline__ int xl_shfl_xor_i(int v, int m) {
    if (m == 1) return __builtin_amdgcn_update_dpp(0, v, 0xB1, 0xF, 0xF, true);
    if (m == 2) return __builtin_amdgcn_update_dpp(0, v, 0x4E, 0xF, 0xF, true);
    if (m == 7) return __builtin_amdgcn_update_dpp(0, v, 0x141, 0xF, 0xF, true);
    if (m == 15) return __builtin_amdgcn_update_dpp(0, v, 0x140, 0xF, 0xF, true);
    return __builtin_amdgcn_ds_bpermute((lane_fresh() ^ m) << 2, v);
}
__device__ __forceinline__ float xl_shfl_xor(float v, int m) { return __builtin_bit_cast(float, xl_shfl_xor_i(__builtin_bit_cast(int, v), m)); }
__device__ __forceinline__ int xl_shfl_xor(int v, int m) { return xl_shfl_xor_i(v, m); }
__device__ __forceinline__ float xl_shfl(float v, int src) { return __builtin_bit_cast(float, __builtin_amdgcn_ds_bpermute(src << 2, __builtin_bit_cast(int, v))); }
__device__ __forceinline__ int xl_shfl(int v, int src) { return __builtin_amdgcn_ds_bpermute(src << 2, v); }
#define __shfl_xor xl_shfl_xor
#define __shfl xl_shfl
#endif
constexpr int LDS_MISC = 8 * 19456;
#ifdef CPU_EMU
#define opaque_tid() ((int)threadIdx.x)
#define RFL(x) (x)
HD int opaque_i(int v) { return v; }
#else
__device__ __forceinline__ int opaque_i(int v) { asm volatile("" : "+v"(v)); return v; }
constexpr int LDS_WTAB = LDS_MISC + 320;
__device__ __forceinline__ int hw_tid(__attribute__((address_space(3))) unsigned char* ldsb) {
    const unsigned hw = (unsigned)__builtin_amdgcn_s_getreg((5 << 11) | 4) & 63u;
    const int wv = __builtin_amdgcn_readfirstlane(*(__attribute__((address_space(3))) const int*)(ldsb + LDS_WTAB + hw * 4));
    unsigned t = (unsigned)wv * 64u + __builtin_amdgcn_mbcnt_hi(~0u, __builtin_amdgcn_mbcnt_lo(~0u, 0u)); asm volatile("" : "+v"(t)); return (int)t;
}
#define RFL(x) __builtin_amdgcn_readfirstlane(x)
#define opaque_tid() hw_tid(lds)
#endif
constexpr int NTHREADS = 512;
constexpr int KT_STRIDE = 144, VT_STRIDE = 136, KT_BYTES = 64 * KT_STRIDE, VT_BYTES = 64 * VT_STRIDE;
constexpr int NSA_KT = 0, NSA_VT = 3 * KT_BYTES, NSA_IMP = NSA_VT + 3 * VT_BYTES, NSA_MASK = NSA_IMP + 8 * 8 * 64 * 4, NSA_END = NSA_MASK + 8 * 8 * 8;
constexpr int NSA_COMB = 73728;
constexpr float C2LOG = 0.125f * 1.4426950408889634f;
constexpr float NEG_BIG = -1.0e30f;

typedef unsigned u32x4_t __attribute__((ext_vector_type(4)));
#ifdef CPU_EMU
HD float rlane(float v, int i) { return __shfl(v, i); }
#else
__device__ __forceinline__ float rlane(float v, int i) { return __builtin_bit_cast(float, __builtin_amdgcn_readlane(__builtin_bit_cast(int, v), i)); }
#endif
#ifdef CPU_EMU
HD unsigned pack2bf(float lo, float hi) { return (unsigned)f2bf(lo) | ((unsigned)f2bf(hi) << 16); }
#else
typedef __bf16 hwbf16x2_t __attribute__((ext_vector_type(2)));
typedef float hwf32x2_t __attribute__((ext_vector_type(2)));
__device__ __forceinline__ unsigned pack2bf(float lo, float hi) { const hwf32x2_t v = {lo, hi}; const hwbf16x2_t b = __builtin_convertvector(v, hwbf16x2_t); return __builtin_bit_cast(unsigned, b); }
#endif
HD void ld8f(const float* q, float (&f)[8]) { const f32x4 a = *(const f32x4*)q, b = *(const f32x4*)(q + 4); f[0] = a[0]; f[1] = a[1]; f[2] = a[2]; f[3] = a[3]; f[4] = b[0]; f[5] = b[1]; f[6] = b[2]; f[7] = b[3]; }
struct AttnSt { f32x16 o0, o1; float m, l; };
template <bool MASK> HD bool softmax_tile(f32x16& s0, f32x16& s1, int lim2, int lo2, bool sel, AttnSt& st, bf16x8 (&pf)[4], float& alpha) {
    float tmax = NEG_BIG;
    if (MASK) {
#pragma unroll
        for (int r = 0; r < 16; ++r) { const int kc = (r & 3) + 8 * (r >> 2);
            s0[r] = (kc <= lim2 && kc > lo2) ? s0[r] : NEG_BIG; s1[r] = (kc + 32 <= lim2 && kc + 32 > lo2) ? s1[r] : NEG_BIG; tmax = fmaxf(tmax, fmaxf(s0[r], s1[r])); }
    } else {
#pragma unroll
        for (int r = 0; r < 16; ++r) tmax = fmaxf(tmax, fmaxf(s0[r], s1[r]));
        tmax = sel ? tmax : NEG_BIG;
    }
    tmax = fmaxf(tmax, __shfl_xor(tmax, 32));
    const float mn = fmaxf(st.m, tmax); const bool any = __ballot(mn > st.m) != 0ull;
    alpha = 1.0f;
    if (any) { alpha = EXP2F(st.m - mn); st.l *= alpha; }
    st.m = mn;
    float ls = 0.f;
#pragma unroll
    for (int r = 0; r < 16; ++r) { float p0 = EXP2F(s0[r] - mn), p1 = EXP2F(s1[r] - mn);
        if (MASK) { p0 = s0[r] > -1.0e29f ? p0 : 0.f; p1 = s1[r] > -1.0e29f ? p1 : 0.f; }
        s0[r] = p0; s1[r] = p1; ls += p0 + p1; }
    u32x4_t w0, w1, w2, w3;
#pragma unroll
    for (int i = 0; i < 4; ++i) { w0[i] = pack2bf(s0[2 * i], s0[2 * i + 1]); w1[i] = pack2bf(s0[8 + 2 * i], s0[8 + 2 * i + 1]); w2[i] = pack2bf(s1[2 * i], s1[2 * i + 1]); w3[i] = pack2bf(s1[8 + 2 * i], s1[8 + 2 * i + 1]); }
    if (!MASK) { const unsigned km = sel ? 0xffffffffu : 0u; w0 &= km; w1 &= km; w2 &= km; w3 &= km; ls = sel ? ls : 0.f; }
    st.l += ls;
    pf[0] = __builtin_bit_cast(bf16x8, w0); pf[1] = __builtin_bit_cast(bf16x8, w1); pf[2] = __builtin_bit_cast(bf16x8, w2); pf[3] = __builtin_bit_cast(bf16x8, w3);
    return any;
}
HD void attn_init(AttnSt& s) { for (int r = 0; r < 16; ++r) { s.o0[r] = 0.f; s.o1[r] = 0.f; } s.m = NEG_BIG; s.l = 0.f; }
HD short bfbits(float f) { return (short)f2bf(f); }
template <bool IMP, bool MASK>
HD void attn_tile(ldsp_t lds, int buf, const bf16x8 (&qf)[4], float mb, int lim2, int lo2, bool sel, AttnSt& st, f32x16& i0, f32x16& i1, int ntile64, int c, int hi) {
    f32x16 s0, s1;
    for (int r = 0; r < 16; ++r) { s0[r] = -mb; s1[r] = -mb; }
    const ldsp_t kt = lds + NSA_KT + buf * KT_BYTES + c * KT_STRIDE + hi * 16;
#pragma unroll
    for (int ks = 0; ks < 4; ++ks) {
        const bf16x8 k0 = *(const LDSQ bf16x8*)(kt + ks * 32), k1 = *(const LDSQ bf16x8*)(kt + 32 * KT_STRIDE + ks * 32);
        s0 = __builtin_amdgcn_mfma_f32_32x32x16_bf16(k0, qf[ks], s0, 0, 0, 0);
        s1 = __builtin_amdgcn_mfma_f32_32x32x16_bf16(k1, qf[ks], s1, 0, 0, 0);
    }
    float ls = 0.f;
#pragma unroll
    for (int r = 0; r < 16; ++r) { float p0 = EXP2F(s0[r]), p1 = EXP2F(s1[r]);
        if (MASK) { const int kc = (r & 3) + 8 * (r >> 2); p0 = (kc <= lim2 && kc > lo2) ? p0 : 0.f; p1 = (kc + 32 <= lim2 && kc + 32 > lo2) ? p1 : 0.f; }
        s0[r] = p0; s1[r] = p1; ls += p0 + p1; }
    u32x4_t w0, w1, w2, w3;
#pragma unroll
    for (int i = 0; i < 4; ++i) { w0[i] = pack2bf(s0[2 * i], s0[2 * i + 1]); w1[i] = pack2bf(s0[8 + 2 * i], s0[8 + 2 * i + 1]); w2[i] = pack2bf(s1[2 * i], s1[2 * i + 1]); w3[i] = pack2bf(s1[8 + 2 * i], s1[8 + 2 * i + 1]); }
    if (!MASK) { const unsigned km = sel ? 0xffffffffu : 0u; w0 &= km; w1 &= km; w2 &= km; w3 &= km; ls = sel ? ls : 0.f; }
    st.l += ls;
    bf16x8 pf[4];
    pf[0] = __builtin_bit_cast(bf16x8, w0); pf[1] = __builtin_bit_cast(bf16x8, w1); pf[2] = __builtin_bit_cast(bf16x8, w2); pf[3] = __builtin_bit_cast(bf16x8, w3);
    const ldsp_t vt = lds + NSA_VT + buf * VT_BYTES + c * VT_STRIDE + hi * 8;
#pragma unroll
    for (int ks = 0; ks < 4; ++ks) {
        const bf16x4 a0 = *(const LDSQ bf16x4*)(vt + ks * 32), a1 = *(const LDSQ bf16x4*)(vt + ks * 32 + 16);
        const bf16x4 b0 = *(const LDSQ bf16x4*)(vt + 32 * VT_STRIDE + ks * 32), b1 = *(const LDSQ bf16x4*)(vt + 32 * VT_STRIDE + ks * 32 + 16);
        bf16x8 v0, v1;
#pragma unroll
        for (int j = 0; j < 4; ++j) { v0[j] = a0[j]; v0[4 + j] = a1[j]; v1[j] = b0[j]; v1[4 + j] = b1[j]; }
        st.o0 = __builtin_amdgcn_mfma_f32_32x32x16_bf16(v0, pf[ks], st.o0, 0, 0, 0);
        st.o1 = __builtin_amdgcn_mfma_f32_32x32x16_bf16(v1, pf[ks], st.o1, 0, 0, 0);
        if (IMP) {
#pragma unroll
            for (int jt = 0; jt < 2; ++jt) { const int base = ntile64 * 64 + 16 * ks + 4 * hi - 4 * (jt * 32 + c); bf16x8 af;
#pragma unroll
                for (int jj = 0; jj < 8; ++jj) { const int dl = base + 8 * (jj >> 2) + (jj & 3); af[jj] = (dl == -1 || dl == 3) ? (short)0x3F80 : ((dl >= 0 && dl <= 2) ? (short)0x4000 : (short)0); }
                if (jt == 0) i0 = __builtin_amdgcn_mfma_f32_32x32x16_bf16(af, pf[ks], i0, 0, 0, 0); else i1 = __builtin_amdgcn_mfma_f32_32x32x16_bf16(af, pf[ks], i1, 0, 0, 0); }
        }
    }
}
HD void imp_tile(ldsp_t lds, int buf, const bf16x8 (&qf)[4], float mb, float inv, int lim2, f32x16& i0, f32x16& i1, int ntile64, int c, int hi) {
    f32x16 s0, s1;
    for (int r = 0; r < 16; ++r) { s0[r] = -mb; s1[r] = -mb; }
    const ldsp_t kt = lds + NSA_KT + buf * KT_BYTES + c * KT_STRIDE + hi * 16;
#pragma unroll
    for (int ks = 0; ks < 4; ++ks) {
        const bf16x8 k0 = *(const LDSQ bf16x8*)(kt + ks * 32), k1 = *(const LDSQ bf16x8*)(kt + 32 * KT_STRIDE + ks * 32);
        s0 = __builtin_amdgcn_mfma_f32_32x32x16_bf16(k0, qf[ks], s0, 0, 0, 0);
        s1 = __builtin_amdgcn_mfma_f32_32x32x16_bf16(k1, qf[ks], s1, 0, 0, 0);
    }
#pragma unroll
    for (int r = 0; r < 16; ++r) { const int kc = (r & 3) + 8 * (r >> 2); s0[r] = kc <= lim2 ? EXP2F(s0[r]) * inv : 0.f; s1[r] = kc + 32 <= lim2 ? EXP2F(s1[r]) * inv : 0.f; }
    u32x4_t w0, w1, w2, w3;
#pragma unroll
    for (int i = 0; i < 4; ++i) { w0[i] = pack2bf(s0[2 * i], s0[2 * i + 1]); w1[i] = pack2bf(s0[8 + 2 * i], s0[8 + 2 * i + 1]); w2[i] = pack2bf(s1[2 * i], s1[2 * i + 1]); w3[i] = pack2bf(s1[8 + 2 * i], s1[8 + 2 * i + 1]); }
    bf16x8 pf[4];
    pf[0] = __builtin_bit_cast(bf16x8, w0); pf[1] = __builtin_bit_cast(bf16x8, w1); pf[2] = __builtin_bit_cast(bf16x8, w2); pf[3] = __builtin_bit_cast(bf16x8, w3);
#pragma unroll
    for (int ks = 0; ks < 4; ++ks)
#pragma unroll
        for (int jt = 0; jt < 2; ++jt) { const int base = ntile64 * 64 + 16 * ks + 4 * hi - 4 * (jt * 32 + c); bf16x8 af;
            const int jlo = 16 * ntile64 + 4 * ks;
            if (jlo + 4 < 32 * jt || jlo > 32 * jt + 31) continue;
#pragma unroll
            for (int jj = 0; jj < 8; ++jj) { const int dl = base + 8 * (jj >> 2) + (jj & 3); af[jj] = (dl == -1 || dl == 3) ? (short)0x3F80 : ((dl >= 0 && dl <= 2) ? (short)0x4000 : (short)0); }
            if (jt == 0) i0 = __builtin_amdgcn_mfma_f32_32x32x16_bf16(af, pf[ks], i0, 0, 0, 0); else i1 = __builtin_amdgcn_mfma_f32_32x32x16_bf16(af, pf[ks], i1, 0, 0, 0); }
}
HD float score_bound(const bf16x8 (&qf)[4], const float* kgain, int lane) {
    float ss = 0.f;
#pragma unroll
    for (int ks = 0; ks < 4; ++ks)
#pragma unroll
        for (int j = 0; j < 8; ++j) { const float v = bf2f((bf16_t)qf[ks][j]); ss += v * v; }
    ss += __shfl_xor(ss, 32);
    float g = fabsf(kgain[lane]);
    g = fmaxf(g, __shfl_xor(g, 1)); g = fmaxf(g, __shfl_xor(g, 2)); g = fmaxf(g, __shfl_xor(g, 7)); g = fmaxf(g, __shfl_xor(g, 15));
    g = fmaxf(fmaxf(rlane(g, 0), rlane(g, 16)), fmaxf(rlane(g, 32), rlane(g, 48)));
    return sqrtf(ss) * 8.0f * g * 1.01f + 0.01f;
}
HD void tile_load(const bf16_t* k, const bf16_t* vt, int tid, bf16x8& rk, bf16x8& rv) { rk = *(const bf16x8*)(k + tid * 8); rv = *(const bf16x8*)(vt + tid * 8); }
HD void tile_store(ldsp_t lds, int buf, int tid, const bf16x8& rk, const bf16x8& rv) {
    const int row = tid >> 3, ch = tid & 7;
    *(LDSQ bf16x8*)(lds + NSA_KT + buf * KT_BYTES + row * KT_STRIDE + ch * 16) = rk;
    bf16x4 a, b;
    for (int j = 0; j < 4; ++j) { a[j] = rv[j]; b[j] = rv[4 + j]; }
    *(LDSQ bf16x4*)(lds + NSA_VT + buf * VT_BYTES + row * VT_STRIDE + ch * 16) = a; *(LDSQ bf16x4*)(lds + NSA_VT + buf * VT_BYTES + row * VT_STRIDE + ch * 16 + 8) = b;
}
HD void qk_tile(ldsp_t lds, int buf, const bf16x8 (&qf)[4], float mb, f32x16& s0, f32x16& s1, int c, int hi) {
    for (int r = 0; r < 16; ++r) { s0[r] = -mb; s1[r] = -mb; }
    const ldsp_t kt = lds + NSA_KT + buf * KT_BYTES + c * KT_STRIDE + hi * 16;
#pragma unroll
    for (int ks = 0; ks < 4; ++ks) {
        const bf16x8 k0 = *(const LDSQ bf16x8*)(kt + ks * 32), k1 = *(const LDSQ bf16x8*)(kt + 32 * KT_STRIDE + ks * 32);
        s0 = __builtin_amdgcn_mfma_f32_32x32x16_bf16(k0, qf[ks], s0, 0, 0, 0);
        s1 = __builtin_amdgcn_mfma_f32_32x32x16_bf16(k1, qf[ks], s1, 0, 0, 0);
    }
}
template <bool MASK> HD void sm_tile(f32x16& s0, f32x16& s1, int lim2, int lo2, bool sel, float& l, bf16x8 (&pf)[4]) {
    float ls = 0.f;
#pragma unroll
    for (int r = 0; r < 16; ++r) { float p0 = EXP2F(s0[r]), p1 = EXP2F(s1[r]);
        if (MASK) { const int kc = (r & 3) + 8 * (r >> 2); p0 = (kc <= lim2 && kc > lo2) ? p0 : 0.f; p1 = (kc + 32 <= lim2 && kc + 32 > lo2) ? p1 : 0.f; }
        s0[r] = p0; s1[r] = p1; ls += p0 + p1; }
    u32x4_t w0, w1, w2, w3;
#pragma unroll
    for (int i = 0; i < 4; ++i) { w0[i] = pack2bf(s0[2 * i], s0[2 * i + 1]); w1[i] = pack2bf(s0[8 + 2 * i], s0[8 + 2 * i + 1]); w2[i] = pack2bf(s1[2 * i], s1[2 * i + 1]); w3[i] = pack2bf(s1[8 + 2 * i], s1[8 + 2 * i + 1]); }
    if (!MASK) { const unsigned km = sel ? 0xffffffffu : 0u; w0 &= km; w1 &= km; w2 &= km; w3 &= km; ls = sel ? ls : 0.f; }
    l += ls;
    pf[0] = __builtin_bit_cast(bf16x8, w0); pf[1] = __builtin_bit_cast(bf16x8, w1); pf[2] = __builtin_bit_cast(bf16x8, w2); pf[3] = __builtin_bit_cast(bf16x8, w3);
}
HD void pv_tile(ldsp_t lds, int buf, const bf16x8 (&pf)[4], AttnSt& st, int c, int hi) {
    const ldsp_t vt = lds + NSA_VT + buf * VT_BYTES + c * VT_STRIDE + hi * 8;
#pragma unroll
    for (int ks = 0; ks < 4; ++ks) {
        const bf16x4 a0 = *(const LDSQ bf16x4*)(vt + ks * 32), a1 = *(const LDSQ bf16x4*)(vt + ks * 32 + 16);
        const bf16x4 b0 = *(const LDSQ bf16x4*)(vt + 32 * VT_STRIDE + ks * 32), b1 = *(const LDSQ bf16x4*)(vt + 32 * VT_STRIDE + ks * 32 + 16);
        bf16x8 v0, v1;
#pragma unroll
        for (int j = 0; j < 4; ++j) { v0[j] = a0[j]; v0[4 + j] = a1[j]; v1[j] = b0[j]; v1[4 + j] = b1[j]; }
        st.o0 = __builtin_amdgcn_mfma_f32_32x32x16_bf16(v0, pf[ks], st.o0, 0, 0, 0);
        st.o1 = __builtin_amdgcn_mfma_f32_32x32x16_bf16(v1, pf[ks], st.o1, 0, 0, 0);
    }
}
struct TilePipe { bf16x8 k1, v1; };
HD void tp_start(ldsp_t lds, int tid, const bf16_t* kb, const bf16_t* vb, int nt, TilePipe& tp) {
    bf16x8 rk, rv, rk2, rv2; tile_load(kb, vb, tid, rk, rv);
    if (1 < nt) tile_load(kb + 4096, vb + 4096, tid, rk2, rv2);
    if (2 < nt) tile_load(kb + 2 * 4096, vb + 2 * 4096, tid, tp.k1, tp.v1);
    tile_store(lds, 0, tid, rk, rv);
    if (1 < nt) tile_store(lds, 1, tid, rk2, rv2);
    LDS_BARRIER();
}
HD void tp_advance(ldsp_t lds, int tid, const bf16_t* kb, const bf16_t* vb, int t, int nt, TilePipe& tp) {
    if (t + 2 < nt) tile_store(lds, (t + 2) % 3, tid, tp.k1, tp.v1);
    if (t + 3 < nt) tile_load(kb + (size_t)(t + 3) * 4096, vb + (size_t)(t + 3) * 4096, tid, tp.k1, tp.v1);
    LDS_BARRIER();
}
struct TileParm { bool masked, sel, skip; int lim2, lo2; };
struct BranchCtx { int qt, pos, hi, nlim, nlim_min, kb0; unsigned long long selmask; };
template <int BR> HD TileParm tile_parm(int t, const BranchCtx& x) {
    TileParm q; q.skip = false; q.sel = true; q.lo2 = -100000; q.lim2 = 0;
    if (BR == 0) { q.masked = !(64 * t + 63 <= x.nlim_min); q.lim2 = x.nlim - 64 * t - 4 * x.hi; }
    else if (BR == 1) { const bool s = ((x.selmask >> t) & 1ull) != 0ull; q.masked = t >= x.qt;
        if (q.masked) q.lim2 = s ? x.pos - 64 * t - 4 * x.hi : -100000; else { q.sel = s; q.skip = __ballot(s) == 0ull; } }
    else { const int kbx = x.kb0 + t, off = 64 * kbx + 4 * x.hi; q.masked = !(kbx < x.qt && kbx > x.qt - 8); q.lim2 = x.pos - off; q.lo2 = x.pos - WIN - off; }
    return q;
}
HD void sm_pv(ldsp_t lds, int buf, const TileParm& q, f32x16& s0, f32x16& s1, AttnSt& st, int c, int hi) {
    bf16x8 pf[4];
    if (q.masked) sm_tile<true>(s0, s1, q.lim2, q.lo2, true, st.l, pf); else sm_tile<false>(s0, s1, 0, 0, q.sel, st.l, pf);
    pv_tile(lds, buf, pf, st, c, hi);
}
HD void qk_sm_int(ldsp_t lds, int bufn, const bf16x8 (&qf)[4], float mb, f32x16& n0, f32x16& n1, f32x16& c0, f32x16& c1, bool sel, float& l, bf16x8 (&pf)[4], int c, int hi) {
    for (int r = 0; r < 16; ++r) { n0[r] = -mb; n1[r] = -mb; }
    const ldsp_t kt = lds + NSA_KT + bufn * KT_BYTES + c * KT_STRIDE + hi * 16;
    bf16x8 k0 = *(const LDSQ bf16x8*)(kt), k1 = *(const LDSQ bf16x8*)(kt + 32 * KT_STRIDE);
    float ls = 0.f;
#pragma unroll
    for (int ks = 0; ks < 4; ++ks) {
        n0 = __builtin_amdgcn_mfma_f32_32x32x16_bf16(k0, qf[ks], n0, 0, 0, 0);
        n1 = __builtin_amdgcn_mfma_f32_32x32x16_bf16(k1, qf[ks], n1, 0, 0, 0);
        if (ks < 3) { k0 = *(const LDSQ bf16x8*)(kt + (ks + 1) * 32); k1 = *(const LDSQ bf16x8*)(kt + 32 * KT_STRIDE + (ks + 1) * 32); }
#pragma unroll
        for (int r = 4 * ks; r < 4 * ks + 4; ++r) { const float p0 = EXP2F(c0[r]), p1 = EXP2F(c1[r]); c0[r] = p0; c1[r] = p1; ls += p0 + p1; }
        SCHED_FENCE();
    }
    u32x4_t w0, w1, w2, w3;
#pragma unroll
    for (int i = 0; i < 4; ++i) { w0[i] = pack2bf(c0[2 * i], c0[2 * i + 1]); w1[i] = pack2bf(c0[8 + 2 * i], c0[8 + 2 * i + 1]); w2[i] = pack2bf(c1[2 * i], c1[2 * i + 1]); w3[i] = pack2bf(c1[8 + 2 * i], c1[8 + 2 * i + 1]); }
    const unsigned km = sel ? 0xffffffffu : 0u; w0 &= km; w1 &= km; w2 &= km; w3 &= km; l += sel ? ls : 0.f;
    pf[0] = __builtin_bit_cast(bf16x8, w0); pf[1] = __builtin_bit_cast(bf16x8, w1); pf[2] = __builtin_bit_cast(bf16x8, w2); pf[3] = __builtin_bit_cast(bf16x8, w3);
}
template <int BR> HD void nsa_branch(ldsp_t lds, int tid, const bf16_t* kb, const bf16_t* vb, int nt, int i0, int i1, const bf16x8 (&qf)[4], float mb, AttnSt& st, TilePipe& tp, const BranchCtx& x, int c, int hi) {
    tp_start(lds, tid, kb, vb, nt, tp);
    f32x16 a0, a1, b0, b1; bf16x8 pf[4];
    int t = 0;
#pragma unroll 1
    for (; t < i0; ++t) { const TileParm q = tile_parm<BR>(t, x); qk_tile(lds, t % 3, qf, mb, a0, a1, c, hi); sm_pv(lds, t % 3, q, a0, a1, st, c, hi); tp_advance(lds, tid, kb, vb, t, nt, tp); }
    bool pending = false;
    if (t < i1) {
        qk_tile(lds, t % 3, qf, mb, a0, a1, c, hi);
#pragma unroll 1
        for (; t < i1; ++t) {
            const bool sel = BR == 1 ? ((x.selmask >> t) & 1ull) != 0ull : true;
            qk_sm_int(lds, (t + 1) % 3, qf, mb, b0, b1, a0, a1, sel, st.l, pf, c, hi); pv_tile(lds, t % 3, pf, st, c, hi); tp_advance(lds, tid, kb, vb, t, nt, tp);
            a0 = b0; a1 = b1;
        }
        pending = t < nt;
    }
#pragma unroll 1
    for (; t < nt; ++t) { const TileParm q = tile_parm<BR>(t, x); if (!pending) qk_tile(lds, t % 3, qf, mb, a0, a1, c, hi); pending = false; sm_pv(lds, t % 3, q, a0, a1, st, c, hi); tp_advance(lds, tid, kb, vb, t, nt, tp); }
}
struct NsaIdx { int row, head, hi; };
HD NsaIdx nsa_idx(ldsp_t lds, int b, int g, int qt) { const int tid = opaque_tid(), lane = tid & 63, w = tid >> 6, c = lane & 31; NsaIdx x; x.row = b * SEQ + 64 * qt + 8 * w + (c >> 2); x.head = g * 4 + (c & 3); x.hi = lane >> 5; return x; }
HD float nsa_gate(const P& p, ldsp_t lds, int b, int g, int qt, int br) { const NsaIdx x = nsa_idx(lds, b, g, qt); return sigmoidf_(urow(p, x.row)[C_NG + br * 8 + x.head]); }
HD void nsa_load_q(const P& p, ldsp_t lds, int b, int g, int qt, size_t wb, bf16x8 (&qf)[4]) { const NsaIdx x = nsa_idx(lds, b, g, qt);
    const bf16_t* qp = wsb(p, wb) + (size_t)x.row * 512 + x.head * 64 + x.hi * 8;
#pragma unroll
    for (int ks = 0; ks < 4; ++ks) qf[ks] = *(const bf16x8*)(qp + ks * 16); }
HD float nsa_gate_raw(const P& p, ldsp_t lds, int b, int g, int qt, int br) { const NsaIdx x = nsa_idx(lds, b, g, qt); return urow(p, x.row)[C_NG + br * 8 + x.head]; }
HD void nsa_unit(const P& p, int L, ldsp_t lds, int b, int g, int qt) {
    const int tid = opaque_tid(), lane = tid & 63, w = RFL(tid >> 6), c = lane & 31, hi = lane >> 5;
    const int pos = 64 * qt + 8 * w + (c >> 2);
    const size_t bg = (size_t)b * 2 + g;
    bf16x8 qf[4]; TilePipe tp; AttnSt st; f32x16 i0, i1;
    LDSQ float* combl = (LDSQ float*)(lds + NSA_COMB + w * 8192) + lane;
    for (int r = 0; r < 16; ++r) { i0[r] = 0.f; i1[r] = 0.f; }
    bf16x8 qfr[4];
    nsa_load_q(p, lds, b, g, qt, WB_QNB, qf); nsa_load_q(p, lds, b, g, qt, WB_QRB, qfr);
    const float gr0 = nsa_gate_raw(p, lds, b, g, qt, 0), gr1 = nsa_gate_raw(p, lds, b, g, qt, 1), gr2 = nsa_gate_raw(p, lds, b, g, qt, 2);
    attn_init(st);
    {
        const float mb = score_bound(qf, p.k_norm_g + (L * 3 + 0) * 64, lane);
        const int nt_n = ((4 * qt + 2) >> 6) + 1;
        const bf16_t* kb = wsb(p, WB_KCB) + bg * NCPAD * 64; const bf16_t* vb = wsb(p, WB_VCT) + bg * (NCPAD / 64) * 4096;
        const int nlim = (pos - 31) >> 4, nlim_min = (64 * qt + 8 * w - 31) >> 4;
        BranchCtx bx; bx.qt = qt; bx.pos = pos; bx.hi = hi; bx.nlim = nlim; bx.nlim_min = nlim_min; bx.kb0 = 0; bx.selmask = 0ull;
        { int ni = (nlim_min + 1) >> 6; ni = ni < 0 ? 0 : (ni > nt_n ? nt_n : ni);
          nsa_branch<0>(lds, tid, kb, vb, nt_n, 0, ni, qf, mb, st, tp, bx, c, hi); }
        {
            const float lt1 = st.l + __shfl_xor(st.l, 32), inv1 = lt1 > 0.f ? RCPF(lt1) : 0.f;
            tp_start(lds, tid, kb, vb, nt_n, tp);
            for (int t = 0; t < nt_n; ++t) { imp_tile(lds, t % 3, qf, mb, inv1, nlim - 64 * t - 4 * hi, i0, i1, t, c, hi); tp_advance(lds, tid, kb, vb, t, nt_n, tp); }
        }
    }
    unsigned long long selmask;
    {
        const float lt = st.l + __shfl_xor(st.l, 32), inv = lt > 0.f ? RCPF(lt) : 0.f, gate = sigmoidf_(gr0) * inv;
        LDSQ float* impw = (LDSQ float*)(lds + NSA_IMP) + w * 512;
#pragma unroll
        for (int r = 0; r < 16; ++r) { combl[r * 64] = gate * st.o0[r]; combl[(16 + r) * 64] = gate * st.o1[r];
            float v0 = i0[r], v1 = i1[r];
            v0 += __shfl_xor(v0, 1); v0 += __shfl_xor(v0, 2); v1 += __shfl_xor(v1, 1); v1 += __shfl_xor(v1, 2);
            if ((c & 3) == 0) { const int j = (r & 3) + 8 * (r >> 2) + 4 * hi; impw[(c >> 2) * 64 + j] = v0; impw[(c >> 2) * 64 + 32 + j] = v1; } }
        __syncthreads();
        LDSQ unsigned long long* maskw = (LDSQ unsigned long long*)(lds + NSA_MASK) + w * 8;
#pragma unroll 1
        for (int q = 0; q < 8; ++q) {
            const int j = lane; const bool forced = (j == 0) || (j == qt) || (j == qt - 1), valid = j <= qt;
            const unsigned key = forced ? 0xFFFFFFFFu : (valid ? __builtin_bit_cast(unsigned, impw[q * 64 + j]) + 1u : 0u);
            unsigned thr = 0u;
#pragma unroll 4
            for (int bit = 31; bit >= 0; --bit) { const unsigned cand = thr | (1u << bit); if (__builtin_popcountll(__ballot(key >= cand)) >= 16) thr = cand; }
            const unsigned long long mgt = __ballot(key > thr), meq = __ballot(key == thr), below = (lane == 0) ? 0ull : (~0ull >> (64 - lane));
            const int need = 16 - __builtin_popcountll(mgt);
            const bool pick = key > thr || (key == thr && __builtin_popcountll(meq & below) < need);
            const unsigned long long mk = __ballot(pick);
            if (lane == 0) maskw[q] = mk;
        }
        __syncthreads();
        selmask = maskw[c >> 2];
    }
#pragma unroll
    for (int ks = 0; ks < 4; ++ks) qf[ks] = qfr[ks];
    attn_init(st);
    {
        const bf16_t* kb = wsb(p, WB_KSB) + bg * SEQ * 64; const bf16_t* vb = wsb(p, WB_VST) + bg * NQT * 4096;
        const int nt_n = qt + 1; const float mb = score_bound(qf, p.k_norm_g + (L * 3 + 1) * 64, lane);
        BranchCtx bx; bx.qt = qt; bx.pos = pos; bx.hi = hi; bx.nlim = 0; bx.nlim_min = 0; bx.kb0 = 0; bx.selmask = selmask;
        nsa_branch<1>(lds, tid, kb, vb, nt_n, 0, qt, qf, mb, st, tp, bx, c, hi);
        const float lt = st.l + __shfl_xor(st.l, 32), inv = lt > 0.f ? RCPF(lt) : 0.f, gate = sigmoidf_(gr1) * inv;
#pragma unroll
        for (int r = 0; r < 16; ++r) { combl[r * 64] += gate * st.o0[r]; combl[(16 + r) * 64] += gate * st.o1[r]; }
    }
    attn_init(st);
    {
        const bf16_t* kb = wsb(p, WB_KWB) + bg * SEQ * 64; const bf16_t* vb = wsb(p, WB_VWT) + bg * NQT * 4096;
        const int kb0 = qt - 8 > 0 ? qt - 8 : 0, nt_n = qt - kb0 + 1;
        const float mb = score_bound(qf, p.k_norm_g + (L * 3 + 2) * 64, lane);
        const bf16_t* kb2 = kb + (size_t)kb0 * 4096; const bf16_t* vb2 = vb + (size_t)kb0 * 4096;
        BranchCtx bx; bx.qt = qt; bx.pos = pos; bx.hi = hi; bx.nlim = 0; bx.nlim_min = 0; bx.kb0 = kb0; bx.selmask = 0ull;
        nsa_branch<2>(lds, tid, kb2, vb2, nt_n, qt >= 8 ? 1 : 0, nt_n - 1, qf, mb, st, tp, bx, c, hi);
        const float lt = st.l + __shfl_xor(st.l, 32), inv = lt > 0.f ? RCPF(lt) : 0.f, gate = sigmoidf_(gr2) * inv;
#pragma unroll
        for (int r = 0; r < 16; ++r) { st.o0[r] = combl[r * 64] + gate * st.o0[r]; st.o1[r] = combl[(16 + r) * 64] + gate * st.o1[r]; }
    }
    const NsaIdx xo = nsa_idx(lds, b, g, qt); const int hi2 = xo.hi;
    bf16_t* mo = mixb(p) + (size_t)xo.row * D + 256 + xo.head * 64; const URow nz = urow(p, xo.row) + (C_NZ + xo.head * 64);
#pragma unroll
    for (int q4 = 0; q4 < 4; ++q4) { const int d0 = 8 * q4 + 4 * hi2;
        const bf16x4 z0 = *(const bf16x4*)(nz.q + d0), z1 = *(const bf16x4*)(nz.q + 32 + d0); bf16x4 r0, r1;
#pragma unroll
        for (int e = 0; e < 4; ++e) { r0[e] = (short)f2bf(st.o0[4 * q4 + e] * siluf(bf2f((bf16_t)z0[e]))); r1[e] = (short)f2bf(st.o1[4 * q4 + e] * siluf(bf2f((bf16_t)z1[e]))); }
        *(bf16x4*)(mo + d0) = r0; *(bf16x4*)(mo + 32 + d0) = r1; }
}
HD void bphase_nsa_prompt(const P& p, int L, ldsp_t lds) {
    constexpr int NPAIR = BATCH * 2 * (NQT / 2);
    for (int pi0 = blockIdx.x; pi0 < NPAIR; pi0 += gridDim.x) {
        const int G = (int)gridDim.x, pi = (G % 8 == 0 && NPAIR % G == 0) ? ((pi0 % G) % 8) * (G / 8) + (pi0 % G) / 8 + (pi0 / G) * G : pi0;
        const int bgi = pi / (NQT / 2), q = pi % (NQT / 2);
        nsa_unit(p, L, lds, bgi >> 1, bgi & 1, NQT - 1 - q);
        nsa_unit(p, L, lds, bgi >> 1, bgi & 1, q);
    }
}

#ifdef CPU_EMU
#define WAVE_SYNC() emu_wave_sync()
#else
#define WAVE_SYNC() do { __builtin_amdgcn_fence(__ATOMIC_ACQ_REL, "wavefront"); __builtin_amdgcn_wave_barrier(); } while (0)
#endif
constexpr int GL_Q = 0, GL_K = 5120, GL_V = 10240, GL_WAVE = 19456;
HD int sw64(int row, int chunk) { return row * 80 + (chunk << 4); }
HD int sw128(int row, int chunk) { return row * 144 + (chunk << 4); }
HD int swv(int row, int q) { return row * 136 + (q << 3); }
static_assert(GL_V + 64 * 136 <= GL_WAVE && 64 * 144 <= GL_V, "per-wave LDS map");
HD float* gs_loc(const P& p, int b, int h, int c) { return p.ws + W_GSLOC + (((size_t)b * 4 + h) * NQT + c) * 2048; }
HD float* gs_bl(const P& p, int b, int h, int c) { return p.ws + W_GSBL + (((size_t)b * 4 + h) * NQT + c) * 32; }
template <class Src> HD void stage_vt_load(Src vsrc  , size_t row_stride, int lane, float (&tmp)[64]) {
#pragma unroll
    for (int j = 0; j < 64; ++j) tmp[j] = vsrc[(size_t)j * row_stride + lane];
}
HD void stage_vt_store(ldsp_t lw, int lane, const float (&tmp)[64]) {
#pragma unroll
    for (int j = 0; j < 64; ++j) *(LDSQ bf16_t*)(lw + GL_V + swv(lane, j >> 2) + (j & 3) * 2) = f2bf(tmp[j]);
    SCHED_FENCE();
}
HD bf16x8 ld_vt_frag(ldsp_t lw, int e, int q) {
    const bf16x4 a = *(const LDSQ bf16x4*)(lw + GL_V + swv(e, q)), b = *(const LDSQ bf16x4*)(lw + GL_V + swv(e, q + 2)); bf16x8 v;
    for (int j = 0; j < 4; ++j) { v[j] = a[j]; v[4 + j] = b[j]; } return v;
}
HD bf16x8 ld_vt_nat(ldsp_t lw, int e, int q) {
    const bf16x4 a = *(const LDSQ bf16x4*)(lw + GL_V + swv(e, q)), b = *(const LDSQ bf16x4*)(lw + GL_V + swv(e, q + 1)); bf16x8 v;
    for (int j = 0; j < 4; ++j) { v[j] = a[j]; v[4 + j] = b[j]; } return v;
}
HD void gla_cumsum(const P& p, int row0, int h, int lane, float (&bc)[32], float& tot0, float& blast) {
    const int dk = lane & 31, half = lane >> 5; const float* la = p.ws + W_LOGA + (size_t)(row0 + half * 32) * 128 + h * 32 + dk; float run = 0.f;
#pragma unroll
    for (int i = 0; i < 32; ++i) { run += la[(size_t)i * 128]; bc[i] = run; }
    tot0 = __shfl(run, dk); const float tot1 = __shfl(run, 32 + dk); blast = tot0 + tot1;
    if (half) {
#pragma unroll
        for (int i = 0; i < 32; ++i) bc[i] += tot0; }
}
HD void gla_g1_unit(const P& p, int L, ldsp_t lw, int b, int h, int c, int lane_) {
    const int lane = opaque_i(lane_);
    const int row0 = b * SEQ + c * 64, dk = lane & 31, half = lane >> 5, hi = half;
    WAVE_SYNC();
    float bc[32], tot0, blast; gla_cumsum(p, row0, h, lane, bc, tot0, blast);
    float vtmp[64]; stage_vt_load(urow(p, row0) + (C_GV + h * 64), U_LD, lane, vtmp);
    const URow ku = urow(p, row0 + half * 32) + (C_GK + h * 32 + dk);
#pragma unroll
    for (int i = 0; i < 32; ++i) { const int j = half * 32 + i;
        *(LDSQ bf16_t*)(lw + GL_Q + sw128(dk, j >> 3) + (j & 7) * 2) = f2bf(ku[(size_t)i * U_LD] * EXPF(blast - bc[i])); }
    stage_vt_store(lw, lane, vtmp);
    if (lane < 32) gs_bl(p, b, h, c)[lane] = blast;
    WAVE_SYNC();
    f32x16 a0, a1;
    for (int r = 0; r < 16; ++r) { a0[r] = 0.f; a1[r] = 0.f; }
#pragma unroll
    for (int ks = 0; ks < 4; ++ks) {
        const bf16x8 kf = *(const LDSQ bf16x8*)(lw + GL_Q + sw128(dk, 2 * ks + hi));
        a0 = __builtin_amdgcn_mfma_f32_32x32x16_bf16(ld_vt_nat(lw, dk, 4 * ks + 2 * hi), kf, a0, 0, 0, 0);
        a1 = __builtin_amdgcn_mfma_f32_32x32x16_bf16(ld_vt_nat(lw, 32 + dk, 4 * ks + 2 * hi), kf, a1, 0, 0, 0);
    }
    float* so = gs_loc(p, b, h, c);
#pragma unroll
    for (int r = 0; r < 16; ++r) { const int e = (r & 3) + 8 * (r >> 2) + 4 * hi; so[e * 32 + dk] = a0[r]; so[(32 + e) * 32 + dk] = a1[r]; }
}
HD void k_gla_scan(const P& p, int L, long it) {
    const int d = (int)(it % 32), e = (int)((it / 32) % 64), h = (int)((it / 2048) % 4), b = (int)(it / 8192); float S = 0.f;
    for (int c0 = 0; c0 < NQT; c0 += 16) { float loc[16], al[16];
#pragma unroll
        for (int k = 0; k < 16; ++k) { const int c = c0 + k < NQT ? c0 + k : NQT - 1; loc[k] = gs_loc(p, b, h, c)[e * 32 + d]; al[k] = gs_bl(p, b, h, c)[d]; }
#pragma unroll
        for (int k = 0; k < 16; ++k) if (c0 + k < NQT) { const float prev = S; S = EXPF(al[k]) * S + loc[k]; loc[k] = prev; }
#pragma unroll
        for (int k = 0; k < 16; ++k) if (c0 + k < NQT) gs_loc(p, b, h, c0 + k)[e * 32 + d] = loc[k]; }
    p.out[O_PGLA + (((size_t)L * BATCH + b) * 4 + h) * 2048 + d * 64 + e] = S;
}
HD void gla_g2_unit(const P& p, int L, ldsp_t lw, int b, int h, int c, int lane_) {
    const int lane = opaque_i(lane_);
    const int row0 = b * SEQ + c * 64, dk = lane & 31, half = lane >> 5, hi = half, cl = lane & 31;
    WAVE_SYNC();
    float bc[32], tot0, blast; gla_cumsum(p, row0, h, lane, bc, tot0, blast);
    float svr[2][2][8];
    { const float* ss = gs_loc(p, b, h, c);
#pragma unroll
      for (int et = 0; et < 2; ++et)
#pragma unroll
        for (int ks = 0; ks < 2; ++ks) ld8f(ss + (32 * et + cl) * 32 + 16 * ks + 8 * hi, svr[et][ks]); }
    float vtmp[64]; stage_vt_load(urow(p, row0) + (C_GV + h * 64), U_LD, lane, vtmp);
    const URow qu = urow(p, row0 + half * 32) + (C_GQ + h * 32 + dk); const URow ku = qu + (C_GK - C_GQ);
#pragma unroll
    for (int i = 0; i < 32; ++i) { const int j = half * 32 + i; const float dl = bc[i] - tot0;
        *(LDSQ bf16_t*)(lw + GL_Q + sw64(j, dk >> 3) + (dk & 7) * 2) = f2bf(qu[(size_t)i * U_LD] * 0.17677669529663687f * EXPF(dl));
        *(LDSQ bf16_t*)(lw + GL_K + sw64(j, dk >> 3) + (dk & 7) * 2) = f2bf(ku[(size_t)i * U_LD] * EXPF(-dl)); }
    stage_vt_store(lw, lane, vtmp);
    WAVE_SYNC();
    bf16x8 sf[2][2];
    {
#pragma unroll
      for (int et = 0; et < 2; ++et)
#pragma unroll
        for (int ks = 0; ks < 2; ++ks)
            {
#pragma unroll
              for (int jj = 0; jj < 8; ++jj) { const int d = 16 * ks + 8 * hi + jj; const float br = __shfl(tot0, d); sf[et][ks][jj] = (short)f2bf(svr[et][ks][jj] * EXPF(br)); } } }
    const URow gz = urow(p, row0) + (C_GZ + h * 64); const float* ng = p.gla_norm_g + L * 64;
#pragma unroll
    for (int it = 0; it < 2; ++it) {
        const int i = 32 * it + cl;
        bf16x8 qf[2];
        qf[0] = *(const LDSQ bf16x8*)(lw + GL_Q + sw64(i, hi)); qf[1] = *(const LDSQ bf16x8*)(lw + GL_Q + sw64(i, 2 + hi));
        f32x16 o0, o1;
        for (int r = 0; r < 16; ++r) { o0[r] = 0.f; o1[r] = 0.f; }
#pragma unroll
        for (int ks = 0; ks < 2; ++ks) { o0 = __builtin_amdgcn_mfma_f32_32x32x16_bf16(sf[0][ks], qf[ks], o0, 0, 0, 0); o1 = __builtin_amdgcn_mfma_f32_32x32x16_bf16(sf[1][ks], qf[ks], o1, 0, 0, 0); }
#pragma unroll
        for (int jt = 0; jt <= it; ++jt) {
            f32x16 at;
            for (int r = 0; r < 16; ++r) at[r] = 0.f;
#pragma unroll
            for (int ks = 0; ks < 2; ++ks) at = __builtin_amdgcn_mfma_f32_32x32x16_bf16(*(const LDSQ bf16x8*)(lw + GL_K + sw64(32 * jt + cl, 2 * ks + hi)), qf[ks], at, 0, 0, 0);
            bf16x8 pf[2];
#pragma unroll
            for (int r = 0; r < 16; ++r) { const int jl = (r & 3) + 8 * (r >> 2) + 4 * hi; const float v = (jt < it || jl <= cl) ? at[r] : 0.f; pf[r >> 3][r & 7] = (short)f2bf(v); }
#pragma unroll
            for (int s = 0; s < 2; ++s) { const int q = 8 * jt + 4 * s + hi;
                o0 = __builtin_amdgcn_mfma_f32_32x32x16_bf16(ld_vt_frag(lw, cl, q), pf[s], o0, 0, 0, 0);
                o1 = __builtin_amdgcn_mfma_f32_32x32x16_bf16(ld_vt_frag(lw, 32 + cl, q), pf[s], o1, 0, 0, 0); }
        }
        float ss = 0.f;
#pragma unroll
        for (int r = 0; r < 16; ++r) ss += o0[r] * o0[r] + o1[r] * o1[r];
        ss += __shfl_xor(ss, 32);
        const float rs = RSQRTF(ss * (1.0f / 64) + 1e-6f);
        bf16_t* mo = mixb(p) + (size_t)(row0 + i) * D + h * 64; const URow gzr = gz + (size_t)i * U_LD;
#pragma unroll
        for (int q4 = 0; q4 < 4; ++q4) { const int e0 = 8 * q4 + 4 * hi;
            const bf16x4 z0 = *(const bf16x4*)(gzr.q + e0), z1 = *(const bf16x4*)(gzr.q + 32 + e0); const f32x4 g0 = *(const f32x4*)(ng + e0), g1 = *(const f32x4*)(ng + 32 + e0); bf16x4 r0, r1;
#pragma unroll
            for (int k = 0; k < 4; ++k) { r0[k] = (short)f2bf(o0[4 * q4 + k] * rs * g0[k] * siluf(bf2f((bf16_t)z0[k]))); r1[k] = (short)f2bf(o1[4 * q4 + k] * rs * g1[k] * siluf(bf2f((bf16_t)z1[k]))); }
            *(bf16x4*)(mo + e0) = r0; *(bf16x4*)(mo + 32 + e0) = r1; }
    }
}
constexpr int LDS_WX = LDS_MISC + 1024;
HD float* ml_cloc(const P& p, int b, int h, int c) { return p.ws + W_MCLOC + (((size_t)b * 4 + h) * NQT + c) * 4160; }
HD float* ml_fg(const P& p, int b, int h, int c) { return p.ws + W_MFG + (((size_t)b * 4 + h) * NQT + c) * 4; }
HD float wave_max(float v) { for (int o = 1; o < 64; o <<= 1) v = fmaxf(v, __shfl_xor(v, o)); return v; }
HD void ml_gates(const P& p, int L, int row0, int h, int lane, float& ii, float& fcum) {
    const URow u = urow(p, row0 + lane) + C_MIF;
    ii = u[h] + p.gate_b[(L * 2 + 0) * 4 + h]; float f = log_sigmoidf(u[4 + h] + p.gate_b[(L * 2 + 1) * 4 + h]);
    for (int o = 1; o < 64; o <<= 1) { const float t = __shfl(f, lane - o >= 0 ? lane - o : lane); if (lane >= o) f += t; }
    fcum = f;
}
HD void ml_g1_unit(const P& p, int L, ldsp_t lw, int b, int h, int c, int lane_) {
    const int lane = opaque_i(lane_);
    const int row0 = b * SEQ + c * 64, cl = lane & 31, hi = lane >> 5;
    WAVE_SYNC();
    float ii, fcum; ml_gates(p, L, row0, h, lane, ii, fcum);
    const float F = __shfl(fcum, 63), g = ii - fcum, G = F + wave_max(g), wj = EXPF(F + g - G);
    float nacc = 0.f;
    float vtmp[64]; stage_vt_load(urow(p, row0) + (C_MV + h * 64), U_LD, lane, vtmp);
    const float* ku = p.ws + W_MK + (size_t)row0 * 256 + h * 64 + lane;
#pragma unroll 32
    for (int j = 0; j < 64; ++j) { const float v = ku[(size_t)j * 256] * __shfl(wj, j); nacc += v; *(LDSQ bf16_t*)(lw + GL_Q + sw128(lane, j >> 3) + (j & 7) * 2) = f2bf(v); }
    stage_vt_store(lw, lane, vtmp);
    WAVE_SYNC();
    f32x16 a[2][2];
    for (int x = 0; x < 4; ++x) for (int r = 0; r < 16; ++r) a[x >> 1][x & 1][r] = 0.f;
#pragma unroll
    for (int ks = 0; ks < 4; ++ks) {
        const bf16x8 v0 = ld_vt_nat(lw, cl, 4 * ks + 2 * hi), v1 = ld_vt_nat(lw, 32 + cl, 4 * ks + 2 * hi);
#pragma unroll
        for (int dt = 0; dt < 2; ++dt) { const bf16x8 kf = *(const LDSQ bf16x8*)(lw + GL_Q + sw128(32 * dt + cl, 2 * ks + hi));
            a[0][dt] = __builtin_amdgcn_mfma_f32_32x32x16_bf16(v0, kf, a[0][dt], 0, 0, 0); a[1][dt] = __builtin_amdgcn_mfma_f32_32x32x16_bf16(v1, kf, a[1][dt], 0, 0, 0); }
    }
    float* so = ml_cloc(p, b, h, c);
#pragma unroll
    for (int et = 0; et < 2; ++et)
#pragma unroll
        for (int dt = 0; dt < 2; ++dt)
#pragma unroll
            for (int r = 0; r < 16; ++r) so[(32 * et + (r & 3) + 8 * (r >> 2) + 4 * hi) * 64 + 32 * dt + cl] = a[et][dt][r];
    so[64 * 64 + lane] = nacc;
    if (lane == 0) { float* fg = ml_fg(p, b, h, c); fg[0] = F; fg[1] = G; }
}
HD void k_ml_scan(const P& p, int L, long it) {
    const int d = (int)(it % 64), e = (int)((it / 64) % 65), h = (int)((it / 4160) % 4), b = (int)(it / 16640); float S = 0.f, ms = 0.f;
    for (int c0 = 0; c0 < NQT; c0 += 16) { float loc[16], Fv[16], Gv[16];
#pragma unroll
        for (int k = 0; k < 16; ++k) { const int c = c0 + k < NQT ? c0 + k : NQT - 1; loc[k] = ml_cloc(p, b, h, c)[e * 64 + d]; const float* fg = ml_fg(p, b, h, c); Fv[k] = fg[0]; Gv[k] = fg[1]; }
#pragma unroll
        for (int k = 0; k < 16; ++k) if (c0 + k < NQT) { const float mn = fmaxf(Fv[k] + ms, Gv[k]), prev = S; S = EXPF(Fv[k] + ms - mn) * S + EXPF(Gv[k] - mn) * loc[k]; loc[k] = prev; Fv[k] = ms; ms = mn; }
#pragma unroll
        for (int k = 0; k < 16; ++k) if (c0 + k < NQT) { ml_cloc(p, b, h, c0 + k)[e * 64 + d] = loc[k]; if (e == 64 && d == 0) ml_fg(p, b, h, c0 + k)[2] = Fv[k]; } }
    const size_t sb = ((size_t)L * BATCH + b) * 4 + h;
    if (e < 64) p.out[O_PC + (sb * 64 + e) * 64 + d] = S; else { p.out[O_PN + sb * 64 + d] = S; if (d == 0) p.out[O_PM + sb] = ms; }
}
HD void ml_g2_unit(const P& p, int L, ldsp_t lw, LDSQ float* gx, int b, int h, int c, int lane_) {
    const int lane = opaque_i(lane_);
    const int row0 = b * SEQ + c * 64, cl = lane & 31, hi = lane >> 5;
    WAVE_SYNC();
    float ii, fcum; ml_gates(p, L, row0, h, lane, ii, fcum);
    const float ms = ml_fg(p, b, h, c)[2], g = ii - fcum;
    float M = fmaxf(g, ms);
    for (int o = 1; o < 64; o <<= 1) { const float t = __shfl(M, lane - o >= 0 ? lane - o : lane); if (lane >= o) M = fmaxf(M, t); }
    gx[lane] = g;
    { float vtmp[64]; stage_vt_load(urow(p, row0) + (C_MV + h * 64), U_LD, lane, vtmp);
      const float* ku = p.ws + W_MK + (size_t)row0 * 256 + h * 64 + lane;
#pragma unroll 32
      for (int j = 0; j < 64; ++j) *(LDSQ bf16_t*)(lw + GL_Q + sw128(j, lane >> 3) + (lane & 7) * 2) = f2bf(ku[(size_t)j * 256]);
      SCHED_FENCE();
      stage_vt_store(lw, lane, vtmp); }
    WAVE_SYNC();
    const float* cs = ml_cloc(p, b, h, c);
    const float* ng = p.ml_norm_g + L * 64;
#pragma unroll 1
    for (int it = 0; it < 2; ++it) {
        const int i = 32 * it + cl; const float Mi = __shfl(M, i), fi = __shfl(fcum, i), wint = EXPF(ms - Mi);
        const float* qr = p.ws + W_MQ + (size_t)(row0 + i) * 256 + h * 64;
        bf16x8 qf[4]; float nq = 0.f; float ca[4][8], cb[4][8];
#pragma unroll
        for (int ks = 0; ks < 4; ++ks) { ld8f(cs + cl * 64 + 16 * ks + 8 * hi, ca[ks]); ld8f(cs + (32 + cl) * 64 + 16 * ks + 8 * hi, cb[ks]); }
#pragma unroll
        for (int ks = 0; ks < 4; ++ks) { float qv8[8], nv8[8]; ld8f(qr + 16 * ks + 8 * hi, qv8); ld8f(cs + 64 * 64 + 16 * ks + 8 * hi, nv8);
#pragma unroll
            for (int jj = 0; jj < 8; ++jj) { qf[ks][jj] = (short)f2bf(qv8[jj]); nq += qv8[jj] * nv8[jj]; } }
        nq += __shfl_xor(nq, 32);
        f32x16 o0, o1;
        for (int r = 0; r < 16; ++r) { o0[r] = 0.f; o1[r] = 0.f; }
#pragma unroll
        for (int ks = 0; ks < 4; ++ks) { bf16x8 c0, c1;
#pragma unroll
            for (int jj = 0; jj < 8; ++jj) { c0[jj] = (short)f2bf(ca[ks][jj]); c1[jj] = (short)f2bf(cb[ks][jj]); }
            o0 = __builtin_amdgcn_mfma_f32_32x32x16_bf16(c0, qf[ks], o0, 0, 0, 0); o1 = __builtin_amdgcn_mfma_f32_32x32x16_bf16(c1, qf[ks], o1, 0, 0, 0); }
        bf16_t* mo = mixb(p) + (size_t)(row0 + i) * D + 768 + h * 64; const URow ur = urow(p, row0 + i);
        bf16x4 ga0[4], ga1[4], gz0[4], gz1[4];
#pragma unroll
        for (int q4 = 0; q4 < 4; ++q4) { const int e0 = 8 * q4 + 4 * hi; const bf16_t* uo = ur.q + C_MO + h * 64 + e0; const bf16_t* uz = ur.q + C_MZ + h * 64 + e0;
            ga0[q4] = *(const bf16x4*)uo; ga1[q4] = *(const bf16x4*)(uo + 32); gz0[q4] = *(const bf16x4*)uz; gz1[q4] = *(const bf16x4*)(uz + 32); }
        SCHED_FENCE();
#pragma unroll
        for (int r = 0; r < 16; ++r) { o0[r] *= wint; o1[r] *= wint; }
        float dsum = 0.f;
#pragma unroll 1
        for (int jt = 0; jt <= it; ++jt) {
            f32x16 st;
            for (int r = 0; r < 16; ++r) st[r] = 0.f;
#pragma unroll
            for (int ks = 0; ks < 4; ++ks) st = __builtin_amdgcn_mfma_f32_32x32x16_bf16(*(const LDSQ bf16x8*)(lw + GL_Q + sw128(32 * jt + cl, 2 * ks + hi)), qf[ks], st, 0, 0, 0);
            bf16x8 pf[2];
#pragma unroll
            for (int r = 0; r < 16; ++r) { const int jl = (r & 3) + 8 * (r >> 2) + 4 * hi;
                const float v = (jt < it || jl <= cl) ? st[r] * EXPF(gx[32 * jt + jl] - Mi) : 0.f; dsum += v; pf[r >> 3][r & 7] = (short)f2bf(v); }
#pragma unroll
            for (int s = 0; s < 2; ++s) { const int q = 8 * jt + 4 * s + hi;
                o0 = __builtin_amdgcn_mfma_f32_32x32x16_bf16(ld_vt_frag(lw, cl, q), pf[s], o0, 0, 0, 0);
                o1 = __builtin_amdgcn_mfma_f32_32x32x16_bf16(ld_vt_frag(lw, 32 + cl, q), pf[s], o1, 0, 0, 0); }
        }
        dsum += __shfl_xor(dsum, 32);
        const float den = wint * nq + dsum, hinv = RCPF(fmaxf(fabsf(den), EXPF(-(fi + Mi))));
        float ss = 0.f;
#pragma unroll
        for (int r = 0; r < 16; ++r) { o0[r] *= hinv; o1[r] *= hinv; ss += o0[r] * o0[r] + o1[r] * o1[r]; }
        ss += __shfl_xor(ss, 32);
        const float rs = RSQRTF(ss * (1.0f / 64) + 1e-6f);
#pragma unroll
        for (int q4 = 0; q4 < 4; ++q4) { const int e0 = 8 * q4 + 4 * hi;
            const bf16x4 a0 = ga0[q4], a1 = ga1[q4], z0 = gz0[q4], z1 = gz1[q4]; const f32x4 g0 = *(const f32x4*)(ng + e0), g1 = *(const f32x4*)(ng + 32 + e0); bf16x4 r0, r1;
#pragma unroll
            for (int k = 0; k < 4; ++k) { r0[k] = (short)f2bf(o0[4 * q4 + k] * rs * g0[k] * sigmoidf_(bf2f((bf16_t)a0[k])) * siluf(bf2f((bf16_t)z0[k])));
                r1[k] = (short)f2bf(o1[4 * q4 + k] * rs * g1[k] * sigmoidf_(bf2f((bf16_t)a1[k])) * siluf(bf2f((bf16_t)z1[k]))); }
            *(bf16x4*)(mo + e0) = r0; *(bf16x4*)(mo + 32 + e0) = r1; }
    }
}
HD void bphase_rec_g1(const P& p, int L, ldsp_t lds) {
    const int w = RFL(opaque_tid() >> 6); const ldsp_t lw = lds + w * GL_WAVE; constexpr int NU = BATCH * 4 * NQT;
#define lane (opaque_tid() & 63)
    for (int u2 = blockIdx.x * 8 + w; u2 < 2 * NU; u2 += gridDim.x * 8) { const int u = u2 % NU;
        if (u2 < NU) gla_g1_unit(p, L, lw, u / (4 * NQT), (u / NQT) % 4, u % NQT, lane); else ml_g1_unit(p, L, lw, u / (4 * NQT), (u / NQT) % 4, u % NQT, lane); }
#undef lane
}
HD void bphase_rec_g2(const P& p, int L, ldsp_t lds) {
    const int w = RFL(opaque_tid() >> 6); const ldsp_t lw = lds + w * GL_WAVE; LDSQ float* gx = (LDSQ float*)(lds + LDS_WX + w * 256); constexpr int NU = BATCH * 4 * NQT;
#define lane (opaque_tid() & 63)
    for (int u2 = blockIdx.x * 8 + w; u2 < 2 * NU; u2 += gridDim.x * 8) { const int u = u2 % NU;
        if (u2 < NU) gla_g2_unit(p, L, lw, u / (4 * NQT), (u / NQT) % 4, u % NQT, lane); else ml_g2_unit(p, L, lw, gx, u / (4 * NQT), (u / NQT) % 4, u % NQT, lane); }
#undef lane
}

constexpr int CS_STRIDE = 528, CS_BUF = 33 * CS_STRIDE, CS_GROUP = 2 * CS_BUF;
static_assert(2 * CS_GROUP + 32 * 256 * 4 <= LDS_MISC, "summary staging + partial-sum exchange fit the scratch region");
HD bf16_t* wctp(const P& p, int L, int kv) { return (bf16_t*)((char*)p.ws + WB_WCT) + ((size_t)(L * 2 + kv)) * 64 * 2048; }
HD void k_prep_wc(const P& p, int L, long it) {
    const int lane = (int)(it % 64), et = (int)((it / 64) % 2), ks = (int)((it / 128) % 4), hs = (int)((it / 512) % 2), r = (int)((it / 1024) % 16), kv = (int)((it / 16384) % 2), L2 = (int)(it / 32768);
    bf16_t* o = wctp(p, L2, kv) + (size_t)(it % 16384) * 8; const int e = 32 * et + (lane & 31), s = 16 * hs + r, d0 = 16 * ks + 8 * (lane >> 5);
    const float* w = p.cmp_w + (((size_t)(L2 * 2 + kv) * 32 + s) * 64 + d0) * 64 + e;
    for (int j = 0; j < 8; ++j) o[j] = f2bf(w[(size_t)j * 64]);
}
HD void k_cmp_pad(const P& p, int L, long it) {
    const int g = (int)(it % 2); const long q = it / 2; const int j = (int)(q % NCPAD), s = (int)(q / NCPAD);
    if (j < seq_ncmp(s)) return;
    bf16_t* kb = wsb(p, WB_KCB) + (((size_t)s * 2 + g) * NCPAD + j) * 64; bf16_t* vt = wsb(p, WB_VCT) + (((size_t)s * 2 + g) * (NCPAD / 64) + j / 64) * 4096 + (j % 64);
    for (int d = 0; d < 64; ++d) { kb[d] = 0; vt[(size_t)d * 64] = 0; }
}
HD void cs_stage_load(const float* const (&bp)[9], int r, f32x4 (&rg)[9]) {
#pragma unroll
    for (int q = 0; q < 9; ++q) { f32x4 v = {0.f, 0.f, 0.f, 0.f}; if (bp[q]) v = *(const f32x4*)(bp[q] + (size_t)r * 512); rg[q] = v; }
}
HD void cs_stage_store(ldsp_t lg, int buf, int tl, const f32x4 (&rg)[9]) {
#pragma unroll
    for (int q = 0; q < 9; ++q) { const int i = tl + q * 256; const int jj = i >> 6, c4 = i & 63;
        if (i < 33 * 64) { bf16x4 o; for (int e = 0; e < 4; ++e) o[e] = (short)f2bf(rg[q][e]); *(LDSQ bf16x4*)(lg + buf * CS_BUF + jj * CS_STRIDE + c4 * 8) = o; } }
}
template <int WHICH  > HD void bphase_cmp_sum_t(const P& p, int L, ldsp_t lds) {
    const int tid = opaque_tid(), lane = tid & 63, w = tid >> 6, grp = w >> 2, kv = (w >> 1) & 1, g = w & 1, tl = tid & 255, cl = lane & 31, hi = lane >> 5;
    constexpr int TP = (SEQ / 16 + 31) / 32, TS = ((PAST_LEN + DEC_SEQ) / 16 + 31) / 32, U0 = WHICH ? BATCH * TP : 0, NUNIT = WHICH ? DEC_BATCH * TS : BATCH * TP;
    constexpr bool SPLIT = (WHICH == 0);
    constexpr int NITER = SPLIT ? NUNIT : (NUNIT + 1) / 2, NSTEP = SPLIT ? 8 : 16;
    const ldsp_t lg = lds + grp * CS_GROUP;
    for (int itx = blockIdx.x; itx < NITER; itx += gridDim.x) {
        const int un = SPLIT ? U0 + itx : U0 + 2 * itx + grp; const bool live = SPLIT ? true : (2 * itx + grp < NUNIT); const int r0 = SPLIT ? 8 * grp : 0;
        int s = 0, t = 0;
        if (live) { if (un < BATCH * TP) { s = un / TP; t = un % TP; } else { s = BATCH + (un - BATCH * TP) / TS; t = (un - BATCH * TP) % TS; } }
        const int nhalf = live ? (s < BATCH ? SEQ / 16 : (PAST_LEN + DEC_SEQ) / 16) : 0, j0 = 32 * t;
        f32x4 rg[9]; f32x16 a0, a1; const float* bp[9];
        for (int r = 0; r < 16; ++r) { a0[r] = 0.f; a1[r] = 0.f; }
#pragma unroll
        for (int q = 0; q < 9; ++q) { const int i = tl + q * 256, jj = i >> 6, c4 = i & 63; bp[q] = (i < 33 * 64 && j0 + jj < nhalf) ? hist(p, L, s, 16 * (j0 + jj), 0, 0) + c4 * 4 : nullptr; }
        cs_stage_load(bp, r0, rg); cs_stage_store(lg, 0, tl, rg); cs_stage_load(bp, r0 + 1, rg); LDS_BARRIER();
        const bf16_t* wt = wctp(p, L, kv) + (size_t)lane * 8;
#define CS_WLOADH(R, HS, WF) { _Pragma("unroll") for (int ks = 0; ks < 4; ++ks) { const bf16_t* wp = wt + ((((R) * 2 + (HS)) * 4 + ks) * 2) * 512; \
            WF[ks][0] = *(const bf16x8*)wp; WF[ks][1] = *(const bf16x8*)(wp + 512); } }
#define CS_COMPUTEH(BUF, HS, WF) { const ldsp_t xb = lg + (BUF) * CS_BUF + cl * CS_STRIDE + (kv * 2 + g) * 128 + hi * 16; \
            _Pragma("unroll") for (int ks = 0; ks < 4; ++ks) { const bf16x8 xf = *(const LDSQ bf16x8*)(xb + (HS) * CS_STRIDE + ks * 32); \
                a0 = __builtin_amdgcn_mfma_f32_32x32x16_bf16(WF[ks][0], xf, a0, 0, 0, 0); \
                a1 = __builtin_amdgcn_mfma_f32_32x32x16_bf16(WF[ks][1], xf, a1, 0, 0, 0); } }
        bf16x8 wfa[4][2], wfb[4][2];
        CS_WLOADH(r0, 0, wfa) CS_WLOADH(r0, 1, wfb)
#pragma unroll 1
        for (int rr = 0; rr < NSTEP; ++rr) {
            const int r = r0 + rr;
            CS_COMPUTEH(rr & 1, 0, wfa)
            if (rr + 1 < NSTEP) CS_WLOADH(r + 1, 0, wfa)
            SCHED_FENCE();
            CS_COMPUTEH(rr & 1, 1, wfb)
            if (rr + 1 < NSTEP) CS_WLOADH(r + 1, 1, wfb)
            SCHED_FENCE();
            if (rr + 1 < NSTEP) cs_stage_store(lg, (rr + 1) & 1, tl, rg);
            if (rr + 2 < NSTEP) cs_stage_load(bp, r + 2, rg);
            LDS_BARRIER();
        }
        if (SPLIT) {
            LDSQ float* xs = (LDSQ float*)(lds + 2 * CS_GROUP) + tl;
            if (grp == 1) {
#pragma unroll
                for (int r = 0; r < 16; ++r) { xs[r * 256] = a0[r]; xs[(16 + r) * 256] = a1[r]; } }
            __syncthreads();
            if (grp == 0) {
#pragma unroll
                for (int r = 0; r < 16; ++r) { a0[r] += xs[r * 256]; a1[r] += xs[(16 + r) * 256]; } }
            __syncthreads();
        }
#undef CS_WLOADH
#undef CS_COMPUTEH
        const int j = j0 + cl; const bool ok = live && j < seq_ncmp(s) && (!SPLIT || grp == 0);
        const float* bias = p.ws + W_CBIAS + L * 128 + kv * 64;
        float ss = 0.f;
#pragma unroll
        for (int r = 0; r < 16; ++r) { const int e = (r & 3) + 8 * (r >> 2) + 4 * hi; a0[r] += bias[e]; a1[r] += bias[32 + e]; ss += a0[r] * a0[r] + a1[r] * a1[r]; }
        ss += __shfl_xor(ss, 32);
        const float rs = kv == 0 ? RSQRTF(ss * (1.0f / 64) + 1e-6f) : 1.0f; const float* kg = p.k_norm_g + (L * 3 + 0) * 64;
        if (ok) {
            bf16_t* kb = wsb(p, WB_KCB) + (((size_t)s * 2 + g) * NCPAD + j) * 64; bf16_t* vt = wsb(p, WB_VCT) + (((size_t)s * 2 + g) * (NCPAD / 64) + j / 64) * 4096 + (j % 64);
#pragma unroll
            for (int r = 0; r < 16; ++r) { const int e = (r & 3) + 8 * (r >> 2) + 4 * hi;
                const float v0 = kv == 0 ? a0[r] * rs * kg[e] : a0[r], v1 = kv == 0 ? a1[r] * rs * kg[32 + e] : a1[r];
                if (kv == 0) { kb[e] = f2bf(v0); kb[32 + e] = f2bf(v1); } else { vt[(size_t)e * 64] = f2bf(v0); vt[(size_t)(32 + e) * 64] = f2bf(v1); } }
        }
    }
}

HD void bphase_cmp_sum_p(const P& p, int L, ldsp_t lds) { bphase_cmp_sum_t<0>(p, L, lds); }
HD void bphase_cmp_sum_s(const P& p, int L, ldsp_t lds) { bphase_cmp_sum_t<1>(p, L, lds); }
constexpr int SP_NCMP = 8, SP_NITEM = 40, SP_STRIDE = 68, SP_WIN0 = 8, SP_NWIN = 3, SP_SLC0 = 11, SP_NSLC = 28, SL_MAX = 4 * SP_NSLC;
constexpr int NJ = NSELS - 1;
static_assert(PAST_LEN % 64 == 0 && NJ <= 128 && NJ >= 16 && WKEEP_S % 64 == 0 && (WKEEP_S + DEC_SEQ + 63) / 64 <= 3 * SP_NWIN, "sample NSA geometry");
HD float* spart(const P& p, int b, int g, int item) { return p.ws + W_SPART + ((((size_t)b * 2 + g) * SP_NITEM + item) * 32) * SP_STRIDE; }
HD int* slist(const P& p, int b, int g) { return (int*)(p.ws + W_SLIST) + ((size_t)b * 2 + g) * 2 * SL_MAX; }
template <bool MASK>
HD void wattn_tile(ldsp_t lw, const bf16x8 (&qf)[4], int lim2, int lo2, bool sel, AttnSt& st, bf16x8 (&pf)[4], int c, int hi) {
    f32x16 s0, s1;
    for (int r = 0; r < 16; ++r) { s0[r] = 0.f; s1[r] = 0.f; }
#pragma unroll
    for (int ks = 0; ks < 4; ++ks) {
        s0 = __builtin_amdgcn_mfma_f32_32x32x16_bf16(*(const LDSQ bf16x8*)(lw + sw128(c, 2 * ks + hi)), qf[ks], s0, 0, 0, 0);
        s1 = __builtin_amdgcn_mfma_f32_32x32x16_bf16(*(const LDSQ bf16x8*)(lw + sw128(32 + c, 2 * ks + hi)), qf[ks], s1, 0, 0, 0);
    }
    float alpha;
    if (softmax_tile<MASK>(s0, s1, lim2, lo2, sel, st, pf, alpha)) {
#pragma unroll
        for (int r = 0; r < 16; ++r) { st.o0[r] *= alpha; st.o1[r] *= alpha; } }
#pragma unroll
    for (int ks = 0; ks < 4; ++ks) {
        st.o0 = __builtin_amdgcn_mfma_f32_32x32x16_bf16(ld_vt_frag(lw, c, 4 * ks + hi), pf[ks], st.o0, 0, 0, 0);
        st.o1 = __builtin_amdgcn_mfma_f32_32x32x16_bf16(ld_vt_frag(lw, 32 + c, 4 * ks + hi), pf[ks], st.o1, 0, 0, 0);
    }
}
HD void wattn_probs(ldsp_t lw, const bf16x8 (&qf)[4], int lim2, float m, float inv, bf16x8 (&pf)[4], int c, int hi) {
    f32x16 s0, s1;
    for (int r = 0; r < 16; ++r) { s0[r] = 0.f; s1[r] = 0.f; }
#pragma unroll
    for (int ks = 0; ks < 4; ++ks) {
        s0 = __builtin_amdgcn_mfma_f32_32x32x16_bf16(*(const LDSQ bf16x8*)(lw + sw128(c, 2 * ks + hi)), qf[ks], s0, 0, 0, 0);
        s1 = __builtin_amdgcn_mfma_f32_32x32x16_bf16(*(const LDSQ bf16x8*)(lw + sw128(32 + c, 2 * ks + hi)), qf[ks], s1, 0, 0, 0);
    }
#pragma unroll
    for (int r = 0; r < 16; ++r) { const int kc = (r & 3) + 8 * (r >> 2);
        s0[r] = kc <= lim2 ? EXP2F(s0[r] - m) * inv : 0.f; s1[r] = kc + 32 <= lim2 ? EXP2F(s1[r] - m) * inv : 0.f; }
#pragma unroll
    for (int j = 0; j < 8; ++j) { pf[0][j] = bfbits(s0[j]); pf[1][j] = bfbits(s0[8 + j]); pf[2][j] = bfbits(s1[j]); pf[3][j] = bfbits(s1[8 + j]); }
}
HD void wimp_tile(const bf16x8 (&pf)[4], f32x16& acc, int nt, int jt, int c, int hi) {
#pragma unroll
    for (int ks = 0; ks < 4; ++ks) { const int base = nt * 64 + 16 * ks + 4 * hi - 4 * (jt * 32 + c); bf16x8 af;
#pragma unroll
        for (int jj = 0; jj < 8; ++jj) { const int dl = base + 8 * (jj >> 2) + (jj & 3); af[jj] = (dl == -1 || dl == 3) ? (short)0x3F80 : ((dl >= 0 && dl <= 2) ? (short)0x4000 : (short)0); }
        acc = __builtin_amdgcn_mfma_f32_32x32x16_bf16(af, pf[ks], acc, 0, 0, 0); }
}
HD void wstage_f32(ldsp_t lw, const float* kbase, const float* vbase, size_t rs, int nvalid, int lane_) {
    const int lane = opaque_i(lane_);
#pragma unroll 4
    for (int i = 0; i < 16; ++i) { const int row = 4 * i + (lane >> 4), c4 = lane & 15; f32x4 kv = {0.f, 0.f, 0.f, 0.f}, vv = {0.f, 0.f, 0.f, 0.f};
        if (row < nvalid) { kv = *(const f32x4*)(kbase + (size_t)row * rs + c4 * 4); vv = *(const f32x4*)(vbase + (size_t)row * rs + c4 * 4); }
        bf16x4 kb; for (int e = 0; e < 4; ++e) kb[e] = (short)f2bf(kv[e]);
        *(LDSQ bf16x4*)(lw + sw128(row, c4 >> 1) + (c4 & 1) * 8) = kb;
#pragma unroll
        for (int e = 0; e < 4; ++e) *(LDSQ bf16_t*)(lw + GL_V + swv(4 * c4 + e, row >> 2) + (row & 3) * 2) = f2bf(vv[e]); }
}
HD void wstage_bf16(ldsp_t lw, const bf16_t* k, const bf16_t* vt, int lane_) {
    const int lane = opaque_i(lane_);
#pragma unroll
    for (int i = 0; i < 8; ++i) { const int id = i * 64 + lane; *(LDSQ bf16x8*)(lw + sw128(id >> 3, id & 7)) = *(const bf16x8*)(k + id * 8); }
#pragma unroll
    for (int i = 0; i < 16; ++i) { const int id = i * 64 + lane; *(LDSQ bf16x4*)(lw + GL_V + swv(id >> 4, id & 15)) = *(const bf16x4*)(vt + id * 4); }
}
HD void wpart_store(const P& p, int b, int g, int item, const AttnSt& st, int c, int hi) {
    float* o = spart(p, b, g, item) + c * SP_STRIDE; const float lt = st.l + __shfl_xor(st.l, 32);
    if (hi == 0) { o[0] = st.m; o[1] = lt; }
#pragma unroll
    for (int r = 0; r < 16; ++r) { const int d = (r & 3) + 8 * (r >> 2) + 4 * hi; o[4 + d] = st.o0[r]; o[4 + 32 + d] = st.o1[r]; }
}
HD void wload_q(const P& p, size_t wb, int b, int g, int c, int hi, bf16x8 (&qf)[4]) {
    const bf16_t* qp = wsb(p, wb) + (size_t)(NP + b * DEC_SEQ + (c >> 2)) * 512 + (g * 4 + (c & 3)) * 64 + hi * 8;
#pragma unroll
    for (int ks = 0; ks < 4; ++ks) qf[ks] = *(const bf16x8*)(qp + ks * 16);
}
static_assert(NCPADS / 64 <= SP_NCMP && SP_NCMP == 8, "one compressed tile per wave");
HD void snsa_cmp_unit(const P& p, int L, ldsp_t lds, int b, int g) {
    const int tid = opaque_tid(), lane = tid & 63, w = RFL(tid >> 6), c = lane & 31, hi = lane >> 5, s = BATCH + b; const size_t sg = (size_t)s * 2 + g;
    const ldsp_t lw = lds + w * GL_WAVE; LDSQ float* mstat = (LDSQ float*)(lds + LDS_WX);
    LDSQ float* impw = (LDSQ float*)lds;
    bf16x8 qf[4], pf[4]; AttnSt st; attn_init(st); f32x16 ima, imb;
    for (int r = 0; r < 16; ++r) { ima[r] = 0.f; imb[r] = 0.f; }
    const bool live = w < NCPADS / 64;
    if (live) {
        wload_q(p, WB_QNB, b, g, c, hi, qf);
        const int nlim = (PAST_LEN + (c >> 2) - 31) >> 4;
        wstage_bf16(lw, wsb(p, WB_KCB) + sg * NCPAD * 64 + (size_t)w * 4096, wsb(p, WB_VCT) + sg * (NCPAD / 64) * 4096 + (size_t)w * 4096, lane); WAVE_SYNC();
        wattn_tile<true>(lw, qf, nlim - 64 * w - 4 * hi, -100000, true, st, pf, c, hi);
        wimp_tile(pf, ima, w, w >> 1, c, hi);
        if ((w & 1) && (w >> 1) + 1 < 4) wimp_tile(pf, imb, w, (w >> 1) + 1, c, hi);
    }
    wpart_store(p, b, g, w, st, c, hi);
    { const float lt = st.l + __shfl_xor(st.l, 32); if (hi == 0) { mstat[(w * 32 + c) * 2] = st.m; mstat[(w * 32 + c) * 2 + 1] = lt; } }
    __syncthreads();
    float f;
    { float M = NEG_BIG;
#pragma unroll
      for (int k = 0; k < 8; ++k) M = fmaxf(M, mstat[(k * 32 + c) * 2]);
      float Lt = 0.f;
#pragma unroll
      for (int k = 0; k < 8; ++k) Lt += mstat[(k * 32 + c) * 2 + 1] * EXP2F(mstat[(k * 32 + c) * 2] - M);
      f = Lt > 0.f ? EXP2F(st.m - M) * RCPF(Lt) : 0.f; }
    for (int i = tid; i < 1024; i += NTHREADS) impw[i] = 0.f;
    __syncthreads();
    if (live) {
#define SNSA_IMP_ADD(IM, JT) { _Pragma("unroll") for (int r = 0; r < 16; ++r) { const int j = (r & 3) + 8 * (r >> 2) + 4 * hi; float v0 = IM[r] * f; \
        v0 += __shfl_xor(v0, 1); v0 += __shfl_xor(v0, 2); if ((c & 3) == 0) LDS_ADDF(&impw[(c >> 2) * 128 + (JT) * 32 + j], v0); } }
        SNSA_IMP_ADD(ima, w >> 1)
        if ((w & 1) && (w >> 1) + 1 < 4) SNSA_IMP_ADD(imb, (w >> 1) + 1)
#undef SNSA_IMP_ADD
    }
    __syncthreads();
    if (w != 0) return;
    unsigned long long u0 = 0ull, u1 = 0ull; unsigned qa = 0u, qb = 0u;
#pragma unroll 1
    for (int q = 0; q < 8; ++q) {
        const int ja = lane, jb = 64 + lane;
        const float sa = (ja < NJ) ? ((ja == 0 || ja == NJ - 1) ? INFINITY : impw[q * 128 + ja]) : -INFINITY, sb = (jb < NJ) ? ((jb == NJ - 1) ? INFINITY : impw[q * 128 + jb]) : -INFINITY;
        int ra = 0, rb = 0;
#pragma unroll 8
        for (int i = 0; i < 64; ++i) { const float a = rlane(sa, i), bq = rlane(sb, i);
            ra += ((a > sa || (a == sa && i < lane)) ? 1 : 0) + ((bq > sa) ? 1 : 0);
            rb += ((a > sb || a == sb) ? 1 : 0) + ((bq > sb || (bq == sb && i < lane)) ? 1 : 0); }
        const bool sela = ra < 15 && ja < NJ, selb = rb < 15 && jb < NJ;
        u0 |= __ballot(sela); u1 |= __ballot(selb); qa |= sela ? (1u << q) : 0u; qb |= selb ? (1u << q) : 0u;
    }
    int* sl = slist(p, b, g);
    const unsigned long long below = (lane == 0) ? 0ull : (~0ull >> (64 - lane));
    const int n0 = __builtin_popcountll(u0), n1 = __builtin_popcountll(u1);
    if ((u0 >> lane) & 1ull) { const int idx = __builtin_popcountll(u0 & below); sl[idx] = lane; sl[SL_MAX + idx] = (int)qa; }
    if ((u1 >> lane) & 1ull) { const int idx = n0 + __builtin_popcountll(u1 & below); sl[idx] = 64 + lane; sl[SL_MAX + idx] = (int)qb; }
    for (int idx = n0 + n1 + lane; idx < SL_MAX; idx += 64) { sl[idx] = (idx == n0 + n1) ? NJ : -1; sl[SL_MAX + idx] = 0xFF; }
}
HD void snsa_win_item(const P& p, int L, ldsp_t lw, int b, int g, int wi, int lane_) {
    const int lane = opaque_i(lane_), c = lane & 31, hi = lane >> 5, t = c >> 2;
    bf16x8 qf[4], pf[4]; AttnSt st; attn_init(st);
    wload_q(p, WB_QRB, b, g, c, hi, qf);
    constexpr int NCT = (WKEEP_S + DEC_SEQ + 63) / 64;
    for (int k = 0; k < 3; ++k) { const int wt = wi * 3 + k; if (wt >= NCT) break;
        const int ci0 = 64 * wt; const float* kbase; int nvalid;
        if (ci0 < WKEEP_S) { kbase = p.state_win + (((size_t)L * DEC_BATCH + b) * WKEEP_S + ci0) * 256 + g * 64; nvalid = 64; }
        else { kbase = p.ws + W_WINNEW + ((size_t)NP + b * DEC_SEQ + (ci0 - WKEEP_S)) * 256 + g * 64; nvalid = WKEEP_S + DEC_SEQ - ci0; }
        WAVE_SYNC(); wstage_f32(lw, kbase, kbase + 128, 256, nvalid, lane); WAVE_SYNC();
        if (ci0 + 63 <= WKEEP_S && ci0 > WKEEP_S + DEC_SEQ - 1 - WIN) wattn_tile<false>(lw, qf, 0, 0, true, st, pf, c, hi);
        else wattn_tile<true>(lw, qf, WKEEP_S + t - ci0 - 4 * hi, WKEEP_S + t - WIN - ci0 - 4 * hi, true, st, pf, c, hi); }
    wpart_store(p, b, g, SP_WIN0 + wi, st, c, hi);
}
HD void snsa_slc_item(const P& p, int L, ldsp_t lw, int b, int g, int si, int lane_) {
    const int lane = opaque_i(lane_), c = lane & 31, hi = lane >> 5, t = c >> 2, s = BATCH + b;
    bf16x8 qf[4], pf[4]; AttnSt st; attn_init(st);
    wload_q(p, WB_QRB, b, g, c, hi, qf);
    const int* sl = slist(p, b, g);
    for (int k = 0; k < 4; ++k) { const int e = si * 4 + k, blk = sl[e]; if (blk < 0) break;
        const unsigned qm = (unsigned)sl[SL_MAX + e];
        const float* kbase = hist(p, L, s, 64 * blk, 2, g); const int nvalid = blk < NJ ? 64 : DEC_SEQ;
        WAVE_SYNC(); wstage_f32(lw, kbase, kbase + 128, 512, nvalid, lane); WAVE_SYNC();
        const bool sel = ((qm >> t) & 1u) != 0u;
        if (blk < NJ) wattn_tile<false>(lw, qf, 0, 0, sel, st, pf, c, hi); else wattn_tile<true>(lw, qf, sel ? PAST_LEN + t - 64 * blk - 4 * hi : -100000, -100000, true, st, pf, c, hi); }
    wpart_store(p, b, g, SP_SLC0 + si, st, c, hi);
}
HD void bphase_snsa_a(const P& p, int L, ldsp_t lds) {
    const int w = RFL(opaque_tid() >> 6); const ldsp_t lw = lds + w * GL_WAVE; const int rb = (int)gridDim.x - 1 - (int)blockIdx.x;
    for (int u = rb; u < DEC_BATCH * 2; u += gridDim.x) { snsa_cmp_unit(p, L, lds, u >> 1, u & 1); __syncthreads(); }
#define lane (opaque_tid() & 63)
    for (int u = blockIdx.x * 8 + w; u < DEC_BATCH * 2 * SP_NWIN; u += gridDim.x * 8) { const int bg = u / SP_NWIN, k = u % SP_NWIN; snsa_win_item(p, L, lw, bg >> 1, bg & 1, k, lane); }
#undef lane
}
HD void bphase_snsa_b(const P& p, int L, ldsp_t lds) {
    const int w = RFL(opaque_tid() >> 6); const ldsp_t lw = lds + w * GL_WAVE;
#define lane (opaque_tid() & 63)
    for (int u = blockIdx.x * 8 + w; u < DEC_BATCH * 2 * SP_NSLC; u += gridDim.x * 8) { const int bg = u / SP_NSLC, k = u % SP_NSLC; snsa_slc_item(p, L, lw, bg >> 1, bg & 1, k, lane); }
#undef lane
}
HD void k_snsa_combine(const P& p, int L, long it) {
    const int d = (int)(it % 64), head = (int)((it / 64) % 8), rs = (int)(it / 512), b = rs / DEC_SEQ, t = rs % DEC_SEQ, g = head >> 2, col = t * 4 + (head & 3), r = NP + rs;
    const URow u = urow(p, r); float o = 0.f;
    for (int br = 0; br < 3; ++br) { const int i0 = br == 0 ? 0 : br == 1 ? SP_SLC0 : SP_WIN0, n = br == 0 ? SP_NCMP : br == 1 ? SP_NSLC : SP_NWIN;
        float M = NEG_BIG; for (int i = 0; i < n; ++i) M = fmaxf(M, spart(p, b, g, i0 + i)[col * SP_STRIDE]);
        float Ls = 0.f, Os = 0.f;
        for (int i = 0; i < n; ++i) { const float* q = spart(p, b, g, i0 + i) + col * SP_STRIDE; const float wgt = EXP2F(q[0] - M); Ls += q[1] * wgt; Os += q[4 + d] * wgt; }
        if (Ls > 0.f) o += sigmoidf_(u[C_NG + br * 8 + head]) * Os * RCPF(Ls); }
    mixb(p)[(size_t)r * D + 256 + head * 64 + d] = f2bf(o * siluf(u[C_NZ + head * 64 + d]));
}

HD float sum8(float v) { v += __shfl_xor(v, 1); v += __shfl_xor(v, 2); v += __shfl_xor(v, 7); return v; }
HD float wave_sum(float v) { v = sum8(v); v += __shfl_xor(v, 15); return (rlane(v, 0) + rlane(v, 16)) + (rlane(v, 32) + rlane(v, 48)); }
HD void cvt8(const bf16x8& x, float (&f)[8]) {
#pragma unroll
    for (int j = 0; j < 8; ++j) f[j] = bf2f((bf16_t)x[j]); }
HD bf16x8 pack8(const float (&f)[8]) { bf16x8 o;
#pragma unroll
    for (int j = 0; j < 8; ++j) o[j] = (short)f2bf(f[j]);
    return o; }
HD void st8f(float* dst, const float (&f)[8]) { f32x4 a = {f[0], f[1], f[2], f[3]}, b = {f[4], f[5], f[6], f[7]}; *(f32x4*)dst = a; *(f32x4*)(dst + 4) = b; }
HD void bphase_xin(const P& p, int L, ldsp_t lds) {
    const int w = RFL(opaque_tid() >> 6), lane = opaque_tid() & 63; const int stride = (int)gridDim.x * 8;
#pragma unroll 1
    for (int r0 = blockIdx.x * 8 + w; r0 < NT; r0 += 4 * stride) {
        f32x4 v[4][4];
#pragma unroll
        for (int q = 0; q < 4; ++q) { const int r = r0 + q * stride; const float* x = xrow(p, L, r < NT ? r : r0);
#pragma unroll
            for (int k = 0; k < 4; ++k) v[q][k] = *(const f32x4*)(x + k * 256 + lane * 4); }
#pragma unroll
        for (int q = 0; q < 4; ++q) { const int r = r0 + q * stride; float ss = 0.f;
#pragma unroll
            for (int k = 0; k < 4; ++k) ss += v[q][k][0] * v[q][k][0] + v[q][k][1] * v[q][k][1] + v[q][k][2] * v[q][k][2] + v[q][k][3] * v[q][k][3];
            ss = wave_sum(ss);
            if (r < NT) { if (lane == 0) p.ws[W_RSTD + r] = RSQRTF(ss * (1.0f / D) + 1e-6f);
                bf16_t* o = xbp(p) + (size_t)r * D;
#pragma unroll
                for (int k = 0; k < 4; ++k) { bf16x4 b; for (int e = 0; e < 4; ++e) b[e] = (short)f2bf(v[q][k][e]); *(bf16x4*)(o + k * 256 + lane * 4) = b; } } }
    }
}
HD void bphase_cmp_bias(const P& p, int L, ldsp_t lds) {
    const int w = RFL(opaque_tid() >> 6), lane = opaque_tid() & 63;
    for (int o = blockIdx.x * 8 + w; o < DEPTH * 128; o += gridDim.x * 8) { const int e = o % 64, lk = o / 64; float s = 0.f;
#pragma unroll
        for (int i = 0; i < 32; ++i) { const int q = lane + 64 * i; s += p.cmp_pos[(size_t)lk * 2048 + q] * p.cmp_w[((size_t)lk * 2048 + q) * 64 + e]; }
        s = wave_sum(s);
        if (lane == 0) p.ws[W_CBIAS + o] = s; }
}
HD void bphase_mix(const P& p, int L, ldsp_t lds) {
    const int w = RFL(opaque_tid() >> 6), lane = opaque_tid() & 63;
#pragma unroll 1
    for (int un = blockIdx.x * 8 + w; un < NS * 8; un += gridDim.x * 8) { const int kind = un >= NS * 4 ? 1 : 0, it = un - kind * NS * 4, h = it % 4, r = NP + it / 4; const URow u = urow(p, r);
        if (kind == 0) { const float o = p.ws[W_OA + (size_t)r * 256 + h * 64 + lane]; const float z = u[C_GZ + h * 64 + lane], gn = p.gla_norm_g[L * 64 + lane];
            const float rs = RSQRTF(wave_sum(o * o) * (1.0f / 64) + 1e-6f);
            mixb(p)[(size_t)r * D + h * 64 + lane] = f2bf(o * rs * gn * siluf(z)); }
        else { const float dinv = 1.0f / fmaxf(fabsf(p.ws[W_DEN + (size_t)NP * 4 + it]), EXPF(-p.ws[W_MT + (size_t)NP * 4 + it]));
            const float o = p.ws[W_H + (size_t)r * 256 + h * 64 + lane] * dinv; const float og = u[C_MO + h * 64 + lane], z = u[C_MZ + h * 64 + lane], gn = p.ml_norm_g[L * 64 + lane];
            const float rs = RSQRTF(wave_sum(o * o) * (1.0f / 64) + 1e-6f);
            mixb(p)[(size_t)r * D + 768 + h * 64 + lane] = f2bf(o * rs * gn * sigmoidf_(og) * siluf(z)); }
    }
}
HD void bphase_prep_win(const P& p, int L, ldsp_t lds) {
    constexpr long NI = (long)DEPTH * D_INP * (D / 8);
    const int tid = opaque_tid(); const long stride = (long)gridDim.x * NTHREADS;
#pragma unroll 1
    for (long i0 = (long)blockIdx.x * NTHREADS + tid; i0 < NI; i0 += 4 * stride) {
        float v[4][8];
#pragma unroll
        for (int k = 0; k < 4; ++k) { const long it = i0 + k * stride; const int n = (int)(it % D_INP), kc = (int)((it / D_INP) % (D / 8)), L2 = (int)(it / ((long)D_INP * (D / 8)));
            if (it < NI && n < D_IN) { const float* wp = p.w_in + ((size_t)L2 * D + kc * 8) * D_IN + orig_col(n);
#pragma unroll
                for (int j = 0; j < 8; ++j) v[k][j] = wp[(size_t)j * D_IN]; }
            else {
#pragma unroll
                for (int j = 0; j < 8; ++j) v[k][j] = 0.f; } }
#pragma unroll
        for (int k = 0; k < 4; ++k) { const long it = i0 + k * stride; const int n = (int)(it % D_INP), kc = (int)((it / D_INP) % (D / 8)), L2 = (int)(it / ((long)D_INP * (D / 8)));
            if (it < NI) { float gn[8]; ld8f(p.norm_g + L2 * D + kc * 8, gn);
#pragma unroll
                for (int j = 0; j < 8; ++j) v[k][j] *= gn[j];
                *(bf16x8*)(wintp(p, L2) + (size_t)n * D + kc * 8) = pack8(v[k]); } }
    }
}
HD void bphase_prep_wout(const P& p, int L, ldsp_t lds) {
    constexpr long NI = (long)DEPTH * D * (D / 8);
    const int tid = opaque_tid(); const long stride = (long)gridDim.x * NTHREADS;
#pragma unroll 1
    for (long i0 = (long)blockIdx.x * NTHREADS + tid; i0 < NI; i0 += 2 * stride) {
        float v[2][8];
#pragma unroll
        for (int k = 0; k < 2; ++k) { const long it = i0 + k * stride; const int n = (int)(it % D), kc = (int)((it / D) % (D / 8)), L2 = (int)(it / ((long)D * (D / 8)));
            if (it < NI) { const float* wp = p.w_out + ((size_t)L2 * D + kc * 8) * D + n;
#pragma unroll
                for (int j = 0; j < 8; ++j) v[k][j] = wp[(size_t)j * D]; } }
#pragma unroll
        for (int k = 0; k < 2; ++k) { const long it = i0 + k * stride; const int n = (int)(it % D), kc = (int)((it / D) % (D / 8)), L2 = (int)(it / ((long)D * (D / 8)));
            if (it < NI) *(bf16x8*)(wouttp(p, L2) + (size_t)n * D + kc * 8) = pack8(v[k]); }
    }
}
HD void bphase_win_copy(const P& p, int L, ldsp_t lds) {
    constexpr int NOLD = WKEEP_S - DEC_SEQ > 0 ? WKEEP_S - DEC_SEQ : 0; constexpr long NV = (long)DEC_BATCH * NOLD * 64;
    static_assert(O_SWIN % 4 == 0, "16-byte aligned window output");
    const int tid = opaque_tid(); const long stride = (long)gridDim.x * NTHREADS;
#pragma unroll 1
    for (long i0 = (long)blockIdx.x * NTHREADS + tid; i0 < NV; i0 += 4 * stride) {
        f32x4 a[4];
#pragma unroll
        for (int k = 0; k < 4; ++k) { const long i = i0 + k * stride; if (i < NV) { const int e4 = (int)(i % 64); const long q = i / 64; const int r = (int)(q % NOLD), b = (int)(q / NOLD);
            a[k] = *(const f32x4*)(p.state_win + (((size_t)L * DEC_BATCH + b) * WKEEP_S + r + DEC_SEQ) * 256 + 4 * e4); } }
#pragma unroll
        for (int k = 0; k < 4; ++k) { const long i = i0 + k * stride; if (i < NV) { const int e4 = (int)(i % 64); const long q = i / 64; const int r = (int)(q % NOLD), b = (int)(q / NOLD);
            *(f32x4*)(p.out + O_SWIN + (((size_t)L * DEC_BATCH + b) * WKEEP_S + r) * 256 + 4 * e4) = a[k]; } }
    }
}
template <int IN> HD void bphase_sgemm_t(const P& p, int L, ldsp_t lds) {
    static_assert(NP % 256 == 0, "prompt rows fill whole 256-row GEMM panels");
    constexpr int NTILE = IN ? 4 : 1, N = IN ? D_INP : D, NRT = (NS + 31) / 32, NCG = N / (32 * NTILE), NU = NRT * NCG;
    const int tid = opaque_tid(), w = RFL(tid >> 6), lane = tid & 63;
    const bf16_t* A = IN ? xbp(p) : mixb(p); const bf16_t* Bt = IN ? wintp(p, L) : wouttp(p, L);
    LDSQ float* red = (LDSQ float*)lds;
#pragma unroll 1
    for (int un = blockIdx.x; un < NU; un += gridDim.x) {
        const int rt = un % NRT, cg = un / NRT, row0 = NP + 32 * rt, col0 = cg * 32 * NTILE;
        f32x16 acc[NTILE];
#pragma unroll
        for (int j = 0; j < NTILE; ++j)
#pragma unroll
            for (int e = 0; e < 16; ++e) acc[j][e] = 0.f;
        const bf16_t* ap = A + (size_t)(row0 + (lane & 31)) * D + 128 * w + 8 * (lane >> 5);
        const bf16_t* bp = Bt + (size_t)(col0 + (lane & 31)) * D + 128 * w + 8 * (lane >> 5);
#pragma unroll
        for (int hh = 0; hh < 2; ++hh) {
            bf16x8 af[4], bfr[NTILE][4];
#pragma unroll
            for (int s = 0; s < 4; ++s) af[s] = *(const bf16x8*)(ap + 16 * (4 * hh + s));
#pragma unroll
            for (int j = 0; j < NTILE; ++j)
#pragma unroll
                for (int s = 0; s < 4; ++s) bfr[j][s] = *(const bf16x8*)(bp + (size_t)j * 32 * D + 16 * (4 * hh + s));
#pragma unroll
            for (int s = 0; s < 4; ++s)
#pragma unroll
                for (int j = 0; j < NTILE; ++j) acc[j] = __builtin_amdgcn_mfma_f32_32x32x16_bf16(af[s], bfr[j][s], acc[j], 0, 0, 0);
            SCHED_FENCE();
        }
#pragma unroll
        for (int j = 0; j < NTILE; ++j)
#pragma unroll
            for (int e = 0; e < 16; ++e) red[((w * NTILE + j) * 16 + e) * 64 + lane] = acc[j][e];
        __syncthreads();
        float rsr[2] = {0.f, 0.f};
        if (IN) {
#pragma unroll
            for (int k = 0; k < 2; ++k) { const int reg = w + 8 * k, row = row0 + (reg & 3) + 8 * (reg >> 2) + 4 * (lane >> 5);
                if (L == 0) rsr[k] = row < NT ? p.ws[W_RSTD + row] : 0.f;
                else { const f32x4* q = (const f32x4*)(p.ws + W_XN + (size_t)row * 32); f32x4 a = q[0];
#pragma unroll
                    for (int e = 1; e < 8; ++e) a += q[e];
                    rsr[k] = RSQRTF(((a[0] + a[1]) + (a[2] + a[3])) * (1.0f / D) + 1e-6f); } } }
#pragma unroll
        for (int i = 0; i < NTILE * 2; ++i) { const int idx = tid + 512 * i, ln = idx & 63, reg = (idx >> 6) & 15, j = idx >> 10; float sm = 0.f;
#pragma unroll
            for (int w2 = 0; w2 < 8; ++w2) sm += red[((w2 * NTILE + j) * 16 + reg) * 64 + ln];
            const int row = row0 + (reg & 3) + 8 * (reg >> 2) + 4 * (ln >> 5), col = col0 + 32 * j + (ln & 31);
            if (IN) { if (row < NT) ubase(p)[(size_t)row * U_LD + col] = f2bf(sm * rsr[i & 1]); }
            else { const float y = row < NT ? xrow(p, L, row)[col] + sm : 0.f;
                if (row < NT) (L == DEPTH - 1 ? p.out + O_Y : p.ws + W_Y0)[(size_t)row * D + col] = y;
                if (L + 1 < DEPTH) {
                    if (row < NT) xbp(p)[(size_t)row * D + col] = f2bf(y);
                    float ss = y * y; ss += __shfl_xor(ss, 1); ss += __shfl_xor(ss, 2); ss += __shfl_xor(ss, 4); ss += __shfl_xor(ss, 8); ss += __shfl_xor(ss, 16);
                    if ((ln & 31) == 0 && row < NTP) p.ws[W_XN + (size_t)row * 32 + cg] = ss; } } }
        __syncthreads();
    }
}
HD void bphase_sgemm_in(const P& p, int L, ldsp_t lds) { bphase_sgemm_t<1>(p, L, lds); }
HD void bphase_sgemm_out(const P& p, int L, ldsp_t lds) { bphase_sgemm_t<0>(p, L, lds); }
HD void rope8(float (&x)[8], int l7, const float (&rc)[8], const float (&rsn)[8]) {
#pragma unroll
    for (int j = 0; j < 8; ++j) { const float pt = __shfl_xor(x[j], 1); x[j] = l7 == 0 ? x[j] * rc[j] - pt * rsn[j] : (l7 == 1 ? x[j] * rc[j] + pt * rsn[j] : x[j]); }
}
HD void bphase_rows(const P& p, int L, ldsp_t lds) {
    const int w = RFL(opaque_tid() >> 6), lane = opaque_tid() & 63, l7 = lane & 7;
    constexpr int NGP = NP / 8, NUN = NGP + NS;
#pragma unroll 1
    for (int un = blockIdx.x * 8 + w; un < NUN; un += gridDim.x * 8) {
        const int r0 = un < NGP ? un * 8 : NP + (un - NGP), ntk = un < NGP ? 8 : 1, s = seq_of_row(r0), t0 = r0 - seq_row0(s);
        float pw[3][8];
#pragma unroll
        for (int i = 0; i < 3; ++i) { const int tp = t0 + i;
            if (tp < 3) {
#pragma unroll
                for (int j = 0; j < 8; ++j) pw[i][j] = s < BATCH ? 0.f : p.state_conv[(((size_t)L * DEC_BATCH + (s - BATCH)) * 3 + tp) * 512 + 8 * lane + j]; }
            else cvt8(*(const bf16x8*)(ubase(p) + (size_t)(r0 + i - 3) * U_LD + C_MQK + 8 * lane), pw[i]); }
        const ldsp_t vtl = lds + w * GL_WAVE + lane * 16;
        bf16x8 R1, R2, R3, R5, R7;
        { const bf16_t* ur = ubase(p) + (size_t)r0 * U_LD + 8 * lane;
          R1 = *(const bf16x8*)(ur + 512); R2 = *(const bf16x8*)(ur + 1024); R3 = *(const bf16x8*)(ur + 1536); R5 = *(const bf16x8*)(ur + 2560); R7 = *(const bf16x8*)(ur + 3584); }
#pragma unroll 1
        for (int ti = 0; ti < ntk; ++ti) { {
            const int r = r0 + ti, pos = row_pos(r);
            bf16x8 N1, N2, N3, N5, N7;
            { const bf16_t* ur = ubase(p) + (size_t)(ti + 1 < ntk ? r + 1 : r) * U_LD + 8 * lane;
              N1 = *(const bf16x8*)(ur + 512); N2 = *(const bf16x8*)(ur + 1024); N3 = *(const bf16x8*)(ur + 1536); N5 = *(const bf16x8*)(ur + 2560); N7 = *(const bf16x8*)(ur + 3584); }
            float rc[8], rsn[8];
            { const float ang = (float)pos * rope_inv(l7); float c, sn; SINCOSF(ang, sn, c);
#pragma unroll
              for (int j = 0; j < 8; ++j) { rc[j] = rlane(c, j); rsn[j] = rlane(sn, j); } }
            { float v[8]; cvt8(lane >= 32 ? R1 : R2, v); float ss = 0.f;
#pragma unroll
              for (int j = 0; j < 8; ++j) ss += v[j] * v[j];
              const float rs = RSQRTF(sum8(ss) * (1.0f / 64) + 1e-6f);
#pragma unroll
              for (int j = 0; j < 8; ++j) v[j] *= rs * p.q_norm_g[L * 64 + 8 * l7 + j] * C2LOG;
              const int head = lane >= 32 ? (lane - 32) >> 3 : 4 + (lane >> 3); const size_t qo = (size_t)r * 512 + head * 64 + 8 * l7;
              *(bf16x8*)(wsb(p, WB_QNB) + qo) = pack8(v); rope8(v, l7, rc, rsn); *(bf16x8*)(wsb(p, WB_QRB) + qo) = pack8(v); }
            float* nr = new_rows_ptr(p, L, r);
            if (lane >= 32) { float v[8]; cvt8(R2, v); st8f(nr + ((lane - 32) >> 4) * 128 + (((lane - 32) >> 3) & 1) * 64 + 8 * l7, v); }
            { const int role = lane >> 4, g = (lane >> 3) & 1; float v[8]; cvt8(R3, v); float ss = 0.f;
#pragma unroll
              for (int j = 0; j < 8; ++j) ss += v[j] * v[j];
              const float rs = RSQRTF(sum8(ss) * (1.0f / 64) + 1e-6f);
              float kn[8];
#pragma unroll
              for (int j = 0; j < 8; ++j) kn[j] = v[j] * rs * p.k_norm_g[(L * 3 + (role == 0 ? 1 : 2)) * 64 + 8 * l7 + j];
              rope8(kn, l7, rc, rsn);
              if ((role & 1) == 0) {
#pragma unroll
                  for (int j = 0; j < 8; ++j) v[j] = kn[j]; }
              const bf16x8 vb = pack8(v);
              if (r < NP && (role & 1)) {
#pragma unroll
                  for (int j = 0; j < 8; ++j) *(LDSQ bf16_t*)(vtl + j * 1024 + ti * 2) = (bf16_t)vb[j]; }
              if (role < 2) st8f(nr + (2 + role) * 128 + g * 64 + 8 * l7, v);
              else { st8f(p.ws + W_WINNEW + (size_t)r * 256 + (role - 2) * 128 + g * 64 + 8 * l7, v);
                  float* wo = nullptr; const int t = t0 + ti;
                  if (r < NP) { if (t >= SEQ - WKEEP_P) wo = p.out + O_PWIN + (((size_t)L * BATCH + s) * WKEEP_P + (t - (SEQ - WKEEP_P))) * 256; }
                  else { const int i = WKEEP_S - DEC_SEQ + t; if (i >= 0) wo = p.out + O_SWIN + (((size_t)L * DEC_BATCH + (s - BATCH)) * WKEEP_S + i) * 256; }
                  if (wo) st8f(wo + (role - 2) * 128 + g * 64 + 8 * l7, v); }
              if (r < NP && (role & 1) == 0) *(bf16x8*)(wsb(p, role == 0 ? WB_KSB : WB_KWB) + (((size_t)s * 2 + g) * SEQ + (t0 + ti)) * 64 + 8 * l7) = vb; }
            { float f7[8]; cvt8(R7, f7); float a0 = p.gla_b_gate[L * 128 + lane], a1 = p.gla_b_gate[L * 128 + 64 + lane];
#pragma unroll
              for (int q = 0; q < 16; ++q) { const float x = rlane(f7[q & 7], 32 + (q >> 3)); a0 += x * p.gla_w_gate[(L * 16 + q) * 128 + lane]; a1 += x * p.gla_w_gate[(L * 16 + q) * 128 + 64 + lane]; }
              p.ws[W_LOGA + (size_t)r * 128 + lane] = log_sigmoidf(a0) * (1.0f / 16.0f); p.ws[W_LOGA + (size_t)r * 128 + 64 + lane] = log_sigmoidf(a1) * (1.0f / 16.0f); }
            { float x0[8], o[8]; cvt8(R5, x0);
#pragma unroll
              for (int j = 0; j < 8; ++j) { const int ch = 8 * lane + j; const float* cwp = p.conv_w + (size_t)L * 2048 + ch; const float a = p.conv_b[L * 512 + ch] + pw[0][j] * cwp[0] + pw[1][j] * cwp[512] + pw[2][j] * cwp[1024] + x0[j] * cwp[1536]; o[j] = siluf(a) * (lane < 32 ? 1.0f : 0.125f);
                  pw[0][j] = pw[1][j]; pw[1][j] = pw[2][j]; pw[2][j] = x0[j]; }
              st8f(lane < 32 ? p.ws + W_MQ + (size_t)r * 256 + 8 * lane : p.ws + W_MK + (size_t)r * 256 + 8 * (lane - 32), o); }
            R1 = N1; R2 = N2; R3 = N3; R5 = N5; R7 = N7;
            } SCHED_FENCE();
        }
        if (r0 < NP && ((lane >> 4) & 1)) { const int role = lane >> 4, g = (lane >> 3) & 1;
            bf16_t* vt = wsb(p, role == 1 ? WB_VST : WB_VWT) + (((size_t)s * 2 + g) * NQT + t0 / 64) * 4096 + (size_t)(8 * l7) * 64 + (t0 % 64);
#pragma unroll
            for (int j = 0; j < 8; ++j) *(bf16x8*)(vt + (size_t)j * 64) = *(const LDSQ bf16x8*)(vtl + j * 1024); }
    }
}

typedef void (*ItemFn)(const P&, int, long);
typedef void (*BlockFn)(const P&, int, ldsp_t);
static P make_params(void* const* d_in, void* d_out, void* d_ws) {
    P p;
    p.x_prompt = (const float*)d_in[0]; p.x_sample = (const float*)d_in[1]; p.cache = (const float*)d_in[2]; p.state_win = (const float*)d_in[3];
    p.state_gla = (const float*)d_in[4]; p.state_C = (const float*)d_in[5]; p.state_n = (const float*)d_in[6]; p.state_m = (const float*)d_in[7];
    p.state_conv = (const float*)d_in[8]; p.page_table = (const int*)d_in[9]; p.norm_g = (const float*)d_in[10]; p.w_in = (const float*)d_in[11];
    p.w_out = (const float*)d_in[12]; p.gla_w_gate = (const float*)d_in[13]; p.gla_b_gate = (const float*)d_in[14]; p.gla_norm_g = (const float*)d_in[15];
    p.q_norm_g = (const float*)d_in[16]; p.k_norm_g = (const float*)d_in[17]; p.cmp_pos = (const float*)d_in[18]; p.cmp_w = (const float*)d_in[19];
    p.conv_w = (const float*)d_in[20]; p.conv_b = (const float*)d_in[21]; p.gate_b = (const float*)d_in[22]; p.ml_norm_g = (const float*)d_in[23];
    p.out = (float*)d_out; p.ws = (float*)d_ws;
    return p;
}
#define LAYER_PROGRAM(LL) { const int L = LL; \
        if (XIN_NEEDED(L)) { BLK(bphase_xin); GRID_BAR(); } \
        GEMM_IN(); \
        BLK(bphase_sgemm_in); \
        GRID_BAR(); \
        BLK(bphase_rows); \
        BLK(bphase_win_copy); \
        PH(k_conv_out, (long)NSEQ * 3 * 512); \
        GRID_BAR(); \
        BLK(bphase_rec_g1); \
        BLK(bphase_cmp_sum_s); \
        GRID_BAR(); \
        PH_MID(k_gla, (long)DEC_BATCH * 256, 5); \
        PH_MID(k_mlstm, (long)DEC_BATCH * 260, 4); \
        PH_MID(k_gla_scan, (long)BATCH * 8192, 1); \
        PH_MID(k_ml_scan, (long)BATCH * 16640, 0); \
        BLK(bphase_snsa_a); \
        BLK(bphase_cmp_sum_p); \
        GRID_BAR(); \
        BLK(bphase_nsa_prompt); \
        BLK(bphase_rec_g2); \
        BLK(bphase_snsa_b); \
        BLK(bphase_mix); \
        GRID_BAR(); \
        PH(k_snsa_combine, (long)NS * 512); \
        GRID_BAR(); \
        GEMM_OUT(); \
        BLK(bphase_sgemm_out); \
        GRID_BAR(); \
    }
constexpr int LDS_BYTES = LDS_MISC + 1024 + 2048;
static_assert(NSA_END <= NSA_COMB && NSA_COMB + 8 * 8192 <= LDS_MISC, "NSA unit LDS map");

#ifdef CPU_EMU
template <ItemFn F> static void run_items(const P& p, int L, long n) {
#pragma omp parallel for schedule(dynamic, 256)
    for (long i = 0; i < n; ++i) F(p, L, i);
}
struct EmuArgs { BlockFn f; const P* p; int L; };
static void emu_tramp(void* a) { EmuArgs* e = (EmuArgs*)a; e->f(*e->p, e->L, (ldsp_t)emu_lds); }
static void emu_phase(BlockFn f, const P& p, int L) {
    const int G = 8;
#pragma omp parallel for schedule(dynamic, 1)
    for (int bx = 0; bx < G; ++bx) { EmuArgs a{f, &p, L}; emu_run_block(NTHREADS, bx, G, LDS_BYTES, emu_tramp, &a); }
}
#define PH(F, n) run_items<F>(p, L, (long)(n))
#define PH_MID(F, n, ROT) run_items<F>(p, L, (long)(n))
#define XIN_NEEDED(L) true
#define BLK(F) emu_phase(F, p, L)
#define GRID_BAR() do {} while (0)
#define GEMM_IN() PH(k_gemm_in_emu, (long)NP * D_IN)
#define GEMM_OUT() PH(k_gemm_out_emu, (long)NP * D)
static void forward(const P& p) {
#else

namespace pg8 {
#define PG8_LAS __attribute__((address_space(3)))
typedef unsigned short bf16_t;
typedef short bf16x8 __attribute__((ext_vector_type(8)));
typedef float f32x4 __attribute__((ext_vector_type(4)));
typedef unsigned u32x4 __attribute__((ext_vector_type(4)));
constexpr int BM = 256, BK = 64, HALF = 128, HTB = HALF * BK * 2  , STAGE_BYTES = 8 * HTB, NXCD = 8, WGM = 8;

__host__ __device__ __forceinline__ int lds_byte(int r, int c) { const int st = (r >> 4) * 2 + (c >> 5), rr = r & 15, cc = c & 31, ob = rr * 64 + cc * 2; return st * 1024 + (ob ^ (((ob >> 9) & 1) << 5)); }
__host__ __device__ __forceinline__ void stage_rc(int b, int& R, int& C) { const int st = b / 1024, sb = b % 1024, swz = sb ^ (((sb >> 9) & 1) << 5); R = (st >> 1) * 16 + swz / 64; C = (st & 1) * 32 + (swz % 64) / 2; }
__host__ __device__ __forceinline__ int perm32(int rho) { const int n = rho >> 4, i = rho & 15; return 8 * (i >> 2) + 4 * n + (i & 3); }

struct Unit { int pm, pn; };
struct Gemm { const bf16_t* A; const bf16_t* Bt; int M, N, K; };

struct StaticOrder {
    int nM, nN, nwg, G, c;
    __host__ __device__ void init(int M, int N, int G_, int c_) { nM = M / BM; nN = N / BM; nwg = nM * nN; G = G_; c = c_; }
    __host__ __device__ bool next(int i, Unit& u) const {
        const long L = (long)i * G + c; if (L >= nwg) return false;
        int wgid = (int)L; { const int q = nwg / NXCD, r = nwg % NXCD, xcd = wgid % NXCD, off = wgid / NXCD; wgid = (xcd < r ? xcd * (q + 1) : r * (q + 1) + (xcd - r) * q) + off; }
        const int nig = WGM * nN, gid = wgid / nig, fm = gid * WGM, gsz = (nM - fm) < WGM ? (nM - fm) : WGM;
        u.pm = fm + ((wgid % nig) % gsz); u.pn = (wgid % nig) / gsz; return true;
    }
    __device__ __forceinline__ void a_ready(const Unit&) const {}
    __device__ __forceinline__ void done(const Unit&) const {}
};
__device__ __forceinline__ unsigned cvt_pk_bf16(float lo, float hi) { unsigned r; asm volatile("v_cvt_pk_bf16_f32 %0, %1, %2" : "=v"(r) : "v"(lo), "v"(hi)); return r; }
struct EpiInBf16 {
    static constexpr bool PERM = true, AFTER_DRAIN = false;
    bf16_t* U; const float* rstd; const float* pss;
    __device__ __forceinline__ void operator()(const f32x4 (&acc)[2][2][4][2], const Unit& u, int wr, int wc, int fr, int fq) const {
        const int row0 = u.pm * BM + wr * 64 + fr, col0 = u.pn * BM + wc * 32 + 8 * fq;
#pragma unroll
        for (int ai = 0; ai < 2; ++ai)
#pragma unroll
            for (int m = 0; m < 4; ++m) { const int row = row0 + ai * HALF + m * 16; if (row >= NT) continue; float rs;
                if (pss) { const f32x4* q = (const f32x4*)(pss + (size_t)row * 32); const f32x4 a = (q[0] + q[1]) + (q[2] + q[3]); rs = __builtin_amdgcn_rsqf(((a[0] + a[1]) + (a[2] + a[3])) * (1.0f / D) + 1e-6f); }
                else rs = rstd[row];
                bf16_t* rowp = U + (size_t)row * U_LD + col0;
#pragma unroll
                for (int bj = 0; bj < 2; ++bj) { const f32x4 v0 = acc[ai][bj][m][0] * rs, v1 = acc[ai][bj][m][1] * rs; u32x4 wv;
                    wv.x = cvt_pk_bf16(v0[0], v0[1]); wv.y = cvt_pk_bf16(v0[2], v0[3]); wv.z = cvt_pk_bf16(v1[0], v1[1]); wv.w = cvt_pk_bf16(v1[2], v1[3]);
                    *(u32x4*)(rowp + bj * HALF) = wv; } }
    }
};
struct EpiOutF32 {
    static constexpr bool PERM = true, AFTER_DRAIN = false;
    float* Y; const float* Xa; const float* Xb;
    bf16_t* XB; float* PSS;
    __device__ __forceinline__ void operator()(const f32x4 (&acc)[2][2][4][2], const Unit& u, int wr, int wc, int fr, int fq) const {
        const int row0 = u.pm * BM + wr * 64 + fr, col0 = u.pn * BM + wc * 32 + 8 * fq;
#pragma unroll
        for (int ai = 0; ai < 2; ++ai)
#pragma unroll
            for (int m = 0; m < 4; ++m) { const int row = row0 + ai * HALF + m * 16; if (row >= NT) continue;
                const float* xr = row < NP ? Xa + (size_t)row * D : Xb + (size_t)(row - NP) * D; float* rowp = Y + (size_t)row * D; float ss = 0.f;
#pragma unroll
                for (int bj = 0; bj < 2; ++bj) { const int c = col0 + bj * HALF;
                    const f32x4 y0 = acc[ai][bj][m][0] + *(const f32x4*)(xr + c), y1 = acc[ai][bj][m][1] + *(const f32x4*)(xr + c + 4);
                    *(f32x4*)(rowp + c) = y0; *(f32x4*)(rowp + c + 4) = y1;
                    if (XB) { ss += y0[0] * y0[0] + y0[1] * y0[1] + y0[2] * y0[2] + y0[3] * y0[3] + y1[0] * y1[0] + y1[1] * y1[1] + y1[2] * y1[2] + y1[3] * y1[3]; u32x4 wv;
                        wv.x = cvt_pk_bf16(y0[0], y0[1]); wv.y = cvt_pk_bf16(y0[2], y0[3]); wv.z = cvt_pk_bf16(y1[0], y1[1]); wv.w = cvt_pk_bf16(y1[2], y1[3]);
                        *(u32x4*)(XB + (size_t)row * D + c) = wv; } }
                if (XB) { ss += xl_shfl_xor(ss, 16); ss += xl_shfl_xor(ss, 32); if (fq == 0) PSS[(size_t)row * 32 + u.pn * 4 + wc] = ss; } }
    }
};
template <class Epi, class Sched, bool ALIGN_EPI = false, bool SP2 = false>
__device__ __forceinline__ void gemm_phase(PG8_LAS unsigned char* lds, const Gemm g, const Sched& S, const Epi& E) {
    const int tid = hw_tid(lds), wid = __builtin_amdgcn_readfirstlane(tid >> 6), lane = tid & 63, wr = wid >> 2, wc = wid & 3, fr = lane & 15, fq = lane >> 4;
    const int K = g.K, nt = K / BK;
    unsigned voffA[2], voffB[2];
#pragma unroll
    for (int i = 0; i < 2; ++i) { int R, C; stage_rc(tid * 16 + i * 8192, R, C); const int Rb = Epi::PERM ? ((R & ~31) + perm32(R & 31)) : R;
        voffA[i] = (unsigned)(R * K + C) * 2u; voffB[i] = (unsigned)(Rb * K + C) * 2u; }
    const size_t kstep = (size_t)(BK * 2);
    const size_t hstep = (size_t)HALF * K * 2;
    const size_t tstep = 2 * hstep;
    const unsigned ldsw = (unsigned)wid * 1024u;
    const int aoff = lds_byte(wr * 64 + fr, fq * 8), boff = lds_byte(wc * 32 + fr, fq * 8);
#define PG8_SA(b, h) (((b) * 2 + (h)) * HTB)
#define PG8_SB(b, h) ((4 + (b) * 2 + (h)) * HTB)
#define PG8_STAGE(bufoff, gbase, voff) do { _Pragma("unroll") for (int _i = 0; _i < 2; ++_i) \
        __builtin_amdgcn_global_load_lds((const unsigned*)((const char*)(gbase) + (voff)[_i]), (PG8_LAS unsigned*)(lds + (bufoff) + ldsw + _i * 8192), 16, 0, 0); } while (0)
#define PG8_LDA(dst, b, h) do { _Pragma("unroll") for (int m = 0; m < 4; ++m) _Pragma("unroll") for (int k = 0; k < 2; ++k) dst[m][k] = *(const PG8_LAS bf16x8*)(lds + PG8_SA(b, h) + aoff + m * 2048 + k * 1024); } while (0)
#define PG8_LDB(dst, b, h) do { _Pragma("unroll") for (int n = 0; n < 2; ++n) _Pragma("unroll") for (int k = 0; k < 2; ++k) dst[n][k] = *(const PG8_LAS bf16x8*)(lds + PG8_SB(b, h) + boff + n * 2048 + k * 1024); } while (0)
#define PG8_MMA(ai, bj, At, Bt) do { __builtin_amdgcn_s_setprio(1); _Pragma("unroll") for (int m = 0; m < 4; ++m) _Pragma("unroll") for (int n = 0; n < 2; ++n) _Pragma("unroll") for (int k = 0; k < 2; ++k) \
        acc[ai][bj][m][n] = __builtin_amdgcn_mfma_f32_16x16x32_bf16(Bt[n][k], At[m][k], acc[ai][bj][m][n], 0, 0, 0); __builtin_amdgcn_s_setprio(0); } while (0)
#define PG8_WAIT_V(n) asm volatile("s_waitcnt vmcnt(" #n ")" ::: "memory")
#define PG8_WAIT_L(n) asm volatile("s_waitcnt lgkmcnt(" #n ")" ::: "memory")
#define PG8_BAR __builtin_amdgcn_s_barrier()
#define PG8_SCHED __builtin_amdgcn_sched_barrier(0)
    Unit cur, nxt; int ui = 0;
    if (!S.next(0, cur)) return;
    f32x4 acc[2][2][4][2];
#pragma unroll
    for (int a = 0; a < 2; ++a)
#pragma unroll
        for (int b = 0; b < 2; ++b)
#pragma unroll
            for (int m = 0; m < 4; ++m)
#pragma unroll
                for (int n = 0; n < 2; ++n) acc[a][b][m][n] = (f32x4){0.f, 0.f, 0.f, 0.f};
    bf16x8 At[4][2], B0[2][2], B1[2][2];
    const char* cA = (const char*)g.A + (size_t)cur.pm * tstep; const char* cB = (const char*)g.Bt + (size_t)cur.pn * tstep;
    S.a_ready(cur);
    if constexpr (SP2) {
        PG8_STAGE(PG8_SB(0, 0), cB, voffB); PG8_STAGE(PG8_SB(0, 1), cB + hstep, voffB); PG8_STAGE(PG8_SA(0, 0), cA, voffA); PG8_STAGE(PG8_SA(0, 1), cA + hstep, voffA);
        if (wr == 1) PG8_BAR;
        PG8_WAIT_V(2); PG8_BAR;
        PG8_STAGE(PG8_SB(1, 0), cB + kstep, voffB); PG8_STAGE(PG8_SA(1, 0), cA + kstep, voffA); PG8_STAGE(PG8_SB(1, 1), cB + hstep + kstep, voffB);
        PG8_WAIT_V(6); PG8_BAR;
    } else {
        PG8_STAGE(PG8_SB(0, 0), cB, voffB); PG8_STAGE(PG8_SA(0, 0), cA, voffA); PG8_STAGE(PG8_SB(0, 1), cB + hstep, voffB); PG8_STAGE(PG8_SA(0, 1), cA + hstep, voffA);
        if (wr == 1) PG8_BAR;
        PG8_WAIT_V(4); PG8_BAR;
        PG8_STAGE(PG8_SB(1, 0), cB + kstep, voffB); PG8_STAGE(PG8_SA(1, 0), cA + kstep, voffA); PG8_STAGE(PG8_SB(1, 1), cB + hstep + kstep, voffB);
        PG8_WAIT_V(6); PG8_BAR;
    }
    for (;;) {
        const bool has_next = S.next(ui + 1, nxt);
        const char* nA = has_next ? (const char*)g.A + (size_t)nxt.pm * tstep : cA; const char* nB = has_next ? (const char*)g.Bt + (size_t)nxt.pn * tstep : cB;
        for (int t = 0; t < nt; t += 2) {
            const bool last = (t == nt - 2);
            const char* a1 = cA + (size_t)(t + 1) * kstep;
            const char* a2 = last ? nA : cA + (size_t)(t + 2) * kstep; const char* b2 = last ? nB : cB + (size_t)(t + 2) * kstep;
            const char* a3 = a2 + kstep; const char* b3 = b2 + kstep;
            if (last && has_next) S.a_ready(nxt);
            if constexpr (SP2) {
            PG8_LDB(B0, 0, 0); PG8_LDB(B1, 0, 1); PG8_SCHED; PG8_LDA(At, 0, 0); PG8_STAGE(PG8_SA(1, 1), a1 + hstep, voffA);
            PG8_WAIT_V(8); PG8_WAIT_L(0); PG8_BAR; PG8_MMA(0, 0, At, B0); PG8_MMA(0, 1, At, B1); PG8_BAR; PG8_SCHED;
            PG8_LDA(At, 0, 1); PG8_STAGE(PG8_SB(0, 0), b2, voffB); PG8_STAGE(PG8_SB(0, 1), b2 + hstep, voffB); PG8_STAGE(PG8_SA(0, 0), a2, voffA);
            PG8_WAIT_V(8); PG8_WAIT_L(0); PG8_BAR; PG8_MMA(1, 0, At, B0); PG8_MMA(1, 1, At, B1); PG8_BAR; PG8_SCHED;
            PG8_LDB(B0, 1, 0); PG8_LDB(B1, 1, 1); PG8_SCHED; PG8_LDA(At, 1, 0); PG8_STAGE(PG8_SA(0, 1), a2 + hstep, voffA);
            PG8_WAIT_V(8); PG8_WAIT_L(0); PG8_BAR; PG8_MMA(0, 0, At, B0); PG8_MMA(0, 1, At, B1); PG8_BAR; PG8_SCHED;
            PG8_LDA(At, 1, 1); PG8_STAGE(PG8_SB(1, 0), b3, voffB); PG8_STAGE(PG8_SB(1, 1), b3 + hstep, voffB); PG8_STAGE(PG8_SA(1, 0), a3, voffA);
            PG8_WAIT_V(8); PG8_WAIT_L(0); PG8_BAR; PG8_MMA(1, 0, At, B0); PG8_MMA(1, 1, At, B1); PG8_BAR; PG8_SCHED;
            } else {
            PG8_LDB(B0, 0, 0); PG8_SCHED; PG8_LDA(At, 0, 0); PG8_STAGE(PG8_SA(1, 1), a1 + hstep, voffA);
            PG8_WAIT_L(8); PG8_BAR; PG8_WAIT_L(0); PG8_MMA(0, 0, At, B0); PG8_BAR; PG8_SCHED;
            PG8_LDB(B1, 0, 1); PG8_STAGE(PG8_SB(0, 0), b2, voffB);
            PG8_BAR; PG8_WAIT_L(0); PG8_MMA(0, 1, At, B1); PG8_BAR;
            PG8_LDA(At, 0, 1); PG8_STAGE(PG8_SA(0, 0), a2, voffA);
            PG8_BAR; PG8_WAIT_L(0); PG8_MMA(1, 0, At, B0); PG8_BAR; PG8_SCHED;
            PG8_STAGE(PG8_SB(0, 1), b2 + hstep, voffB);
            PG8_WAIT_V(6); PG8_BAR; PG8_MMA(1, 1, At, B1); PG8_BAR;
            PG8_LDB(B0, 1, 0); PG8_SCHED; PG8_LDA(At, 1, 0); PG8_STAGE(PG8_SA(0, 1), a2 + hstep, voffA);
            PG8_WAIT_L(8); PG8_BAR; PG8_WAIT_L(0); PG8_MMA(0, 0, At, B0); PG8_BAR; PG8_SCHED;
            PG8_LDB(B1, 1, 1); PG8_STAGE(PG8_SB(1, 0), b3, voffB);
            PG8_BAR; PG8_WAIT_L(0); PG8_MMA(0, 1, At, B1); PG8_BAR;
            PG8_LDA(At, 1, 1); PG8_STAGE(PG8_SA(1, 0), a3, voffA);
            PG8_BAR; PG8_WAIT_L(0); PG8_MMA(1, 0, At, B0); PG8_BAR; PG8_SCHED;
            PG8_STAGE(PG8_SB(1, 1), b3 + hstep, voffB);
            PG8_WAIT_V(6); PG8_BAR; PG8_MMA(1, 1, At, B1); PG8_BAR;
            }
        }
        if constexpr (ALIGN_EPI) { if (wr == 0) PG8_BAR; }
        if constexpr (!Epi::AFTER_DRAIN) { E(acc, cur, wr, wc, fr, fq); S.done(cur); }
        if (!has_next) break;
#pragma unroll
        for (int a = 0; a < 2; ++a)
#pragma unroll
            for (int b = 0; b < 2; ++b)
#pragma unroll
                for (int m = 0; m < 4; ++m)
#pragma unroll
                    for (int n = 0; n < 2; ++n) acc[a][b][m][n] = (f32x4){0.f, 0.f, 0.f, 0.f};
        cur = nxt; cA = nA; cB = nB; ++ui;
        if constexpr (ALIGN_EPI) { if (wr == 1) PG8_BAR; }
    }
    PG8_WAIT_V(0);
    if constexpr (!ALIGN_EPI) { if (wr == 0) PG8_BAR; }
    PG8_BAR;
    if constexpr (Epi::AFTER_DRAIN) { E.fused(acc, cur, wr, wc, fr, fq, lds, wid, lane); S.done(cur); }
#undef PG8_SA
#undef PG8_SB
#undef PG8_STAGE
#undef PG8_LDA
#undef PG8_LDB
#undef PG8_MMA
#undef PG8_WAIT_V
#undef PG8_WAIT_L
#undef PG8_BAR
#undef PG8_SCHED
}
}
#define XB_TMO      128
#define XB_XCNT(j)  (256  + 64 * (j))
#define XB_XSUB(j)  (1280 + 64 * (j))
#define XB_XGEN(j)  (2304 + 64 * (j))
#define XB_TOP      3328
#define XB_TOPGEN   3392
#define XCD_BAR_WORDS 3456
#define XB_SPIN_CAP (1u << 22)
#define LAS __attribute__((address_space(3)))
__device__ __forceinline__ unsigned xb_ld(unsigned* p)              { return __hip_atomic_load(p, __ATOMIC_RELAXED, __HIP_MEMORY_SCOPE_AGENT); }
__device__ __forceinline__ unsigned xb_add(unsigned* p, unsigned v) { return __hip_atomic_fetch_add(p, v, __ATOMIC_RELAXED, __HIP_MEMORY_SCOPE_AGENT); }
__device__ __forceinline__ unsigned xb_xcc_id() { return (unsigned)__builtin_amdgcn_s_getreg((3 << 11) | 20) & 0xFu; }
#define XB_SPIN(cond, bar) do { unsigned _sp = 0; while (cond) { __builtin_amdgcn_s_sleep(1); \
    if ((++_sp & 255u) == 0u) { if (xb_ld(&(bar)[XB_TMO])) break; if (_sp > XB_SPIN_CAP) { atomicAdd(&(bar)[XB_TMO], 1u); break; } } } } while (0)
struct XcdBarrier { unsigned* bar; unsigned x; volatile LAS unsigned* st; };
#define XB_TID0() (hw_tid((LAS unsigned char*)b.st - LDS_MISC) == 0)
__device__ __forceinline__ XcdBarrier xcd_barrier_post(unsigned* bar, volatile LAS unsigned* st) {
    XcdBarrier b; b.bar = bar; b.x = xb_xcc_id(); b.st = st;
    if (XB_TID0()) (void)xb_add(&bar[XB_XCNT(b.x)], 1u);
    return b;
}
__device__ __forceinline__ void xcd_barrier_complete(unsigned* bar, unsigned x, unsigned& nloc, unsigned& nx) {
    const unsigned G = gridDim.x * gridDim.y * gridDim.z;
    unsigned sum, cnt, mine, sp = 0u;
    for (;;) {
        sum = 0u; cnt = 0u; mine = 0u;
#pragma unroll
        for (unsigned j = 0; j < 16; ++j) { const unsigned c = xb_ld(&bar[XB_XCNT(j)]); sum += c; cnt += (c > 0u) ? 1u : 0u; mine = (j == x) ? c : mine; }
        if (sum == G) break;
        __builtin_amdgcn_s_sleep(1);
        if ((++sp & 255u) == 0u) { if (xb_ld(&bar[XB_TMO])) break; if (sp > XB_SPIN_CAP) { atomicAdd(&bar[XB_TMO], 1u); break; } }
    }
    nloc = mine > 0u ? mine : 1u; nx = cnt > 0u ? cnt : 1u;
}
__device__ __forceinline__ void xcd_barrier(const XcdBarrier& b) {
    asm volatile("s_waitcnt vmcnt(0)" ::: "memory");
    __syncthreads();
    if (XB_TID0()) {
        unsigned* bar = b.bar;
        __builtin_amdgcn_s_waitcnt(0);
        unsigned nloc = b.st[0], nx = b.st[1];
        if (nloc == 0u) { xcd_barrier_complete(bar, b.x, nloc, nx); b.st[0] = nloc; b.st[1] = nx; }
        const unsigned old = xb_add(&bar[XB_XSUB(b.x)], 1u);
        const unsigned gen = old / nloc;
        if (old + 1u == (gen + 1u) * nloc) {
            __builtin_amdgcn_fence(__ATOMIC_RELEASE, "agent");
            asm volatile("s_waitcnt vmcnt(0)" ::: "memory");
            const unsigned og = xb_add(&bar[XB_TOP], 1u);
            const unsigned tg = og / nx;
            if (og + 1u == (tg + 1u) * nx) xb_add(&bar[XB_TOPGEN], 1u);
            else XB_SPIN(xb_ld(&bar[XB_TOPGEN]) == tg, bar);
            __builtin_amdgcn_fence(__ATOMIC_ACQUIRE, "agent");
            xb_add(&bar[XB_XGEN(b.x)], 1u);
            asm volatile("s_waitcnt vmcnt(0)" ::: "memory");
        } else {
            XB_SPIN(xb_ld(&bar[XB_XGEN(b.x)]) == gen, bar);
            __builtin_amdgcn_fence(__ATOMIC_ACQUIRE, "agent");
            asm volatile("s_waitcnt vmcnt(0)" ::: "memory");
        }
    }
    __syncthreads();
}

constexpr int LDS_PTAB = LDS_MISC + 64;
__device__ __forceinline__ P load_params(LAS unsigned char* ldsb) {
    unsigned off = LDS_PTAB; asm volatile("" : "+s"(off) :: "memory");
    LAS const unsigned long long* t = (LAS const unsigned long long*)(ldsb + off);
    union { P p; const void* v[NPTR]; } u;
#pragma unroll
    for (int i = 0; i < NPTR; ++i) { const unsigned long long x = t[i]; const unsigned lo = __builtin_amdgcn_readfirstlane((unsigned)x), hi = __builtin_amdgcn_readfirstlane((unsigned)(x >> 32));
        u.v[i] = (const void*)(__attribute__((address_space(1))) const void*)(((unsigned long long)hi << 32) | lo); }
    return u.p;
}
#define PH(F, n) do { const unsigned _t = (unsigned)hw_tid((LAS unsigned char*)lds); const long _G = (long)gridDim.x; const P _q = load_params((LAS unsigned char*)lds); \
        for (long _i = ((long)blockIdx.x + _G * (_t >> 6)) * 64 + (_t & 63); _i < (long)(n); _i += _G * NTHREADS) F(_q, L, _i); } while (0)
#define PH_MID(F, n, ROT) do { const unsigned _t = (unsigned)hw_tid((LAS unsigned char*)lds); const long _G = (long)gridDim.x, _b0 = _G / 8, _nb = _G - _b0 - _G / 4, _lb = (long)blockIdx.x - _b0; \
        const P _q = load_params((LAS unsigned char*)lds); \
        if (_lb >= 0 && _lb < _nb) for (long _i = (_lb + _nb * (long)(((_t >> 6) + (ROT)) & 7u)) * 64 + (_t & 63); _i < (long)(n); _i += _nb * NTHREADS) F(_q, L, _i); } while (0)
#define BLK(F) do { __syncthreads(); const P _q = load_params((LAS unsigned char*)lds); F(_q, L, (ldsp_t)lds); } while (0)
#define GRID_BAR() xcd_barrier(bar)
#define XIN_NEEDED(L) ((L) == 0)
#define GEMM_IN() do { const P p = load_params((LAS unsigned char*)lds); pg8::Gemm g{xbp(p), wintp(p, L), NP, D_INP, D}; pg8::StaticOrder S; S.init(NP, D_INP, (int)gridDim.x, (int)blockIdx.x); \
        pg8::EpiInBf16 E{ubase(p), p.ws + W_RSTD, L == 0 ? (const float*)nullptr : p.ws + W_XN}; pg8::gemm_phase<pg8::EpiInBf16, pg8::StaticOrder, true, true>((LAS unsigned char*)lds, g, S, E); } while (0)
#define GEMM_OUT() do { const P p = load_params((LAS unsigned char*)lds); pg8::Gemm g{mixb(p), wouttp(p, L), NP, D, D}; pg8::StaticOrder S; S.init(NP, D, (int)gridDim.x, (int)blockIdx.x); \
        pg8::EpiOutF32 E{L == DEPTH - 1 ? p.out + O_Y : p.ws + W_Y0, L == 0 ? p.x_prompt : p.ws + W_Y0, L == 0 ? p.x_sample : p.ws + W_Y0 + (size_t)NP * D, L + 1 < DEPTH ? xbp(p) : (bf16_t*)nullptr, p.ws + W_XN}; \
        pg8::gemm_phase<pg8::EpiOutF32, pg8::StaticOrder, true, true>((LAS unsigned char*)lds, g, S, E); } while (0)
__global__ void __launch_bounds__(NTHREADS, 2) mega(P parg, unsigned* barw) {
    extern __shared__ __attribute__((aligned(16))) unsigned char lds[];
    if (threadIdx.x < 16) ((LAS unsigned*)((LAS unsigned char*)lds + LDS_MISC))[threadIdx.x] = 0u;
    if ((threadIdx.x & 63) == 0) { const unsigned hw = (unsigned)__builtin_amdgcn_s_getreg((5 << 11) | 4) & 63u; *(LAS int*)((LAS unsigned char*)lds + LDS_WTAB + hw * 4) = (int)(threadIdx.x >> 6); }
    if (threadIdx.x == 64) { union { P p; unsigned long long v[NPTR]; } u; u.p = parg;
#pragma unroll
        for (int i = 0; i < NPTR; ++i) ((LAS unsigned long long*)((LAS unsigned char*)lds + LDS_PTAB))[i] = u.v[i]; }
    __syncthreads();
    XcdBarrier bar = xcd_barrier_post(barw, (volatile LAS unsigned*)((LAS unsigned char*)lds + LDS_MISC));
#endif
    { const int L = 0; BLK(bphase_prep_win); BLK(bphase_prep_wout); PH(k_prep_wc, (long)DEPTH * 32768); PH(k_cmp_pad, (long)NSEQ * NCPAD * 2); BLK(bphase_cmp_bias); }
    static_assert(DEPTH == 2, "layer program is instantiated per layer");
    LAYER_PROGRAM(0)
    LAYER_PROGRAM(1)
}

#ifndef CPU_EMU
extern "C" void kernel_launch(void* const* d_in, const int* in_sizes, int n_in, void* d_out, int out_size, void* d_ws, size_t ws_size, hipStream_t stream) {
    P p = make_params(d_in, d_out, d_ws);
    static int grid = 0;
    if (!grid) {
        int dev = 0, cus = 0, per_cu = 0;
        hipGetDevice(&dev);
        hipDeviceGetAttribute(&cus, hipDeviceAttributeMultiprocessorCount, dev);
        (void)hipFuncSetAttribute((const void*)mega, hipFuncAttributeMaxDynamicSharedMemorySize, LDS_BYTES);
        (void)hipOccupancyMaxActiveBlocksPerMultiprocessor(&per_cu, (const void*)mega, NTHREADS, LDS_BYTES);
        (void)hipGetLastError(); grid = cus;
    }
    unsigned* barw = (unsigned*)((char*)d_ws + WB_BAR);
    hipMemsetAsync(barw, 0, 16384, stream);
    hipLaunchKernelGGL(mega, dim3(grid), dim3(NTHREADS), LDS_BYTES, stream, p, barw);
}
#endif
```
